# Optimizing an MI355X kernel written in HIP

```python
import jax, jax.numpy as jnp
from jax import lax
import numpy as np

D_MODEL = 1024
BATCH = 2
SEQ = 16384
DEPTH = 2
DEC_BATCH = 32
DEC_SEQ = 64
PAST_LEN = 1024

CHUNK = 64
N_MEM = 256
EPS = 1e-6
MLA_HEADS = 8
Q_RANK = 256
KV_RANK = 128
NOPE_DIM = 64
ROPE_DIM = 32
QK_DIM = NOPE_DIM + ROPE_DIM
V_DIM = 64
ROPE_THETA = 10000.0
MLA_SCALE = QK_DIM ** -0.5
Q_BLOCK = 128
ML_HEADS = 4
ML_DH = 128
ML_WIDTH = ML_HEADS * ML_DH
CONV_W = 4
XA_HEADS = 4
XA_DH = D_MODEL // XA_HEADS
XA_SCALE = XA_DH ** -0.5
D_FF = 4 * D_MODEL
OFF_QA = 0
OFF_KVA = OFF_QA + Q_RANK
OFF_KR = OFF_KVA + KV_RANK
OFF_MQK = OFF_KR + ROPE_DIM
OFF_MV = OFF_MQK + 2 * ML_WIDTH
OFF_MI = OFF_MV + ML_WIDTH
OFF_MF = OFF_MI + ML_HEADS
OFF_MO = OFF_MF + ML_HEADS
IN_COLS = OFF_MO + ML_WIDTH

kernel_name = 'hybrid_mla_mlstm_stream_step'

f32 = jnp.float32


def rmsnorm(x, g):
    x32 = x.astype(f32)
    y = x32 * lax.rsqrt(jnp.mean(x32 * x32, axis=-1, keepdims=True) + EPS)
    return (y * g.astype(f32)).astype(x.dtype)


def apply_rope(x, pos):
    half = ROPE_DIM // 2
    inv_freq = ROPE_THETA ** (-jnp.arange(half, dtype=f32) / half)
    ang = pos.astype(f32)[:, None] * inv_freq[None, :]
    ang = ang.reshape(ang.shape[:1] + (1,) * (x.ndim - 3) + (half,))
    cos, sin = jnp.cos(ang), jnp.sin(ang)
    x32 = x.astype(f32)
    x1, x2 = x32[..., :half], x32[..., half:]
    return jnp.concatenate([x1 * cos - x2 * sin, x1 * sin + x2 * cos], axis=-1).astype(x.dtype)


def causal_conv(x, buf, w, b):
    S = x.shape[1]
    xp = jnp.concatenate([buf.astype(x.dtype), x], axis=1)
    y = b + sum(xp[:, j:j + S] * w[j] for j in range(CONV_W))
    return jax.nn.silu(y), xp[:, S:]


def softmax_attend(q, k, v, mask, scale):
    s = jnp.einsum('bqhd,bkhd->bhqk', q.astype(f32), k.astype(f32)) * scale
    if mask is not None:
        s = jnp.where(mask, s, -jnp.inf)
    p = jax.nn.softmax(s, axis=-1)
    return jnp.einsum('bhqk,bkhd->bqhd', p, v.astype(f32)).astype(v.dtype)


def split_projections(p, pos, conv_buf, P):
    B, S, _ = p.shape
    q_lat = rmsnorm(p[..., OFF_QA:OFF_KVA], P['g_qa'])
    q = (q_lat @ P['w_q_up']).reshape(B, S, MLA_HEADS, QK_DIM)
    q = jnp.concatenate([q[..., :NOPE_DIM], apply_rope(q[..., NOPE_DIM:], pos)], axis=-1)
    q = rmsnorm(q, P['g_qnorm'])
    c_kv = rmsnorm(p[..., OFF_KVA:OFF_KR], P['g_kva'])
    k_rope = apply_rope(p[..., OFF_KR:OFF_MQK], pos)
    qk, new_buf = causal_conv(p[..., OFF_MQK:OFF_MV], conv_buf, P['w_conv'], P['b_conv'])
    mq = qk[..., :ML_WIDTH].reshape(B, S, ML_HEADS, ML_DH)
    mk = qk[..., ML_WIDTH:].reshape(B, S, ML_HEADS, ML_DH) * (ML_DH ** -0.5)
    mv = p[..., OFF_MV:OFF_MI].reshape(B, S, ML_HEADS, ML_DH)
    ig = (p[..., OFF_MI:OFF_MF] + P['b_igate']).astype(f32)
    logf = jax.nn.log_sigmoid((p[..., OFF_MF:OFF_MO] + P['b_fgate']).astype(f32))
    og = jax.nn.sigmoid(p[..., OFF_MO:IN_COLS])
    return q, c_kv, k_rope, mq, mk, mv, ig, logf, og, new_buf


def mla_kv(c_kv, k_rope, P):
    B, T, _ = c_kv.shape
    kv = (c_kv @ P['w_kv_up']).reshape(B, T, MLA_HEADS, NOPE_DIM + V_DIM)
    k_r = jnp.broadcast_to(k_rope[:, :, None, :], (B, T, MLA_HEADS, ROPE_DIM))
    k = rmsnorm(jnp.concatenate([kv[..., :NOPE_DIM], k_r], axis=-1), P['g_knorm'])
    return k, kv[..., NOPE_DIM:]


def mla_prompt(q, k, v):
    B, S = q.shape[:2]
    nb = S // Q_BLOCK
    qb = jnp.moveaxis(q.reshape(B, nb, Q_BLOCK, MLA_HEADS, QK_DIM), 1, 0)
    k_chunk = jnp.arange(S) // CHUNK

    def block(args):
        qi, bi = args
        q_chunk = (bi * Q_BLOCK + jnp.arange(Q_BLOCK)) // CHUNK
        mask = k_chunk[None, :] <= q_chunk[:, None]
        return softmax_attend(qi, k, v, mask, MLA_SCALE)

    o = lax.map(block, (qb, jnp.arange(nb)))
    return jnp.moveaxis(o, 0, 1).reshape(B, S, MLA_HEADS * V_DIM)


def mlstm_chunk(state, q, k, v, ig, logf):
    C, n, m = state
    q, k, v = (jnp.swapaxes(a, 1, 2) for a in (q, k, v))
    ig, logf = jnp.swapaxes(ig, 1, 2), jnp.swapaxes(logf, 1, 2)
    L = q.shape[2]
    b = jnp.cumsum(logf, axis=-1)
    causal = jnp.tril(jnp.ones((L, L), dtype=bool))
    d = jnp.where(causal, b[..., :, None] - b[..., None, :] + ig[..., None, :], -jnp.inf)
    inter = b + m[..., None]
    m_t = jnp.maximum(inter, jnp.max(d, axis=-1))
    w = jnp.exp(d - m_t[..., None])
    a_inter = jnp.exp(inter - m_t)
    sqk = jnp.einsum('bhtd,bhsd->bhts', q, k) * w
    num = a_inter[..., None] * jnp.einsum('bhtd,bhde->bhte', q, C) + jnp.einsum('bhts,bhse->bhte', sqk, v)
    qn = a_inter * jnp.einsum('bhtd,bhd->bht', q, n) + jnp.sum(sqk, axis=-1)
    h = num / jnp.maximum(jnp.abs(qn), jnp.exp(-m_t))[..., None]
    b_last = b[..., -1]
    m_end = m_t[..., -1]
    decay = jnp.exp(b_last + m - m_end)
    wk = jnp.exp(b_last[..., None] - b + ig - m_end[..., None])
    C_new = decay[..., None, None] * C + jnp.einsum('bhs,bhsd,bhse->bhde', wk, k, v)
    n_new = decay[..., None] * n + jnp.einsum('bhs,bhsd->bhd', wk, k)
    return jnp.swapaxes(h, 1, 2), (C_new, n_new, m_end)


def mlstm_prompt(mq, mk, mv, ig, logf):
    B, S = mq.shape[:2]
    nc = S // CHUNK

    def to_chunks(a):
        return jnp.moveaxis(a.astype(f32).reshape((B, nc, CHUNK) + a.shape[2:]), 1, 0)

    init = (jnp.zeros((B, ML_HEADS, ML_DH, ML_DH), f32),
            jnp.zeros((B, ML_HEADS, ML_DH), f32),
            jnp.zeros((B, ML_HEADS), f32))

    def step(carry, xs):
        h, carry = mlstm_chunk(carry, *xs)
        return carry, h

    st, h = lax.scan(step, init, tuple(to_chunks(a) for a in (mq, mk, mv, ig, logf)))
    return jnp.moveaxis(h, 0, 1).reshape(B, S, ML_HEADS, ML_DH), st


def mem_kv(mem, P):
    B = mem.shape[0]
    hm = rmsnorm(mem, P['g_mem'])
    k = rmsnorm((hm @ P['w_xk']).reshape(B, N_MEM, XA_HEADS, XA_DH), P['g_xk'])
    v = (hm @ P['w_xv']).reshape(B, N_MEM, XA_HEADS, XA_DH)
    return k, v


def run_layer(x, pos, conv_buf, mlstm_state, past_ckv, past_krope, mem_k, mem_v, P, prompt):
    B, S, _ = x.shape
    p = rmsnorm(x, P['g_mix']) @ P['w_in']
    q, c_kv, k_rope, mq, mk, mv, ig, logf, og, new_buf = split_projections(p, pos, conv_buf, P)
    if prompt:
        k, v = mla_kv(c_kv, k_rope, P)
        a = mla_prompt(q, k, v)
        hm, st = mlstm_prompt(mq, mk, mv, ig, logf)
    else:
        k, v = mla_kv(jnp.concatenate([past_ckv.astype(c_kv.dtype), c_kv], axis=1),
                      jnp.concatenate([past_krope.astype(k_rope.dtype), k_rope], axis=1), P)
        a = softmax_attend(q, k, v, None, MLA_SCALE).reshape(B, S, MLA_HEADS * V_DIM)
        hm, st = mlstm_chunk(tuple(s.astype(f32) for s in mlstm_state),
                             mq.astype(f32), mk.astype(f32), mv.astype(f32), ig, logf)
    hm = rmsnorm(hm.astype(x.dtype), P['g_mhead']).reshape(B, S, ML_WIDTH) * og
    x = x + jnp.concatenate([a, hm], axis=-1) @ P['w_out']
    hx = rmsnorm(x, P['g_xattn'])
    qx = rmsnorm((hx @ P['w_xq']).reshape(B, S, XA_HEADS, XA_DH), P['g_xq'])
    ox = softmax_attend(qx, mem_k, mem_v, None, XA_SCALE).reshape(B, S, D_MODEL)
    x = x + ox @ P['w_xo']
    hf = rmsnorm(x, P['g_mlp'])
    x = x + jnp.square(jax.nn.relu(hf @ P['w_ff1'])) @ P['w_ff2']
    C, n, m = st
    return x, (c_kv, k_rope, C, n, m, new_buf)


def setup_inputs(seed: int = 0) -> dict:
    key = jax.random.key(seed)
    ks = iter(jax.random.split(key, 64))
    L = DEPTH

    def nrm(shape, scale=1.0):
        return jax.random.normal(next(ks), shape, f32) * scale

    def gain(shape):
        return 1.0 + nrm(shape, 0.01)

    return {
        'x_prompt': nrm((BATCH, SEQ, D_MODEL)),
        'x_sample': nrm((DEC_BATCH, DEC_SEQ, D_MODEL)),
        'cache_mla_ckv': nrm((L, DEC_BATCH, PAST_LEN, KV_RANK)),
        'cache_mla_krope': nrm((L, DEC_BATCH, PAST_LEN, ROPE_DIM)),
        'state_mlstm_C': nrm((L, DEC_BATCH, ML_HEADS, ML_DH, ML_DH), 0.05),
        'state_mlstm_n': nrm((L, DEC_BATCH, ML_HEADS, ML_DH), 0.5),
        'state_mlstm_m': nrm((L, DEC_BATCH, ML_HEADS), 0.5),
        'state_mlstm_conv': nrm((L, DEC_BATCH, CONV_W - 1, 2 * ML_WIDTH)),
        'cache_mem_k': nrm((L, DEC_BATCH, N_MEM, XA_HEADS, XA_DH)),
        'cache_mem_v': nrm((L, DEC_BATCH, N_MEM, XA_HEADS, XA_DH)),
        'mem_prompt': nrm((BATCH, N_MEM, D_MODEL)),
        'g_mix': gain((L, D_MODEL)),
        'w_in': nrm((L, D_MODEL, IN_COLS), D_MODEL ** -0.5),
        'g_qa': gain((L, Q_RANK)),
        'w_q_up': nrm((L, Q_RANK, MLA_HEADS * QK_DIM), Q_RANK ** -0.5),
        'g_qnorm': gain((L, QK_DIM)),
        'g_kva': gain((L, KV_RANK)),
        'w_kv_up': nrm((L, KV_RANK, MLA_HEADS * (NOPE_DIM + V_DIM)), KV_RANK ** -0.5),
        'g_knorm': gain((L, QK_DIM)),
        'w_conv': nrm((L, CONV_W, 2 * ML_WIDTH), 0.5),
        'b_conv': nrm((L, 2 * ML_WIDTH), 0.02),
        'b_igate': nrm((L, ML_HEADS), 0.1),
        'b_fgate': jnp.linspace(3.0, 6.0, ML_HEADS, dtype=f32)[None, :] + nrm((L, ML_HEADS), 0.01),
        'g_mhead': gain((L, ML_HEADS, ML_DH)),
        'w_out': nrm((L, D_MODEL, D_MODEL), D_MODEL ** -0.5),
        'g_xattn': gain((L, D_MODEL)),
        'g_mem': gain((L, D_MODEL)),
        'w_xq': nrm((L, D_MODEL, D_MODEL), D_MODEL ** -0.5),
        'w_xk': nrm((L, D_MODEL, D_MODEL), D_MODEL ** -0.5),
        'w_xv': nrm((L, D_MODEL, D_MODEL), D_MODEL ** -0.5),
        'g_xq': gain((L, XA_DH)),
        'g_xk': gain((L, XA_DH)),
        'w_xo': nrm((L, D_MODEL, D_MODEL), D_MODEL ** -0.5),
        'g_mlp': gain((L, D_MODEL)),
        'w_ff1': nrm((L, D_MODEL, D_FF), D_MODEL ** -0.5),
        'w_ff2': nrm((L, D_FF, D_MODEL), D_FF ** -0.5),
    }


def reference(x_prompt, x_sample, cache_mla_ckv, cache_mla_krope, state_mlstm_C, state_mlstm_n,
              state_mlstm_m, state_mlstm_conv, cache_mem_k, cache_mem_v, mem_prompt,
              g_mix, w_in, g_qa, w_q_up, g_qnorm, g_kva, w_kv_up, g_knorm, w_conv, b_conv,
              b_igate, b_fgate, g_mhead, w_out, g_xattn, g_mem, w_xq, w_xk, w_xv, g_xq, g_xk,
              w_xo, g_mlp, w_ff1, w_ff2):
    Bp, Sp, _ = x_prompt.shape
    past = cache_mla_ckv.shape[2]
    pos_p = jnp.arange(Sp)
    pos_s = past + jnp.arange(x_sample.shape[1])
    xp, xs = x_prompt, x_sample
    conv0 = jnp.zeros((Bp, CONV_W - 1, 2 * ML_WIDTH), x_prompt.dtype)
    p_out = [[] for _ in range(8)]
    s_out = [[] for _ in range(6)]
    for l in range(DEPTH):
        P = {'g_mix': g_mix[l], 'w_in': w_in[l], 'g_qa': g_qa[l], 'w_q_up': w_q_up[l],
             'g_qnorm': g_qnorm[l], 'g_kva': g_kva[l], 'w_kv_up': w_kv_up[l], 'g_knorm': g_knorm[l],
             'w_conv': w_conv[l], 'b_conv': b_conv[l], 'b_igate': b_igate[l], 'b_fgate': b_fgate[l],
             'g_mhead': g_mhead[l], 'w_out': w_out[l], 'g_xattn': g_xattn[l], 'g_mem': g_mem[l],
             'w_xq': w_xq[l], 'w_xk': w_xk[l], 'w_xv': w_xv[l], 'g_xq': g_xq[l], 'g_xk': g_xk[l],
             'w_xo': w_xo[l], 'g_mlp': g_mlp[l], 'w_ff1': w_ff1[l], 'w_ff2': w_ff2[l]}
        mk_p, mv_p = mem_kv(mem_prompt, P)
        xp, st_p = run_layer(xp, pos_p, conv0, None, None, None, mk_p, mv_p, P, True)
        for lst, a in zip(p_out, st_p + (mk_p, mv_p)):
            lst.append(a.astype(x_prompt.dtype))
        xs, st_s = run_layer(xs, pos_s, state_mlstm_conv[l],
                             (state_mlstm_C[l], state_mlstm_n[l], state_mlstm_m[l]),
                             cache_mla_ckv[l], cache_mla_krope[l], cache_mem_k[l], cache_mem_v[l], P, False)
        for lst, a in zip(s_out, st_s):
            lst.append(a.astype(x_sample.dtype))
    p_ckv, p_krope, p_C, p_n, p_m, p_conv, p_mem_k, p_mem_v = (jnp.stack(a) for a in p_out)
    s_ckv, s_krope, s_C, s_n, s_m, s_conv = (jnp.stack(a) for a in s_out)
    return (xp, xs, p_ckv, p_krope, p_C, p_n, p_m, p_conv, p_mem_k, p_mem_v,
            s_ckv, s_krope, s_C, s_n, s_m, s_conv)
```

```cpp
#include <hip/hip_runtime.h>
#include <hip/hip_cooperative_groups.h>
#include <stdint.h>
#include <stdio.h>
namespace cg = cooperative_groups;

typedef unsigned short u16;
typedef short bf16x8 __attribute__((ext_vector_type(8)));
typedef short s16x4 __attribute__((ext_vector_type(4)));
typedef float f32x16 __attribute__((ext_vector_type(16)));
typedef __bf16 bfv2 __attribute__((ext_vector_type(2)));
typedef float fv2 __attribute__((ext_vector_type(2)));
typedef unsigned u32x4 __attribute__((ext_vector_type(4)));
#define DI __device__ __forceinline__
#define MFMA(a, b, c) __builtin_amdgcn_mfma_f32_32x32x16_bf16((a), (b), (c), 0, 0, 0)

constexpr int NP = 32768;
constexpr int NS = 2048;
constexpr int NTOK = NP + NS;
constexpr int NROWS = NP + 32 * 1088;
constexpr int INC = 2472;
constexpr float EPS = 1e-6f;
constexpr float LOG2E = 1.4426950408889634f;
constexpr int NITEM = 2048 + 128;

constexpr size_t O_Y = 0;
constexpr size_t O_PCKV = 35651584;
constexpr size_t O_PKROPE = O_PCKV + 8388608;
constexpr size_t O_PC = O_PKROPE + 2097152;
constexpr size_t O_PN = O_PC + 262144;
constexpr size_t O_PM = O_PN + 2048;
constexpr size_t O_PCONV = O_PM + 16;
constexpr size_t O_PMEMK = O_PCONV + 12288;
constexpr size_t O_PMEMV = O_PMEMK + 1048576;
constexpr size_t O_SCKV = O_PMEMV + 1048576;
constexpr size_t O_SKROPE = O_SCKV + 524288;
constexpr size_t O_SC = O_SKROPE + 131072;
constexpr size_t O_SN = O_SC + 4194304;
constexpr size_t O_SM = O_SN + 32768;
constexpr size_t O_SCONV = O_SM + 256;

constexpr size_t W_IN = 0;
constexpr size_t W_Q = W_IN + 2560 * 1024;
constexpr size_t W_KV = W_Q + 768 * 256;
constexpr size_t W_OUT = W_KV + 1024 * 128;
constexpr size_t W_XQ = W_OUT + 1048576;
constexpr size_t W_XK = W_XQ + 1048576;
constexpr size_t W_XV = W_XK + 1048576;
constexpr size_t W_XO = W_XV + 1048576;
constexpr size_t W_FF1 = W_XO + 1048576;
constexpr size_t W_FF2 = W_FF1 + 4194304;
constexpr size_t W_LAYER = W_FF2 + 4194304;

constexpr size_t WS_W = 0;
constexpr size_t WS_ACT = WS_W + 2 * W_LAYER * 2;
constexpr size_t WS_CKV = WS_ACT + (size_t)NTOK * 1024 * 2;
constexpr size_t WS_KROPE = WS_CKV + (size_t)NROWS * 128 * 2;
constexpr size_t WS_RQ = WS_KROPE + (size_t)NROWS * 32 * 4;
constexpr size_t WS_GATES = WS_RQ + (size_t)NTOK * 4;
constexpr size_t WS_ROPE = WS_GATES + (size_t)NTOK * 8 * 4;
constexpr size_t WS_SCAL = WS_ROPE + (size_t)16384 * 16 * 8;
constexpr size_t WS_MST = WS_SCAL + (size_t)NITEM * 2 * 4;
constexpr size_t WS_NU = WS_MST + (size_t)NITEM * 4 + 256;
constexpr size_t WS_HM = WS_NU + (size_t)NITEM * 128 * 4;
constexpr size_t WS_BIG = WS_HM + (size_t)512 * 1024 * 2;
constexpr size_t B_P = 0;
constexpr size_t B_K = 0;
constexpr size_t B_VT = B_K + (size_t)8 * NROWS * 96 * 2;
constexpr size_t B_Q = B_VT + (size_t)8 * 64 * NROWS * 2;
constexpr size_t B_ST = B_Q + (size_t)NTOK * 768 * 2;
constexpr size_t B_XK = B_ST + (size_t)NITEM * 16384 * 2;
constexpr size_t B_XVT = B_XK + (size_t)34 * 4 * 256 * 256 * 2;
constexpr size_t B_END = B_XVT + (size_t)34 * 4 * 256 * 256 * 2;
constexpr size_t B_QX = 0;
constexpr size_t B_H1 = 0;
static_assert((size_t)NTOK * INC * 2 <= B_Q, "p overlaps q");
static_assert((size_t)NTOK * 4096 * 2 <= B_XK, "h1 overlaps xkv");
static_assert(WS_BIG + B_END <= (size_t)536870912, "workspace too large");
static_assert(WS_BIG % 256 == 0 && B_Q % 256 == 0 && B_ST % 256 == 0 && B_VT % 256 == 0, "align");

constexpr int SMEM_BYTES = 73728;

struct Params {
  const float* x_prompt; const float* x_sample; const float* cache_ckv; const float* cache_krope;
  const float* st_C; const float* st_n; const float* st_m; const float* st_conv;
  const float* cache_mem_k; const float* cache_mem_v; const float* mem_prompt;
  const float* g_mix; const float* w_in; const float* g_qa; const float* w_q_up; const float* g_qnorm; const float* g_kva;
  const float* w_kv_up; const float* g_knorm; const float* w_conv; const float* b_conv; const float* b_igate; const float* b_fgate;
  const float* g_mhead; const float* w_out; const float* g_xattn; const float* g_mem; const float* w_xq; const float* w_xk; const float* w_xv;
  const float* g_xq; const float* g_xk; const float* w_xo; const float* g_mlp; const float* w_ff1; const float* w_ff2;
  float* out; char* ws;
};

DI unsigned pk2(float a, float b) { fv2 v = {a, b}; bfv2 r = __builtin_convertvector(v, bfv2); return __builtin_bit_cast(unsigned, r); }
DI u16 f2bf(float a) { return (u16)(pk2(a, 0.f) & 0xffffu); }
DI float bf2f(u16 v) { return __uint_as_float(((unsigned)v) << 16); }
DI float bflo(unsigned v) { return __uint_as_float(v << 16); }
DI float bfhi(unsigned v) { return __uint_as_float(v & 0xffff0000u); }
DI int crow(int i, int h) { return (i & 3) + 8 * (i >> 2) + 4 * h; }
DI float wave_sum(float v) {
#pragma unroll
  for (int o = 32; o >= 1; o >>= 1) v += __shfl_xor(v, o);
  return v;
}
DI float wave_max(float v) {
#pragma unroll
  for (int o = 32; o >= 1; o >>= 1) v = fmaxf(v, __shfl_xor(v, o));
  return v;
}
DI void unpack8(uint4 v, float (&x)[8]) {
  x[0] = bflo(v.x); x[1] = bfhi(v.x); x[2] = bflo(v.y); x[3] = bfhi(v.y);
  x[4] = bflo(v.z); x[5] = bfhi(v.z); x[6] = bflo(v.w); x[7] = bfhi(v.w);
}
DI uint4 pack8(const float (&x)[8]) {
  uint4 v; v.x = pk2(x[0], x[1]); v.y = pk2(x[2], x[3]); v.z = pk2(x[4], x[5]); v.w = pk2(x[6], x[7]); return v;
}
DI u16* wsb(const Params& p, size_t off) { return (u16*)(p.ws + off); }
DI float* wsf(const Params& p, size_t off) { return (float*)(p.ws + off); }
DI const float* xrow(const Params& p, int l, int tok) {
  if (l == 0) return tok < NP ? p.x_prompt + (size_t)tok * 1024 : p.x_sample + (size_t)(tok - NP) * 1024;
  return p.out + (size_t)tok * 1024;
}
DI int tok_pos(int tok) { return tok < NP ? (tok & 16383) : 1024 + ((tok - NP) & 63); }

template <int TM, int TN>
DI void gemm_mainloop(const u16* __restrict__ A, long lda, const u16* __restrict__ Bt, long ldb, int K, char* smem,
                      f32x16 (&acc)[TM][TN]) {
  constexpr int BM = 64 * TM, BN = 64 * TN, LD = 72;
  u16* sA = (u16*)smem;
  u16* sB = sA + 2 * BM * LD;
  const int tid = threadIdx.x, lane = tid & 63, w = tid >> 6, r = lane & 31, h = lane >> 5;
  const int wm = w >> 1, wn = w & 1;
  constexpr int NA = BM / 32, NB = BN / 32;
  u32x4 ra[NA], rb[NB];
#pragma unroll
  for (int tm = 0; tm < TM; tm++)
#pragma unroll
    for (int tn = 0; tn < TN; tn++)
#pragma unroll
      for (int i = 0; i < 16; i++) acc[tm][tn][i] = 0.f;
  const int nk = K / 64;
#pragma unroll
  for (int i = 0; i < NA; i++) { int id = tid + 256 * i; int row = id >> 3, ch = id & 7; ra[i] = *(const u32x4*)(A + (long)row * lda + ch * 8); }
#pragma unroll
  for (int i = 0; i < NB; i++) { int id = tid + 256 * i; int row = id >> 3, ch = id & 7; rb[i] = *(const u32x4*)(Bt + (long)row * ldb + ch * 8); }
  __syncthreads();
#pragma unroll
  for (int i = 0; i < NA; i++) { int id = tid + 256 * i; int row = id >> 3, ch = id & 7; *(u32x4*)(sA + row * LD + ch * 8) = ra[i]; }
#pragma unroll
  for (int i = 0; i < NB; i++) { int id = tid + 256 * i; int row = id >> 3, ch = id & 7; *(u32x4*)(sB + row * LD + ch * 8) = rb[i]; }
  __syncthreads();
  for (int kt = 0; kt < nk; kt++) {
    const int buf = kt & 1;
    const bool more = (kt + 1 < nk);
    if (more) {
      const int k0 = (kt + 1) * 64;
#pragma unroll
      for (int i = 0; i < NA; i++) { int id = tid + 256 * i; int row = id >> 3, ch = id & 7; ra[i] = *(const u32x4*)(A + (long)row * lda + k0 + ch * 8); }
#pragma unroll
      for (int i = 0; i < NB; i++) { int id = tid + 256 * i; int row = id >> 3, ch = id & 7; rb[i] = *(const u32x4*)(Bt + (long)row * ldb + k0 + ch * 8); }
    }
    const u16* cA = sA + buf * BM * LD + (wm * 32 * TM + r) * LD + h * 8;
    const u16* cB = sB + buf * BN * LD + (wn * 32 * TN + r) * LD + h * 8;
#pragma unroll
    for (int ks = 0; ks < 4; ks++) {
      bf16x8 af[TM], bfr[TN];
#pragma unroll
      for (int tm = 0; tm < TM; tm++) af[tm] = *(const bf16x8*)(cA + tm * 32 * LD + ks * 16);
#pragma unroll
      for (int tn = 0; tn < TN; tn++) bfr[tn] = *(const bf16x8*)(cB + tn * 32 * LD + ks * 16);
#pragma unroll
      for (int tm = 0; tm < TM; tm++)
#pragma unroll
        for (int tn = 0; tn < TN; tn++) acc[tm][tn] = MFMA(af[tm], bfr[tn], acc[tm][tn]);
    }
    if (more) {
      u16* dA = sA + (buf ^ 1) * BM * LD;
      u16* dB = sB + (buf ^ 1) * BN * LD;
#pragma unroll
      for (int i = 0; i < NA; i++) { int id = tid + 256 * i; int row = id >> 3, ch = id & 7; *(u32x4*)(dA + row * LD + ch * 8) = ra[i]; }
#pragma unroll
      for (int i = 0; i < NB; i++) { int id = tid + 256 * i; int row = id >> 3, ch = id & 7; *(u32x4*)(dB + row * LD + ch * 8) = rb[i]; }
    }
    __syncthreads();
  }
}

template <int TM, int TN, class Epi>
DI void gemm_tile(const u16* A, long lda, const u16* Bt, long ldb, int K, int m0, int n0, char* smem, const Epi& epi) {
  constexpr int BM = 64 * TM, BN = 64 * TN, LDC = BN + 4;
  f32x16 acc[TM][TN];
  gemm_mainloop<TM, TN>(A + (long)m0 * lda, lda, Bt + (long)n0 * ldb, ldb, K, smem, acc);
  const int tid = threadIdx.x, lane = tid & 63, w = tid >> 6, r = lane & 31, h = lane >> 5;
  const int wm = w >> 1, wn = w & 1;
  float* Ct = (float*)smem;
#pragma unroll
  for (int tm = 0; tm < TM; tm++)
#pragma unroll
    for (int tn = 0; tn < TN; tn++)
#pragma unroll
      for (int i = 0; i < 16; i++)
        Ct[(wm * 32 * TM + tm * 32 + crow(i, h)) * LDC + wn * 32 * TN + tn * 32 + r] = acc[tm][tn][i];
  __syncthreads();
  epi(Ct, LDC, m0, n0, tid);
  __syncthreads();
  (void)BM;
}

struct EpiStoreBf16 {
  u16* out; long ldo; int nmax; float* gates;
  DI void operator()(const float* Ct, int ldc, int m0, int n0, int tid) const {
#pragma unroll
    for (int it = 0; it < 8; it++) {
      int id = tid + 256 * it; int row = id >> 4, c8 = (id & 15) * 8;
      int n = n0 + c8;
      if (n < nmax) {
        const float* c = Ct + row * ldc + c8;
        float4 a = *(const float4*)c, b = *(const float4*)(c + 4);
        uint4 v; v.x = pk2(a.x, a.y); v.y = pk2(a.z, a.w); v.z = pk2(b.x, b.y); v.w = pk2(b.z, b.w);
        *(uint4*)(out + (long)(m0 + row) * ldo + n) = v;
        if (gates != nullptr && n == 1952) {
          float* g = gates + (long)(m0 + row) * 8;
          *(float4*)g = a; *(float4*)(g + 4) = b;
        }
      }
    }
  }
};
struct EpiRelu2 {
  u16* out; long ldo;
  DI void operator()(const float* Ct, int ldc, int m0, int n0, int tid) const {
#pragma unroll
    for (int it = 0; it < 8; it++) {
      int id = tid + 256 * it; int row = id >> 4, c8 = (id & 15) * 8;
      const float* c = Ct + row * ldc + c8;
      float x[8];
#pragma unroll
      for (int j = 0; j < 8; j++) { float v = fmaxf(c[j], 0.f); x[j] = v * v; }
      *(uint4*)(out + (long)(m0 + row) * ldo + n0 + c8) = pack8(x);
    }
  }
};
struct EpiF32 {
  float* out; long ldo;
  DI void operator()(const float* Ct, int ldc, int m0, int n0, int tid) const {
#pragma unroll
    for (int it = 0; it < 8; it++) {
      int id = tid + 256 * it; int row = id >> 4, c8 = (id & 15) * 8;
      const float* c = Ct + row * ldc + c8;
      float* o = out + (long)(m0 + row) * ldo + n0 + c8;
      *(float4*)o = *(const float4*)c; *(float4*)(o + 4) = *(const float4*)(c + 4);
    }
  }
};
struct EpiRes {
  const float* src0; const float* src1; float* dst;
  DI void operator()(const float* Ct, int ldc, int m0, int n0, int tid) const {
#pragma unroll
    for (int it = 0; it < 8; it++) {
      int id = tid + 256 * it; int row = id >> 4, c8 = (id & 15) * 8;
      int m = m0 + row;
      const float* s = (m < NP ? src0 + (size_t)m * 1024 : src1 + (size_t)(m - NP) * 1024) + n0 + c8;
      const float* c = Ct + row * ldc + c8;
      float4 a = *(const float4*)c, b = *(const float4*)(c + 4);
      float4 sa = *(const float4*)s, sb = *(const float4*)(s + 4);
      a.x += sa.x; a.y += sa.y; a.z += sa.z; a.w += sa.w; b.x += sb.x; b.y += sb.y; b.z += sb.z; b.w += sb.w;
      float* o = dst + (size_t)m * 1024 + n0 + c8;
      *(float4*)o = a; *(float4*)(o + 4) = b;
    }
  }
};
struct EpiQ {
  u16* q; const float* rq; const float2* rope; const float* g;
  DI void operator()(const float* Ct, int ldc, int m0, int n0, int tid) const {
    if (tid < 128) {
      int row = tid >> 1, hh = tid & 1; int m = m0 + row;
      const float* c = Ct + row * ldc + hh * 96;
      float rqv = rq[m];
      float ss = 0.f;
#pragma unroll 8
      for (int d = 0; d < 96; d++) ss += c[d] * c[d];
      ss *= rqv * rqv;
      float r2 = rsqrtf(ss * (1.f / 96.f) + EPS) * rqv * (0.10206207261596575f * LOG2E);
      u16* o = q + (size_t)m * 768 + n0 + hh * 96;
#pragma unroll
      for (int c8 = 0; c8 < 8; c8++) {
        float x[8];
#pragma unroll
        for (int j = 0; j < 8; j++) x[j] = c[c8 * 8 + j] * r2 * g[c8 * 8 + j];
        *(uint4*)(o + c8 * 8) = pack8(x);
      }
      const float2* tab = rope + (size_t)tok_pos(m) * 16;
#pragma unroll
      for (int half = 0; half < 2; half++) {
        float x1[8], x2[8];
#pragma unroll
        for (int j = 0; j < 8; j++) {
          int i = half * 8 + j;
          float a = c[64 + i], b = c[80 + i]; float2 cs = tab[i];
          x1[j] = (a * cs.x - b * cs.y) * r2 * g[64 + i];
          x2[j] = (a * cs.y + b * cs.x) * r2 * g[80 + i];
        }
        *(uint4*)(o + 64 + half * 8) = pack8(x1);
        *(uint4*)(o + 80 + half * 8) = pack8(x2);
      }
    }
  }
};
struct EpiKV {
  u16* Kb; u16* Vt; const float* krope; const float* g;
  DI void operator()(const float* Ct, int ldc, int m0, int n0, int tid) const {
    const int hd = n0 >> 7;
#pragma unroll
    for (int it = 0; it < 4; it++) {
      int id = tid + 256 * it; int e = id & 63, oct = id >> 6;
      float x[8];
#pragma unroll
      for (int j = 0; j < 8; j++) x[j] = Ct[(oct * 8 + j) * ldc + 64 + e];
      *(uint4*)(Vt + (size_t)(hd * 64 + e) * NROWS + m0 + oct * 8) = pack8(x);
    }
    if (tid < 128) {
      int row = tid;
      const float* c = Ct + row * ldc;
      const float* kr = krope + (size_t)(m0 + row) * 32;
      float ss = 0.f;
#pragma unroll 8
      for (int d = 0; d < 64; d++) ss += c[d] * c[d];
#pragma unroll 8
      for (int d = 0; d < 32; d++) ss += kr[d] * kr[d];
      float rr = rsqrtf(ss * (1.f / 96.f) + EPS);
      u16* o = Kb + ((size_t)hd * NROWS + m0 + row) * 96;
#pragma unroll
      for (int c8 = 0; c8 < 8; c8++) {
        float x[8];
#pragma unroll
        for (int j = 0; j < 8; j++) x[j] = c[c8 * 8 + j] * rr * g[c8 * 8 + j];
        *(uint4*)(o + c8 * 8) = pack8(x);
      }
#pragma unroll
      for (int c8 = 0; c8 < 4; c8++) {
        float x[8];
#pragma unroll
        for (int j = 0; j < 8; j++) x[j] = kr[c8 * 8 + j] * rr * g[64 + c8 * 8 + j];
        *(uint4*)(o + 64 + c8 * 8) = pack8(x);
      }
    }
  }
};

template <int DQK, int NE, int EV, bool DB, bool QNORM, bool QREG>
DI void flash_item(const u16* Qrow, bool wave_active, int ntb, int ntw, const u16* Kbase, long ldk, const u16* Vtbase, long ldv,
                   int e0, u16* Orow, char* smem) {
  constexpr int LDK = DQK + 8, LDV = 72;
  constexpr int KS = DQK / 16;
  constexpr int KTILE = 64 * LDK, VTILE = EV * LDV;
  constexpr int NKC = 64 * (DQK / 8) / 256;
  constexpr int NVC = EV * 8 / 256;
  u16* sK = (u16*)smem;
  u16* sV = sK + (DB ? 2 : 1) * KTILE;
  const int tid = threadIdx.x, lane = tid & 63, r = lane & 31, h = lane >> 5;
  bf16x8 qf[QREG ? KS : 1];
  float rqs = 1.f;
  if (wave_active) {
    if (QREG) {
#pragma unroll
      for (int ks = 0; ks < KS; ks++) qf[QREG ? ks : 0] = *(const bf16x8*)(Qrow + ks * 16 + h * 8);
    }
    if (QNORM) {
      float ss = 0.f;
#pragma unroll
      for (int ks = 0; ks < KS; ks++) {
        bf16x8 qq = QREG ? qf[QREG ? ks : 0] : *(const bf16x8*)(Qrow + ks * 16 + h * 8);
#pragma unroll
        for (int j = 0; j < 8; j++) { float v = bf2f((u16)qq[j]); ss += v * v; }
      }
      ss += __shfl_xor(ss, 32);
      rqs = rsqrtf(ss * (1.f / DQK) + EPS);
    }
  } else if (QREG) {
#pragma unroll
    for (int ks = 0; ks < KS; ks++)
#pragma unroll
      for (int j = 0; j < 8; j++) qf[QREG ? ks : 0][j] = 0;
  }
  f32x16 o[NE];
#pragma unroll
  for (int et = 0; et < NE; et++)
#pragma unroll
    for (int i = 0; i < 16; i++) o[et][i] = 0.f;
  float mrun = -1e30f, lrun = 0.f;

  u32x4 rk[DB ? NKC : 1], rv[DB ? NVC : 1];
  auto gload = [&](int t) {
#pragma unroll
    for (int i = 0; i < NKC; i++) {
      int id = tid + 256 * i; int row = id / (DQK / 8), ch = id % (DQK / 8);
      u32x4 v = *(const u32x4*)(Kbase + (long)(t * 64 + row) * ldk + ch * 8);
      if (DB) rk[DB ? i : 0] = v; else *(u32x4*)(sK + row * LDK + ch * 8) = v;
    }
#pragma unroll
    for (int i = 0; i < NVC; i++) {
      int id = tid + 256 * i; int row = id >> 3, ch = id & 7;
      u32x4 v = *(const u32x4*)(Vtbase + (long)row * ldv + t * 64 + ch * 8);
      if (DB) rv[DB ? i : 0] = v; else *(u32x4*)(sV + row * LDV + ch * 8) = v;
    }
  };
  auto sstore = [&](int buf) {
#pragma unroll
    for (int i = 0; i < NKC; i++) { int id = tid + 256 * i; int row = id / (DQK / 8), ch = id % (DQK / 8); *(u32x4*)(sK + buf * KTILE + row * LDK + ch * 8) = rk[DB ? i : 0]; }
#pragma unroll
    for (int i = 0; i < NVC; i++) { int id = tid + 256 * i; int row = id >> 3, ch = id & 7; *(u32x4*)(sV + buf * VTILE + row * LDV + ch * 8) = rv[DB ? i : 0]; }
  };
  auto compute = [&](int buf) {
    const u16* cK = sK + buf * KTILE + r * LDK + h * 8;
    const u16* cV = sV + buf * VTILE + (e0 + r) * LDV + 4 * h;
    f32x16 s[2];
#pragma unroll
    for (int sub = 0; sub < 2; sub++) {
#pragma unroll
      for (int i = 0; i < 16; i++) s[sub][i] = 0.f;
#pragma unroll
      for (int ks = 0; ks < KS; ks++) {
        bf16x8 a = *(const bf16x8*)(cK + sub * 32 * LDK + ks * 16);
        bf16x8 qq = QREG ? qf[QREG ? ks : 0] : *(const bf16x8*)(Qrow + ks * 16 + h * 8);
        s[sub] = MFMA(a, qq, s[sub]);
      }
    }
    float mx = -1e30f;
#pragma unroll
    for (int sub = 0; sub < 2; sub++)
#pragma unroll
      for (int i = 0; i < 16; i++) { if (QNORM) s[sub][i] *= rqs; mx = fmaxf(mx, s[sub][i]); }
    mx = fmaxf(mx, __shfl_xor(mx, 32));
    const float mnew = fmaxf(mrun, mx);
    const float alpha = exp2f(mrun - mnew);
    mrun = mnew;
    float psum = 0.f;
#pragma unroll
    for (int sub = 0; sub < 2; sub++)
#pragma unroll
      for (int i = 0; i < 16; i++) { float pv = exp2f(s[sub][i] - mnew); s[sub][i] = pv; psum += pv; }
    lrun = lrun * alpha + psum;
#pragma unroll
    for (int et = 0; et < NE; et++)
#pragma unroll
      for (int i = 0; i < 16; i++) o[et][i] *= alpha;
#pragma unroll
    for (int sub = 0; sub < 2; sub++)
#pragma unroll
      for (int st = 0; st < 2; st++) {
        uint4 pp;
        pp.x = pk2(s[sub][8 * st + 0], s[sub][8 * st + 1]); pp.y = pk2(s[sub][8 * st + 2], s[sub][8 * st + 3]);
        pp.z = pk2(s[sub][8 * st + 4], s[sub][8 * st + 5]); pp.w = pk2(s[sub][8 * st + 6], s[sub][8 * st + 7]);
        bf16x8 pb = __builtin_bit_cast(bf16x8, pp);
#pragma unroll
        for (int et = 0; et < NE; et++) {
          const u16* vp = cV + et * 32 * LDV + sub * 32 + st * 16;
          s16x4 lo = *(const s16x4*)vp;
          s16x4 hi = *(const s16x4*)(vp + 8);
          bf16x8 a = __builtin_shufflevector(lo, hi, 0, 1, 2, 3, 4, 5, 6, 7);
          o[et] = MFMA(a, pb, o[et]);
        }
      }
  };

  __syncthreads();
  if (DB) {
    gload(0);
    sstore(0);
    __syncthreads();
    for (int t = 0; t < ntb; t++) {
      const bool more = (t + 1 < ntb);
      if (more) gload(t + 1);
      if (wave_active && t < ntw) compute(t & 1);
      if (more) sstore((t + 1) & 1);
      __syncthreads();
    }
  } else {
    for (int t = 0; t < ntb; t++) {
      if (t > 0) __syncthreads();
      gload(t);
      __syncthreads();
      if (wave_active && t < ntw) compute(0);
    }
    __syncthreads();
  }
  if (wave_active) {
    float lt = lrun + __shfl_xor(lrun, 32);
    float inv = 1.f / lt;
#pragma unroll
    for (int et = 0; et < NE; et++)
#pragma unroll
      for (int g = 0; g < 4; g++) {
        uint2 v;
        v.x = pk2(o[et][4 * g + 0] * inv, o[et][4 * g + 1] * inv);
        v.y = pk2(o[et][4 * g + 2] * inv, o[et][4 * g + 3] * inv);
        *(uint2*)(Orow + et * 32 + 8 * g + 4 * h) = v;
      }
  }
}

DI void norm_row_wave(const float* src, u16* dst, int lane) {
  float4 v[4]; float ss = 0.f;
#pragma unroll
  for (int i = 0; i < 4; i++) { v[i] = *(const float4*)(src + i * 256 + lane * 4); ss += v[i].x * v[i].x + v[i].y * v[i].y + v[i].z * v[i].z + v[i].w * v[i].w; }
  ss = wave_sum(ss);
  float rr = rsqrtf(ss * (1.f / 1024.f) + EPS);
#pragma unroll
  for (int i = 0; i < 4; i++) {
    uint2 o; o.x = pk2(v[i].x * rr, v[i].y * rr); o.y = pk2(v[i].z * rr, v[i].w * rr);
    *(uint2*)(dst + i * 256 + lane * 4) = o;
  }
}

DI void phase_norm(const Params& p, int l) {
  const int lane = threadIdx.x & 63, w = threadIdx.x >> 6;
  u16* act = wsb(p, WS_ACT);
  for (int t = blockIdx.x * 4 + w; t < NTOK; t += gridDim.x * 4) norm_row_wave(xrow(p, l, t), act + (size_t)t * 1024, lane);
}

DI void wtile(const float* src, const float* gain, int K, int N, u16* dst, int k0, int n0, char* smem) {
  u16* T = (u16*)smem;
  const int tid = threadIdx.x;
  __syncthreads();
  {
    const int nn = tid & 63, kk0 = tid >> 6;
    const int n = n0 + nn;
#pragma unroll 4
    for (int i = 0; i < 16; i++) {
      int kk = kk0 + 4 * i;
      float v = 0.f;
      if (n < N) { v = src[(size_t)(k0 + kk) * N + n]; if (gain) v *= gain[k0 + kk]; }
      T[nn * 72 + kk] = f2bf(v);
    }
  }
  __syncthreads();
  {
    const int nn = tid >> 2, kq = tid & 3;
    const uint4* s = (const uint4*)(T + nn * 72 + kq * 16);
    uint4* d = (uint4*)(dst + (size_t)(n0 + nn) * K + k0 + kq * 16);
    d[0] = s[0]; d[1] = s[1];
  }
}

DI void phase_prep(const Params& p, char* smem) {
  const int tid = threadIdx.x, lane = tid & 63, w = tid >> 6;
  for (int t = blockIdx.x; t < 2 * 4048; t += gridDim.x) {
    int l = t / 4048, u = t % 4048;
    const float* src; const float* gain = nullptr; int K, N, Npad; size_t doff;
    if (u < 640) { src = p.w_in + (size_t)l * 1024 * INC; gain = p.g_mix + l * 1024; K = 1024; N = INC; Npad = 2560; doff = W_IN; }
    else if (u < 688) { u -= 640; src = p.w_q_up + (size_t)l * 256 * 768; gain = p.g_qa + l * 256; K = 256; N = 768; Npad = 768; doff = W_Q; }
    else if (u < 720) { u -= 688; src = p.w_kv_up + (size_t)l * 128 * 1024; K = 128; N = 1024; Npad = 1024; doff = W_KV; }
    else if (u < 976) { u -= 720; src = p.w_out + (size_t)l * 1048576; K = 1024; N = 1024; Npad = 1024; doff = W_OUT; }
    else if (u < 1232) { u -= 976; src = p.w_xq + (size_t)l * 1048576; gain = p.g_xattn + l * 1024; K = 1024; N = 1024; Npad = 1024; doff = W_XQ; }
    else if (u < 1488) { u -= 1232; src = p.w_xk + (size_t)l * 1048576; gain = p.g_mem + l * 1024; K = 1024; N = 1024; Npad = 1024; doff = W_XK; }
    else if (u < 1744) { u -= 1488; src = p.w_xv + (size_t)l * 1048576; gain = p.g_mem + l * 1024; K = 1024; N = 1024; Npad = 1024; doff = W_XV; }
    else if (u < 2000) { u -= 1744; src = p.w_xo + (size_t)l * 1048576; K = 1024; N = 1024; Npad = 1024; doff = W_XO; }
    else if (u < 3024) { u -= 2000; src = p.w_ff1 + (size_t)l * 4194304; gain = p.g_mlp + l * 1024; K = 1024; N = 4096; Npad = 4096; doff = W_FF1; }
    else { u -= 3024; src = p.w_ff2 + (size_t)l * 4194304; K = 4096; N = 1024; Npad = 1024; doff = W_FF2; }
    int nt = Npad / 64;
    int kt = u / nt, ntile = u % nt;
    wtile(src, gain, K, N, wsb(p, WS_W) + (size_t)l * W_LAYER + doff, kt * 64, ntile * 64, smem);
  }
  float2* tab = (float2*)(p.ws + WS_ROPE);
  for (int t = blockIdx.x; t < 1024; t += gridDim.x) {
    int idx = t * 256 + tid; int pos = idx >> 4, i = idx & 15;
    float inv_freq = exp2f(-(float)i * 0.830482023721841f);
    float ang = (float)pos * inv_freq;
    double rev = (double)ang * 0.15915494309189535;
    rev -= rint(rev);
    float fr = (float)rev;
    tab[idx] = make_float2(__builtin_amdgcn_cosf(fr), __builtin_amdgcn_sinf(fr));
  }
  u16* hm = wsb(p, WS_HM);
  for (int t = blockIdx.x * 4 + w; t < 512; t += gridDim.x * 4) norm_row_wave(p.mem_prompt + (size_t)t * 1024, hm + (size_t)t * 1024, lane);
  phase_norm(p, 0);
}

DI void phase_inproj(const Params& p, int l, char* smem) {
  const u16* W = wsb(p, WS_W) + (size_t)l * W_LAYER;
  const int n_main = 272 * 20;
  const int n_tot = n_main + (l == 0 ? 128 : 0);
  for (int t = blockIdx.x; t < n_tot; t += gridDim.x) {
    if (t < n_main) {
      int mt = t / 20, nt = t % 20;
      EpiStoreBf16 epi{wsb(p, WS_BIG + B_P), INC, INC, wsf(p, WS_GATES)};
      gemm_tile<2, 2>(wsb(p, WS_ACT), 1024, W + W_IN, 1024, 1024, mt * 128, nt * 128, smem, epi);
    } else {
      int u = t - n_main; int l2 = u >> 6, which = (u >> 5) & 1, mt = (u >> 3) & 3, nt = u & 7;
      const u16* W2 = wsb(p, WS_W) + (size_t)l2 * W_LAYER + (which ? W_XV : W_XK);
      EpiF32 epi{p.out + (which ? O_PMEMV : O_PMEMK) + (size_t)l2 * 524288, 1024};
      gemm_tile<2, 2>(wsb(p, WS_HM), 1024, W2, 1024, 1024, mt * 128, nt * 128, smem, epi);
    }
  }
}

DI void post_token(const Params& p, int l, int tok, int lane) {
  const u16* pr = wsb(p, WS_BIG + B_P) + (size_t)tok * INC;
  {
    uint2 q4 = *(const uint2*)(pr + lane * 4);
    float a = bflo(q4.x), b = bfhi(q4.x), c = bflo(q4.y), d = bfhi(q4.y);
    float ss = wave_sum(a * a + b * b + c * c + d * d);
    if (lane == 0) wsf(p, WS_RQ)[tok] = rsqrtf(ss * (1.f / 256.f) + EPS);
  }
  const bool prompt = tok < NP;
  int b, s, row, pos; float* ckv_out; float* kr_out;
  if (prompt) {
    b = tok >> 14; s = tok & 16383; row = tok; pos = s;
    ckv_out = p.out + O_PCKV + ((size_t)(l * 2 + b) * 16384 + s) * 128;
    kr_out = p.out + O_PKROPE + ((size_t)(l * 2 + b) * 16384 + s) * 32;
  } else {
    int t2 = tok - NP; b = t2 >> 6; s = t2 & 63; row = NP + b * 1088 + 1024 + s; pos = 1024 + s;
    ckv_out = p.out + O_SCKV + ((size_t)(l * 32 + b) * 64 + s) * 128;
    kr_out = p.out + O_SKROPE + ((size_t)(l * 32 + b) * 64 + s) * 32;
  }
  {
    unsigned c2 = *(const unsigned*)(pr + 256 + lane * 2);
    float c0 = bflo(c2), c1 = bfhi(c2);
    float ss = wave_sum(c0 * c0 + c1 * c1);
    float rr = rsqrtf(ss * (1.f / 128.f) + EPS);
    float o0 = c0 * rr * p.g_kva[l * 128 + lane * 2], o1 = c1 * rr * p.g_kva[l * 128 + lane * 2 + 1];
    *(float2*)(ckv_out + lane * 2) = make_float2(o0, o1);
    *(unsigned*)(wsb(p, WS_CKV) + (size_t)row * 128 + lane * 2) = pk2(o0, o1);
  }
  if (lane < 16) {
    float x1 = bf2f(pr[384 + lane]), x2 = bf2f(pr[400 + lane]);
    float2 cs = ((const float2*)(p.ws + WS_ROPE))[(size_t)pos * 16 + lane];
    float o1 = x1 * cs.x - x2 * cs.y, o2 = x1 * cs.y + x2 * cs.x;
    kr_out[lane] = o1; kr_out[16 + lane] = o2;
    float* ka = wsf(p, WS_KROPE) + (size_t)row * 32;
    ka[lane] = o1; ka[16 + lane] = o2;
  }
  const int S = prompt ? 16384 : 64;
  if (s >= S - 3) {
    int j = s - (S - 3);
    float* dst = prompt ? p.out + O_PCONV + ((size_t)(l * 2 + b) * 3 + j) * 1024 : p.out + O_SCONV + ((size_t)(l * 32 + b) * 3 + j) * 1024;
#pragma unroll 4
    for (int i = 0; i < 16; i++) dst[lane + 64 * i] = bf2f(pr[416 + lane + 64 * i]);
  }
}

DI void post_past(const Params& p, int l, int pi, int lane) {
  int b = pi >> 10, t = pi & 1023;
  size_t row = (size_t)NP + b * 1088 + t;
  const float* src = p.cache_ckv + ((size_t)(l * 32 + b) * 1024 + t) * 128;
  float2 v = *(const float2*)(src + lane * 2);
  *(unsigned*)(wsb(p, WS_CKV) + row * 128 + lane * 2) = pk2(v.x, v.y);
  if (lane < 32) wsf(p, WS_KROPE)[row * 32 + lane] = p.cache_krope[((size_t)(l * 32 + b) * 1024 + t) * 32 + lane];
}

struct ChunkInfo { int tok0, b, h, chain, has_prev, sample; };
DI ChunkInfo chunk_info(int item) {
  ChunkInfo ci;
  if (item < 2048) {
    ci.chain = item >> 8; ci.b = ci.chain >> 2; ci.h = ci.chain & 3; int c = item & 255;
    ci.tok0 = ci.b * 16384 + c * 64; ci.has_prev = (c > 0); ci.sample = 0;
  } else {
    int j = item - 2048; ci.chain = 8 + j; ci.b = j >> 2; ci.h = j & 3; ci.tok0 = NP + ci.b * 64; ci.has_prev = 0; ci.sample = 1;
  }
  return ci;
}
DI void load_x8(const Params& p, int l, const ChunkInfo& ci, int tp, int col, float (&x)[8]) {
  if (tp >= 0 || ci.has_prev) {
    uint4 v = *(const uint4*)(wsb(p, WS_BIG + B_P) + (size_t)(ci.tok0 + tp) * INC + col);
    unpack8(v, x);
  } else if (ci.sample) {
    const float* s = p.st_conv + (((size_t)l * 32 + ci.b) * 3 + (3 + tp)) * 1024 + (col - 416);
    float4 a = *(const float4*)s, b = *(const float4*)(s + 4);
    x[0] = a.x; x[1] = a.y; x[2] = a.z; x[3] = a.w; x[4] = b.x; x[5] = b.y; x[6] = b.z; x[7] = b.w;
  } else {
#pragma unroll
    for (int j = 0; j < 8; j++) x[j] = 0.f;
  }
}
template <class Emit>
DI void conv_run(const Params& p, int l, const ChunkInfo& ci, int mat, int chunk, int row0, int nrows, Emit emit) {
  const int ch0 = mat * 512 + ci.h * 128 + chunk * 8;
  const int col = 416 + ch0;
  float w0[8], w1[8], w2[8], w3[8], bias[8];
  {
    const float* wc = p.w_conv + (size_t)l * 4096 + ch0;
    float4 a, b;
    a = *(const float4*)(wc); b = *(const float4*)(wc + 4);
    w0[0] = a.x; w0[1] = a.y; w0[2] = a.z; w0[3] = a.w; w0[4] = b.x; w0[5] = b.y; w0[6] = b.z; w0[7] = b.w;
    a = *(const float4*)(wc + 1024); b = *(const float4*)(wc + 1028);
    w1[0] = a.x; w1[1] = a.y; w1[2] = a.z; w1[3] = a.w; w1[4] = b.x; w1[5] = b.y; w1[6] = b.z; w1[7] = b.w;
    a = *(const float4*)(wc + 2048); b = *(const float4*)(wc + 2052);
    w2[0] = a.x; w2[1] = a.y; w2[2] = a.z; w2[3] = a.w; w2[4] = b.x; w2[5] = b.y; w2[6] = b.z; w2[7] = b.w;
    a = *(const float4*)(wc + 3072); b = *(const float4*)(wc + 3076);
    w3[0] = a.x; w3[1] = a.y; w3[2] = a.z; w3[3] = a.w; w3[4] = b.x; w3[5] = b.y; w3[6] = b.z; w3[7] = b.w;
    const float* bc = p.b_conv + (size_t)l * 1024 + ch0;
    a = *(const float4*)(bc); b = *(const float4*)(bc + 4);
    bias[0] = a.x; bias[1] = a.y; bias[2] = a.z; bias[3] = a.w; bias[4] = b.x; bias[5] = b.y; bias[6] = b.z; bias[7] = b.w;
  }
  float xa[8], xb[8], xc[8], xd[8];
  load_x8(p, l, ci, row0 - 3, col, xa);
  load_x8(p, l, ci, row0 - 2, col, xb);
  load_x8(p, l, ci, row0 - 1, col, xc);
  for (int t = row0; t < row0 + nrows; t++) {
    load_x8(p, l, ci, t, col, xd);
    float y[8];
#pragma unroll
    for (int j = 0; j < 8; j++) {
      float v = bias[j] + xa[j] * w0[j] + xb[j] * w1[j] + xc[j] * w2[j] + xd[j] * w3[j];
      y[j] = v / (1.f + __expf(-v));
      xa[j] = xb[j]; xb[j] = xc[j]; xc[j] = xd[j];
    }
    emit(t, y);
  }
}
DI float logsigmoid(float z) { return fminf(z, 0.f) - log1pf(__expf(-fabsf(z))); }

DI void mlstm_m1(const Params& p, int l, int item, char* smem) {
  const ChunkInfo ci = chunk_info(item);
  const int tid = threadIdx.x, lane = tid & 63, w = tid >> 6, r = lane & 31, h = lane >> 5;
  u16* sVt = (u16*)smem;
  u16* sKt = sVt + 128 * 72;
  float* swk = (float*)(sKt + 128 * 72);
  __syncthreads();
  if (w == 0) {
    const float* g = wsf(p, WS_GATES) + (size_t)(ci.tok0 + lane) * 8;
    float ig = g[ci.h] + p.b_igate[l * 4 + ci.h];
    float lf = logsigmoid(g[4 + ci.h] + p.b_fgate[l * 4 + ci.h]);
    float bcs = lf;
#pragma unroll
    for (int o = 1; o < 64; o <<= 1) { float t = __shfl_up(bcs, o); if (lane >= o) bcs += t; }
    float u = ig - bcs;
    float umax = wave_max(u);
    swk[lane] = __expf(u - umax);
    float blast = __shfl(bcs, 63);
    if (lane == 0) { float* sc = wsf(p, WS_SCAL) + (size_t)item * 2; sc[0] = blast; sc[1] = blast + umax; }
  }
#pragma unroll
  for (int it = 0; it < 4; it++) {
    int id = tid + 256 * it; int s = id >> 4, ch = id & 15;
    uint4 v = *(const uint4*)(wsb(p, WS_BIG + B_P) + (size_t)(ci.tok0 + s) * INC + 1440 + ci.h * 128 + ch * 8);
    const u16* vv = (const u16*)&v;
    unsigned a[4] = {v.x, v.y, v.z, v.w};
#pragma unroll
    for (int j = 0; j < 4; j++) { sVt[(ch * 8 + 2 * j) * 72 + s] = (u16)(a[j] & 0xffffu); sVt[(ch * 8 + 2 * j + 1) * 72 + s] = (u16)(a[j] >> 16); }
    (void)vv;
  }
  __syncthreads();
  {
    const int chunk = tid & 15, rg = tid >> 4;
    conv_run(p, l, ci, 1, chunk, rg * 4, 4, [&](int t, const float (&y)[8]) {
      float sc = 0.08838834764831845f * swk[t];
#pragma unroll
      for (int j = 0; j < 8; j++) sKt[(chunk * 8 + j) * 72 + t] = f2bf(y[j] * sc);
    });
  }
  __syncthreads();
  const int wm = w >> 1, wn = w & 1;
  f32x16 acc[2][2];
#pragma unroll
  for (int a = 0; a < 2; a++)
#pragma unroll
    for (int b = 0; b < 2; b++)
#pragma unroll
      for (int i = 0; i < 16; i++) acc[a][b][i] = 0.f;
#pragma unroll
  for (int ks = 0; ks < 4; ks++) {
    bf16x8 af[2], bfr[2];
#pragma unroll
    for (int tm = 0; tm < 2; tm++) af[tm] = *(const bf16x8*)(sVt + (wm * 64 + tm * 32 + r) * 72 + ks * 16 + h * 8);
#pragma unroll
    for (int tn = 0; tn < 2; tn++) bfr[tn] = *(const bf16x8*)(sKt + (wn * 64 + tn * 32 + r) * 72 + ks * 16 + h * 8);
#pragma unroll
    for (int tm = 0; tm < 2; tm++)
#pragma unroll
      for (int tn = 0; tn < 2; tn++) acc[tm][tn] = MFMA(af[tm], bfr[tn], acc[tm][tn]);
  }
  u16* slot = wsb(p, WS_BIG + B_ST) + (size_t)item * 16384;
#pragma unroll
  for (int tm = 0; tm < 2; tm++)
#pragma unroll
    for (int tn = 0; tn < 2; tn++)
#pragma unroll
      for (int i = 0; i < 16; i++) slot[(wm * 64 + tm * 32 + crow(i, h)) * 128 + wn * 64 + tn * 32 + r] = f2bf(acc[tm][tn][i]);
  if (tid < 128) {
    float sum = 0.f;
    const u16* kr = sKt + tid * 72;
#pragma unroll 8
    for (int s = 0; s < 64; s++) sum += bf2f(kr[s]);
    wsf(p, WS_NU)[(size_t)item * 128 + tid] = sum;
  }
}

DI void mlstm_m2(const Params& p, int l, int unit) {
  const int tid = threadIdx.x;
  int chain, g, nc, item0, b, h; bool sample;
  if (unit < 256) { chain = unit >> 5; g = unit & 31; nc = 256; item0 = chain * 256; b = chain >> 2; h = chain & 3; sample = false; }
  else { int u = unit - 256; int j = u >> 5; g = u & 31; chain = 8 + j; nc = 1; item0 = 2048 + j; b = j >> 2; h = j & 3; sample = true; }
  const int el = g * 512 + tid * 2; const int e = el >> 7, d = el & 127;
  float c0 = 0.f, c1 = 0.f, nst = 0.f, m = 0.f;
  const bool do_n = (g == 0 && tid < 128);
  if (sample) {
    const float* C0 = p.st_C + ((size_t)(l * 32 + b) * 4 + h) * 16384;
    c0 = C0[d * 128 + e]; c1 = C0[(d + 1) * 128 + e];
    if (do_n) nst = p.st_n[((size_t)(l * 32 + b) * 4 + h) * 128 + tid];
    m = p.st_m[(l * 32 + b) * 4 + h];
  }
  u16* slots = wsb(p, WS_BIG + B_ST);
  const float* scal = wsf(p, WS_SCAL);
  float* nu = wsf(p, WS_NU);
  float* mst = wsf(p, WS_MST);
  for (int cb = 0; cb < nc; cb += 8) {
    unsigned uu[8]; float nn[8];
#pragma unroll
    for (int j = 0; j < 8; j++) {
      uu[j] = 0; nn[j] = 0.f;
      if (cb + j < nc) {
        uu[j] = *(const unsigned*)(slots + (size_t)(item0 + cb + j) * 16384 + el);
        if (do_n) nn[j] = nu[(size_t)(item0 + cb + j) * 128 + tid];
      }
    }
#pragma unroll
    for (int j = 0; j < 8; j++) {
      if (cb + j < nc) {
        const int item = item0 + cb + j;
        const float A = scal[item * 2], Cm = scal[item * 2 + 1];
        const float mnew = fmaxf(A + m, Cm);
        const float dec = __expf(A + m - mnew), us = __expf(Cm - mnew);
        *(unsigned*)(slots + (size_t)item * 16384 + el) = pk2(c0, c1);
        c0 = dec * c0 + us * bflo(uu[j]);
        c1 = dec * c1 + us * bfhi(uu[j]);
        if (do_n) { nu[(size_t)item * 128 + tid] = nst; nst = dec * nst + us * nn[j]; }
        if (g == 0 && tid == 0) mst[item] = m;
        m = mnew;
      }
    }
  }
  float* oC = sample ? p.out + O_SC + ((size_t)(l * 32 + b) * 4 + h) * 16384 : p.out + O_PC + ((size_t)(l * 2 + b) * 4 + h) * 16384;
  oC[d * 128 + e] = c0; oC[(d + 1) * 128 + e] = c1;
  if (do_n) { float* on = sample ? p.out + O_SN + ((size_t)(l * 32 + b) * 4 + h) * 128 : p.out + O_PN + ((size_t)(l * 2 + b) * 4 + h) * 128; on[tid] = nst; }
  if (g == 0 && tid == 0) { float* om = sample ? p.out + O_SM + (l * 32 + b) * 4 + h : p.out + O_PM + (l * 2 + b) * 4 + h; *om = m; }
}

DI void mlstm_m3(const Params& p, int l, int item, char* smem) {
  const ChunkInfo ci = chunk_info(item);
  const int tid = threadIdx.x, lane = tid & 63, w = tid >> 6, r = lane & 31, h = lane >> 5;
  u16* sQ = (u16*)smem;
  u16* sK = sQ + 64 * 136;
  u16* sVt = sK + 64 * 136;
  u16* sP = sVt + 128 * 72;
  float* su = (float*)(sP + 64 * 72);
  float* sM = su + 64;
  float* sa = sM + 64;
  float* sden = sa + 64;
  float* sinv = sden + 64;
  float* sn = sinv + 64;
  float* sH = (float*)smem;
  __syncthreads();
  const float m_start = wsf(p, WS_MST)[item];
  if (w == 0) {
    const float* g = wsf(p, WS_GATES) + (size_t)(ci.tok0 + lane) * 8;
    float ig = g[ci.h] + p.b_igate[l * 4 + ci.h];
    float lf = logsigmoid(g[4 + ci.h] + p.b_fgate[l * 4 + ci.h]);
    float bcs = lf;
#pragma unroll
    for (int o = 1; o < 64; o <<= 1) { float t = __shfl_up(bcs, o); if (lane >= o) bcs += t; }
    float u = ig - bcs;
    float cm = u;
#pragma unroll
    for (int o = 1; o < 64; o <<= 1) { float t = __shfl_up(cm, o); if (lane >= o) cm = fmaxf(cm, t); }
    float Mt = fmaxf(m_start, cm);
    su[lane] = u; sM[lane] = Mt; sa[lane] = __expf(m_start - Mt); sden[lane] = __expf(-(bcs + Mt));
  } else if (w == 1) {
    sn[lane] = wsf(p, WS_NU)[(size_t)item * 128 + lane];
    sn[lane + 64] = wsf(p, WS_NU)[(size_t)item * 128 + lane + 64];
  }
#pragma unroll
  for (int it = 0; it < 4; it++) {
    int id = tid + 256 * it; int s = id >> 4, ch = id & 15;
    uint4 v = *(const uint4*)(wsb(p, WS_BIG + B_P) + (size_t)(ci.tok0 + s) * INC + 1440 + ci.h * 128 + ch * 8);
    unsigned a[4] = {v.x, v.y, v.z, v.w};
#pragma unroll
    for (int j = 0; j < 4; j++) { sVt[(ch * 8 + 2 * j) * 72 + s] = (u16)(a[j] & 0xffffu); sVt[(ch * 8 + 2 * j + 1) * 72 + s] = (u16)(a[j] >> 16); }
  }
  {
    const int mc = tid & 31, mat = mc >> 4, chunk = mc & 15, rg = tid >> 5;
    u16* dst = mat ? sK : sQ;
    const float sc = mat ? 0.08838834764831845f : 1.f;
    conv_run(p, l, ci, mat, chunk, rg * 8, 8, [&](int t, const float (&y)[8]) {
      float x[8];
#pragma unroll
      for (int j = 0; j < 8; j++) x[j] = y[j] * sc;
      *(uint4*)(dst + t * 136 + chunk * 8) = pack8(x);
    });
  }
  __syncthreads();
  {
    const int tq = w >> 1, ts = w & 1;
    f32x16 s;
#pragma unroll
    for (int i = 0; i < 16; i++) s[i] = 0.f;
#pragma unroll
    for (int ks = 0; ks < 8; ks++) {
      bf16x8 a = *(const bf16x8*)(sQ + (tq * 32 + r) * 136 + ks * 16 + h * 8);
      bf16x8 b = *(const bf16x8*)(sK + (ts * 32 + r) * 136 + ks * 16 + h * 8);
      s = MFMA(a, b, s);
    }
    const int sidx = ts * 32 + r;
    const float us = su[sidx];
#pragma unroll
    for (int i = 0; i < 16; i++) {
      int t = tq * 32 + crow(i, h);
      float v = (sidx <= t) ? s[i] * __expf(us - sM[t]) : 0.f;
      sP[t * 72 + sidx] = f2bf(v);
    }
  }
  __syncthreads();
  if (tid < 64) {
    float rs = 0.f, qd = 0.f;
    const u16* pr = sP + tid * 72;
#pragma unroll 8
    for (int s = 0; s < 64; s++) rs += bf2f(pr[s]);
    const u16* qr = sQ + tid * 136;
#pragma unroll 8
    for (int d = 0; d < 128; d++) qd += bf2f(qr[d]) * sn[d];
    float qn = sa[tid] * qd + rs;
    sinv[tid] = 1.f / fmaxf(fabsf(qn), sden[tid]);
  }
  const int tq = w & 1, eb = (w >> 1) * 2;
  f32x16 a1[2], a2[2];
#pragma unroll
  for (int et = 0; et < 2; et++)
#pragma unroll
    for (int i = 0; i < 16; i++) { a1[et][i] = 0.f; a2[et][i] = 0.f; }
  const u16* slot = wsb(p, WS_BIG + B_ST) + (size_t)item * 16384;
#pragma unroll
  for (int ks = 0; ks < 8; ks++) {
    bf16x8 a = *(const bf16x8*)(sQ + (tq * 32 + r) * 136 + ks * 16 + h * 8);
#pragma unroll
    for (int et = 0; et < 2; et++) {
      bf16x8 b = *(const bf16x8*)(slot + ((eb + et) * 32 + r) * 128 + ks * 16 + h * 8);
      a1[et] = MFMA(a, b, a1[et]);
    }
  }
#pragma unroll
  for (int ks = 0; ks < 4; ks++) {
    bf16x8 a = *(const bf16x8*)(sP + (tq * 32 + r) * 72 + ks * 16 + h * 8);
#pragma unroll
    for (int et = 0; et < 2; et++) {
      bf16x8 b = *(const bf16x8*)(sVt + ((eb + et) * 32 + r) * 72 + ks * 16 + h * 8);
      a2[et] = MFMA(a, b, a2[et]);
    }
  }
  __syncthreads();
#pragma unroll
  for (int et = 0; et < 2; et++)
#pragma unroll
    for (int i = 0; i < 16; i++) {
      int t = tq * 32 + crow(i, h);
      sH[t * 132 + (eb + et) * 32 + r] = (sa[t] * a1[et][i] + a2[et][i]) * sinv[t];
    }
  __syncthreads();
  {
    const int t = tid >> 2, part = tid & 3;
    const float* hr = sH + t * 132 + part * 32;
    float ss = 0.f;
#pragma unroll 8
    for (int j = 0; j < 32; j++) ss += hr[j] * hr[j];
    ss += __shfl_xor(ss, 1); ss += __shfl_xor(ss, 2);
    const float rr = rsqrtf(ss * (1.f / 128.f) + EPS);
    const int tok = ci.tok0 + t;
    const u16* og = wsb(p, WS_BIG + B_P) + (size_t)tok * INC + 1960 + ci.h * 128 + part * 32;
    const float* gm = p.g_mhead + (size_t)l * 512 + ci.h * 128 + part * 32;
    u16* o = wsb(p, WS_ACT) + (size_t)tok * 1024 + 512 + ci.h * 128 + part * 32;
#pragma unroll
    for (int c8 = 0; c8 < 4; c8++) {
      float gv[8], x[8];
      unpack8(*(const uint4*)(og + c8 * 8), gv);
#pragma unroll
      for (int j = 0; j < 8; j++) x[j] = hr[c8 * 8 + j] * rr * gm[c8 * 8 + j] / (1.f + __expf(-gv[j]));
      *(uint4*)(o + c8 * 8) = pack8(x);
    }
  }
}

DI void xkv_item(const Params& p, int l, int item, char* smem) {
  const int tid = threadIdx.x;
  const int kg = item & 3, hh = (item >> 2) & 3, bidx = item >> 4;
  u16* T = (u16*)smem;
  __syncthreads();
  const int key = tid >> 2, qt = tid & 3;
  const int mem = kg * 64 + key;
  const bool prompt = bidx < 2;
  float* kp; const float* vp;
  if (prompt) {
    kp = p.out + O_PMEMK + (((size_t)(l * 2 + bidx) * 256 + mem) * 4 + hh) * 256 + qt * 64;
    vp = p.out + O_PMEMV + (((size_t)(l * 2 + bidx) * 256 + mem) * 4 + hh) * 256 + qt * 64;
  } else {
    kp = (float*)(p.cache_mem_k + (((size_t)(l * 32 + bidx - 2) * 256 + mem) * 4 + hh) * 256 + qt * 64);
    vp = p.cache_mem_v + (((size_t)(l * 32 + bidx - 2) * 256 + mem) * 4 + hh) * 256 + qt * 64;
  }
  float rr = 1.f;
  if (prompt) {
    float ss = 0.f;
#pragma unroll 4
    for (int j = 0; j < 16; j++) { float4 v = *(const float4*)(kp + j * 4); ss += v.x * v.x + v.y * v.y + v.z * v.z + v.w * v.w; }
    ss += __shfl_xor(ss, 1); ss += __shfl_xor(ss, 2);
    rr = rsqrtf(ss * (1.f / 256.f) + EPS);
  }
  const float* gk = p.g_xk + l * 256 + qt * 64;
  const float* gq = p.g_xq + l * 256 + qt * 64;
  u16* xk = wsb(p, WS_BIG + B_XK) + ((size_t)(bidx * 4 + hh) * 256 + mem) * 256 + qt * 64;
#pragma unroll 2
  for (int c8 = 0; c8 < 8; c8++) {
    float4 a = *(const float4*)(kp + c8 * 8), b = *(const float4*)(kp + c8 * 8 + 4);
    float x[8] = {a.x, a.y, a.z, a.w, b.x, b.y, b.z, b.w};
    if (prompt) {
#pragma unroll
      for (int j = 0; j < 8; j++) x[j] = x[j] * rr * gk[c8 * 8 + j];
      *(float4*)(kp + c8 * 8) = make_float4(x[0], x[1], x[2], x[3]);
      *(float4*)(kp + c8 * 8 + 4) = make_float4(x[4], x[5], x[6], x[7]);
    }
#pragma unroll
    for (int j = 0; j < 8; j++) x[j] = x[j] * gq[c8 * 8 + j] * (0.0625f * LOG2E);
    *(uint4*)(xk + c8 * 8) = pack8(x);
    float4 va = *(const float4*)(vp + c8 * 8), vb = *(const float4*)(vp + c8 * 8 + 4);
    float y[8] = {va.x, va.y, va.z, va.w, vb.x, vb.y, vb.z, vb.w};
    *(uint4*)(T + key * 264 + qt * 64 + c8 * 8) = pack8(y);
  }
  __syncthreads();
  {
    const int e = tid;
    u16* xv = wsb(p, WS_BIG + B_XVT) + ((size_t)(bidx * 4 + hh) * 256 + e) * 256 + kg * 64;
#pragma unroll 2
    for (int oct = 0; oct < 8; oct++) {
      uint4 v;
      v.x = (unsigned)T[(oct * 8 + 0) * 264 + e] | ((unsigned)T[(oct * 8 + 1) * 264 + e] << 16);
      v.y = (unsigned)T[(oct * 8 + 2) * 264 + e] | ((unsigned)T[(oct * 8 + 3) * 264 + e] << 16);
      v.z = (unsigned)T[(oct * 8 + 4) * 264 + e] | ((unsigned)T[(oct * 8 + 5) * 264 + e] << 16);
      v.w = (unsigned)T[(oct * 8 + 6) * 264 + e] | ((unsigned)T[(oct * 8 + 7) * 264 + e] << 16);
      *(uint4*)(xv + oct * 8) = v;
    }
  }
}

DI void phase_C(const Params& p, int l, char* smem) {
  const int lane = threadIdx.x & 63, w = threadIdx.x >> 6;
  for (int t = blockIdx.x; t < NITEM; t += gridDim.x) mlstm_m1(p, l, t, smem);
  for (int t = blockIdx.x; t < 544; t += gridDim.x) xkv_item(p, l, t, smem);
  for (int t = blockIdx.x * 4 + w; t < NTOK + 32768; t += gridDim.x * 4) {
    if (t < NTOK) post_token(p, l, t, lane); else post_past(p, l, t - NTOK, lane);
  }
}

DI void phase_D(const Params& p, int l, char* smem) {
  const int n_scan = 256 + 4096;
  const int n_q = 544 * 4;
  const u16* W = wsb(p, WS_W) + (size_t)l * W_LAYER;
  for (int t = blockIdx.x; t < n_scan + n_q; t += gridDim.x) {
    if (t < n_scan) mlstm_m2(p, l, t);
    else {
      int u = t - n_scan; int mt = u >> 2, nt = u & 3;
      EpiQ epi{wsb(p, WS_BIG + B_Q), wsf(p, WS_RQ), (const float2*)(p.ws + WS_ROPE), p.g_qnorm + l * 96};
      gemm_tile<1, 3>(wsb(p, WS_BIG + B_P), INC, W + W_Q, 256, 256, mt * 64, nt * 192, smem, epi);
    }
  }
}

DI void phase_E(const Params& p, int l, char* smem) {
  for (int t = blockIdx.x; t < NITEM; t += gridDim.x) mlstm_m3(p, l, t, smem);
}

DI void phase_F(const Params& p, int l, char* smem) {
  const u16* W = wsb(p, WS_W) + (size_t)l * W_LAYER;
  for (int t = blockIdx.x; t < 528 * 8; t += gridDim.x) {
    int mt = t >> 3, nt = t & 7;
    EpiKV epi{wsb(p, WS_BIG + B_K), wsb(p, WS_BIG + B_VT), wsf(p, WS_KROPE), p.g_knorm + l * 96};
    gemm_tile<2, 2>(wsb(p, WS_CKV), 128, W + W_KV, 128, 128, mt * 128, nt * 128, smem, epi);
  }
}

DI void phase_G(const Params& p, char* smem) {
  const int G = gridDim.x, j = blockIdx.x;
  const int lane = threadIdx.x & 63, w = threadIdx.x >> 6, r = lane & 31;
  const int NIT = 2048 + 256;
  const u16* qb = wsb(p, WS_BIG + B_Q);
  const u16* Kb = wsb(p, WS_BIG + B_K);
  const u16* Vt = wsb(p, WS_BIG + B_VT);
  u16* act = wsb(p, WS_ACT);
  for (int k = 0; k * G < NIT; k++) {
    int it = (k & 1) ? (k * G + (G - 1 - j)) : (k * G + j);
    if (it >= NIT) continue;
    if (it < 2048) {
      int bi = 127 - (it >> 4), bh = it & 15, b = bh >> 3, hd = bh & 7;
      int tok = b * 16384 + bi * 128 + w * 32 + r;
      flash_item<96, 2, 64, true, false, true>(qb + (size_t)tok * 768 + hd * 96, true, 2 * bi + 2, 2 * bi + 1 + (w >> 1),
                                         Kb + ((size_t)hd * NROWS + b * 16384) * 96, 96, Vt + (size_t)hd * 64 * NROWS + b * 16384, NROWS, 0,
                                         act + (size_t)tok * 1024 + hd * 64, smem);
    } else {
      int u = it - 2048; int b = u >> 3, hd = u & 7;
      int tok = NP + b * 64 + (w & 1) * 32 + r;
      size_t row0 = (size_t)NP + b * 1088;
      flash_item<96, 2, 64, true, false, true>(qb + (size_t)tok * 768 + hd * 96, w < 2, 17, 17, Kb + ((size_t)hd * NROWS + row0) * 96, 96,
                                         Vt + (size_t)hd * 64 * NROWS + row0, NROWS, 0, act + (size_t)tok * 1024 + hd * 64, smem);
    }
  }
}

DI void phase_K(const Params& p, char* smem) {
  const int lane = threadIdx.x & 63, w = threadIdx.x >> 6, r = lane & 31;
  const u16* qx = wsb(p, WS_BIG + B_QX);
  u16* act = wsb(p, WS_ACT);
  for (int t = blockIdx.x; t < 2176; t += gridDim.x) {
    int bidx, hh, tok0;
    if (t < 2048) { bidx = t >> 10; hh = (t >> 8) & 3; tok0 = bidx * 16384 + (t & 255) * 64; }
    else { int u = t - 2048; bidx = 2 + (u >> 2); hh = u & 3; tok0 = NP + (u >> 2) * 64; }
    int tok = tok0 + (w & 1) * 32 + r;
    int e0 = (w >> 1) * 128;
    const u16* Kb = wsb(p, WS_BIG + B_XK) + (size_t)(bidx * 4 + hh) * 65536;
    const u16* Vt = wsb(p, WS_BIG + B_XVT) + (size_t)(bidx * 4 + hh) * 65536;
    flash_item<256, 4, 256, false, true, false>(qx + (size_t)tok * 1024 + hh * 256, true, 4, 4, Kb, 256, Vt, 256, e0,
                                         act + (size_t)tok * 1024 + hh * 256 + e0, smem);
  }
}

template <class Epi>
DI void phase_gemm128(const u16* A, long lda, const u16* Bt, long ldb, int K, int MT, int NT, char* smem, const Epi& epi) {
  for (int t = blockIdx.x; t < MT * NT; t += gridDim.x) {
    int mt = t / NT, nt = t % NT;
    gemm_tile<2, 2>(A, lda, Bt, ldb, K, mt * 128, nt * 128, smem, epi);
  }
}

template <int L>
DI void run_layer(const Params& p, int ph_begin, int ph_end, char* smem, cg::grid_group& grid) {
  const u16* W = wsb(p, WS_W) + (size_t)L * W_LAYER;
  const float* xs0 = (L == 0) ? p.x_prompt : p.out;
  const float* xs1 = (L == 0) ? p.x_sample : p.out + (size_t)NP * 1024;
  const int base = 1 + 15 * L;
#define RUN_PHASE(S, ...)                                    \
  {                                                          \
    const int ph = base + (S);                               \
    if (ph >= ph_begin && ph < ph_end) {                     \
      __VA_ARGS__;                                           \
      if (ph + 1 < ph_end) grid.sync();                      \
    }                                                        \
  }
  if (L > 0) RUN_PHASE(0, phase_norm(p, L))
  RUN_PHASE(1, phase_inproj(p, L, smem))
  RUN_PHASE(2, phase_C(p, L, smem))
  RUN_PHASE(3, phase_D(p, L, smem))
  RUN_PHASE(4, phase_E(p, L, smem))
  RUN_PHASE(5, phase_F(p, L, smem))
  RUN_PHASE(6, phase_G(p, smem))
  RUN_PHASE(7, { EpiRes epi{xs0, xs1, p.out}; phase_gemm128(wsb(p, WS_ACT), 1024, W + W_OUT, 1024, 1024, 272, 8, smem, epi); })
  RUN_PHASE(8, phase_norm(p, 1))
  RUN_PHASE(9, { EpiStoreBf16 epi{wsb(p, WS_BIG + B_QX), 1024, 1024, nullptr}; phase_gemm128(wsb(p, WS_ACT), 1024, W + W_XQ, 1024, 1024, 272, 8, smem, epi); })
  RUN_PHASE(10, phase_K(p, smem))
  RUN_PHASE(11, { EpiRes epi{p.out, p.out + (size_t)NP * 1024, p.out}; phase_gemm128(wsb(p, WS_ACT), 1024, W + W_XO, 1024, 1024, 272, 8, smem, epi); })
  RUN_PHASE(12, phase_norm(p, 1))
  RUN_PHASE(13, { EpiRelu2 epi{wsb(p, WS_BIG + B_H1), 4096}; phase_gemm128(wsb(p, WS_ACT), 1024, W + W_FF1, 1024, 1024, 272, 32, smem, epi); })
  RUN_PHASE(14, { EpiRes epi{p.out, p.out + (size_t)NP * 1024, p.out}; phase_gemm128(wsb(p, WS_BIG + B_H1), 4096, W + W_FF2, 4096, 4096, 272, 8, smem, epi); })
#undef RUN_PHASE
}

__global__ void __launch_bounds__(256, 2) fwd_megakernel(Params p, int ph_begin, int ph_end) {
  __shared__ __attribute__((aligned(16))) char smem[SMEM_BYTES];
  cg::grid_group grid = cg::this_grid();
  if (ph_begin <= 0 && 0 < ph_end) {
    phase_prep(p, smem);
    if (1 < ph_end) grid.sync();
  }
  run_layer<0>(p, ph_begin, ph_end, smem, grid);
  run_layer<1>(p, ph_begin, ph_end, smem, grid);
}

extern "C" void kernel_launch(void* const* d_in, const int* in_sizes, int n_in, void* d_out, int out_size, void* d_ws, size_t ws_size,
                              hipStream_t stream) {
  static int grid_blocks = 0;
  if (!grid_blocks) {
    int dev = 0, cus = 0, per_cu = 0;
    (void)hipGetDevice(&dev);
    (void)hipDeviceGetAttribute(&cus, hipDeviceAttributeMultiprocessorCount, dev);
    (void)hipOccupancyMaxActiveBlocksPerMultiprocessor(&per_cu, fwd_megakernel, 256, 0);
    if (per_cu > 2) per_cu = 2;
    if (per_cu < 1) per_cu = 1;
    grid_blocks = cus * per_cu;
  }
  Params p{};
  const float** pp = (const float**)&p;
  for (int i = 0; i < 36; i++) pp[i] = (const float*)d_in[i];
  p.out = (float*)d_out;
  p.ws = (char*)d_ws;
  int ph_begin = 0, ph_end = 31;
  void* args[] = {&p, &ph_begin, &ph_end};
  hipError_t e = hipLaunchCooperativeKernel((void*)fwd_megakernel, dim3(grid_blocks), dim3(256), args, 0, stream);
  if (e != hipSuccess) fprintf(stderr, "cooperative launch failed: %s (grid %d)\n", hipGetErrorString(e), grid_blocks);
}
```

```cpp
#include <hip/hip_runtime.h>
#include <hip/hip_cooperative_groups.h>
#include <stdint.h>
#include <stdio.h>
namespace cg = cooperative_groups;

typedef unsigned short u16;
typedef short bf16x8 __attribute__((ext_vector_type(8)));
typedef short s16x4 __attribute__((ext_vector_type(4)));
typedef float f32x16 __attribute__((ext_vector_type(16)));
typedef __bf16 bfv2 __attribute__((ext_vector_type(2)));
typedef float fv2 __attribute__((ext_vector_type(2)));
typedef unsigned u32x4 __attribute__((ext_vector_type(4)));
#define DI __device__ __forceinline__
#define MFMA(a, b, c) __builtin_amdgcn_mfma_f32_32x32x16_bf16((a), (b), (c), 0, 0, 0)

constexpr int NP = 32768;
constexpr int NS = 2048;
constexpr int NTOK = NP + NS;
constexpr int NROWS = NP + 32 * 1088;
constexpr int INC = 2472;
constexpr float EPS = 1e-6f;
constexpr float LOG2E = 1.4426950408889634f;
constexpr int NITEM = 2048 + 128;
constexpr int LDA = 1088;
constexpr int LDW = 1088;
constexpr int LDW2 = 4160;
constexpr int LDWQ = 320;
constexpr int LDWKV = 192;
constexpr int LDH1 = 4160;
constexpr int LDVT = NROWS + 64;
constexpr int LDXV = 320;

constexpr size_t O_Y = 0;
constexpr size_t O_PCKV = 35651584;
constexpr size_t O_PKROPE = O_PCKV + 8388608;
constexpr size_t O_PC = O_PKROPE + 2097152;
constexpr size_t O_PN = O_PC + 262144;
constexpr size_t O_PM = O_PN + 2048;
constexpr size_t O_PCONV = O_PM + 16;
constexpr size_t O_PMEMK = O_PCONV + 12288;
constexpr size_t O_PMEMV = O_PMEMK + 1048576;
constexpr size_t O_SCKV = O_PMEMV + 1048576;
constexpr size_t O_SKROPE = O_SCKV + 524288;
constexpr size_t O_SC = O_SKROPE + 131072;
constexpr size_t O_SN = O_SC + 4194304;
constexpr size_t O_SM = O_SN + 32768;
constexpr size_t O_SCONV = O_SM + 256;

constexpr size_t W_IN = 0;
constexpr size_t W_Q = W_IN + 2560 * LDW;
constexpr size_t W_KV = W_Q + 768 * LDWQ;
constexpr size_t W_OUT = W_KV + 1024 * LDWKV;
constexpr size_t W_XQ = W_OUT + 1024 * LDW;
constexpr size_t W_XK = W_XQ + 1024 * LDW;
constexpr size_t W_XV = W_XK + 1024 * LDW;
constexpr size_t W_XO = W_XV + 1024 * LDW;
constexpr size_t W_FF1 = W_XO + 1024 * LDW;
constexpr size_t W_FF2 = W_FF1 + 4096 * LDW;
constexpr size_t W_LAYER = W_FF2 + 1024 * LDW2;

constexpr size_t WS_W = 0;
constexpr size_t WS_ACT = WS_W + 2 * W_LAYER * 2;
constexpr size_t WS_CKV = WS_ACT + (size_t)NTOK * LDA * 2;
constexpr size_t WS_KROPE = WS_CKV + (size_t)NROWS * 128 * 2;
constexpr size_t WS_RQ = WS_KROPE + (size_t)NROWS * 32 * 4;
constexpr size_t WS_GATES = WS_RQ + (size_t)NTOK * 4;
constexpr size_t WS_ROPE = WS_GATES + (size_t)NTOK * 8 * 4;
constexpr size_t WS_SCAL = WS_ROPE + (size_t)16384 * 16 * 8;
constexpr size_t WS_MST = WS_SCAL + (size_t)NITEM * 2 * 4;
constexpr size_t WS_NU = WS_MST + (size_t)NITEM * 4 + 256;
constexpr size_t WS_CNT = WS_NU + (size_t)NITEM * 128 * 4;
constexpr size_t WS_HM = WS_CNT + 256;
constexpr size_t WS_BIG = WS_HM + (size_t)512 * LDA * 2;
constexpr size_t B_P = 0;
constexpr size_t B_K = 0;
constexpr size_t B_VT = B_K + (size_t)8 * NROWS * 96 * 2;
constexpr size_t B_Q = B_VT + (size_t)8 * 64 * LDVT * 2;
constexpr size_t B_ST = B_Q + (size_t)NTOK * 768 * 2;
constexpr size_t B_XK = B_ST + (size_t)NITEM * 16384 * 2;
constexpr size_t B_XVT = B_XK + (size_t)34 * 4 * 256 * 256 * 2;
constexpr size_t B_END = B_XVT + (size_t)34 * 4 * 256 * LDXV * 2;
constexpr size_t B_QX = 0;
constexpr size_t B_H1 = 0;
static_assert((size_t)NTOK * INC * 2 <= B_Q, "p overlaps q");
static_assert((size_t)NTOK * LDH1 * 2 <= B_XK, "h1 overlaps xkv");
static_assert((size_t)NTOK * LDA * 2 <= B_Q, "qx overlaps q");
static_assert(WS_BIG + B_END <= (size_t)536870912, "workspace too large");
static_assert(WS_BIG % 256 == 0 && B_Q % 256 == 0 && B_ST % 256 == 0 && B_VT % 256 == 0, "align");

constexpr int SMEM_BYTES = 73728;
#ifndef REP_INPROJ
#define REP_INPROJ 1
#endif
#ifndef REP_C
#define REP_C 1
#endif
#ifndef REP_E
#define REP_E 1
#endif
#ifndef REP_F
#define REP_F 1
#endif
#ifndef REP_G
#define REP_G 1
#endif
#ifndef REP_K
#define REP_K 1
#endif
#ifndef REP_FF1
#define REP_FF1 1
#endif
#ifndef REP_NORM
#define REP_NORM 1
#endif

struct Params {
  const float* x_prompt; const float* x_sample; const float* cache_ckv; const float* cache_krope;
  const float* st_C; const float* st_n; const float* st_m; const float* st_conv;
  const float* cache_mem_k; const float* cache_mem_v; const float* mem_prompt;
  const float* g_mix; const float* w_in; const float* g_qa; const float* w_q_up; const float* g_qnorm; const float* g_kva;
  const float* w_kv_up; const float* g_knorm; const float* w_conv; const float* b_conv; const float* b_igate; const float* b_fgate;
  const float* g_mhead; const float* w_out; const float* g_xattn; const float* g_mem; const float* w_xq; const float* w_xk; const float* w_xv;
  const float* g_xq; const float* g_xk; const float* w_xo; const float* g_mlp; const float* w_ff1; const float* w_ff2;
  float* out; char* ws;
};

struct Sched { int xg, xi, ok; };
DI int tidx() { int t = (int)threadIdx.x; asm volatile("" : "+v"(t)); return t; }
DI unsigned pk2(float a, float b) { fv2 v = {a, b}; bfv2 r = __builtin_convertvector(v, bfv2); return __builtin_bit_cast(unsigned, r); }
DI u16 f2bf(float a) { return (u16)(pk2(a, 0.f) & 0xffffu); }
DI float bf2f(u16 v) { return __uint_as_float(((unsigned)v) << 16); }
DI float bflo(unsigned v) { return __uint_as_float(v << 16); }
DI float bfhi(unsigned v) { return __uint_as_float(v & 0xffff0000u); }
DI int crow(int i, int h) { return (i & 3) + 8 * (i >> 2) + 4 * h; }
DI float wave_sum(float v) {
#pragma unroll
  for (int o = 32; o >= 1; o >>= 1) v += __shfl_xor(v, o);
  return v;
}
DI float wave_max(float v) {
#pragma unroll
  for (int o = 32; o >= 1; o >>= 1) v = fmaxf(v, __shfl_xor(v, o));
  return v;
}
DI void unpack8(uint4 v, float (&x)[8]) {
  x[0] = bflo(v.x); x[1] = bfhi(v.x); x[2] = bflo(v.y); x[3] = bfhi(v.y);
  x[4] = bflo(v.z); x[5] = bfhi(v.z); x[6] = bflo(v.w); x[7] = bfhi(v.w);
}
DI uint4 pack8(const float (&x)[8]) {
  uint4 v; v.x = pk2(x[0], x[1]); v.y = pk2(x[2], x[3]); v.z = pk2(x[4], x[5]); v.w = pk2(x[6], x[7]); return v;
}
DI u16* wsb(const Params& p, size_t off) { return (u16*)(p.ws + off); }
DI float* wsf(const Params& p, size_t off) { return (float*)(p.ws + off); }
DI const float* xrow(const Params& p, int l, int tok) {
  if (l == 0) return tok < NP ? p.x_prompt + (size_t)tok * 1024 : p.x_sample + (size_t)(tok - NP) * 1024;
  return p.out + (size_t)tok * 1024;
}
DI int tok_pos(int tok) { return tok < NP ? (tok & 16383) : 1024 + ((tok - NP) & 63); }

template <int TM, int TN>
DI void gemm_mainloop(const u16* __restrict__ A, long lda, const u16* __restrict__ Bt, long ldb, int K, char* smem,
                      f32x16 (&acc)[TM][TN]) {
  constexpr int BM = 64 * TM, BN = 64 * TN, LD = 72;
  u16* sA = (u16*)smem;
  u16* sB = sA + 2 * BM * LD;
  const int tid = tidx(), lane = tid & 63, w = tid >> 6, r = lane & 31, h = lane >> 5;
  const int wm = w >> 1, wn = w & 1;
  constexpr int NA = BM / 32, NB = BN / 32;
  u32x4 ra[NA], rb[NB];
#pragma unroll
  for (int tm = 0; tm < TM; tm++)
#pragma unroll
    for (int tn = 0; tn < TN; tn++)
#pragma unroll
      for (int i = 0; i < 16; i++) acc[tm][tn][i] = 0.f;
  const int nk = K / 64;
  const int lrow = tid >> 3, lch = (tid & 7) * 8;
  const u16* gA = A + (long)lrow * lda + lch;
  const u16* gB = Bt + (long)lrow * ldb + lch;
  const int soff = lrow * LD + lch;
#define GEMM_GLOAD(k0)                                                                   \
  {                                                                                      \
    _Pragma("unroll") for (int i = 0; i < NA; i++) ra[i] = *(const u32x4*)(gA + (long)(32 * i) * lda + (k0)); \
    _Pragma("unroll") for (int i = 0; i < NB; i++) rb[i] = *(const u32x4*)(gB + (long)(32 * i) * ldb + (k0)); \
  }
#define GEMM_SSTORE(buf)                                                                 \
  {                                                                                      \
    _Pragma("unroll") for (int i = 0; i < NA; i++) *(u32x4*)(sA + (buf) * BM * LD + soff + 32 * i * LD) = ra[i]; \
    _Pragma("unroll") for (int i = 0; i < NB; i++) *(u32x4*)(sB + (buf) * BN * LD + soff + 32 * i * LD) = rb[i]; \
  }
  GEMM_GLOAD(0)
  __syncthreads();
  GEMM_SSTORE(0)
  if (nk > 1) GEMM_GLOAD(64)
  __syncthreads();
  for (int kt = 0; kt < nk; kt++) {
    const int buf = kt & 1;
    const u16* cA = sA + buf * BM * LD + (wm * 32 * TM + r) * LD + h * 8;
    const u16* cB = sB + buf * BN * LD + (wn * 32 * TN + r) * LD + h * 8;
    bf16x8 af[TM], bfr[TN];
#pragma unroll
    for (int tm = 0; tm < TM; tm++) af[tm] = *(const bf16x8*)(cA + tm * 32 * LD);
#pragma unroll
    for (int tn = 0; tn < TN; tn++) bfr[tn] = *(const bf16x8*)(cB + tn * 32 * LD);
    if (kt + 1 < nk) GEMM_SSTORE(buf ^ 1)
    __builtin_amdgcn_sched_barrier(0);
#pragma unroll
    for (int tm = 0; tm < TM; tm++)
#pragma unroll
      for (int tn = 0; tn < TN; tn++) acc[tm][tn] = MFMA(af[tm], bfr[tn], acc[tm][tn]);
#pragma unroll
    for (int tm = 0; tm < TM; tm++) af[tm] = *(const bf16x8*)(cA + tm * 32 * LD + 16);
#pragma unroll
    for (int tn = 0; tn < TN; tn++) bfr[tn] = *(const bf16x8*)(cB + tn * 32 * LD + 16);
#pragma unroll
    for (int tm = 0; tm < TM; tm++)
#pragma unroll
      for (int tn = 0; tn < TN; tn++) acc[tm][tn] = MFMA(af[tm], bfr[tn], acc[tm][tn]);
    __builtin_amdgcn_sched_barrier(0);
    if (kt + 2 < nk) GEMM_GLOAD((kt + 2) * 64)
    __builtin_amdgcn_sched_barrier(0);
#pragma unroll
    for (int ks = 2; ks < 4; ks++) {
#pragma unroll
      for (int tm = 0; tm < TM; tm++) af[tm] = *(const bf16x8*)(cA + tm * 32 * LD + ks * 16);
#pragma unroll
      for (int tn = 0; tn < TN; tn++) bfr[tn] = *(const bf16x8*)(cB + tn * 32 * LD + ks * 16);
#pragma unroll
      for (int tm = 0; tm < TM; tm++)
#pragma unroll
        for (int tn = 0; tn < TN; tn++) acc[tm][tn] = MFMA(af[tm], bfr[tn], acc[tm][tn]);
    }
    __syncthreads();
  }
#undef GEMM_GLOAD
#undef GEMM_SSTORE
}

template <int TM, int TN, class Epi>
DI void gemm_tile(const u16* A, long lda, const u16* Bt, long ldb, int K, int m0, int n0, char* smem, const Epi& epi) {
  constexpr int BM = 64 * TM, BN = 64 * TN, LDC = BN + Epi::PAD;
  f32x16 acc[TM][TN];
  gemm_mainloop<TM, TN>(A + (long)m0 * lda, lda, Bt + (long)n0 * ldb, ldb, K, smem, acc);
  const int tid = tidx(), lane = tid & 63, w = tid >> 6, r = lane & 31, h = lane >> 5;
  const int wm = w >> 1, wn = w & 1;
  float* Ct = (float*)smem;
#pragma unroll
  for (int tm = 0; tm < TM; tm++)
#pragma unroll
    for (int tn = 0; tn < TN; tn++)
#pragma unroll
      for (int i = 0; i < 16; i++)
        Ct[(wm * 32 * TM + tm * 32 + crow(i, h)) * LDC + wn * 32 * TN + tn * 32 + r] = acc[tm][tn][i];
  __syncthreads();
  epi(Ct, LDC, m0, n0, tid);
  __syncthreads();
  (void)BM;
}

struct EpiStoreBf16 {
  static constexpr int PAD = 4;
  u16* out; long ldo; int nmax; float* gates;
  DI void operator()(const float* Ct, int ldc, int m0, int n0, int tid) const {
#pragma unroll
    for (int it = 0; it < 8; it++) {
      int id = tid + 256 * it; int row = id >> 4, c8 = (id & 15) * 8;
      int n = n0 + c8;
      if (n < nmax) {
        const float* c = Ct + row * ldc + c8;
        float4 a = *(const float4*)c, b = *(const float4*)(c + 4);
        uint4 v; v.x = pk2(a.x, a.y); v.y = pk2(a.z, a.w); v.z = pk2(b.x, b.y); v.w = pk2(b.z, b.w);
        *(uint4*)(out + (long)(m0 + row) * ldo + n) = v;
        if (gates != nullptr && n == 1952) {
          float* g = gates + (long)(m0 + row) * 8;
          *(float4*)g = a; *(float4*)(g + 4) = b;
        }
      }
    }
  }
};
struct EpiRelu2 {
  static constexpr int PAD = 4;
  u16* out; long ldo;
  DI void operator()(const float* Ct, int ldc, int m0, int n0, int tid) const {
#pragma unroll
    for (int it = 0; it < 8; it++) {
      int id = tid + 256 * it; int row = id >> 4, c8 = (id & 15) * 8;
      const float* c = Ct + row * ldc + c8;
      float x[8];
#pragma unroll
      for (int j = 0; j < 8; j++) { float v = fmaxf(c[j], 0.f); x[j] = v * v; }
      *(uint4*)(out + (long)(m0 + row) * ldo + n0 + c8) = pack8(x);
    }
  }
};
struct EpiF32 {
  static constexpr int PAD = 4;
  float* out; long ldo;
  DI void operator()(const float* Ct, int ldc, int m0, int n0, int tid) const {
#pragma unroll
    for (int it = 0; it < 8; it++) {
      int id = tid + 256 * it; int row = id >> 4, c8 = (id & 15) * 8;
      const float* c = Ct + row * ldc + c8;
      float* o = out + (long)(m0 + row) * ldo + n0 + c8;
      *(float4*)o = *(const float4*)c; *(float4*)(o + 4) = *(const float4*)(c + 4);
    }
  }
};
struct EpiRes {
  static constexpr int PAD = 4;
  const float* src0; const float* src1; float* dst;
  DI void operator()(const float* Ct, int ldc, int m0, int n0, int tid) const {
#pragma unroll
    for (int it = 0; it < 8; it++) {
      int id = tid + 256 * it; int row = id >> 4, c8 = (id & 15) * 8;
      int m = m0 + row;
      const float* s = (m < NP ? src0 + (size_t)m * 1024 : src1 + (size_t)(m - NP) * 1024) + n0 + c8;
      const float* c = Ct + row * ldc + c8;
      float4 a = *(const float4*)c, b = *(const float4*)(c + 4);
      float4 sa = *(const float4*)s, sb = *(const float4*)(s + 4);
      a.x += sa.x; a.y += sa.y; a.z += sa.z; a.w += sa.w; b.x += sb.x; b.y += sb.y; b.z += sb.z; b.w += sb.w;
      float* o = dst + (size_t)m * 1024 + n0 + c8;
      *(float4*)o = a; *(float4*)(o + 4) = b;
    }
  }
};
struct EpiQ {
  static constexpr int PAD = 1;
  u16* q; const float* rq; const float2* rope; const float* g;
  DI void operator()(const float* Ct, int ldc, int m0, int n0, int tid) const {
    if (tid < 128) {
      int row = tid >> 1, hh = tid & 1; int m = m0 + row;
      const float* c = Ct + row * ldc + hh * 96;
      float rqv = rq[m];
      float ss = 0.f;
#pragma unroll 8
      for (int d = 0; d < 96; d++) ss += c[d] * c[d];
      ss *= rqv * rqv;
      float r2 = rsqrtf(ss * (1.f / 96.f) + EPS) * rqv * (0.10206207261596575f * LOG2E);
      u16* o = q + (size_t)m * 768 + n0 + hh * 96;
#pragma unroll
      for (int c8 = 0; c8 < 8; c8++) {
        float x[8];
#pragma unroll
        for (int j = 0; j < 8; j++) x[j] = c[c8 * 8 + j] * r2 * g[c8 * 8 + j];
        *(uint4*)(o + c8 * 8) = pack8(x);
      }
      const float2* tab = rope + (size_t)tok_pos(m) * 16;
#pragma unroll
      for (int half = 0; half < 2; half++) {
        float x1[8], x2[8];
#pragma unroll
        for (int j = 0; j < 8; j++) {
          int i = half * 8 + j;
          float a = c[64 + i], b = c[80 + i]; float2 cs = tab[i];
          x1[j] = (a * cs.x - b * cs.y) * r2 * g[64 + i];
          x2[j] = (a * cs.y + b * cs.x) * r2 * g[80 + i];
        }
        *(uint4*)(o + 64 + half * 8) = pack8(x1);
        *(uint4*)(o + 80 + half * 8) = pack8(x2);
      }
    }
  }
};
struct EpiKV {
  static constexpr int PAD = 1;
  u16* Kb; u16* Vt; const float* krope; const float* g;
  DI void operator()(const float* Ct, int ldc, int m0, int n0, int tid) const {
    const int hd = n0 >> 7;
#pragma unroll
    for (int it = 0; it < 4; it++) {
      int id = tid + 256 * it; int oct = id & 15, e = id >> 4;
      float x[8];
#pragma unroll
      for (int j = 0; j < 8; j++) x[j] = Ct[(oct * 8 + j) * ldc + 64 + e];
      *(uint4*)(Vt + (size_t)(hd * 64 + e) * LDVT + m0 + oct * 8) = pack8(x);
    }
    if (tid < 128) {
      int row = tid;
      const float* c = Ct + row * ldc;
      const float* kr = krope + (size_t)(m0 + row) * 32;
      float ss = 0.f;
#pragma unroll 8
      for (int d = 0; d < 64; d++) ss += c[d] * c[d];
#pragma unroll 8
      for (int d = 0; d < 32; d++) ss += kr[d] * kr[d];
      float rr = rsqrtf(ss * (1.f / 96.f) + EPS);
      u16* o = Kb + ((size_t)hd * NROWS + m0 + row) * 96;
#pragma unroll
      for (int c8 = 0; c8 < 8; c8++) {
        float x[8];
#pragma unroll
        for (int j = 0; j < 8; j++) x[j] = c[c8 * 8 + j] * rr * g[c8 * 8 + j];
        *(uint4*)(o + c8 * 8) = pack8(x);
      }
#pragma unroll
      for (int c8 = 0; c8 < 4; c8++) {
        float x[8];
#pragma unroll
        for (int j = 0; j < 8; j++) x[j] = kr[c8 * 8 + j] * rr * g[64 + c8 * 8 + j];
        *(uint4*)(o + 64 + c8 * 8) = pack8(x);
      }
    }
  }
};

template <int DQK, int NE, int EV, bool DB, bool QNORM, bool QREG>
DI void flash_item(const u16* Qrow, bool wave_active, int ntb, int ntw, const u16* Kbase, long ldk, const u16* Vtbase, long ldv,
                   int e0, u16* Orow, char* smem) {
  constexpr int LDK = DQK + 8, LDV = 72;
  constexpr int KS = DQK / 16;
  constexpr int KTILE = 64 * LDK, VTILE = EV * LDV;
  constexpr int NKC = 64 * (DQK / 8) / 256;
  constexpr int NVC = EV * 8 / 256;
  u16* sK = (u16*)smem;
  u16* sV = sK + (DB ? 2 : 1) * KTILE;
  const int tid = tidx(), lane = tid & 63, r = lane & 31, h = lane >> 5;
  bf16x8 qf[QREG ? KS : 1];
  float rqs = 1.f;
  if (wave_active) {
    if (QREG) {
#pragma unroll
      for (int ks = 0; ks < KS; ks++) qf[QREG ? ks : 0] = *(const bf16x8*)(Qrow + ks * 16 + h * 8);
    }
    if (QNORM) {
      float ss = 0.f;
#pragma unroll
      for (int ks = 0; ks < KS; ks++) {
        bf16x8 qq = QREG ? qf[QREG ? ks : 0] : *(const bf16x8*)(Qrow + ks * 16 + h * 8);
#pragma unroll
        for (int j = 0; j < 8; j++) { float v = bf2f((u16)qq[j]); ss += v * v; }
      }
      ss += __shfl_xor(ss, 32);
      rqs = rsqrtf(ss * (1.f / DQK) + EPS);
    }
  } else if (QREG) {
#pragma unroll
    for (int ks = 0; ks < KS; ks++)
#pragma unroll
      for (int j = 0; j < 8; j++) qf[QREG ? ks : 0][j] = 0;
  }
  f32x16 o[NE];
#pragma unroll
  for (int et = 0; et < NE; et++)
#pragma unroll
    for (int i = 0; i < 16; i++) o[et][i] = 0.f;
  float mrun = 0.f, lrun = 0.f;
  const float rqinv = 1.f / rqs;

  u32x4 rk[DB ? NKC : 1], rv[DB ? NVC : 1];
  auto gload = [&](int t) {
#pragma unroll
    for (int i = 0; i < NKC; i++) {
      int id = tid + 256 * i; int row = id / (DQK / 8), ch = id % (DQK / 8);
      u32x4 v = *(const u32x4*)(Kbase + (long)(t * 64 + row) * ldk + ch * 8);
      if (DB) rk[DB ? i : 0] = v; else *(u32x4*)(sK + row * LDK + ch * 8) = v;
    }
#pragma unroll
    for (int i = 0; i < NVC; i++) {
      int id = tid + 256 * i; int row = id >> 3, ch = id & 7;
      u32x4 v = *(const u32x4*)(Vtbase + (long)row * ldv + t * 64 + ch * 8);
      if (DB) rv[DB ? i : 0] = v; else *(u32x4*)(sV + row * LDV + ch * 8) = v;
    }
  };
  auto sstore = [&](int buf) {
#pragma unroll
    for (int i = 0; i < NKC; i++) { int id = tid + 256 * i; int row = id / (DQK / 8), ch = id % (DQK / 8); *(u32x4*)(sK + buf * KTILE + row * LDK + ch * 8) = rk[DB ? i : 0]; }
#pragma unroll
    for (int i = 0; i < NVC; i++) { int id = tid + 256 * i; int row = id >> 3, ch = id & 7; *(u32x4*)(sV + buf * VTILE + row * LDV + ch * 8) = rv[DB ? i : 0]; }
  };
  auto compute = [&](int buf) {
    const u16* cK = sK + buf * KTILE + r * LDK + h * 8;
    const u16* cV = sV + buf * VTILE + (e0 + r) * LDV + 4 * h;
    const float sinit = QNORM ? -mrun * rqinv : -mrun;
    f32x16 s[2];
#pragma unroll
    for (int sub = 0; sub < 2; sub++) {
#pragma unroll
      for (int i = 0; i < 16; i++) s[sub][i] = sinit;
#pragma unroll
      for (int ks = 0; ks < KS; ks++) {
        bf16x8 a = *(const bf16x8*)(cK + sub * 32 * LDK + ks * 16);
        bf16x8 qq = QREG ? qf[QREG ? ks : 0] : *(const bf16x8*)(Qrow + ks * 16 + h * 8);
        s[sub] = MFMA(a, qq, s[sub]);
      }
    }
    float mx = -1e30f;
#pragma unroll
    for (int sub = 0; sub < 2; sub++)
#pragma unroll
      for (int i = 0; i < 16; i++) { if (QNORM) s[sub][i] *= rqs; mx = fmaxf(mx, s[sub][i]); }
    mx = fmaxf(mx, __shfl_xor(mx, 32));
    if (__any(mx > 8.f)) {
      const float d = fmaxf(mx, 0.f);
      const float alpha = exp2f(-d);
      mrun += d;
      lrun *= alpha;
#pragma unroll
      for (int et = 0; et < NE; et++)
#pragma unroll
        for (int i = 0; i < 16; i++) o[et][i] *= alpha;
#pragma unroll
      for (int sub = 0; sub < 2; sub++)
#pragma unroll
        for (int i = 0; i < 16; i++) s[sub][i] -= d;
    }
    float psum = 0.f;
#pragma unroll
    for (int sub = 0; sub < 2; sub++)
#pragma unroll
      for (int i = 0; i < 16; i++) { float pv = exp2f(s[sub][i]); s[sub][i] = pv; psum += pv; }
    lrun += psum;
#pragma unroll
    for (int sub = 0; sub < 2; sub++)
#pragma unroll
      for (int st = 0; st < 2; st++) {
        uint4 pp;
        pp.x = pk2(s[sub][8 * st + 0], s[sub][8 * st + 1]); pp.y = pk2(s[sub][8 * st + 2], s[sub][8 * st + 3]);
        pp.z = pk2(s[sub][8 * st + 4], s[sub][8 * st + 5]); pp.w = pk2(s[sub][8 * st + 6], s[sub][8 * st + 7]);
        bf16x8 pb = __builtin_bit_cast(bf16x8, pp);
#pragma unroll
        for (int et = 0; et < NE; et++) {
          const u16* vp = cV + et * 32 * LDV + sub * 32 + st * 16;
          s16x4 lo = *(const s16x4*)vp;
          s16x4 hi = *(const s16x4*)(vp + 8);
          bf16x8 a = __builtin_shufflevector(lo, hi, 0, 1, 2, 3, 4, 5, 6, 7);
          o[et] = MFMA(a, pb, o[et]);
        }
      }
  };

  __syncthreads();
  if (DB) {
    gload(0);
    sstore(0);
    __syncthreads();
    for (int t = 0; t < ntb; t++) {
      const bool more = (t + 1 < ntb);
      if (more) gload(t + 1);
      __builtin_amdgcn_sched_barrier(0);
      if (wave_active && t < ntw) compute(t & 1);
      if (more) sstore((t + 1) & 1);
      __syncthreads();
    }
  } else {
    for (int t = 0; t < ntb; t++) {
      if (t > 0) __syncthreads();
      gload(t);
      __syncthreads();
      if (wave_active && t < ntw) compute(0);
    }
    __syncthreads();
  }
  if (wave_active) {
    float lt = lrun + __shfl_xor(lrun, 32);
    float inv = 1.f / lt;
#pragma unroll
    for (int et = 0; et < NE; et++)
#pragma unroll
      for (int g = 0; g < 4; g++) {
        uint2 v;
        v.x = pk2(o[et][4 * g + 0] * inv, o[et][4 * g + 1] * inv);
        v.y = pk2(o[et][4 * g + 2] * inv, o[et][4 * g + 3] * inv);
        *(uint2*)(Orow + et * 32 + 8 * g + 4 * h) = v;
      }
  }
}

DI void norm_row_wave(const float* src, u16* dst, int lane) {
  float4 v[4]; float ss = 0.f;
#pragma unroll
  for (int i = 0; i < 4; i++) { v[i] = *(const float4*)(src + i * 256 + lane * 4); ss += v[i].x * v[i].x + v[i].y * v[i].y + v[i].z * v[i].z + v[i].w * v[i].w; }
  ss = wave_sum(ss);
  float rr = rsqrtf(ss * (1.f / 1024.f) + EPS);
#pragma unroll
  for (int i = 0; i < 4; i++) {
    uint2 o; o.x = pk2(v[i].x * rr, v[i].y * rr); o.y = pk2(v[i].z * rr, v[i].w * rr);
    *(uint2*)(dst + i * 256 + lane * 4) = o;
  }
}

DI void phase_norm(const Params& p, int l) {
  const int lane = tidx() & 63, w = tidx() >> 6;
  u16* act = wsb(p, WS_ACT);
  for (int t = blockIdx.x * 4 + w; t < NTOK; t += gridDim.x * 4) norm_row_wave(xrow(p, l, t), act + (size_t)t * LDA, lane);
}

DI void wtile(const float* src, const float* gain, int K, int N, u16* dst, int ldd, int k0, int n0, char* smem) {
  u16* T = (u16*)smem;
  const int tid = tidx();
  __syncthreads();
  {
    const int nn = tid & 63, kk0 = tid >> 6;
    const int n = n0 + nn;
#pragma unroll 4
    for (int i = 0; i < 16; i++) {
      int kk = kk0 + 4 * i;
      float v = 0.f;
      if (n < N) { v = src[(size_t)(k0 + kk) * N + n]; if (gain) v *= gain[k0 + kk]; }
      T[nn * 72 + kk] = f2bf(v);
    }
  }
  __syncthreads();
  {
    const int nn = tid >> 2, kq = tid & 3;
    const uint4* s = (const uint4*)(T + nn * 72 + kq * 16);
    uint4* d = (uint4*)(dst + (size_t)(n0 + nn) * ldd + k0 + kq * 16);
    d[0] = s[0]; d[1] = s[1];
  }
}

DI void phase_prep(const Params& p, char* smem) {
  const int tid = tidx(), lane = tid & 63, w = tid >> 6;
  for (int t = blockIdx.x; t < 2 * 4048; t += gridDim.x) {
    int l = t / 4048, u = t % 4048;
    const float* src; const float* gain = nullptr; int K, N, Npad; size_t doff; int ldd = LDW;
    if (u < 640) { src = p.w_in + (size_t)l * 1024 * INC; gain = p.g_mix + l * 1024; K = 1024; N = INC; Npad = 2560; doff = W_IN; }
    else if (u < 688) { u -= 640; src = p.w_q_up + (size_t)l * 256 * 768; gain = p.g_qa + l * 256; K = 256; N = 768; Npad = 768; doff = W_Q; ldd = LDWQ; }
    else if (u < 720) { u -= 688; src = p.w_kv_up + (size_t)l * 128 * 1024; K = 128; N = 1024; Npad = 1024; doff = W_KV; ldd = LDWKV; }
    else if (u < 976) { u -= 720; src = p.w_out + (size_t)l * 1048576; K = 1024; N = 1024; Npad = 1024; doff = W_OUT; }
    else if (u < 1232) { u -= 976; src = p.w_xq + (size_t)l * 1048576; gain = p.g_xattn + l * 1024; K = 1024; N = 1024; Npad = 1024; doff = W_XQ; }
    else if (u < 1488) { u -= 1232; src = p.w_xk + (size_t)l * 1048576; gain = p.g_mem + l * 1024; K = 1024; N = 1024; Npad = 1024; doff = W_XK; }
    else if (u < 1744) { u -= 1488; src = p.w_xv + (size_t)l * 1048576; gain = p.g_mem + l * 1024; K = 1024; N = 1024; Npad = 1024; doff = W_XV; }
    else if (u < 2000) { u -= 1744; src = p.w_xo + (size_t)l * 1048576; K = 1024; N = 1024; Npad = 1024; doff = W_XO; }
    else if (u < 3024) { u -= 2000; src = p.w_ff1 + (size_t)l * 4194304; gain = p.g_mlp + l * 1024; K = 1024; N = 4096; Npad = 4096; doff = W_FF1; }
    else { u -= 3024; src = p.w_ff2 + (size_t)l * 4194304; K = 4096; N = 1024; Npad = 1024; doff = W_FF2; ldd = LDW2; }
    int nt = Npad / 64;
    int kt = u / nt, ntile = u % nt;
    wtile(src, gain, K, N, wsb(p, WS_W) + (size_t)l * W_LAYER + doff, ldd, kt * 64, ntile * 64, smem);
  }
  float2* tab = (float2*)(p.ws + WS_ROPE);
  for (int t = blockIdx.x; t < 1024; t += gridDim.x) {
    int idx = t * 256 + tid; int pos = idx >> 4, i = idx & 15;
    float inv_freq = exp2f(-(float)i * 0.830482023721841f);
    float ang = (float)pos * inv_freq;
    double rev = (double)ang * 0.15915494309189535;
    rev -= rint(rev);
    float fr = (float)rev;
    tab[idx] = make_float2(__builtin_amdgcn_cosf(fr), __builtin_amdgcn_sinf(fr));
  }
  u16* hm = wsb(p, WS_HM);
  for (int t = blockIdx.x * 4 + w; t < 512; t += gridDim.x * 4) norm_row_wave(p.mem_prompt + (size_t)t * 1024, hm + (size_t)t * LDA, lane);
  phase_norm(p, 0);
}

template <class Epi>
DI void phase_gemm128(const Sched& sc, const u16* A, long lda, const u16* Bt, long ldb, int K, int MT, int NT, int SN, char* smem, const Epi& epi);
DI void phase_inproj(const Params& p, const Sched& sc, int l, char* smem) {
  const u16* W = wsb(p, WS_W) + (size_t)l * W_LAYER;
  {
    EpiStoreBf16 epi{wsb(p, WS_BIG + B_P), INC, INC, wsf(p, WS_GATES)};
    phase_gemm128(sc, wsb(p, WS_ACT), LDA, W + W_IN, LDW, 1024, 272, 20, 4, smem, epi);
  }
  if (l == 0) {
    for (int u = blockIdx.x; u < 128; u += gridDim.x) {
      int l2 = u >> 6, which = (u >> 5) & 1, mt = (u >> 3) & 3, nt = u & 7;
      const u16* W2 = wsb(p, WS_W) + (size_t)l2 * W_LAYER + (which ? W_XV : W_XK);
      EpiF32 epi{p.out + (which ? O_PMEMV : O_PMEMK) + (size_t)l2 * 524288, 1024};
      gemm_tile<2, 2>(wsb(p, WS_HM), LDA, W2, LDW, 1024, mt * 128, nt * 128, smem, epi);
    }
  }
}

DI void post_token(const Params& p, int l, int tok, int lane) {
  const u16* pr = wsb(p, WS_BIG + B_P) + (size_t)tok * INC;
  {
    uint2 q4 = *(const uint2*)(pr + lane * 4);
    float a = bflo(q4.x), b = bfhi(q4.x), c = bflo(q4.y), d = bfhi(q4.y);
    float ss = wave_sum(a * a + b * b + c * c + d * d);
    if (lane == 0) wsf(p, WS_RQ)[tok] = rsqrtf(ss * (1.f / 256.f) + EPS);
  }
  const bool prompt = tok < NP;
  int b, s, row, pos; float* ckv_out; float* kr_out;
  if (prompt) {
    b = tok >> 14; s = tok & 16383; row = tok; pos = s;
    ckv_out = p.out + O_PCKV + ((size_t)(l * 2 + b) * 16384 + s) * 128;
    kr_out = p.out + O_PKROPE + ((size_t)(l * 2 + b) * 16384 + s) * 32;
  } else {
    int t2 = tok - NP; b = t2 >> 6; s = t2 & 63; row = NP + b * 1088 + 1024 + s; pos = 1024 + s;
    ckv_out = p.out + O_SCKV + ((size_t)(l * 32 + b) * 64 + s) * 128;
    kr_out = p.out + O_SKROPE + ((size_t)(l * 32 + b) * 64 + s) * 32;
  }
  {
    unsigned c2 = *(const unsigned*)(pr + 256 + lane * 2);
    float c0 = bflo(c2), c1 = bfhi(c2);
    float ss = wave_sum(c0 * c0 + c1 * c1);
    float rr = rsqrtf(ss * (1.f / 128.f) + EPS);
    float o0 = c0 * rr * p.g_kva[l * 128 + lane * 2], o1 = c1 * rr * p.g_kva[l * 128 + lane * 2 + 1];
    *(float2*)(ckv_out + lane * 2) = make_float2(o0, o1);
    *(unsigned*)(wsb(p, WS_CKV) + (size_t)row * 128 + lane * 2) = pk2(o0, o1);
  }
  if (lane < 16) {
    float x1 = bf2f(pr[384 + lane]), x2 = bf2f(pr[400 + lane]);
    float2 cs = ((const float2*)(p.ws + WS_ROPE))[(size_t)pos * 16 + lane];
    float o1 = x1 * cs.x - x2 * cs.y, o2 = x1 * cs.y + x2 * cs.x;
    kr_out[lane] = o1; kr_out[16 + lane] = o2;
    float* ka = wsf(p, WS_KROPE) + (size_t)row * 32;
    ka[lane] = o1; ka[16 + lane] = o2;
  }
  const int S = prompt ? 16384 : 64;
  if (s >= S - 3) {
    int j = s - (S - 3);
    float* dst = prompt ? p.out + O_PCONV + ((size_t)(l * 2 + b) * 3 + j) * 1024 : p.out + O_SCONV + ((size_t)(l * 32 + b) * 3 + j) * 1024;
#pragma unroll 4
    for (int i = 0; i < 16; i++) dst[lane + 64 * i] = bf2f(pr[416 + lane + 64 * i]);
  }
}

DI void post_past(const Params& p, int l, int pi, int lane) {
  int b = pi >> 10, t = pi & 1023;
  size_t row = (size_t)NP + b * 1088 + t;
  const float* src = p.cache_ckv + ((size_t)(l * 32 + b) * 1024 + t) * 128;
  float2 v = *(const float2*)(src + lane * 2);
  *(unsigned*)(wsb(p, WS_CKV) + row * 128 + lane * 2) = pk2(v.x, v.y);
  if (lane < 32) wsf(p, WS_KROPE)[row * 32 + lane] = p.cache_krope[((size_t)(l * 32 + b) * 1024 + t) * 32 + lane];
}

struct ChunkInfo { int tok0, b, h, chain, has_prev, sample; };
DI ChunkInfo chunk_info(int item) {
  ChunkInfo ci;
  if (item < 2048) {
    ci.chain = item >> 8; ci.b = ci.chain >> 2; ci.h = ci.chain & 3; int c = item & 255;
    ci.tok0 = ci.b * 16384 + c * 64; ci.has_prev = (c > 0); ci.sample = 0;
  } else {
    int j = item - 2048; ci.chain = 8 + j; ci.b = j >> 2; ci.h = j & 3; ci.tok0 = NP + ci.b * 64; ci.has_prev = 0; ci.sample = 1;
  }
  return ci;
}
DI void load_x8(const Params& p, int l, const ChunkInfo& ci, int tp, int col, float (&x)[8]) {
  if (tp >= 0 || ci.has_prev) {
    uint4 v = *(const uint4*)(wsb(p, WS_BIG + B_P) + (size_t)(ci.tok0 + tp) * INC + col);
    unpack8(v, x);
  } else if (ci.sample) {
    const float* s = p.st_conv + (((size_t)l * 32 + ci.b) * 3 + (3 + tp)) * 1024 + (col - 416);
    float4 a = *(const float4*)s, b = *(const float4*)(s + 4);
    x[0] = a.x; x[1] = a.y; x[2] = a.z; x[3] = a.w; x[4] = b.x; x[5] = b.y; x[6] = b.z; x[7] = b.w;
  } else {
#pragma unroll
    for (int j = 0; j < 8; j++) x[j] = 0.f;
  }
}
template <class Emit>
DI void conv_run(const Params& p, int l, const ChunkInfo& ci, int mat, int chunk, int row0, int nrows, Emit emit) {
  const int ch0 = mat * 512 + ci.h * 128 + chunk * 8;
  const int col = 416 + ch0;
  float w0[8], w1[8], w2[8], w3[8], bias[8];
  {
    const float* wc = p.w_conv + (size_t)l * 4096 + ch0;
    float4 a, b;
    a = *(const float4*)(wc); b = *(const float4*)(wc + 4);
    w0[0] = a.x; w0[1] = a.y; w0[2] = a.z; w0[3] = a.w; w0[4] = b.x; w0[5] = b.y; w0[6] = b.z; w0[7] = b.w;
    a = *(const float4*)(wc + 1024); b = *(const float4*)(wc + 1028);
    w1[0] = a.x; w1[1] = a.y; w1[2] = a.z; w1[3] = a.w; w1[4] = b.x; w1[5] = b.y; w1[6] = b.z; w1[7] = b.w;
    a = *(const float4*)(wc + 2048); b = *(const float4*)(wc + 2052);
    w2[0] = a.x; w2[1] = a.y; w2[2] = a.z; w2[3] = a.w; w2[4] = b.x; w2[5] = b.y; w2[6] = b.z; w2[7] = b.w;
    a = *(const float4*)(wc + 3072); b = *(const float4*)(wc + 3076);
    w3[0] = a.x; w3[1] = a.y; w3[2] = a.z; w3[3] = a.w; w3[4] = b.x; w3[5] = b.y; w3[6] = b.z; w3[7] = b.w;
    const float* bc = p.b_conv + (size_t)l * 1024 + ch0;
    a = *(const float4*)(bc); b = *(const float4*)(bc + 4);
    bias[0] = a.x; bias[1] = a.y; bias[2] = a.z; bias[3] = a.w; bias[4] = b.x; bias[5] = b.y; bias[6] = b.z; bias[7] = b.w;
  }
  float xa[8], xb[8], xc[8], xd[8];
  load_x8(p, l, ci, row0 - 3, col, xa);
  load_x8(p, l, ci, row0 - 2, col, xb);
  load_x8(p, l, ci, row0 - 1, col, xc);
  for (int t = row0; t < row0 + nrows; t++) {
    load_x8(p, l, ci, t, col, xd);
    float y[8];
#pragma unroll
    for (int j = 0; j < 8; j++) {
      float v = bias[j] + xa[j] * w0[j] + xb[j] * w1[j] + xc[j] * w2[j] + xd[j] * w3[j];
      y[j] = v / (1.f + __expf(-v));
      xa[j] = xb[j]; xb[j] = xc[j]; xc[j] = xd[j];
    }
    emit(t, y);
  }
}
DI float logsigmoid(float z) { return fminf(z, 0.f) - log1pf(__expf(-fabsf(z))); }

DI void mlstm_m1(const Params& p, int l, int item, char* smem) {
  const ChunkInfo ci = chunk_info(item);
  const int tid = tidx(), lane = tid & 63, w = tid >> 6, r = lane & 31, h = lane >> 5;
  u16* sVt = (u16*)smem;
  u16* sKt = sVt + 128 * 72;
  float* swk = (float*)(sKt + 128 * 72);
  __syncthreads();
  if (w == 0) {
    const float* g = wsf(p, WS_GATES) + (size_t)(ci.tok0 + lane) * 8;
    float ig = g[ci.h] + p.b_igate[l * 4 + ci.h];
    float lf = logsigmoid(g[4 + ci.h] + p.b_fgate[l * 4 + ci.h]);
    float bcs = lf;
#pragma unroll
    for (int o = 1; o < 64; o <<= 1) { float t = __shfl_up(bcs, o); if (lane >= o) bcs += t; }
    float u = ig - bcs;
    float umax = wave_max(u);
    swk[lane] = __expf(u - umax);
    float blast = __shfl(bcs, 63);
    if (lane == 0) { float* sc = wsf(p, WS_SCAL) + (size_t)item * 2; sc[0] = blast; sc[1] = blast + umax; }
  }
#pragma unroll
  for (int it = 0; it < 4; it++) {
    int id = tid + 256 * it; int s = id >> 4, ch = id & 15;
    uint4 v = *(const uint4*)(wsb(p, WS_BIG + B_P) + (size_t)(ci.tok0 + s) * INC + 1440 + ci.h * 128 + ch * 8);
    const u16* vv = (const u16*)&v;
    unsigned a[4] = {v.x, v.y, v.z, v.w};
#pragma unroll
    for (int j = 0; j < 4; j++) { sVt[(ch * 8 + 2 * j) * 72 + s] = (u16)(a[j] & 0xffffu); sVt[(ch * 8 + 2 * j + 1) * 72 + s] = (u16)(a[j] >> 16); }
    (void)vv;
  }
  __syncthreads();
  {
    const int chunk = tid & 15, rg = tid >> 4;
    conv_run(p, l, ci, 1, chunk, rg * 4, 4, [&](int t, const float (&y)[8]) {
      float sc = 0.08838834764831845f * swk[t];
#pragma unroll
      for (int j = 0; j < 8; j++) sKt[(chunk * 8 + j) * 72 + t] = f2bf(y[j] * sc);
    });
  }
  __syncthreads();
  const int wm = w >> 1, wn = w & 1;
  f32x16 acc[2][2];
#pragma unroll
  for (int a = 0; a < 2; a++)
#pragma unroll
    for (int b = 0; b < 2; b++)
#pragma unroll
      for (int i = 0; i < 16; i++) acc[a][b][i] = 0.f;
#pragma unroll
  for (int ks = 0; ks < 4; ks++) {
    bf16x8 af[2], bfr[2];
#pragma unroll
    for (int tm = 0; tm < 2; tm++) af[tm] = *(const bf16x8*)(sVt + (wm * 64 + tm * 32 + r) * 72 + ks * 16 + h * 8);
#pragma unroll
    for (int tn = 0; tn < 2; tn++) bfr[tn] = *(const bf16x8*)(sKt + (wn * 64 + tn * 32 + r) * 72 + ks * 16 + h * 8);
#pragma unroll
    for (int tm = 0; tm < 2; tm++)
#pragma unroll
      for (int tn = 0; tn < 2; tn++) acc[tm][tn] = MFMA(af[tm], bfr[tn], acc[tm][tn]);
  }
  u16* slot = wsb(p, WS_BIG + B_ST) + (size_t)item * 16384;
#pragma unroll
  for (int tm = 0; tm < 2; tm++)
#pragma unroll
    for (int tn = 0; tn < 2; tn++)
#pragma unroll
      for (int i = 0; i < 16; i++) slot[(wm * 64 + tm * 32 + crow(i, h)) * 128 + wn * 64 + tn * 32 + r] = f2bf(acc[tm][tn][i]);
  if (tid < 128) {
    float sum = 0.f;
    const u16* kr = sKt + tid * 72;
#pragma unroll 8
    for (int s = 0; s < 64; s++) sum += bf2f(kr[s]);
    wsf(p, WS_NU)[(size_t)item * 128 + tid] = sum;
  }
}

DI void mlstm_m2(const Params& p, int l, int unit) {
  const int tid = tidx();
  int chain, g, nc, item0, b, h; bool sample;
  if (unit < 256) { chain = unit >> 5; g = unit & 31; nc = 256; item0 = chain * 256; b = chain >> 2; h = chain & 3; sample = false; }
  else { int u = unit - 256; int j = u >> 5; g = u & 31; chain = 8 + j; nc = 1; item0 = 2048 + j; b = j >> 2; h = j & 3; sample = true; }
  const int el = g * 512 + tid * 2; const int e = el >> 7, d = el & 127;
  float c0 = 0.f, c1 = 0.f, nst = 0.f, m = 0.f;
  const bool do_n = (g == 0 && tid < 128);
  if (sample) {
    const float* C0 = p.st_C + ((size_t)(l * 32 + b) * 4 + h) * 16384;
    c0 = C0[d * 128 + e]; c1 = C0[(d + 1) * 128 + e];
    if (do_n) nst = p.st_n[((size_t)(l * 32 + b) * 4 + h) * 128 + tid];
    m = p.st_m[(l * 32 + b) * 4 + h];
  }
  u16* slots = wsb(p, WS_BIG + B_ST);
  const float* scal = wsf(p, WS_SCAL);
  float* nu = wsf(p, WS_NU);
  float* mst = wsf(p, WS_MST);
  for (int cb = 0; cb < nc; cb += 8) {
    unsigned uu[8]; float nn[8];
#pragma unroll
    for (int j = 0; j < 8; j++) {
      uu[j] = 0; nn[j] = 0.f;
      if (cb + j < nc) {
        uu[j] = *(const unsigned*)(slots + (size_t)(item0 + cb + j) * 16384 + el);
        if (do_n) nn[j] = nu[(size_t)(item0 + cb + j) * 128 + tid];
      }
    }
#pragma unroll
    for (int j = 0; j < 8; j++) {
      if (cb + j < nc) {
        const int item = item0 + cb + j;
        const float A = scal[item * 2], Cm = scal[item * 2 + 1];
        const float mnew = fmaxf(A + m, Cm);
        const float dec = __expf(A + m - mnew), us = __expf(Cm - mnew);
        *(unsigned*)(slots + (size_t)item * 16384 + el) = pk2(c0, c1);
        c0 = dec * c0 + us * bflo(uu[j]);
        c1 = dec * c1 + us * bfhi(uu[j]);
        if (do_n) { nu[(size_t)item * 128 + tid] = nst; nst = dec * nst + us * nn[j]; }
        if (g == 0 && tid == 0) mst[item] = m;
        m = mnew;
      }
    }
  }
  float* oC = sample ? p.out + O_SC + ((size_t)(l * 32 + b) * 4 + h) * 16384 : p.out + O_PC + ((size_t)(l * 2 + b) * 4 + h) * 16384;
  oC[d * 128 + e] = c0; oC[(d + 1) * 128 + e] = c1;
  if (do_n) { float* on = sample ? p.out + O_SN + ((size_t)(l * 32 + b) * 4 + h) * 128 : p.out + O_PN + ((size_t)(l * 2 + b) * 4 + h) * 128; on[tid] = nst; }
  if (g == 0 && tid == 0) { float* om = sample ? p.out + O_SM + (l * 32 + b) * 4 + h : p.out + O_PM + (l * 2 + b) * 4 + h; *om = m; }
}

DI void mlstm_m3(const Params& p, int l, int item, char* smem) {
  const ChunkInfo ci = chunk_info(item);
  const int tid = tidx(), lane = tid & 63, w = tid >> 6, r = lane & 31, h = lane >> 5;
  u16* sQ = (u16*)smem;
  u16* sK = sQ + 64 * 136;
  u16* sVt = sK + 64 * 136;
  u16* sP = sVt + 128 * 72;
  float* su = (float*)(sP + 64 * 72);
  float* sM = su + 64;
  float* sa = sM + 64;
  float* sden = sa + 64;
  float* sinv = sden + 64;
  float* sn = sinv + 64;
  float* sH = (float*)smem;
  __syncthreads();
  const float m_start = wsf(p, WS_MST)[item];
  if (w == 0) {
    const float* g = wsf(p, WS_GATES) + (size_t)(ci.tok0 + lane) * 8;
    float ig = g[ci.h] + p.b_igate[l * 4 + ci.h];
    float lf = logsigmoid(g[4 + ci.h] + p.b_fgate[l * 4 + ci.h]);
    float bcs = lf;
#pragma unroll
    for (int o = 1; o < 64; o <<= 1) { float t = __shfl_up(bcs, o); if (lane >= o) bcs += t; }
    float u = ig - bcs;
    float cm = u;
#pragma unroll
    for (int o = 1; o < 64; o <<= 1) { float t = __shfl_up(cm, o); if (lane >= o) cm = fmaxf(cm, t); }
    float Mt = fmaxf(m_start, cm);
    su[lane] = u; sM[lane] = Mt; sa[lane] = __expf(m_start - Mt); sden[lane] = __expf(-(bcs + Mt));
  } else if (w == 1) {
    sn[lane] = wsf(p, WS_NU)[(size_t)item * 128 + lane];
    sn[lane + 64] = wsf(p, WS_NU)[(size_t)item * 128 + lane + 64];
  }
#pragma unroll
  for (int it = 0; it < 4; it++) {
    int id = tid + 256 * it; int s = id >> 4, ch = id & 15;
    uint4 v = *(const uint4*)(wsb(p, WS_BIG + B_P) + (size_t)(ci.tok0 + s) * INC + 1440 + ci.h * 128 + ch * 8);
    unsigned a[4] = {v.x, v.y, v.z, v.w};
#pragma unroll
    for (int j = 0; j < 4; j++) { sVt[(ch * 8 + 2 * j) * 72 + s] = (u16)(a[j] & 0xffffu); sVt[(ch * 8 + 2 * j + 1) * 72 + s] = (u16)(a[j] >> 16); }
  }
  {
    const int mc = tid & 31, mat = mc >> 4, chunk = mc & 15, rg = tid >> 5;
    u16* dst = mat ? sK : sQ;
    const float sc = mat ? 0.08838834764831845f : 1.f;
    conv_run(p, l, ci, mat, chunk, rg * 8, 8, [&](int t, const float (&y)[8]) {
      float x[8];
#pragma unroll
      for (int j = 0; j < 8; j++) x[j] = y[j] * sc;
      *(uint4*)(dst + t * 136 + chunk * 8) = pack8(x);
    });
  }
  __syncthreads();
  {
    const int tq = w >> 1, ts = w & 1;
    f32x16 s;
#pragma unroll
    for (int i = 0; i < 16; i++) s[i] = 0.f;
#pragma unroll
    for (int ks = 0; ks < 8; ks++) {
      bf16x8 a = *(const bf16x8*)(sQ + (tq * 32 + r) * 136 + ks * 16 + h * 8);
      bf16x8 b = *(const bf16x8*)(sK + (ts * 32 + r) * 136 + ks * 16 + h * 8);
      s = MFMA(a, b, s);
    }
    const int sidx = ts * 32 + r;
    const float us = su[sidx];
#pragma unroll
    for (int i = 0; i < 16; i++) {
      int t = tq * 32 + crow(i, h);
      float v = (sidx <= t) ? s[i] * __expf(us - sM[t]) : 0.f;
      sP[t * 72 + sidx] = f2bf(v);
    }
  }
  __syncthreads();
  if (tid < 64) {
    float rs = 0.f, qd = 0.f;
    const u16* pr = sP + tid * 72;
#pragma unroll 8
    for (int s = 0; s < 64; s++) rs += bf2f(pr[s]);
    const u16* qr = sQ + tid * 136;
#pragma unroll 8
    for (int d = 0; d < 128; d++) qd += bf2f(qr[d]) * sn[d];
    float qn = sa[tid] * qd + rs;
    sinv[tid] = 1.f / fmaxf(fabsf(qn), sden[tid]);
  }
  const int tq = w & 1, eb = (w >> 1) * 2;
  f32x16 a1[2], a2[2];
#pragma unroll
  for (int et = 0; et < 2; et++)
#pragma unroll
    for (int i = 0; i < 16; i++) { a1[et][i] = 0.f; a2[et][i] = 0.f; }
  const u16* slot = wsb(p, WS_BIG + B_ST) + (size_t)item * 16384;
#pragma unroll
  for (int ks = 0; ks < 8; ks++) {
    bf16x8 a = *(const bf16x8*)(sQ + (tq * 32 + r) * 136 + ks * 16 + h * 8);
#pragma unroll
    for (int et = 0; et < 2; et++) {
      bf16x8 b = *(const bf16x8*)(slot + ((eb + et) * 32 + r) * 128 + ks * 16 + h * 8);
      a1[et] = MFMA(a, b, a1[et]);
    }
  }
#pragma unroll
  for (int ks = 0; ks < 4; ks++) {
    bf16x8 a = *(const bf16x8*)(sP + (tq * 32 + r) * 72 + ks * 16 + h * 8);
#pragma unroll
    for (int et = 0; et < 2; et++) {
      bf16x8 b = *(const bf16x8*)(sVt + ((eb + et) * 32 + r) * 72 + ks * 16 + h * 8);
      a2[et] = MFMA(a, b, a2[et]);
    }
  }
  __syncthreads();
#pragma unroll
  for (int et = 0; et < 2; et++)
#pragma unroll
    for (int i = 0; i < 16; i++) {
      int t = tq * 32 + crow(i, h);
      sH[t * 132 + (eb + et) * 32 + r] = (sa[t] * a1[et][i] + a2[et][i]) * sinv[t];
    }
  __syncthreads();
  {
    const int t = tid >> 2, part = tid & 3;
    const float* hr = sH + t * 132 + part * 32;
    float ss = 0.f;
#pragma unroll 8
    for (int j = 0; j < 32; j++) ss += hr[j] * hr[j];
    ss += __shfl_xor(ss, 1); ss += __shfl_xor(ss, 2);
    const float rr = rsqrtf(ss * (1.f / 128.f) + EPS);
    const int tok = ci.tok0 + t;
    const u16* og = wsb(p, WS_BIG + B_P) + (size_t)tok * INC + 1960 + ci.h * 128 + part * 32;
    const float* gm = p.g_mhead + (size_t)l * 512 + ci.h * 128 + part * 32;
    u16* o = wsb(p, WS_ACT) + (size_t)tok * LDA + 512 + ci.h * 128 + part * 32;
#pragma unroll
    for (int c8 = 0; c8 < 4; c8++) {
      float gv[8], x[8];
      unpack8(*(const uint4*)(og + c8 * 8), gv);
#pragma unroll
      for (int j = 0; j < 8; j++) x[j] = hr[c8 * 8 + j] * rr * gm[c8 * 8 + j] / (1.f + __expf(-gv[j]));
      *(uint4*)(o + c8 * 8) = pack8(x);
    }
  }
}

DI void xkv_item(const Params& p, int l, int item, char* smem) {
  const int tid = tidx();
  const int kg = item & 3, hh = (item >> 2) & 3, bidx = item >> 4;
  u16* T = (u16*)smem;
  __syncthreads();
  const int key = tid >> 2, qt = tid & 3;
  const int mem = kg * 64 + key;
  const bool prompt = bidx < 2;
  float* kp; const float* vp;
  if (prompt) {
    kp = p.out + O_PMEMK + (((size_t)(l * 2 + bidx) * 256 + mem) * 4 + hh) * 256 + qt * 64;
    vp = p.out + O_PMEMV + (((size_t)(l * 2 + bidx) * 256 + mem) * 4 + hh) * 256 + qt * 64;
  } else {
    kp = (float*)(p.cache_mem_k + (((size_t)(l * 32 + bidx - 2) * 256 + mem) * 4 + hh) * 256 + qt * 64);
    vp = p.cache_mem_v + (((size_t)(l * 32 + bidx - 2) * 256 + mem) * 4 + hh) * 256 + qt * 64;
  }
  float rr = 1.f;
  if (prompt) {
    float ss = 0.f;
#pragma unroll 4
    for (int j = 0; j < 16; j++) { float4 v = *(const float4*)(kp + j * 4); ss += v.x * v.x + v.y * v.y + v.z * v.z + v.w * v.w; }
    ss += __shfl_xor(ss, 1); ss += __shfl_xor(ss, 2);
    rr = rsqrtf(ss * (1.f / 256.f) + EPS);
  }
  const float* gk = p.g_xk + l * 256 + qt * 64;
  const float* gq = p.g_xq + l * 256 + qt * 64;
  u16* xk = wsb(p, WS_BIG + B_XK) + ((size_t)(bidx * 4 + hh) * 256 + mem) * 256 + qt * 64;
#pragma unroll 2
  for (int c8 = 0; c8 < 8; c8++) {
    float4 a = *(const float4*)(kp + c8 * 8), b = *(const float4*)(kp + c8 * 8 + 4);
    float x[8] = {a.x, a.y, a.z, a.w, b.x, b.y, b.z, b.w};
    if (prompt) {
#pragma unroll
      for (int j = 0; j < 8; j++) x[j] = x[j] * rr * gk[c8 * 8 + j];
      *(float4*)(kp + c8 * 8) = make_float4(x[0], x[1], x[2], x[3]);
      *(float4*)(kp + c8 * 8 + 4) = make_float4(x[4], x[5], x[6], x[7]);
    }
#pragma unroll
    for (int j = 0; j < 8; j++) x[j] = x[j] * gq[c8 * 8 + j] * (0.0625f * LOG2E);
    *(uint4*)(xk + c8 * 8) = pack8(x);
    float4 va = *(const float4*)(vp + c8 * 8), vb = *(const float4*)(vp + c8 * 8 + 4);
    float y[8] = {va.x, va.y, va.z, va.w, vb.x, vb.y, vb.z, vb.w};
    *(uint4*)(T + key * 264 + qt * 64 + c8 * 8) = pack8(y);
  }
  __syncthreads();
  {
    const int e = tid;
    u16* xv = wsb(p, WS_BIG + B_XVT) + ((size_t)(bidx * 4 + hh) * 256 + e) * LDXV + kg * 64;
#pragma unroll 2
    for (int oct = 0; oct < 8; oct++) {
      uint4 v;
      v.x = (unsigned)T[(oct * 8 + 0) * 264 + e] | ((unsigned)T[(oct * 8 + 1) * 264 + e] << 16);
      v.y = (unsigned)T[(oct * 8 + 2) * 264 + e] | ((unsigned)T[(oct * 8 + 3) * 264 + e] << 16);
      v.z = (unsigned)T[(oct * 8 + 4) * 264 + e] | ((unsigned)T[(oct * 8 + 5) * 264 + e] << 16);
      v.w = (unsigned)T[(oct * 8 + 6) * 264 + e] | ((unsigned)T[(oct * 8 + 7) * 264 + e] << 16);
      *(uint4*)(xv + oct * 8) = v;
    }
  }
}

DI void phase_C2(const Params& p, int l, char* smem) {
  for (int t = blockIdx.x; t < 544; t += gridDim.x) xkv_item(p, l, t, smem);
}
DI void phase_C1(const Params& p, int l, char* smem) {
  const int lane = tidx() & 63, w = tidx() >> 6;
  for (int t = blockIdx.x; t < NITEM; t += gridDim.x) mlstm_m1(p, l, t, smem);
  for (int t = blockIdx.x * 4 + w; t < NTOK + 32768; t += gridDim.x * 4) {
    if (t < NTOK) post_token(p, l, t, lane); else post_past(p, l, t - NTOK, lane);
  }
}

DI void phase_D(const Params& p, int l, char* smem) {
  const int n_scan = 256 + 4096;
  const int n_q = 544 * 4;
  const u16* W = wsb(p, WS_W) + (size_t)l * W_LAYER;
  for (int t = blockIdx.x; t < n_scan + n_q; t += gridDim.x) {
    if (t < n_scan) mlstm_m2(p, l, t);
    else {
      int u = t - n_scan; int mt = u >> 2, nt = u & 3;
      EpiQ epi{wsb(p, WS_BIG + B_Q), wsf(p, WS_RQ), (const float2*)(p.ws + WS_ROPE), p.g_qnorm + l * 96};
      gemm_tile<1, 3>(wsb(p, WS_BIG + B_P), INC, W + W_Q, LDWQ, 256, mt * 64, nt * 192, smem, epi);
    }
  }
}

DI void phase_E(const Params& p, int l, char* smem) {
  for (int t = blockIdx.x; t < NITEM; t += gridDim.x) mlstm_m3(p, l, t, smem);
}

DI void phase_F(const Params& p, int l, char* smem) {
  const u16* W = wsb(p, WS_W) + (size_t)l * W_LAYER;
  for (int t = blockIdx.x; t < 528 * 8; t += gridDim.x) {
    int mt = t >> 3, nt = t & 7;
    EpiKV epi{wsb(p, WS_BIG + B_K), wsb(p, WS_BIG + B_VT), wsf(p, WS_KROPE), p.g_knorm + l * 96};
    gemm_tile<2, 2>(wsb(p, WS_CKV), 128, W + W_KV, LDWKV, 128, mt * 128, nt * 128, smem, epi);
  }
}

DI void phase_G(const Params& p, const Sched& sc, char* smem) {
  const int G = gridDim.x, j = blockIdx.x;
  const int lane = tidx() & 63, w = tidx() >> 6, r = lane & 31;
  const int NIT = 2048 + 256;
  const u16* qb = wsb(p, WS_BIG + B_Q);
  const u16* Kb = wsb(p, WS_BIG + B_K);
  const u16* Vt = wsb(p, WS_BIG + B_VT);
  u16* act = wsb(p, WS_ACT);
  auto run_prompt = [&](int bh, int bi) {
    int b = bh >> 3, hd = bh & 7;
    int tok = b * 16384 + bi * 128 + w * 32 + r;
    flash_item<96, 2, 64, true, false, true>(qb + (size_t)tok * 768 + hd * 96, true, 2 * bi + 2, 2 * bi + 1 + (w >> 1),
                                             Kb + ((size_t)hd * NROWS + b * 16384) * 96, 96, Vt + (size_t)hd * 64 * LDVT + b * 16384, LDVT, 0,
                                             act + (size_t)tok * LDA + hd * 64, smem);
  };
  auto run_sample = [&](int u) {
    int b = u >> 3, hd = u & 7;
    int tok = NP + b * 64 + (w & 1) * 32 + r;
    size_t row0 = (size_t)NP + b * 1088;
    flash_item<96, 2, 64, true, false, true>(qb + (size_t)tok * 768 + hd * 96, w < 2, 17, 17, Kb + ((size_t)hd * NROWS + row0) * 96, 96,
                                             Vt + (size_t)hd * 64 * LDVT + row0, LDVT, 0, act + (size_t)tok * LDA + hd * 64, smem);
  };
  if (sc.ok) {
    const int xg = sc.xg, xi = sc.xi;
    for (int pass = 0; pass < 2; pass++) {
      const int bh = xg + 8 * pass;
      run_prompt(bh, xi);
      run_prompt(bh, 127 - xi);
    }
    if ((j & 1) == 0) run_sample(j >> 1);
  } else {
    for (int k = 0; k * G < NIT; k++) {
      int it = (k & 1) ? (k * G + (G - 1 - j)) : (k * G + j);
      if (it >= NIT) continue;
      if (it < 2048) run_prompt(it & 15, 127 - (it >> 4)); else run_sample(it - 2048);
    }
  }
}

DI void phase_K(const Params& p, char* smem) {
  const int lane = tidx() & 63, w = tidx() >> 6, r = lane & 31;
  const u16* qx = wsb(p, WS_BIG + B_QX);
  u16* act = wsb(p, WS_ACT);
  for (int t = blockIdx.x; t < 2176; t += gridDim.x) {
    int bidx, hh, tok0;
    if (t < 2048) { bidx = t >> 10; hh = (t >> 8) & 3; tok0 = bidx * 16384 + (t & 255) * 64; }
    else { int u = t - 2048; bidx = 2 + (u >> 2); hh = u & 3; tok0 = NP + (u >> 2) * 64; }
    int tok = tok0 + (w & 1) * 32 + r;
    int e0 = (w >> 1) * 128;
    const u16* Kb = wsb(p, WS_BIG + B_XK) + (size_t)(bidx * 4 + hh) * 65536;
    const u16* Vt = wsb(p, WS_BIG + B_XVT) + (size_t)(bidx * 4 + hh) * 256 * LDXV;
    flash_item<256, 4, 256, false, true, false>(qx + (size_t)tok * LDA + hh * 256, true, 4, 4, Kb, 256, Vt, LDXV, e0,
                                         act + (size_t)tok * LDA + hh * 256 + e0, smem);
  }
}

template <class Epi>
DI void phase_gemm128(const Sched& sc, const u16* A, long lda, const u16* Bt, long ldb, int K, int MT, int NT, int SN, char* smem, const Epi& epi) {
  if (sc.ok) {
    const int xg = sc.xg, xi = sc.xi;
    const int SM = 64 / SN;
    const int sng = NT / SN, smg = MT / SM;
    for (int st = xg; st < smg * sng; st += 8) {
      int sm = st / sng, sn = st % sng;
      int mt = sm * SM + xi / SN, nt = sn * SN + xi % SN;
      gemm_tile<2, 2>(A, lda, Bt, ldb, K, mt * 128, nt * 128, smem, epi);
    }
  } else {
    for (int t = blockIdx.x; t < MT * NT; t += gridDim.x) {
      int mt = t / NT, nt = t % NT;
      gemm_tile<2, 2>(A, lda, Bt, ldb, K, mt * 128, nt * 128, smem, epi);
    }
  }
}

#if defined(__HIP_DEVICE_COMPILE__)
typedef const __attribute__((address_space(4))) Params* KargPtr;
#define KARG_LOAD KargPtr pp4 = (KargPtr)__builtin_amdgcn_kernarg_segment_ptr(); asm volatile("" : "+s"(pp4)); const Params p = *pp4;
#else
#define KARG_LOAD const Params p{};
#endif
template <int L>
DI void run_layer(const Sched& sc, int ph_begin, int ph_end, char* smem, cg::grid_group& grid) {
  const int base = 1 + 15 * L;
#define RUN_PHASE(S, ...)  RUN_PHASE_R(S, 1, __VA_ARGS__)
#define RUN_PHASE_R(S, R, ...)                                    \
  {                                                          \
    const int ph = base + (S);                               \
    if (ph >= ph_begin && ph < ph_end) {                     \
      for (int rep_ = 0; rep_ < (R); rep_++) {               \
        KARG_LOAD                                            \
        const u16* W = wsb(p, WS_W) + (size_t)L * W_LAYER;   \
        const float* xs0 = (L == 0) ? p.x_prompt : p.out;    \
        const float* xs1 = (L == 0) ? p.x_sample : p.out + (size_t)NP * 1024; \
        (void)W; (void)xs0; (void)xs1;                       \
        __VA_ARGS__;                                         \
        if (ph + 1 < ph_end) grid.sync();                    \
      }                                                      \
    }                                                        \
  }
  if (L > 0) RUN_PHASE(0, phase_norm(p, L))
  RUN_PHASE_R(1, REP_INPROJ, phase_inproj(p, sc, L, smem))
  RUN_PHASE_R(2, REP_C, phase_C1(p, L, smem))
  RUN_PHASE(2, phase_C2(p, L, smem))
  RUN_PHASE(3, phase_D(p, L, smem))
  RUN_PHASE_R(4, REP_E, phase_E(p, L, smem))
  RUN_PHASE_R(5, REP_F, phase_F(p, L, smem))
  RUN_PHASE_R(6, REP_G, phase_G(p, sc, smem))
  RUN_PHASE(7, { EpiRes epi{xs0, xs1, p.out}; phase_gemm128(sc, wsb(p, WS_ACT), LDA, W + W_OUT, LDW, 1024, 272, 8, 8, smem, epi); })
  RUN_PHASE_R(8, REP_NORM, phase_norm(p, 1))
  RUN_PHASE(9, { EpiStoreBf16 epi{wsb(p, WS_BIG + B_QX), LDA, 1024, nullptr}; phase_gemm128(sc, wsb(p, WS_ACT), LDA, W + W_XQ, LDW, 1024, 272, 8, 8, smem, epi); })
  RUN_PHASE_R(10, REP_K, phase_K(p, smem))
  RUN_PHASE(11, { EpiRes epi{p.out, p.out + (size_t)NP * 1024, p.out}; phase_gemm128(sc, wsb(p, WS_ACT), LDA, W + W_XO, LDW, 1024, 272, 8, 8, smem, epi); })
  RUN_PHASE(12, phase_norm(p, 1))
  RUN_PHASE_R(13, REP_FF1, { EpiRelu2 epi{wsb(p, WS_BIG + B_H1), LDH1}; phase_gemm128(sc, wsb(p, WS_ACT), LDA, W + W_FF1, LDW, 1024, 272, 32, 8, smem, epi); })
  RUN_PHASE(14, { EpiRes epi{p.out, p.out + (size_t)NP * 1024, p.out}; phase_gemm128(sc, wsb(p, WS_BIG + B_H1), LDH1, W + W_FF2, LDW2, 4096, 272, 8, 8, smem, epi); })
#undef RUN_PHASE
#undef RUN_PHASE_R
}

__global__ void __launch_bounds__(256, 2) fwd_megakernel(Params p, int ph_begin, int ph_end) {
  __shared__ __attribute__((aligned(16))) char smem[SMEM_BYTES];
  cg::grid_group grid = cg::this_grid();
  __shared__ int s_rank;
  Sched sc;
  sc.xg = (int)((unsigned)__builtin_amdgcn_s_getreg((3 << 11) | 20) & 7u);
  unsigned* cnt = (unsigned*)(p.ws + WS_CNT);
  if (tidx() == 0) s_rank = (int)atomicAdd(&cnt[sc.xg], 1u);
  __syncthreads();
  sc.xi = __builtin_amdgcn_readfirstlane(s_rank);
  sc.ok = 0;
  if (ph_begin <= 0 && 0 < ph_end) {
    phase_prep(p, smem);
    if (1 < ph_end) grid.sync();
  }
  {
    int ok = (gridDim.x == 512);
#pragma unroll
    for (int i = 0; i < 8; i++) ok &= (__atomic_load_n(&cnt[i], __ATOMIC_RELAXED) == 64u);
    sc.ok = ok;
  }
  run_layer<0>(sc, ph_begin, ph_end, smem, grid);
  run_layer<1>(sc, ph_begin, ph_end, smem, grid);
}

extern "C" void kernel_launch(void* const* d_in, const int* in_sizes, int n_in, void* d_out, int out_size, void* d_ws, size_t ws_size,
                              hipStream_t stream) {
  static int grid_blocks = 0;
  if (!grid_blocks) {
    int dev = 0, cus = 0, per_cu = 0;
    (void)hipGetDevice(&dev);
    (void)hipDeviceGetAttribute(&cus, hipDeviceAttributeMultiprocessorCount, dev);
    (void)hipOccupancyMaxActiveBlocksPerMultiprocessor(&per_cu, fwd_megakernel, 256, 0);
    per_cu = 2;
    grid_blocks = cus * per_cu;
  }
  Params p{};
  const float** pp = (const float**)&p;
  for (int i = 0; i < 36; i++) pp[i] = (const float*)d_in[i];
  p.out = (float*)d_out;
  p.ws = (char*)d_ws;
  int ph_begin = 0, ph_end = 31;
  (void)hipMemsetAsync((char*)d_ws + WS_CNT, 0, 256, stream);
  void* args[] = {&p, &ph_begin, &ph_end};
  hipError_t e = hipLaunchCooperativeKernel((void*)fwd_megakernel, dim3(grid_blocks), dim3(256), args, 0, stream);
  if (e != hipSuccess) fprintf(stderr, "cooperative launch failed: %s (grid %d)\n", hipGetErrorString(e), grid_blocks);
}
```

```cpp
#include <hip/hip_runtime.h>
#include <hip/hip_cooperative_groups.h>
#include <stdint.h>
#include <stdio.h>
namespace cg = cooperative_groups;

typedef unsigned short u16;
typedef short bf16x8 __attribute__((ext_vector_type(8)));
typedef short s16x4 __attribute__((ext_vector_type(4)));
typedef float f32x16 __attribute__((ext_vector_type(16)));
typedef __bf16 bfv2 __attribute__((ext_vector_type(2)));
typedef float fv2 __attribute__((ext_vector_type(2)));
typedef unsigned u32x4 __attribute__((ext_vector_type(4)));
#define DI __device__ __forceinline__
#define MFMA(a, b, c) __builtin_amdgcn_mfma_f32_32x32x16_bf16((a), (b), (c), 0, 0, 0)

constexpr int NP = 32768;
constexpr int NS = 2048;
constexpr int NTOK = NP + NS;
constexpr int NROWS = NP + 32 * 1088;
constexpr int INC = 2472;
constexpr float EPS = 1e-6f;
constexpr float LOG2E = 1.4426950408889634f;
constexpr int NITEM = 2048 + 128;
constexpr int LDA = 1088;
constexpr int LDW = 1088;
constexpr int LDW2 = 4160;
constexpr int LDWQ = 320;
constexpr int LDWKV = 192;
constexpr int LDH1 = 4160;
constexpr int LDVT = NROWS + 64;
constexpr int LDXV = 320;

constexpr size_t O_Y = 0;
constexpr size_t O_PCKV = 35651584;
constexpr size_t O_PKROPE = O_PCKV + 8388608;
constexpr size_t O_PC = O_PKROPE + 2097152;
constexpr size_t O_PN = O_PC + 262144;
constexpr size_t O_PM = O_PN + 2048;
constexpr size_t O_PCONV = O_PM + 16;
constexpr size_t O_PMEMK = O_PCONV + 12288;
constexpr size_t O_PMEMV = O_PMEMK + 1048576;
constexpr size_t O_SCKV = O_PMEMV + 1048576;
constexpr size_t O_SKROPE = O_SCKV + 524288;
constexpr size_t O_SC = O_SKROPE + 131072;
constexpr size_t O_SN = O_SC + 4194304;
constexpr size_t O_SM = O_SN + 32768;
constexpr size_t O_SCONV = O_SM + 256;

constexpr size_t W_IN = 0;
constexpr size_t W_Q = W_IN + 2560 * LDW;
constexpr size_t W_KV = W_Q + 768 * LDWQ;
constexpr size_t W_OUT = W_KV + 1024 * LDWKV;
constexpr size_t W_XQ = W_OUT + 1024 * LDW;
constexpr size_t W_XK = W_XQ + 1024 * LDW;
constexpr size_t W_XV = W_XK + 1024 * LDW;
constexpr size_t W_XO = W_XV + 1024 * LDW;
constexpr size_t W_FF1 = W_XO + 1024 * LDW;
constexpr size_t W_FF2 = W_FF1 + 4096 * LDW;
constexpr size_t W_LAYER = W_FF2 + 1024 * LDW2;

constexpr size_t WS_W = 0;
constexpr size_t WS_ACT = WS_W + 2 * W_LAYER * 2;
constexpr size_t WS_CKV = WS_ACT + (size_t)NTOK * LDA * 2;
constexpr size_t WS_KROPE = WS_CKV + (size_t)NROWS * 128 * 2;
constexpr size_t WS_RQ = WS_KROPE + (size_t)NROWS * 32 * 4;
constexpr size_t WS_GATES = WS_RQ + (size_t)NTOK * 4;
constexpr size_t WS_ROPE = WS_GATES + (size_t)NTOK * 8 * 4;
constexpr size_t WS_SCAL = WS_ROPE + (size_t)16384 * 16 * 8;
constexpr size_t WS_MST = WS_SCAL + (size_t)NITEM * 2 * 4;
constexpr size_t WS_NU = WS_MST + (size_t)NITEM * 4 + 256;
constexpr size_t WS_CNT = WS_NU + (size_t)NITEM * 128 * 4;
constexpr size_t WS_HM = WS_CNT + 256;
constexpr size_t WS_BIG = WS_HM + (size_t)512 * LDA * 2;
constexpr size_t B_P = 0;
constexpr size_t B_K = 0;
constexpr size_t B_VT = B_K + (size_t)8 * NROWS * 96 * 2;
constexpr size_t B_Q = B_VT + (size_t)8 * 64 * LDVT * 2;
constexpr size_t B_ST = B_Q + (size_t)NTOK * 768 * 2;
constexpr size_t B_XK = B_ST + (size_t)NITEM * 16384 * 2;
constexpr size_t B_XVT = B_XK + (size_t)34 * 4 * 256 * 256 * 2;
constexpr size_t B_END = B_XVT + (size_t)34 * 4 * 256 * LDXV * 2;
constexpr size_t B_QX = 0;
constexpr size_t B_H1 = 0;
static_assert((size_t)NTOK * INC * 2 <= B_Q, "p overlaps q");
static_assert((size_t)NTOK * LDH1 * 2 <= B_XK, "h1 overlaps xkv");
static_assert((size_t)NTOK * LDA * 2 <= B_Q, "qx overlaps q");
static_assert(WS_BIG + B_END <= (size_t)536870912, "workspace too large");
static_assert(WS_BIG % 256 == 0 && B_Q % 256 == 0 && B_ST % 256 == 0 && B_VT % 256 == 0, "align");

constexpr int SMEM_BYTES = 73728;
#ifndef REP_INPROJ
#define REP_INPROJ 1
#endif
#ifndef REP_C
#define REP_C 1
#endif
#ifndef REP_E
#define REP_E 1
#endif
#ifndef REP_F
#define REP_F 1
#endif
#ifndef REP_G
#define REP_G 1
#endif
#ifndef REP_K
#define REP_K 1
#endif
#ifndef REP_FF1
#define REP_FF1 1
#endif
#ifndef REP_NORM
#define REP_NORM 1
#endif

struct Params {
  const float* x_prompt; const float* x_sample; const float* cache_ckv; const float* cache_krope;
  const float* st_C; const float* st_n; const float* st_m; const float* st_conv;
  const float* cache_mem_k; const float* cache_mem_v; const float* mem_prompt;
  const float* g_mix; const float* w_in; const float* g_qa; const float* w_q_up; const float* g_qnorm; const float* g_kva;
  const float* w_kv_up; const float* g_knorm; const float* w_conv; const float* b_conv; const float* b_igate; const float* b_fgate;
  const float* g_mhead; const float* w_out; const float* g_xattn; const float* g_mem; const float* w_xq; const float* w_xk; const float* w_xv;
  const float* g_xq; const float* g_xk; const float* w_xo; const float* g_mlp; const float* w_ff1; const float* w_ff2;
  float* out; char* ws;
};

struct Sched { int xg, xi, ok; };
DI int tidx() { int t = (int)threadIdx.x; asm volatile("" : "+v"(t)); return t; }
DI unsigned pk2(float a, float b) { fv2 v = {a, b}; bfv2 r = __builtin_convertvector(v, bfv2); return __builtin_bit_cast(unsigned, r); }
DI u16 f2bf(float a) { return (u16)(pk2(a, 0.f) & 0xffffu); }
DI float bf2f(u16 v) { return __uint_as_float(((unsigned)v) << 16); }
DI float bflo(unsigned v) { return __uint_as_float(v << 16); }
DI float bfhi(unsigned v) { return __uint_as_float(v & 0xffff0000u); }
DI int crow(int i, int h) { return (i & 3) + 8 * (i >> 2) + 4 * h; }
DI float wave_sum(float v) {
#pragma unroll
  for (int o = 32; o >= 1; o >>= 1) v += __shfl_xor(v, o);
  return v;
}
DI float wave_max(float v) {
#pragma unroll
  for (int o = 32; o >= 1; o >>= 1) v = fmaxf(v, __shfl_xor(v, o));
  return v;
}
DI void unpack8(uint4 v, float (&x)[8]) {
  x[0] = bflo(v.x); x[1] = bfhi(v.x); x[2] = bflo(v.y); x[3] = bfhi(v.y);
  x[4] = bflo(v.z); x[5] = bfhi(v.z); x[6] = bflo(v.w); x[7] = bfhi(v.w);
}
DI uint4 pack8(const float (&x)[8]) {
  uint4 v; v.x = pk2(x[0], x[1]); v.y = pk2(x[2], x[3]); v.z = pk2(x[4], x[5]); v.w = pk2(x[6], x[7]); return v;
}
DI u16* wsb(const Params& p, size_t off) { return (u16*)(p.ws + off); }
DI float* wsf(const Params& p, size_t off) { return (float*)(p.ws + off); }
DI const float* xrow(const Params& p, int l, int tok) {
  if (l == 0) return tok < NP ? p.x_prompt + (size_t)tok * 1024 : p.x_sample + (size_t)(tok - NP) * 1024;
  return p.out + (size_t)tok * 1024;
}
DI int tok_pos(int tok) { return tok < NP ? (tok & 16383) : 1024 + ((tok - NP) & 63); }

template <int TM, int TN>
DI void gemm_mainloop(const u16* __restrict__ A, long lda, const u16* __restrict__ Bt, long ldb, int K, char* smem,
                      f32x16 (&acc)[TM][TN]) {
  constexpr int BM = 64 * TM, BN = 64 * TN, LD = 72;
  u16* sA = (u16*)smem;
  u16* sB = sA + 2 * BM * LD;
  const int tid = tidx(), lane = tid & 63, w = tid >> 6, r = lane & 31, h = lane >> 5;
  const int wm = w >> 1, wn = w & 1;
  constexpr int NA = BM / 32, NB = BN / 32;
  u32x4 ra[NA], rb[NB];
#pragma unroll
  for (int tm = 0; tm < TM; tm++)
#pragma unroll
    for (int tn = 0; tn < TN; tn++)
#pragma unroll
      for (int i = 0; i < 16; i++) acc[tm][tn][i] = 0.f;
  const int nk = K / 64;
  const int lrow = tid >> 3, lch = (tid & 7) * 8;
  const u16* gA = A + (long)lrow * lda + lch;
  const u16* gB = Bt + (long)lrow * ldb + lch;
  const int soff = lrow * LD + lch;
#define GEMM_GLOAD(k0)                                                                   \
  {                                                                                      \
    _Pragma("unroll") for (int i = 0; i < NA; i++) ra[i] = *(const u32x4*)(gA + (long)(32 * i) * lda + (k0)); \
    _Pragma("unroll") for (int i = 0; i < NB; i++) rb[i] = *(const u32x4*)(gB + (long)(32 * i) * ldb + (k0)); \
  }
#define GEMM_SSTORE(buf)                                                                 \
  {                                                                                      \
    _Pragma("unroll") for (int i = 0; i < NA; i++) *(u32x4*)(sA + (buf) * BM * LD + soff + 32 * i * LD) = ra[i]; \
    _Pragma("unroll") for (int i = 0; i < NB; i++) *(u32x4*)(sB + (buf) * BN * LD + soff + 32 * i * LD) = rb[i]; \
  }
  GEMM_GLOAD(0)
  __syncthreads();
  GEMM_SSTORE(0)
  if (nk > 1) GEMM_GLOAD(64)
  __syncthreads();
  for (int kt = 0; kt < nk; kt++) {
    const int buf = kt & 1;
    const u16* cA = sA + buf * BM * LD + (wm * 32 * TM + r) * LD + h * 8;
    const u16* cB = sB + buf * BN * LD + (wn * 32 * TN + r) * LD + h * 8;
    bf16x8 af[TM], bfr[TN];
#pragma unroll
    for (int tm = 0; tm < TM; tm++) af[tm] = *(const bf16x8*)(cA + tm * 32 * LD);
#pragma unroll
    for (int tn = 0; tn < TN; tn++) bfr[tn] = *(const bf16x8*)(cB + tn * 32 * LD);
    if (kt + 1 < nk) GEMM_SSTORE(buf ^ 1)
    __builtin_amdgcn_sched_barrier(0);
#pragma unroll
    for (int tm = 0; tm < TM; tm++)
#pragma unroll
      for (int tn = 0; tn < TN; tn++) acc[tm][tn] = MFMA(af[tm], bfr[tn], acc[tm][tn]);
#pragma unroll
    for (int tm = 0; tm < TM; tm++) af[tm] = *(const bf16x8*)(cA + tm * 32 * LD + 16);
#pragma unroll
    for (int tn = 0; tn < TN; tn++) bfr[tn] = *(const bf16x8*)(cB + tn * 32 * LD + 16);
#pragma unroll
    for (int tm = 0; tm < TM; tm++)
#pragma unroll
      for (int tn = 0; tn < TN; tn++) acc[tm][tn] = MFMA(af[tm], bfr[tn], acc[tm][tn]);
    __builtin_amdgcn_sched_barrier(0);
    if (kt + 2 < nk) GEMM_GLOAD((kt + 2) * 64)
    __builtin_amdgcn_sched_barrier(0);
#pragma unroll
    for (int ks = 2; ks < 4; ks++) {
#pragma unroll
      for (int tm = 0; tm < TM; tm++) af[tm] = *(const bf16x8*)(cA + tm * 32 * LD + ks * 16);
#pragma unroll
      for (int tn = 0; tn < TN; tn++) bfr[tn] = *(const bf16x8*)(cB + tn * 32 * LD + ks * 16);
#pragma unroll
      for (int tm = 0; tm < TM; tm++)
#pragma unroll
        for (int tn = 0; tn < TN; tn++) acc[tm][tn] = MFMA(af[tm], bfr[tn], acc[tm][tn]);
    }
    __syncthreads();
  }
#undef GEMM_GLOAD
#undef GEMM_SSTORE
}

template <int TM, int TN, class Epi>
DI void gemm_tile(const u16* A, long lda, const u16* Bt, long ldb, int K, int m0, int n0, char* smem, const Epi& epi) {
  constexpr int BM = 64 * TM, BN = 64 * TN, LDC = BN + Epi::PAD;
  f32x16 acc[TM][TN];
  gemm_mainloop<TM, TN>(A + (long)m0 * lda, lda, Bt + (long)n0 * ldb, ldb, K, smem, acc);
  const int tid = tidx(), lane = tid & 63, w = tid >> 6, r = lane & 31, h = lane >> 5;
  const int wm = w >> 1, wn = w & 1;
  float* Ct = (float*)smem;
#pragma unroll
  for (int tm = 0; tm < TM; tm++)
#pragma unroll
    for (int tn = 0; tn < TN; tn++)
#pragma unroll
      for (int i = 0; i < 16; i++)
        Ct[(wm * 32 * TM + tm * 32 + crow(i, h)) * LDC + wn * 32 * TN + tn * 32 + r] = acc[tm][tn][i];
  __syncthreads();
  epi(Ct, LDC, m0, n0, tid);
  __syncthreads();
  (void)BM;
}

struct EpiStoreBf16 {
  static constexpr int PAD = 4;
  u16* out; long ldo; int nmax; float* gates;
  DI void operator()(const float* Ct, int ldc, int m0, int n0, int tid) const {
#pragma unroll
    for (int it = 0; it < 8; it++) {
      int id = tid + 256 * it; int row = id >> 4, c8 = (id & 15) * 8;
      int n = n0 + c8;
      if (n < nmax) {
        const float* c = Ct + row * ldc + c8;
        float4 a = *(const float4*)c, b = *(const float4*)(c + 4);
        uint4 v; v.x = pk2(a.x, a.y); v.y = pk2(a.z, a.w); v.z = pk2(b.x, b.y); v.w = pk2(b.z, b.w);
        *(uint4*)(out + (long)(m0 + row) * ldo + n) = v;
        if (gates != nullptr && n == 1952) {
          float* g = gates + (long)(m0 + row) * 8;
          *(float4*)g = a; *(float4*)(g + 4) = b;
        }
      }
    }
  }
};
struct EpiRelu2 {
  static constexpr int PAD = 4;
  u16* out; long ldo;
  DI void operator()(const float* Ct, int ldc, int m0, int n0, int tid) const {
#pragma unroll
    for (int it = 0; it < 8; it++) {
      int id = tid + 256 * it; int row = id >> 4, c8 = (id & 15) * 8;
      const float* c = Ct + row * ldc + c8;
      float x[8];
#pragma unroll
      for (int j = 0; j < 8; j++) { float v = fmaxf(c[j], 0.f); x[j] = v * v; }
      *(uint4*)(out + (long)(m0 + row) * ldo + n0 + c8) = pack8(x);
    }
  }
};
struct EpiF32 {
  static constexpr int PAD = 4;
  float* out; long ldo;
  DI void operator()(const float* Ct, int ldc, int m0, int n0, int tid) const {
#pragma unroll
    for (int it = 0; it < 8; it++) {
      int id = tid + 256 * it; int row = id >> 4, c8 = (id & 15) * 8;
      const float* c = Ct + row * ldc + c8;
      float* o = out + (long)(m0 + row) * ldo + n0 + c8;
      *(float4*)o = *(const float4*)c; *(float4*)(o + 4) = *(const float4*)(c + 4);
    }
  }
};
struct EpiRes {
  static constexpr int PAD = 4;
  const float* src0; const float* src1; float* dst;
  DI void operator()(const float* Ct, int ldc, int m0, int n0, int tid) const {
#pragma unroll
    for (int it = 0; it < 8; it++) {
      int id = tid + 256 * it; int row = id >> 4, c8 = (id & 15) * 8;
      int m = m0 + row;
      const float* s = (m < NP ? src0 + (size_t)m * 1024 : src1 + (size_t)(m - NP) * 1024) + n0 + c8;
      const float* c = Ct + row * ldc + c8;
      float4 a = *(const float4*)c, b = *(const float4*)(c + 4);
      float4 sa = *(const float4*)s, sb = *(const float4*)(s + 4);
      a.x += sa.x; a.y += sa.y; a.z += sa.z; a.w += sa.w; b.x += sb.x; b.y += sb.y; b.z += sb.z; b.w += sb.w;
      float* o = dst + (size_t)m * 1024 + n0 + c8;
      *(float4*)o = a; *(float4*)(o + 4) = b;
    }
  }
};
struct EpiQ {
  static constexpr int PAD = 1;
  u16* q; const float* rq; const float2* rope; const float* g;
  DI void operator()(const float* Ct, int ldc, int m0, int n0, int tid) const {
    if (tid < 128) {
      int row = tid >> 1, hh = tid & 1; int m = m0 + row;
      const float* c = Ct + row * ldc + hh * 96;
      float rqv = rq[m];
      float ss = 0.f;
#pragma unroll 8
      for (int d = 0; d < 96; d++) ss += c[d] * c[d];
      ss *= rqv * rqv;
      float r2 = rsqrtf(ss * (1.f / 96.f) + EPS) * rqv * (0.10206207261596575f * LOG2E);
      u16* o = q + (size_t)m * 768 + n0 + hh * 96;
#pragma unroll
      for (int c8 = 0; c8 < 8; c8++) {
        float x[8];
#pragma unroll
        for (int j = 0; j < 8; j++) x[j] = c[c8 * 8 + j] * r2 * g[c8 * 8 + j];
        *(uint4*)(o + c8 * 8) = pack8(x);
      }
      const float2* tab = rope + (size_t)tok_pos(m) * 16;
#pragma unroll
      for (int half = 0; half < 2; half++) {
        float x1[8], x2[8];
#pragma unroll
        for (int j = 0; j < 8; j++) {
          int i = half * 8 + j;
          float a = c[64 + i], b = c[80 + i]; float2 cs = tab[i];
          x1[j] = (a * cs.x - b * cs.y) * r2 * g[64 + i];
          x2[j] = (a * cs.y + b * cs.x) * r2 * g[80 + i];
        }
        *(uint4*)(o + 64 + half * 8) = pack8(x1);
        *(uint4*)(o + 80 + half * 8) = pack8(x2);
      }
    }
  }
};
struct EpiKV {
  static constexpr int PAD = 1;
  u16* Kb; u16* Vt; const float* krope; const float* g;
  DI void operator()(const float* Ct, int ldc, int m0, int n0, int tid) const {
    const int hd = n0 >> 7;
#pragma unroll
    for (int it = 0; it < 4; it++) {
      int id = tid + 256 * it; int oct = id & 15, e = id >> 4;
      float x[8];
#pragma unroll
      for (int j = 0; j < 8; j++) x[j] = Ct[(oct * 8 + j) * ldc + 64 + e];
      *(uint4*)(Vt + (size_t)(hd * 64 + e) * LDVT + m0 + oct * 8) = pack8(x);
    }
    if (tid < 128) {
      int row = tid;
      const float* c = Ct + row * ldc;
      const float* kr = krope + (size_t)(m0 + row) * 32;
      float ss = 0.f;
#pragma unroll 8
      for (int d = 0; d < 64; d++) ss += c[d] * c[d];
#pragma unroll 8
      for (int d = 0; d < 32; d++) ss += kr[d] * kr[d];
      float rr = rsqrtf(ss * (1.f / 96.f) + EPS);
      u16* o = Kb + ((size_t)hd * NROWS + m0 + row) * 96;
#pragma unroll
      for (int c8 = 0; c8 < 8; c8++) {
        float x[8];
#pragma unroll
        for (int j = 0; j < 8; j++) x[j] = c[c8 * 8 + j] * rr * g[c8 * 8 + j];
        *(uint4*)(o + c8 * 8) = pack8(x);
      }
#pragma unroll
      for (int c8 = 0; c8 < 4; c8++) {
        float x[8];
#pragma unroll
        for (int j = 0; j < 8; j++) x[j] = kr[c8 * 8 + j] * rr * g[64 + c8 * 8 + j];
        *(uint4*)(o + 64 + c8 * 8) = pack8(x);
      }
    }
  }
};

template <int DQK, int NE, int EV, bool DB, bool QNORM, bool QREG>
DI void flash_item(const u16* Qrow, bool wave_active, int ntb, int ntw, const u16* Kbase, long ldk, const u16* Vtbase, long ldv,
                   int e0, u16* Orow, char* smem) {
  constexpr int LDK = DQK + 8, LDV = 72;
  constexpr int KS = DQK / 16;
  constexpr int KTILE = 64 * LDK, VTILE = EV * LDV;
  constexpr int NKC = 64 * (DQK / 8) / 256;
  constexpr int NVC = EV * 8 / 256;
  u16* sK = (u16*)smem;
  u16* sV = sK + (DB ? 2 : 1) * KTILE;
  const int tid = tidx(), lane = tid & 63, r = lane & 31, h = lane >> 5;
  bf16x8 qf[QREG ? KS : 1];
  float rqs = 1.f;
  if (wave_active) {
    if (QREG) {
#pragma unroll
      for (int ks = 0; ks < KS; ks++) qf[QREG ? ks : 0] = *(const bf16x8*)(Qrow + ks * 16 + h * 8);
    }
    if (QNORM) {
      float ss = 0.f;
#pragma unroll
      for (int ks = 0; ks < KS; ks++) {
        bf16x8 qq = QREG ? qf[QREG ? ks : 0] : *(const bf16x8*)(Qrow + ks * 16 + h * 8);
#pragma unroll
        for (int j = 0; j < 8; j++) { float v = bf2f((u16)qq[j]); ss += v * v; }
      }
      ss += __shfl_xor(ss, 32);
      rqs = rsqrtf(ss * (1.f / DQK) + EPS);
    }
  } else if (QREG) {
#pragma unroll
    for (int ks = 0; ks < KS; ks++)
#pragma unroll
      for (int j = 0; j < 8; j++) qf[QREG ? ks : 0][j] = 0;
  }
  f32x16 o[NE];
#pragma unroll
  for (int et = 0; et < NE; et++)
#pragma unroll
    for (int i = 0; i < 16; i++) o[et][i] = 0.f;
  float mrun = 0.f, lrun = 0.f;
  const float rqinv = 1.f / rqs;

  u32x4 rk[DB ? NKC : 1], rv[DB ? NVC : 1];
  auto gload = [&](int t) {
#pragma unroll
    for (int i = 0; i < NKC; i++) {
      int id = tid + 256 * i; int row = id / (DQK / 8), ch = id % (DQK / 8);
      u32x4 v = *(const u32x4*)(Kbase + (long)(t * 64 + row) * ldk + ch * 8);
      if (DB) rk[DB ? i : 0] = v; else *(u32x4*)(sK + row * LDK + ch * 8) = v;
    }
#pragma unroll
    for (int i = 0; i < NVC; i++) {
      int id = tid + 256 * i; int row = id >> 3, ch = id & 7;
      u32x4 v = *(const u32x4*)(Vtbase + (long)row * ldv + t * 64 + ch * 8);
      if (DB) rv[DB ? i : 0] = v; else *(u32x4*)(sV + row * LDV + ch * 8) = v;
    }
  };
  auto sstore = [&](int buf) {
#pragma unroll
    for (int i = 0; i < NKC; i++) { int id = tid + 256 * i; int row = id / (DQK / 8), ch = id % (DQK / 8); *(u32x4*)(sK + buf * KTILE + row * LDK + ch * 8) = rk[DB ? i : 0]; }
#pragma unroll
    for (int i = 0; i < NVC; i++) { int id = tid + 256 * i; int row = id >> 3, ch = id & 7; *(u32x4*)(sV + buf * VTILE + row * LDV + ch * 8) = rv[DB ? i : 0]; }
  };
  auto compute = [&](int buf) {
    const u16* cK = sK + buf * KTILE + r * LDK + h * 8;
    const u16* cV = sV + buf * VTILE + (e0 + r) * LDV + 4 * h;
    const float sinit = QNORM ? -mrun * rqinv : -mrun;
    f32x16 s[2];
#pragma unroll
    for (int sub = 0; sub < 2; sub++) {
#pragma unroll
      for (int i = 0; i < 16; i++) s[sub][i] = sinit;
#pragma unroll
      for (int ks = 0; ks < KS; ks++) {
        bf16x8 a = *(const bf16x8*)(cK + sub * 32 * LDK + ks * 16);
        bf16x8 qq = QREG ? qf[QREG ? ks : 0] : *(const bf16x8*)(Qrow + ks * 16 + h * 8);
        s[sub] = MFMA(a, qq, s[sub]);
      }
    }
    float mx = -1e30f;
#pragma unroll
    for (int sub = 0; sub < 2; sub++)
#pragma unroll
      for (int i = 0; i < 16; i++) { if (QNORM) s[sub][i] *= rqs; mx = fmaxf(mx, s[sub][i]); }
    mx = fmaxf(mx, __shfl_xor(mx, 32));
    if (__any(mx > 8.f)) {
      const float d = fmaxf(mx, 0.f);
      const float alpha = __builtin_amdgcn_exp2f(-d);
      mrun += d;
      lrun *= alpha;
#pragma unroll
      for (int et = 0; et < NE; et++)
#pragma unroll
        for (int i = 0; i < 16; i++) o[et][i] *= alpha;
#pragma unroll
      for (int sub = 0; sub < 2; sub++)
#pragma unroll
        for (int i = 0; i < 16; i++) s[sub][i] -= d;
    }
    float psum = 0.f;
#pragma unroll
    for (int sub = 0; sub < 2; sub++)
#pragma unroll
      for (int i = 0; i < 16; i++) { float pv = __builtin_amdgcn_exp2f(s[sub][i]); s[sub][i] = pv; psum += pv; }
    lrun += psum;
#pragma unroll
    for (int sub = 0; sub < 2; sub++)
#pragma unroll
      for (int st = 0; st < 2; st++) {
        uint4 pp;
        pp.x = pk2(s[sub][8 * st + 0], s[sub][8 * st + 1]); pp.y = pk2(s[sub][8 * st + 2], s[sub][8 * st + 3]);
        pp.z = pk2(s[sub][8 * st + 4], s[sub][8 * st + 5]); pp.w = pk2(s[sub][8 * st + 6], s[sub][8 * st + 7]);
        bf16x8 pb = __builtin_bit_cast(bf16x8, pp);
#pragma unroll
        for (int et = 0; et < NE; et++) {
          const u16* vp = cV + et * 32 * LDV + sub * 32 + st * 16;
          s16x4 lo = *(const s16x4*)vp;
          s16x4 hi = *(const s16x4*)(vp + 8);
          bf16x8 a = __builtin_shufflevector(lo, hi, 0, 1, 2, 3, 4, 5, 6, 7);
          o[et] = MFMA(a, pb, o[et]);
        }
      }
  };

  __syncthreads();
  if (DB) {
    gload(0);
    sstore(0);
    __syncthreads();
    for (int t = 0; t < ntb; t++) {
      const bool more = (t + 1 < ntb);
      if (more) gload(t + 1);
      __builtin_amdgcn_sched_barrier(0);
      if (wave_active && t < ntw) compute(t & 1);
      if (more) sstore((t + 1) & 1);
      __syncthreads();
    }
  } else {
    for (int t = 0; t < ntb; t++) {
      if (t > 0) __syncthreads();
      gload(t);
      __syncthreads();
      if (wave_active && t < ntw) compute(0);
    }
    __syncthreads();
  }
  if (wave_active) {
    float lt = lrun + __shfl_xor(lrun, 32);
    float inv = 1.f / lt;
#pragma unroll
    for (int et = 0; et < NE; et++)
#pragma unroll
      for (int g = 0; g < 4; g++) {
        uint2 v;
        v.x = pk2(o[et][4 * g + 0] * inv, o[et][4 * g + 1] * inv);
        v.y = pk2(o[et][4 * g + 2] * inv, o[et][4 * g + 3] * inv);
        *(uint2*)(Orow + et * 32 + 8 * g + 4 * h) = v;
      }
  }
}

DI void norm_row_wave(const float* src, u16* dst, int lane) {
  float4 v[4]; float ss = 0.f;
#pragma unroll
  for (int i = 0; i < 4; i++) { v[i] = *(const float4*)(src + i * 256 + lane * 4); ss += v[i].x * v[i].x + v[i].y * v[i].y + v[i].z * v[i].z + v[i].w * v[i].w; }
  ss = wave_sum(ss);
  float rr = rsqrtf(ss * (1.f / 1024.f) + EPS);
#pragma unroll
  for (int i = 0; i < 4; i++) {
    uint2 o; o.x = pk2(v[i].x * rr, v[i].y * rr); o.y = pk2(v[i].z * rr, v[i].w * rr);
    *(uint2*)(dst + i * 256 + lane * 4) = o;
  }
}

DI void phase_norm(const Params& p, int l) {
  const int lane = tidx() & 63, w = tidx() >> 6;
  u16* act = wsb(p, WS_ACT);
  for (int t = blockIdx.x * 4 + w; t < NTOK; t += gridDim.x * 4) norm_row_wave(xrow(p, l, t), act + (size_t)t * LDA, lane);
}

DI void wtile(const float* src, const float* gain, int K, int N, u16* dst, int ldd, int k0, int n0, char* smem) {
  u16* T = (u16*)smem;
  const int tid = tidx();
  __syncthreads();
  {
    const int nn = tid & 63, kk0 = tid >> 6;
    const int n = n0 + nn;
#pragma unroll 4
    for (int i = 0; i < 16; i++) {
      int kk = kk0 + 4 * i;
      float v = 0.f;
      if (n < N) { v = src[(size_t)(k0 + kk) * N + n]; if (gain) v *= gain[k0 + kk]; }
      T[nn * 72 + kk] = f2bf(v);
    }
  }
  __syncthreads();
  {
    const int nn = tid >> 2, kq = tid & 3;
    const uint4* s = (const uint4*)(T + nn * 72 + kq * 16);
    uint4* d = (uint4*)(dst + (size_t)(n0 + nn) * ldd + k0 + kq * 16);
    d[0] = s[0]; d[1] = s[1];
  }
}

DI void phase_prep(const Params& p, char* smem) {
  const int tid = tidx(), lane = tid & 63, w = tid >> 6;
  for (int t = blockIdx.x; t < 2 * 4048; t += gridDim.x) {
    int l = t / 4048, u = t % 4048;
    const float* src; const float* gain = nullptr; int K, N, Npad; size_t doff; int ldd = LDW;
    if (u < 640) { src = p.w_in + (size_t)l * 1024 * INC; gain = p.g_mix + l * 1024; K = 1024; N = INC; Npad = 2560; doff = W_IN; }
    else if (u < 688) { u -= 640; src = p.w_q_up + (size_t)l * 256 * 768; gain = p.g_qa + l * 256; K = 256; N = 768; Npad = 768; doff = W_Q; ldd = LDWQ; }
    else if (u < 720) { u -= 688; src = p.w_kv_up + (size_t)l * 128 * 1024; K = 128; N = 1024; Npad = 1024; doff = W_KV; ldd = LDWKV; }
    else if (u < 976) { u -= 720; src = p.w_out + (size_t)l * 1048576; K = 1024; N = 1024; Npad = 1024; doff = W_OUT; }
    else if (u < 1232) { u -= 976; src = p.w_xq + (size_t)l * 1048576; gain = p.g_xattn + l * 1024; K = 1024; N = 1024; Npad = 1024; doff = W_XQ; }
    else if (u < 1488) { u -= 1232; src = p.w_xk + (size_t)l * 1048576; gain = p.g_mem + l * 1024; K = 1024; N = 1024; Npad = 1024; doff = W_XK; }
    else if (u < 1744) { u -= 1488; src = p.w_xv + (size_t)l * 1048576; gain = p.g_mem + l * 1024; K = 1024; N = 1024; Npad = 1024; doff = W_XV; }
    else if (u < 2000) { u -= 1744; src = p.w_xo + (size_t)l * 1048576; K = 1024; N = 1024; Npad = 1024; doff = W_XO; }
    else if (u < 3024) { u -= 2000; src = p.w_ff1 + (size_t)l * 4194304; gain = p.g_mlp + l * 1024; K = 1024; N = 4096; Npad = 4096; doff = W_FF1; }
    else { u -= 3024; src = p.w_ff2 + (size_t)l * 4194304; K = 4096; N = 1024; Npad = 1024; doff = W_FF2; ldd = LDW2; }
    int nt = Npad / 64;
    int kt = u / nt, ntile = u % nt;
    wtile(src, gain, K, N, wsb(p, WS_W) + (size_t)l * W_LAYER + doff, ldd, kt * 64, ntile * 64, smem);
  }
  float2* tab = (float2*)(p.ws + WS_ROPE);
  for (int t = blockIdx.x; t < 1024; t += gridDim.x) {
    int idx = t * 256 + tid; int pos = idx >> 4, i = idx & 15;
    float inv_freq = __builtin_amdgcn_exp2f(-(float)i * 0.830482023721841f);
    float ang = (float)pos * inv_freq;
    double rev = (double)ang * 0.15915494309189535;
    rev -= rint(rev);
    float fr = (float)rev;
    tab[idx] = make_float2(__builtin_amdgcn_cosf(fr), __builtin_amdgcn_sinf(fr));
  }
  u16* hm = wsb(p, WS_HM);
  for (int t = blockIdx.x * 4 + w; t < 512; t += gridDim.x * 4) norm_row_wave(p.mem_prompt + (size_t)t * 1024, hm + (size_t)t * LDA, lane);
  phase_norm(p, 0);
}

template <class Epi>
DI void phase_gemm128(const Sched& sc, const u16* A, long lda, const u16* Bt, long ldb, int K, int MT, int NT, int SN, char* smem, const Epi& epi);
DI void phase_inproj(const Params& p, const Sched& sc, int l, char* smem) {
  const u16* W = wsb(p, WS_W) + (size_t)l * W_LAYER;
  {
    EpiStoreBf16 epi{wsb(p, WS_BIG + B_P), INC, INC, wsf(p, WS_GATES)};
    phase_gemm128(sc, wsb(p, WS_ACT), LDA, W + W_IN, LDW, 1024, 272, 20, 4, smem, epi);
  }
  if (l == 0) {
    for (int u = blockIdx.x; u < 128; u += gridDim.x) {
      int l2 = u >> 6, which = (u >> 5) & 1, mt = (u >> 3) & 3, nt = u & 7;
      const u16* W2 = wsb(p, WS_W) + (size_t)l2 * W_LAYER + (which ? W_XV : W_XK);
      EpiF32 epi{p.out + (which ? O_PMEMV : O_PMEMK) + (size_t)l2 * 524288, 1024};
      gemm_tile<2, 2>(wsb(p, WS_HM), LDA, W2, LDW, 1024, mt * 128, nt * 128, smem, epi);
    }
  }
}

DI void post_token(const Params& p, int l, int tok, int lane) {
  const u16* pr = wsb(p, WS_BIG + B_P) + (size_t)tok * INC;
  {
    uint2 q4 = *(const uint2*)(pr + lane * 4);
    float a = bflo(q4.x), b = bfhi(q4.x), c = bflo(q4.y), d = bfhi(q4.y);
    float ss = wave_sum(a * a + b * b + c * c + d * d);
    if (lane == 0) wsf(p, WS_RQ)[tok] = rsqrtf(ss * (1.f / 256.f) + EPS);
  }
  const bool prompt = tok < NP;
  int b, s, row, pos; float* ckv_out; float* kr_out;
  if (prompt) {
    b = tok >> 14; s = tok & 16383; row = tok; pos = s;
    ckv_out = p.out + O_PCKV + ((size_t)(l * 2 + b) * 16384 + s) * 128;
    kr_out = p.out + O_PKROPE + ((size_t)(l * 2 + b) * 16384 + s) * 32;
  } else {
    int t2 = tok - NP; b = t2 >> 6; s = t2 & 63; row = NP + b * 1088 + 1024 + s; pos = 1024 + s;
    ckv_out = p.out + O_SCKV + ((size_t)(l * 32 + b) * 64 + s) * 128;
    kr_out = p.out + O_SKROPE + ((size_t)(l * 32 + b) * 64 + s) * 32;
  }
  {
    unsigned c2 = *(const unsigned*)(pr + 256 + lane * 2);
    float c0 = bflo(c2), c1 = bfhi(c2);
    float ss = wave_sum(c0 * c0 + c1 * c1);
    float rr = rsqrtf(ss * (1.f / 128.f) + EPS);
    float o0 = c0 * rr * p.g_kva[l * 128 + lane * 2], o1 = c1 * rr * p.g_kva[l * 128 + lane * 2 + 1];
    *(float2*)(ckv_out + lane * 2) = make_float2(o0, o1);
    *(unsigned*)(wsb(p, WS_CKV) + (size_t)row * 128 + lane * 2) = pk2(o0, o1);
  }
  if (lane < 16) {
    float x1 = bf2f(pr[384 + lane]), x2 = bf2f(pr[400 + lane]);
    float2 cs = ((const float2*)(p.ws + WS_ROPE))[(size_t)pos * 16 + lane];
    float o1 = x1 * cs.x - x2 * cs.y, o2 = x1 * cs.y + x2 * cs.x;
    kr_out[lane] = o1; kr_out[16 + lane] = o2;
    float* ka = wsf(p, WS_KROPE) + (size_t)row * 32;
    ka[lane] = o1; ka[16 + lane] = o2;
  }
  const int S = prompt ? 16384 : 64;
  if (s >= S - 3) {
    int j = s - (S - 3);
    float* dst = prompt ? p.out + O_PCONV + ((size_t)(l * 2 + b) * 3 + j) * 1024 : p.out + O_SCONV + ((size_t)(l * 32 + b) * 3 + j) * 1024;
#pragma unroll 4
    for (int i = 0; i < 16; i++) dst[lane + 64 * i] = bf2f(pr[416 + lane + 64 * i]);
  }
}

DI void post_past(const Params& p, int l, int pi, int lane) {
  int b = pi >> 10, t = pi & 1023;
  size_t row = (size_t)NP + b * 1088 + t;
  const float* src = p.cache_ckv + ((size_t)(l * 32 + b) * 1024 + t) * 128;
  float2 v = *(const float2*)(src + lane * 2);
  *(unsigned*)(wsb(p, WS_CKV) + row * 128 + lane * 2) = pk2(v.x, v.y);
  if (lane < 32) wsf(p, WS_KROPE)[row * 32 + lane] = p.cache_krope[((size_t)(l * 32 + b) * 1024 + t) * 32 + lane];
}

struct ChunkInfo { int tok0, b, h, chain, has_prev, sample; };
DI ChunkInfo chunk_info(int item) {
  ChunkInfo ci;
  if (item < 2048) {
    ci.chain = item >> 8; ci.b = ci.chain >> 2; ci.h = ci.chain & 3; int c = item & 255;
    ci.tok0 = ci.b * 16384 + c * 64; ci.has_prev = (c > 0); ci.sample = 0;
  } else {
    int j = item - 2048; ci.chain = 8 + j; ci.b = j >> 2; ci.h = j & 3; ci.tok0 = NP + ci.b * 64; ci.has_prev = 0; ci.sample = 1;
  }
  return ci;
}
DI void load_x8(const Params& p, int l, const ChunkInfo& ci, int tp, int col, float (&x)[8]) {
  if (tp >= 0 || ci.has_prev) {
    uint4 v = *(const uint4*)(wsb(p, WS_BIG + B_P) + (size_t)(ci.tok0 + tp) * INC + col);
    unpack8(v, x);
  } else if (ci.sample) {
    const float* s = p.st_conv + (((size_t)l * 32 + ci.b) * 3 + (3 + tp)) * 1024 + (col - 416);
    float4 a = *(const float4*)s, b = *(const float4*)(s + 4);
    x[0] = a.x; x[1] = a.y; x[2] = a.z; x[3] = a.w; x[4] = b.x; x[5] = b.y; x[6] = b.z; x[7] = b.w;
  } else {
#pragma unroll
    for (int j = 0; j < 8; j++) x[j] = 0.f;
  }
}
template <class Emit>
DI void conv_run(const Params& p, int l, const ChunkInfo& ci, int mat, int chunk, int row0, int nrows, Emit emit) {
  const int ch0 = mat * 512 + ci.h * 128 + chunk * 8;
  const int col = 416 + ch0;
  float w0[8], w1[8], w2[8], w3[8], bias[8];
  {
    const float* wc = p.w_conv + (size_t)l * 4096 + ch0;
    float4 a, b;
    a = *(const float4*)(wc); b = *(const float4*)(wc + 4);
    w0[0] = a.x; w0[1] = a.y; w0[2] = a.z; w0[3] = a.w; w0[4] = b.x; w0[5] = b.y; w0[6] = b.z; w0[7] = b.w;
    a = *(const float4*)(wc + 1024); b = *(const float4*)(wc + 1028);
    w1[0] = a.x; w1[1] = a.y; w1[2] = a.z; w1[3] = a.w; w1[4] = b.x; w1[5] = b.y; w1[6] = b.z; w1[7] = b.w;
    a = *(const float4*)(wc + 2048); b = *(const float4*)(wc + 2052);
    w2[0] = a.x; w2[1] = a.y; w2[2] = a.z; w2[3] = a.w; w2[4] = b.x; w2[5] = b.y; w2[6] = b.z; w2[7] = b.w;
    a = *(const float4*)(wc + 3072); b = *(const float4*)(wc + 3076);
    w3[0] = a.x; w3[1] = a.y; w3[2] = a.z; w3[3] = a.w; w3[4] = b.x; w3[5] = b.y; w3[6] = b.z; w3[7] = b.w;
    const float* bc = p.b_conv + (size_t)l * 1024 + ch0;
    a = *(const float4*)(bc); b = *(const float4*)(bc + 4);
    bias[0] = a.x; bias[1] = a.y; bias[2] = a.z; bias[3] = a.w; bias[4] = b.x; bias[5] = b.y; bias[6] = b.z; bias[7] = b.w;
  }
  float xa[8], xb[8], xc[8], xd[8];
  load_x8(p, l, ci, row0 - 3, col, xa);
  load_x8(p, l, ci, row0 - 2, col, xb);
  load_x8(p, l, ci, row0 - 1, col, xc);
  for (int t = row0; t < row0 + nrows; t++) {
    load_x8(p, l, ci, t, col, xd);
    float y[8];
#pragma unroll
    for (int j = 0; j < 8; j++) {
      float v = bias[j] + xa[j] * w0[j] + xb[j] * w1[j] + xc[j] * w2[j] + xd[j] * w3[j];
      y[j] = v / (1.f + __expf(-v));
      xa[j] = xb[j]; xb[j] = xc[j]; xc[j] = xd[j];
    }
    emit(t, y);
  }
}
DI float logsigmoid(float z) { return fminf(z, 0.f) - log1pf(__expf(-fabsf(z))); }

DI void mlstm_m1(const Params& p, int l, int item, char* smem) {
  const ChunkInfo ci = chunk_info(item);
  const int tid = tidx(), lane = tid & 63, w = tid >> 6, r = lane & 31, h = lane >> 5;
  u16* sVt = (u16*)smem;
  u16* sKt = sVt + 128 * 72;
  float* swk = (float*)(sKt + 128 * 72);
  __syncthreads();
  if (w == 0) {
    const float* g = wsf(p, WS_GATES) + (size_t)(ci.tok0 + lane) * 8;
    float ig = g[ci.h] + p.b_igate[l * 4 + ci.h];
    float lf = logsigmoid(g[4 + ci.h] + p.b_fgate[l * 4 + ci.h]);
    float bcs = lf;
#pragma unroll
    for (int o = 1; o < 64; o <<= 1) { float t = __shfl_up(bcs, o); if (lane >= o) bcs += t; }
    float u = ig - bcs;
    float umax = wave_max(u);
    swk[lane] = __expf(u - umax);
    float blast = __shfl(bcs, 63);
    if (lane == 0) { float* sc = wsf(p, WS_SCAL) + (size_t)item * 2; sc[0] = blast; sc[1] = blast + umax; }
  }
#pragma unroll
  for (int it = 0; it < 4; it++) {
    int id = tid + 256 * it; int s = id >> 4, ch = id & 15;
    uint4 v = *(const uint4*)(wsb(p, WS_BIG + B_P) + (size_t)(ci.tok0 + s) * INC + 1440 + ci.h * 128 + ch * 8);
    const u16* vv = (const u16*)&v;
    unsigned a[4] = {v.x, v.y, v.z, v.w};
#pragma unroll
    for (int j = 0; j < 4; j++) { sVt[(ch * 8 + 2 * j) * 72 + s] = (u16)(a[j] & 0xffffu); sVt[(ch * 8 + 2 * j + 1) * 72 + s] = (u16)(a[j] >> 16); }
    (void)vv;
  }
  __syncthreads();
  {
    const int chunk = tid & 15, rg = tid >> 4;
    conv_run(p, l, ci, 1, chunk, rg * 4, 4, [&](int t, const float (&y)[8]) {
      float sc = 0.08838834764831845f * swk[t];
#pragma unroll
      for (int j = 0; j < 8; j++) sKt[(chunk * 8 + j) * 72 + t] = f2bf(y[j] * sc);
    });
  }
  __syncthreads();
  const int wm = w >> 1, wn = w & 1;
  f32x16 acc[2][2];
#pragma unroll
  for (int a = 0; a < 2; a++)
#pragma unroll
    for (int b = 0; b < 2; b++)
#pragma unroll
      for (int i = 0; i < 16; i++) acc[a][b][i] = 0.f;
#pragma unroll
  for (int ks = 0; ks < 4; ks++) {
    bf16x8 af[2], bfr[2];
#pragma unroll
    for (int tm = 0; tm < 2; tm++) af[tm] = *(const bf16x8*)(sVt + (wm * 64 + tm * 32 + r) * 72 + ks * 16 + h * 8);
#pragma unroll
    for (int tn = 0; tn < 2; tn++) bfr[tn] = *(const bf16x8*)(sKt + (wn * 64 + tn * 32 + r) * 72 + ks * 16 + h * 8);
#pragma unroll
    for (int tm = 0; tm < 2; tm++)
#pragma unroll
      for (int tn = 0; tn < 2; tn++) acc[tm][tn] = MFMA(af[tm], bfr[tn], acc[tm][tn]);
  }
  u16* slot = wsb(p, WS_BIG + B_ST) + (size_t)item * 16384;
#pragma unroll
  for (int tm = 0; tm < 2; tm++)
#pragma unroll
    for (int tn = 0; tn < 2; tn++)
#pragma unroll
      for (int i = 0; i < 16; i++) slot[(wm * 64 + tm * 32 + crow(i, h)) * 128 + wn * 64 + tn * 32 + r] = f2bf(acc[tm][tn][i]);
  if (tid < 128) {
    float sum = 0.f;
    const u16* kr = sKt + tid * 72;
#pragma unroll 8
    for (int s = 0; s < 64; s++) sum += bf2f(kr[s]);
    wsf(p, WS_NU)[(size_t)item * 128 + tid] = sum;
  }
}

DI void mlstm_m2(const Params& p, int l, int unit) {
  const int tid = tidx();
  int chain, g, nc, item0, b, h; bool sample;
  if (unit < 256) { chain = unit >> 5; g = unit & 31; nc = 256; item0 = chain * 256; b = chain >> 2; h = chain & 3; sample = false; }
  else { int u = unit - 256; int j = u >> 5; g = u & 31; chain = 8 + j; nc = 1; item0 = 2048 + j; b = j >> 2; h = j & 3; sample = true; }
  const int el = g * 512 + tid * 2; const int e = el >> 7, d = el & 127;
  float c0 = 0.f, c1 = 0.f, nst = 0.f, m = 0.f;
  const bool do_n = (g == 0 && tid < 128);
  if (sample) {
    const float* C0 = p.st_C + ((size_t)(l * 32 + b) * 4 + h) * 16384;
    c0 = C0[d * 128 + e]; c1 = C0[(d + 1) * 128 + e];
    if (do_n) nst = p.st_n[((size_t)(l * 32 + b) * 4 + h) * 128 + tid];
    m = p.st_m[(l * 32 + b) * 4 + h];
  }
  u16* slots = wsb(p, WS_BIG + B_ST);
  const float* scal = wsf(p, WS_SCAL);
  float* nu = wsf(p, WS_NU);
  float* mst = wsf(p, WS_MST);
  for (int cb = 0; cb < nc; cb += 8) {
    unsigned uu[8]; float nn[8];
#pragma unroll
    for (int j = 0; j < 8; j++) {
      uu[j] = 0; nn[j] = 0.f;
      if (cb + j < nc) {
        uu[j] = *(const unsigned*)(slots + (size_t)(item0 + cb + j) * 16384 + el);
        if (do_n) nn[j] = nu[(size_t)(item0 + cb + j) * 128 + tid];
      }
    }
#pragma unroll
    for (int j = 0; j < 8; j++) {
      if (cb + j < nc) {
        const int item = item0 + cb + j;
        const float A = scal[item * 2], Cm = scal[item * 2 + 1];
        const float mnew = fmaxf(A + m, Cm);
        const float dec = __expf(A + m - mnew), us = __expf(Cm - mnew);
        *(unsigned*)(slots + (size_t)item * 16384 + el) = pk2(c0, c1);
        c0 = dec * c0 + us * bflo(uu[j]);
        c1 = dec * c1 + us * bfhi(uu[j]);
        if (do_n) { nu[(size_t)item * 128 + tid] = nst; nst = dec * nst + us * nn[j]; }
        if (g == 0 && tid == 0) mst[item] = m;
        m = mnew;
      }
    }
  }
  float* oC = sample ? p.out + O_SC + ((size_t)(l * 32 + b) * 4 + h) * 16384 : p.out + O_PC + ((size_t)(l * 2 + b) * 4 + h) * 16384;
  oC[d * 128 + e] = c0; oC[(d + 1) * 128 + e] = c1;
  if (do_n) { float* on = sample ? p.out + O_SN + ((size_t)(l * 32 + b) * 4 + h) * 128 : p.out + O_PN + ((size_t)(l * 2 + b) * 4 + h) * 128; on[tid] = nst; }
  if (g == 0 && tid == 0) { float* om = sample ? p.out + O_SM + (l * 32 + b) * 4 + h : p.out + O_PM + (l * 2 + b) * 4 + h; *om = m; }
}

DI void mlstm_m3(const Params& p, int l, int item, char* smem) {
  const ChunkInfo ci = chunk_info(item);
  const int tid = tidx(), lane = tid & 63, w = tid >> 6, r = lane & 31, h = lane >> 5;
  u16* sQ = (u16*)smem;
  u16* sK = sQ + 64 * 136;
  u16* sVt = sK + 64 * 136;
  u16* sP = sVt + 128 * 72;
  float* su = (float*)(sP + 64 * 72);
  float* sM = su + 64;
  float* sa = sM + 64;
  float* sden = sa + 64;
  float* sinv = sden + 64;
  float* sn = sinv + 64;
  float* sH = (float*)smem;
  __syncthreads();
  const float m_start = wsf(p, WS_MST)[item];
  if (w == 0) {
    const float* g = wsf(p, WS_GATES) + (size_t)(ci.tok0 + lane) * 8;
    float ig = g[ci.h] + p.b_igate[l * 4 + ci.h];
    float lf = logsigmoid(g[4 + ci.h] + p.b_fgate[l * 4 + ci.h]);
    float bcs = lf;
#pragma unroll
    for (int o = 1; o < 64; o <<= 1) { float t = __shfl_up(bcs, o); if (lane >= o) bcs += t; }
    float u = ig - bcs;
    float cm = u;
#pragma unroll
    for (int o = 1; o < 64; o <<= 1) { float t = __shfl_up(cm, o); if (lane >= o) cm = fmaxf(cm, t); }
    float Mt = fmaxf(m_start, cm);
    su[lane] = u; sM[lane] = Mt; sa[lane] = __expf(m_start - Mt); sden[lane] = __expf(-(bcs + Mt));
  } else if (w == 1) {
    sn[lane] = wsf(p, WS_NU)[(size_t)item * 128 + lane];
    sn[lane + 64] = wsf(p, WS_NU)[(size_t)item * 128 + lane + 64];
  }
#pragma unroll
  for (int it = 0; it < 4; it++) {
    int id = tid + 256 * it; int s = id >> 4, ch = id & 15;
    uint4 v = *(const uint4*)(wsb(p, WS_BIG + B_P) + (size_t)(ci.tok0 + s) * INC + 1440 + ci.h * 128 + ch * 8);
    unsigned a[4] = {v.x, v.y, v.z, v.w};
#pragma unroll
    for (int j = 0; j < 4; j++) { sVt[(ch * 8 + 2 * j) * 72 + s] = (u16)(a[j] & 0xffffu); sVt[(ch * 8 + 2 * j + 1) * 72 + s] = (u16)(a[j] >> 16); }
  }
  {
    const int mc = tid & 31, mat = mc >> 4, chunk = mc & 15, rg = tid >> 5;
    u16* dst = mat ? sK : sQ;
    const float sc = mat ? 0.08838834764831845f : 1.f;
    conv_run(p, l, ci, mat, chunk, rg * 8, 8, [&](int t, const float (&y)[8]) {
      float x[8];
#pragma unroll
      for (int j = 0; j < 8; j++) x[j] = y[j] * sc;
      *(uint4*)(dst + t * 136 + chunk * 8) = pack8(x);
    });
  }
  __syncthreads();
  {
    const int tq = w >> 1, ts = w & 1;
    f32x16 s;
#pragma unroll
    for (int i = 0; i < 16; i++) s[i] = 0.f;
#pragma unroll
    for (int ks = 0; ks < 8; ks++) {
      bf16x8 a = *(const bf16x8*)(sQ + (tq * 32 + r) * 136 + ks * 16 + h * 8);
      bf16x8 b = *(const bf16x8*)(sK + (ts * 32 + r) * 136 + ks * 16 + h * 8);
      s = MFMA(a, b, s);
    }
    const int sidx = ts * 32 + r;
    const float us = su[sidx];
#pragma unroll
    for (int i = 0; i < 16; i++) {
      int t = tq * 32 + crow(i, h);
      float v = (sidx <= t) ? s[i] * __expf(us - sM[t]) : 0.f;
      sP[t * 72 + sidx] = f2bf(v);
    }
  }
  __syncthreads();
  if (tid < 64) {
    float rs = 0.f, qd = 0.f;
    const u16* pr = sP + tid * 72;
#pragma unroll 8
    for (int s = 0; s < 64; s++) rs += bf2f(pr[s]);
    const u16* qr = sQ + tid * 136;
#pragma unroll 8
    for (int d = 0; d < 128; d++) qd += bf2f(qr[d]) * sn[d];
    float qn = sa[tid] * qd + rs;
    sinv[tid] = 1.f / fmaxf(fabsf(qn), sden[tid]);
  }
  const int tq = w & 1, eb = (w >> 1) * 2;
  f32x16 a1[2], a2[2];
#pragma unroll
  for (int et = 0; et < 2; et++)
#pragma unroll
    for (int i = 0; i < 16; i++) { a1[et][i] = 0.f; a2[et][i] = 0.f; }
  const u16* slot = wsb(p, WS_BIG + B_ST) + (size_t)item * 16384;
#pragma unroll
  for (int ks = 0; ks < 8; ks++) {
    bf16x8 a = *(const bf16x8*)(sQ + (tq * 32 + r) * 136 + ks * 16 + h * 8);
#pragma unroll
    for (int et = 0; et < 2; et++) {
      bf16x8 b = *(const bf16x8*)(slot + ((eb + et) * 32 + r) * 128 + ks * 16 + h * 8);
      a1[et] = MFMA(a, b, a1[et]);
    }
  }
#pragma unroll
  for (int ks = 0; ks < 4; ks++) {
    bf16x8 a = *(const bf16x8*)(sP + (tq * 32 + r) * 72 + ks * 16 + h * 8);
#pragma unroll
    for (int et = 0; et < 2; et++) {
      bf16x8 b = *(const bf16x8*)(sVt + ((eb + et) * 32 + r) * 72 + ks * 16 + h * 8);
      a2[et] = MFMA(a, b, a2[et]);
    }
  }
  __syncthreads();
#pragma unroll
  for (int et = 0; et < 2; et++)
#pragma unroll
    for (int i = 0; i < 16; i++) {
      int t = tq * 32 + crow(i, h);
      sH[t * 132 + (eb + et) * 32 + r] = (sa[t] * a1[et][i] + a2[et][i]) * sinv[t];
    }
  __syncthreads();
  {
    const int t = tid >> 2, part = tid & 3;
    const float* hr = sH + t * 132 + part * 32;
    float ss = 0.f;
#pragma unroll 8
    for (int j = 0; j < 32; j++) ss += hr[j] * hr[j];
    ss += __shfl_xor(ss, 1); ss += __shfl_xor(ss, 2);
    const float rr = rsqrtf(ss * (1.f / 128.f) + EPS);
    const int tok = ci.tok0 + t;
    const u16* og = wsb(p, WS_BIG + B_P) + (size_t)tok * INC + 1960 + ci.h * 128 + part * 32;
    const float* gm = p.g_mhead + (size_t)l * 512 + ci.h * 128 + part * 32;
    u16* o = wsb(p, WS_ACT) + (size_t)tok * LDA + 512 + ci.h * 128 + part * 32;
#pragma unroll
    for (int c8 = 0; c8 < 4; c8++) {
      float gv[8], x[8];
      unpack8(*(const uint4*)(og + c8 * 8), gv);
#pragma unroll
      for (int j = 0; j < 8; j++) x[j] = hr[c8 * 8 + j] * rr * gm[c8 * 8 + j] / (1.f + __expf(-gv[j]));
      *(uint4*)(o + c8 * 8) = pack8(x);
    }
  }
}

DI void xkv_item(const Params& p, int l, int item, char* smem) {
  const int tid = tidx();
  const int kg = item & 3, hh = (item >> 2) & 3, bidx = item >> 4;
  u16* T = (u16*)smem;
  __syncthreads();
  const int key = tid >> 2, qt = tid & 3;
  const int mem = kg * 64 + key;
  const bool prompt = bidx < 2;
  float* kp; const float* vp;
  if (prompt) {
    kp = p.out + O_PMEMK + (((size_t)(l * 2 + bidx) * 256 + mem) * 4 + hh) * 256 + qt * 64;
    vp = p.out + O_PMEMV + (((size_t)(l * 2 + bidx) * 256 + mem) * 4 + hh) * 256 + qt * 64;
  } else {
    kp = (float*)(p.cache_mem_k + (((size_t)(l * 32 + bidx - 2) * 256 + mem) * 4 + hh) * 256 + qt * 64);
    vp = p.cache_mem_v + (((size_t)(l * 32 + bidx - 2) * 256 + mem) * 4 + hh) * 256 + qt * 64;
  }
  float rr = 1.f;
  if (prompt) {
    float ss = 0.f;
#pragma unroll 4
    for (int j = 0; j < 16; j++) { float4 v = *(const float4*)(kp + j * 4); ss += v.x * v.x + v.y * v.y + v.z * v.z + v.w * v.w; }
    ss += __shfl_xor(ss, 1); ss += __shfl_xor(ss, 2);
    rr = rsqrtf(ss * (1.f / 256.f) + EPS);
  }
  const float* gk = p.g_xk + l * 256 + qt * 64;
  const float* gq = p.g_xq + l * 256 + qt * 64;
  u16* xk = wsb(p, WS_BIG + B_XK) + ((size_t)(bidx * 4 + hh) * 256 + mem) * 256 + qt * 64;
#pragma unroll 2
  for (int c8 = 0; c8 < 8; c8++) {
    float4 a = *(const float4*)(kp + c8 * 8), b = *(const float4*)(kp + c8 * 8 + 4);
    float x[8] = {a.x, a.y, a.z, a.w, b.x, b.y, b.z, b.w};
    if (prompt) {
#pragma unroll
      for (int j = 0; j < 8; j++) x[j] = x[j] * rr * gk[c8 * 8 + j];
      *(float4*)(kp + c8 * 8) = make_float4(x[0], x[1], x[2], x[3]);
      *(float4*)(kp + c8 * 8 + 4) = make_float4(x[4], x[5], x[6], x[7]);
    }
#pragma unroll
    for (int j = 0; j < 8; j++) x[j] = x[j] * gq[c8 * 8 + j] * (0.0625f * LOG2E);
    *(uint4*)(xk + c8 * 8) = pack8(x);
    float4 va = *(const float4*)(vp + c8 * 8), vb = *(const float4*)(vp + c8 * 8 + 4);
    float y[8] = {va.x, va.y, va.z, va.w, vb.x, vb.y, vb.z, vb.w};
    *(uint4*)(T + key * 264 + qt * 64 + c8 * 8) = pack8(y);
  }
  __syncthreads();
  {
    const int e = tid;
    u16* xv = wsb(p, WS_BIG + B_XVT) + ((size_t)(bidx * 4 + hh) * 256 + e) * LDXV + kg * 64;
#pragma unroll 2
    for (int oct = 0; oct < 8; oct++) {
      uint4 v;
      v.x = (unsigned)T[(oct * 8 + 0) * 264 + e] | ((unsigned)T[(oct * 8 + 1) * 264 + e] << 16);
      v.y = (unsigned)T[(oct * 8 + 2) * 264 + e] | ((unsigned)T[(oct * 8 + 3) * 264 + e] << 16);
      v.z = (unsigned)T[(oct * 8 + 4) * 264 + e] | ((unsigned)T[(oct * 8 + 5) * 264 + e] << 16);
      v.w = (unsigned)T[(oct * 8 + 6) * 264 + e] | ((unsigned)T[(oct * 8 + 7) * 264 + e] << 16);
      *(uint4*)(xv + oct * 8) = v;
    }
  }
}

DI void phase_C2(const Params& p, int l, char* smem) {
  for (int t = blockIdx.x; t < 544; t += gridDim.x) xkv_item(p, l, t, smem);
}
DI void phase_C1(const Params& p, int l, char* smem) {
  const int lane = tidx() & 63, w = tidx() >> 6;
  for (int t = blockIdx.x; t < NITEM; t += gridDim.x) mlstm_m1(p, l, t, smem);
  for (int t = blockIdx.x * 4 + w; t < NTOK + 32768; t += gridDim.x * 4) {
    if (t < NTOK) post_token(p, l, t, lane); else post_past(p, l, t - NTOK, lane);
  }
}

DI void phase_D(const Params& p, int l, char* smem) {
  const int n_scan = 256 + 4096;
  const int n_q = 544 * 4;
  const u16* W = wsb(p, WS_W) + (size_t)l * W_LAYER;
  for (int t = blockIdx.x; t < n_scan + n_q; t += gridDim.x) {
    if (t < n_scan) mlstm_m2(p, l, t);
    else {
      int u = t - n_scan; int mt = u >> 2, nt = u & 3;
      EpiQ epi{wsb(p, WS_BIG + B_Q), wsf(p, WS_RQ), (const float2*)(p.ws + WS_ROPE), p.g_qnorm + l * 96};
      gemm_tile<1, 3>(wsb(p, WS_BIG + B_P), INC, W + W_Q, LDWQ, 256, mt * 64, nt * 192, smem, epi);
    }
  }
}

DI void phase_E(const Params& p, int l, char* smem) {
  for (int t = blockIdx.x; t < NITEM; t += gridDim.x) mlstm_m3(p, l, t, smem);
}

DI void phase_F(const Params& p, int l, char* smem) {
  const u16* W = wsb(p, WS_W) + (size_t)l * W_LAYER;
  for (int t = blockIdx.x; t < 528 * 8; t += gridDim.x) {
    int mt = t >> 3, nt = t & 7;
    EpiKV epi{wsb(p, WS_BIG + B_K), wsb(p, WS_BIG + B_VT), wsf(p, WS_KROPE), p.g_knorm + l * 96};
    gemm_tile<2, 2>(wsb(p, WS_CKV), 128, W + W_KV, LDWKV, 128, mt * 128, nt * 128, smem, epi);
  }
}

DI void phase_G(const Params& p, const Sched& sc, char* smem) {
  const int G = gridDim.x, j = blockIdx.x;
  const int lane = tidx() & 63, w = tidx() >> 6, r = lane & 31;
  const int NIT = 2048 + 256;
  const u16* qb = wsb(p, WS_BIG + B_Q);
  const u16* Kb = wsb(p, WS_BIG + B_K);
  const u16* Vt = wsb(p, WS_BIG + B_VT);
  u16* act = wsb(p, WS_ACT);
  auto run_prompt = [&](int bh, int bi) {
    int b = bh >> 3, hd = bh & 7;
    int tok = b * 16384 + bi * 128 + w * 32 + r;
    flash_item<96, 2, 64, true, false, true>(qb + (size_t)tok * 768 + hd * 96, true, 2 * bi + 2, 2 * bi + 1 + (w >> 1),
                                             Kb + ((size_t)hd * NROWS + b * 16384) * 96, 96, Vt + (size_t)hd * 64 * LDVT + b * 16384, LDVT, 0,
                                             act + (size_t)tok * LDA + hd * 64, smem);
  };
  auto run_sample = [&](int u) {
    int b = u >> 3, hd = u & 7;
    int tok = NP + b * 64 + (w & 1) * 32 + r;
    size_t row0 = (size_t)NP + b * 1088;
    flash_item<96, 2, 64, true, false, true>(qb + (size_t)tok * 768 + hd * 96, w < 2, 17, 17, Kb + ((size_t)hd * NROWS + row0) * 96, 96,
                                             Vt + (size_t)hd * 64 * LDVT + row0, LDVT, 0, act + (size_t)tok * LDA + hd * 64, smem);
  };
  if (sc.ok) {
    const int xg = sc.xg, xi = sc.xi;
    for (int pass = 0; pass < 2; pass++) {
      const int bh = xg + 8 * pass;
      run_prompt(bh, xi);
      run_prompt(bh, 127 - xi);
    }
    if ((j & 1) == 0) run_sample(j >> 1);
  } else {
    for (int k = 0; k * G < NIT; k++) {
      int it = (k & 1) ? (k * G + (G - 1 - j)) : (k * G + j);
      if (it >= NIT) continue;
      if (it < 2048) run_prompt(it & 15, 127 - (it >> 4)); else run_sample(it - 2048);
    }
  }
}

DI void phase_K(const Params& p, char* smem) {
  const int lane = tidx() & 63, w = tidx() >> 6, r = lane & 31;
  const u16* qx = wsb(p, WS_BIG + B_QX);
  u16* act = wsb(p, WS_ACT);
  for (int t = blockIdx.x; t < 2176; t += gridDim.x) {
    int bidx, hh, tok0;
    if (t < 2048) { bidx = t >> 10; hh = (t >> 8) & 3; tok0 = bidx * 16384 + (t & 255) * 64; }
    else { int u = t - 2048; bidx = 2 + (u >> 2); hh = u & 3; tok0 = NP + (u >> 2) * 64; }
    int tok = tok0 + (w & 1) * 32 + r;
    int e0 = (w >> 1) * 128;
    const u16* Kb = wsb(p, WS_BIG + B_XK) + (size_t)(bidx * 4 + hh) * 65536;
    const u16* Vt = wsb(p, WS_BIG + B_XVT) + (size_t)(bidx * 4 + hh) * 256 * LDXV;
    flash_item<256, 4, 256, false, true, false>(qx + (size_t)tok * LDA + hh * 256, true, 4, 4, Kb, 256, Vt, LDXV, e0,
                                         act + (size_t)tok * LDA + hh * 256 + e0, smem);
  }
}

template <class Epi>
DI void phase_gemm128(const Sched& sc, const u16* A, long lda, const u16* Bt, long ldb, int K, int MT, int NT, int SN, char* smem, const Epi& epi) {
  if (sc.ok) {
    const int xg = sc.xg, xi = sc.xi;
    const int SM = 64 / SN;
    const int sng = NT / SN, smg = MT / SM;
    for (int st = xg; st < smg * sng; st += 8) {
      int sm = st / sng, sn = st % sng;
      int mt = sm * SM + xi / SN, nt = sn * SN + xi % SN;
      gemm_tile<2, 2>(A, lda, Bt, ldb, K, mt * 128, nt * 128, smem, epi);
    }
  } else {
    for (int t = blockIdx.x; t < MT * NT; t += gridDim.x) {
      int mt = t / NT, nt = t % NT;
      gemm_tile<2, 2>(A, lda, Bt, ldb, K, mt * 128, nt * 128, smem, epi);
    }
  }
}

#if defined(__HIP_DEVICE_COMPILE__)
typedef const __attribute__((address_space(4))) Params* KargPtr;
#define KARG_LOAD KargPtr pp4 = (KargPtr)__builtin_amdgcn_kernarg_segment_ptr(); asm volatile("" : "+s"(pp4)); const Params p = *pp4;
#else
#define KARG_LOAD const Params p{};
#endif
template <int L>
DI void run_layer(const Sched& sc, int ph_begin, int ph_end, char* smem, cg::grid_group& grid) {
  const int base = 1 + 15 * L;
#define RUN_PHASE(S, ...)  RUN_PHASE_R(S, 1, __VA_ARGS__)
#define RUN_PHASE_R(S, R, ...)                                    \
  {                                                          \
    const int ph = base + (S);                               \
    if (ph >= ph_begin && ph < ph_end) {                     \
      for (int rep_ = 0; rep_ < (R); rep_++) {               \
        KARG_LOAD                                            \
        const u16* W = wsb(p, WS_W) + (size_t)L * W_LAYER;   \
        const float* xs0 = (L == 0) ? p.x_prompt : p.out;    \
        const float* xs1 = (L == 0) ? p.x_sample : p.out + (size_t)NP * 1024; \
        (void)W; (void)xs0; (void)xs1;                       \
        __VA_ARGS__;                                         \
        if (ph + 1 < ph_end) grid.sync();                    \
      }                                                      \
    }                                                        \
  }
  if (L > 0) RUN_PHASE(0, phase_norm(p, L))
  RUN_PHASE_R(1, REP_INPROJ, phase_inproj(p, sc, L, smem))
  RUN_PHASE_R(2, REP_C, phase_C1(p, L, smem))
  RUN_PHASE(2, phase_C2(p, L, smem))
  RUN_PHASE(3, phase_D(p, L, smem))
  RUN_PHASE_R(4, REP_E, phase_E(p, L, smem))
  RUN_PHASE_R(5, REP_F, phase_F(p, L, smem))
  RUN_PHASE_R(6, REP_G, phase_G(p, sc, smem))
  RUN_PHASE(7, { EpiRes epi{xs0, xs1, p.out}; phase_gemm128(sc, wsb(p, WS_ACT), LDA, W + W_OUT, LDW, 1024, 272, 8, 8, smem, epi); })
  RUN_PHASE_R(8, REP_NORM, phase_norm(p, 1))
  RUN_PHASE(9, { EpiStoreBf16 epi{wsb(p, WS_BIG + B_QX), LDA, 1024, nullptr}; phase_gemm128(sc, wsb(p, WS_ACT), LDA, W + W_XQ, LDW, 1024, 272, 8, 8, smem, epi); })
  RUN_PHASE_R(10, REP_K, phase_K(p, smem))
  RUN_PHASE(11, { EpiRes epi{p.out, p.out + (size_t)NP * 1024, p.out}; phase_gemm128(sc, wsb(p, WS_ACT), LDA, W + W_XO, LDW, 1024, 272, 8, 8, smem, epi); })
  RUN_PHASE(12, phase_norm(p, 1))
  RUN_PHASE_R(13, REP_FF1, { EpiRelu2 epi{wsb(p, WS_BIG + B_H1), LDH1}; phase_gemm128(sc, wsb(p, WS_ACT), LDA, W + W_FF1, LDW, 1024, 272, 32, 8, smem, epi); })
  RUN_PHASE(14, { EpiRes epi{p.out, p.out + (size_t)NP * 1024, p.out}; phase_gemm128(sc, wsb(p, WS_BIG + B_H1), LDH1, W + W_FF2, LDW2, 4096, 272, 8, 8, smem, epi); })
#undef RUN_PHASE
#undef RUN_PHASE_R
}

__global__ void __launch_bounds__(256, 2) fwd_megakernel(Params p, int ph_begin, int ph_end) {
  __shared__ __attribute__((aligned(16))) char smem[SMEM_BYTES];
  cg::grid_group grid = cg::this_grid();
  __shared__ int s_rank;
  Sched sc;
  sc.xg = (int)((unsigned)__builtin_amdgcn_s_getreg((3 << 11) | 20) & 7u);
  unsigned* cnt = (unsigned*)(p.ws + WS_CNT);
  if (tidx() == 0) s_rank = (int)atomicAdd(&cnt[sc.xg], 1u);
  __syncthreads();
  sc.xi = __builtin_amdgcn_readfirstlane(s_rank);
  sc.ok = 0;
  if (ph_begin <= 0 && 0 < ph_end) {
    phase_prep(p, smem);
    if (1 < ph_end) grid.sync();
  }
  {
    int ok = (gridDim.x == 512);
#pragma unroll
    for (int i = 0; i < 8; i++) ok &= (__atomic_load_n(&cnt[i], __ATOMIC_RELAXED) == 64u);
    sc.ok = ok;
  }
  run_layer<0>(sc, ph_begin, ph_end, smem, grid);
  run_layer<1>(sc, ph_begin, ph_end, smem, grid);
}

extern "C" void kernel_launch(void* const* d_in, const int* in_sizes, int n_in, void* d_out, int out_size, void* d_ws, size_t ws_size,
                              hipStream_t stream) {
  static int grid_blocks = 0;
  if (!grid_blocks) {
    int dev = 0, cus = 0, per_cu = 0;
    (void)hipGetDevice(&dev);
    (void)hipDeviceGetAttribute(&cus, hipDeviceAttributeMultiprocessorCount, dev);
    (void)hipOccupancyMaxActiveBlocksPerMultiprocessor(&per_cu, fwd_megakernel, 256, 0);
    per_cu = 2;
    grid_blocks = cus * per_cu;
  }
  Params p{};
  const float** pp = (const float**)&p;
  for (int i = 0; i < 36; i++) pp[i] = (const float*)d_in[i];
  p.out = (float*)d_out;
  p.ws = (char*)d_ws;
  int ph_begin = 0, ph_end = 31;
  (void)hipMemsetAsync((char*)d_ws + WS_CNT, 0, 256, stream);
  void* args[] = {&p, &ph_begin, &ph_end};
  hipError_t e = hipLaunchCooperativeKernel((void*)fwd_megakernel, dim3(grid_blocks), dim3(256), args, 0, stream);
  if (e != hipSuccess) fprintf(stderr, "cooperative launch failed: %s (grid %d)\n", hipGetErrorString(e), grid_blocks);
}
```

```cpp
#include <hip/hip_runtime.h>
#include <hip/hip_cooperative_groups.h>
#include <stdint.h>
#include <stdio.h>
namespace cg = cooperative_groups;

typedef unsigned short u16;
typedef short bf16x8 __attribute__((ext_vector_type(8)));
typedef short s16x4 __attribute__((ext_vector_type(4)));
typedef float f32x16 __attribute__((ext_vector_type(16)));
typedef __bf16 bfv2 __attribute__((ext_vector_type(2)));
typedef float fv2 __attribute__((ext_vector_type(2)));
typedef unsigned u32x4 __attribute__((ext_vector_type(4)));
#define DI __device__ __forceinline__
#define MFMA(a, b, c) __builtin_amdgcn_mfma_f32_32x32x16_bf16((a), (b), (c), 0, 0, 0)

constexpr int NP = 32768;
constexpr int NS = 2048;
constexpr int NTOK = NP + NS;
constexpr int NROWS = NP + 32 * 1088;
constexpr int INC = 2472;
constexpr float EPS = 1e-6f;
constexpr float LOG2E = 1.4426950408889634f;
constexpr int NITEM = 2048 + 128;
constexpr int LDA = 1088;
constexpr int LDW = 1088;
constexpr int LDW2 = 4160;
constexpr int LDWQ = 320;
constexpr int LDWKV = 192;
constexpr int LDH1 = 4160;
constexpr int LDVT = NROWS + 64;
constexpr int LDXV = 320;

constexpr size_t O_Y = 0;
constexpr size_t O_PCKV = 35651584;
constexpr size_t O_PKROPE = O_PCKV + 8388608;
constexpr size_t O_PC = O_PKROPE + 2097152;
constexpr size_t O_PN = O_PC + 262144;
constexpr size_t O_PM = O_PN + 2048;
constexpr size_t O_PCONV = O_PM + 16;
constexpr size_t O_PMEMK = O_PCONV + 12288;
constexpr size_t O_PMEMV = O_PMEMK + 1048576;
constexpr size_t O_SCKV = O_PMEMV + 1048576;
constexpr size_t O_SKROPE = O_SCKV + 524288;
constexpr size_t O_SC = O_SKROPE + 131072;
constexpr size_t O_SN = O_SC + 4194304;
constexpr size_t O_SM = O_SN + 32768;
constexpr size_t O_SCONV = O_SM + 256;

constexpr size_t W_IN = 0;
constexpr size_t W_Q = W_IN + 2560 * LDW;
constexpr size_t W_KV = W_Q + 768 * LDWQ;
constexpr size_t W_OUT = W_KV + 1024 * LDWKV;
constexpr size_t W_XQ = W_OUT + 1024 * LDW;
constexpr size_t W_XK = W_XQ + 1024 * LDW;
constexpr size_t W_XV = W_XK + 1024 * LDW;
constexpr size_t W_XO = W_XV + 1024 * LDW;
constexpr size_t W_FF1 = W_XO + 1024 * LDW;
constexpr size_t W_FF2 = W_FF1 + 4096 * LDW;
constexpr size_t W_LAYER = W_FF2 + 1024 * LDW2;

constexpr size_t WS_W = 0;
constexpr size_t WS_ACT = WS_W + 2 * W_LAYER * 2;
constexpr size_t WS_CKV = WS_ACT + (size_t)NTOK * LDA * 2;
constexpr size_t WS_KROPE = WS_CKV + (size_t)NROWS * 128 * 2;
constexpr size_t WS_RQ = WS_KROPE + (size_t)NROWS * 32 * 4;
constexpr size_t WS_GATES = WS_RQ + (size_t)NTOK * 4;
constexpr size_t WS_ROPE = WS_GATES + (size_t)NTOK * 8 * 4;
constexpr size_t WS_SCAL = WS_ROPE + (size_t)16384 * 16 * 8;
constexpr size_t WS_MST = WS_SCAL + (size_t)NITEM * 2 * 4;
constexpr size_t WS_NU = WS_MST + (size_t)NITEM * 4 + 256;
constexpr size_t WS_CNT = WS_NU + (size_t)NITEM * 128 * 4;
constexpr size_t WS_HM = WS_CNT + 256;
constexpr size_t WS_BIG = WS_HM + (size_t)512 * LDA * 2;
constexpr size_t B_P = 0;
constexpr size_t B_K = 0;
constexpr size_t B_VT = B_K + (size_t)8 * NROWS * 96 * 2;
constexpr size_t B_Q = B_VT + (size_t)8 * 64 * LDVT * 2;
constexpr size_t B_ST = B_Q + (size_t)NTOK * 768 * 2;
constexpr size_t B_XK = B_ST + (size_t)NITEM * 16384 * 2;
constexpr size_t B_XVT = B_XK + (size_t)34 * 4 * 256 * 256 * 2;
constexpr size_t B_END = B_XVT + (size_t)34 * 4 * 256 * LDXV * 2;
constexpr size_t B_QX = 0;
constexpr size_t B_H1 = 0;
static_assert((size_t)NTOK * INC * 2 <= B_Q, "p overlaps q");
static_assert((size_t)NTOK * LDH1 * 2 <= B_XK, "h1 overlaps xkv");
static_assert((size_t)NTOK * LDA * 2 <= B_Q, "qx overlaps q");
static_assert(WS_BIG + B_END <= (size_t)536870912, "workspace too large");
static_assert(WS_BIG % 256 == 0 && B_Q % 256 == 0 && B_ST % 256 == 0 && B_VT % 256 == 0, "align");

constexpr int SMEM_BYTES = 73728;
#ifndef REP_INPROJ
#define REP_INPROJ 1
#endif
#ifndef REP_C
#define REP_C 1
#endif
#ifndef REP_E
#define REP_E 1
#endif
#ifndef REP_F
#define REP_F 1
#endif
#ifndef REP_G
#define REP_G 1
#endif
#ifndef REP_K
#define REP_K 1
#endif
#ifndef REP_FF1
#define REP_FF1 1
#endif
#ifndef REP_NORM
#define REP_NORM 1
#endif

struct Params {
  const float* x_prompt; const float* x_sample; const float* cache_ckv; const float* cache_krope;
  const float* st_C; const float* st_n; const float* st_m; const float* st_conv;
  const float* cache_mem_k; const float* cache_mem_v; const float* mem_prompt;
  const float* g_mix; const float* w_in; const float* g_qa; const float* w_q_up; const float* g_qnorm; const float* g_kva;
  const float* w_kv_up; const float* g_knorm; const float* w_conv; const float* b_conv; const float* b_igate; const float* b_fgate;
  const float* g_mhead; const float* w_out; const float* g_xattn; const float* g_mem; const float* w_xq; const float* w_xk; const float* w_xv;
  const float* g_xq; const float* g_xk; const float* w_xo; const float* g_mlp; const float* w_ff1; const float* w_ff2;
  float* out; char* ws;
};

struct Sched { int xg, xi, ok; };
DI int tidx() { int t = (int)threadIdx.x; asm volatile("" : "+v"(t)); return t; }
DI unsigned pk2(float a, float b) { fv2 v = {a, b}; bfv2 r = __builtin_convertvector(v, bfv2); return __builtin_bit_cast(unsigned, r); }
DI u16 f2bf(float a) { return (u16)(pk2(a, 0.f) & 0xffffu); }
DI float bf2f(u16 v) { return __uint_as_float(((unsigned)v) << 16); }
DI float bflo(unsigned v) { return __uint_as_float(v << 16); }
DI float bfhi(unsigned v) { return __uint_as_float(v & 0xffff0000u); }
DI int crow(int i, int h) { return (i & 3) + 8 * (i >> 2) + 4 * h; }
DI float wave_sum(float v) {
#pragma unroll
  for (int o = 32; o >= 1; o >>= 1) v += __shfl_xor(v, o);
  return v;
}
DI float wave_max(float v) {
#pragma unroll
  for (int o = 32; o >= 1; o >>= 1) v = fmaxf(v, __shfl_xor(v, o));
  return v;
}
DI void unpack8(uint4 v, float (&x)[8]) {
  x[0] = bflo(v.x); x[1] = bfhi(v.x); x[2] = bflo(v.y); x[3] = bfhi(v.y);
  x[4] = bflo(v.z); x[5] = bfhi(v.z); x[6] = bflo(v.w); x[7] = bfhi(v.w);
}
DI uint4 pack8(const float (&x)[8]) {
  uint4 v; v.x = pk2(x[0], x[1]); v.y = pk2(x[2], x[3]); v.z = pk2(x[4], x[5]); v.w = pk2(x[6], x[7]); return v;
}
DI u16* wsb(const Params& p, size_t off) { return (u16*)(p.ws + off); }
DI float* wsf(const Params& p, size_t off) { return (float*)(p.ws + off); }
DI const float* xrow(const Params& p, int l, int tok) {
  if (l == 0) return tok < NP ? p.x_prompt + (size_t)tok * 1024 : p.x_sample + (size_t)(tok - NP) * 1024;
  return p.out + (size_t)tok * 1024;
}
DI int tok_pos(int tok) { return tok < NP ? (tok & 16383) : 1024 + ((tok - NP) & 63); }

template <int TM, int TN>
DI void gemm_mainloop(const u16* __restrict__ A, long lda, const u16* __restrict__ Bt, long ldb, int K, char* smem,
                      f32x16 (&acc)[TM][TN]) {
  constexpr int BM = 64 * TM, BN = 64 * TN, LD = 72;
  u16* sA = (u16*)smem;
  u16* sB = sA + 2 * BM * LD;
  const int tid = tidx(), lane = tid & 63, w = tid >> 6, r = lane & 31, h = lane >> 5;
  const int wm = w >> 1, wn = w & 1;
  constexpr int NA = BM / 32, NB = BN / 32;
  u32x4 ra[NA], rb[NB];
#pragma unroll
  for (int tm = 0; tm < TM; tm++)
#pragma unroll
    for (int tn = 0; tn < TN; tn++)
#pragma unroll
      for (int i = 0; i < 16; i++) acc[tm][tn][i] = 0.f;
  const int nk = K / 64;
  const int lrow = tid >> 3, lch = (tid & 7) * 8;
  const u16* gA = A + (long)lrow * lda + lch;
  const u16* gB = Bt + (long)lrow * ldb + lch;
  const int soff = lrow * LD + lch;
#define GEMM_GLOAD(k0)                                                                   \
  {                                                                                      \
    _Pragma("unroll") for (int i = 0; i < NA; i++) ra[i] = *(const u32x4*)(gA + (long)(32 * i) * lda + (k0)); \
    _Pragma("unroll") for (int i = 0; i < NB; i++) rb[i] = *(const u32x4*)(gB + (long)(32 * i) * ldb + (k0)); \
  }
#define GEMM_SSTORE(buf)                                                                 \
  {                                                                                      \
    _Pragma("unroll") for (int i = 0; i < NA; i++) *(u32x4*)(sA + (buf) * BM * LD + soff + 32 * i * LD) = ra[i]; \
    _Pragma("unroll") for (int i = 0; i < NB; i++) *(u32x4*)(sB + (buf) * BN * LD + soff + 32 * i * LD) = rb[i]; \
  }
  GEMM_GLOAD(0)
  __syncthreads();
  GEMM_SSTORE(0)
  if (nk > 1) GEMM_GLOAD(64)
  __syncthreads();
  for (int kt = 0; kt < nk; kt++) {
    const int buf = kt & 1;
    const u16* cA = sA + buf * BM * LD + (wm * 32 * TM + r) * LD + h * 8;
    const u16* cB = sB + buf * BN * LD + (wn * 32 * TN + r) * LD + h * 8;
    bf16x8 af[TM], bfr[TN];
#pragma unroll
    for (int tm = 0; tm < TM; tm++) af[tm] = *(const bf16x8*)(cA + tm * 32 * LD);
#pragma unroll
    for (int tn = 0; tn < TN; tn++) bfr[tn] = *(const bf16x8*)(cB + tn * 32 * LD);
    if (kt + 1 < nk) GEMM_SSTORE(buf ^ 1)
    __builtin_amdgcn_sched_barrier(0);
#pragma unroll
    for (int tm = 0; tm < TM; tm++)
#pragma unroll
      for (int tn = 0; tn < TN; tn++) acc[tm][tn] = MFMA(af[tm], bfr[tn], acc[tm][tn]);
#pragma unroll
    for (int tm = 0; tm < TM; tm++) af[tm] = *(const bf16x8*)(cA + tm * 32 * LD + 16);
#pragma unroll
    for (int tn = 0; tn < TN; tn++) bfr[tn] = *(const bf16x8*)(cB + tn * 32 * LD + 16);
#pragma unroll
    for (int tm = 0; tm < TM; tm++)
#pragma unroll
      for (int tn = 0; tn < TN; tn++) acc[tm][tn] = MFMA(af[tm], bfr[tn], acc[tm][tn]);
    __builtin_amdgcn_sched_barrier(0);
    if (kt + 2 < nk) GEMM_GLOAD((kt + 2) * 64)
    __builtin_amdgcn_sched_barrier(0);
#pragma unroll
    for (int ks = 2; ks < 4; ks++) {
#pragma unroll
      for (int tm = 0; tm < TM; tm++) af[tm] = *(const bf16x8*)(cA + tm * 32 * LD + ks * 16);
#pragma unroll
      for (int tn = 0; tn < TN; tn++) bfr[tn] = *(const bf16x8*)(cB + tn * 32 * LD + ks * 16);
#pragma unroll
      for (int tm = 0; tm < TM; tm++)
#pragma unroll
        for (int tn = 0; tn < TN; tn++) acc[tm][tn] = MFMA(af[tm], bfr[tn], acc[tm][tn]);
    }
    __syncthreads();
  }
#undef GEMM_GLOAD
#undef GEMM_SSTORE
}

template <int TM, int TN, class Epi>
DI void gemm_tile(const u16* A, long lda, const u16* Bt, long ldb, int K, int m0, int n0, char* smem, const Epi& epi) {
  constexpr int BM = 64 * TM, BN = 64 * TN, LDC = BN + Epi::PAD;
  f32x16 acc[TM][TN];
  gemm_mainloop<TM, TN>(A + (long)m0 * lda, lda, Bt + (long)n0 * ldb, ldb, K, smem, acc);
  const int tid = tidx(), lane = tid & 63, w = tid >> 6, r = lane & 31, h = lane >> 5;
  const int wm = w >> 1, wn = w & 1;
  float* Ct = (float*)smem;
#pragma unroll
  for (int tm = 0; tm < TM; tm++)
#pragma unroll
    for (int tn = 0; tn < TN; tn++)
#pragma unroll
      for (int i = 0; i < 16; i++)
        Ct[(wm * 32 * TM + tm * 32 + crow(i, h)) * LDC + wn * 32 * TN + tn * 32 + r] = acc[tm][tn][i];
  __syncthreads();
  epi(Ct, LDC, m0, n0, tid);
  __syncthreads();
  (void)BM;
}

struct EpiStoreBf16 {
  static constexpr int PAD = 4;
  u16* out; long ldo; int nmax; float* gates;
  DI void operator()(const float* Ct, int ldc, int m0, int n0, int tid) const {
#pragma unroll
    for (int it = 0; it < 8; it++) {
      int id = tid + 256 * it; int row = id >> 4, c8 = (id & 15) * 8;
      int n = n0 + c8;
      if (n < nmax) {
        const float* c = Ct + row * ldc + c8;
        float4 a = *(const float4*)c, b = *(const float4*)(c + 4);
        uint4 v; v.x = pk2(a.x, a.y); v.y = pk2(a.z, a.w); v.z = pk2(b.x, b.y); v.w = pk2(b.z, b.w);
        *(uint4*)(out + (long)(m0 + row) * ldo + n) = v;
        if (gates != nullptr && n == 1952) {
          float* g = gates + (long)(m0 + row) * 8;
          *(float4*)g = a; *(float4*)(g + 4) = b;
        }
      }
    }
  }
};
struct EpiRelu2 {
  static constexpr int PAD = 4;
  u16* out; long ldo;
  DI void operator()(const float* Ct, int ldc, int m0, int n0, int tid) const {
#pragma unroll
    for (int it = 0; it < 8; it++) {
      int id = tid + 256 * it; int row = id >> 4, c8 = (id & 15) * 8;
      const float* c = Ct + row * ldc + c8;
      float x[8];
#pragma unroll
      for (int j = 0; j < 8; j++) { float v = fmaxf(c[j], 0.f); x[j] = v * v; }
      *(uint4*)(out + (long)(m0 + row) * ldo + n0 + c8) = pack8(x);
    }
  }
};
struct EpiF32 {
  static constexpr int PAD = 4;
  float* out; long ldo;
  DI void operator()(const float* Ct, int ldc, int m0, int n0, int tid) const {
#pragma unroll
    for (int it = 0; it < 8; it++) {
      int id = tid + 256 * it; int row = id >> 4, c8 = (id & 15) * 8;
      const float* c = Ct + row * ldc + c8;
      float* o = out + (long)(m0 + row) * ldo + n0 + c8;
      *(float4*)o = *(const float4*)c; *(float4*)(o + 4) = *(const float4*)(c + 4);
    }
  }
};
struct EpiRes {
  static constexpr int PAD = 4;
  const float* src0; const float* src1; float* dst;
  DI void operator()(const float* Ct, int ldc, int m0, int n0, int tid) const {
#pragma unroll
    for (int it = 0; it < 8; it++) {
      int id = tid + 256 * it; int row = id >> 4, c8 = (id & 15) * 8;
      int m = m0 + row;
      const float* s = (m < NP ? src0 + (size_t)m * 1024 : src1 + (size_t)(m - NP) * 1024) + n0 + c8;
      const float* c = Ct + row * ldc + c8;
      float4 a = *(const float4*)c, b = *(const float4*)(c + 4);
      float4 sa = *(const float4*)s, sb = *(const float4*)(s + 4);
      a.x += sa.x; a.y += sa.y; a.z += sa.z; a.w += sa.w; b.x += sb.x; b.y += sb.y; b.z += sb.z; b.w += sb.w;
      float* o = dst + (size_t)m * 1024 + n0 + c8;
      *(float4*)o = a; *(float4*)(o + 4) = b;
    }
  }
};
struct EpiQ {
  static constexpr int PAD = 1;
  u16* q; const float* rq; const float2* rope; const float* g;
  DI void operator()(const float* Ct, int ldc, int m0, int n0, int tid) const {
    float* r2s = (float*)((char*)Ct + 60000);
    {
      const int row = tid >> 2, hh = (tid >> 1) & 1, half = tid & 1; const int m = m0 + row;
      const float* c = Ct + row * ldc + hh * 96 + half * 48;
      float ss = 0.f;
#pragma unroll 8
      for (int d = 0; d < 48; d++) ss += c[d] * c[d];
      ss += __shfl_xor(ss, 1);
      const float rqv = rq[m];
      ss *= rqv * rqv;
      if (half == 0) r2s[row * 2 + hh] = rsqrtf(ss * (1.f / 96.f) + EPS) * rqv * (0.10206207261596575f * LOG2E);
    }
    __syncthreads();
#pragma unroll
    for (int it = 0; it < 6; it++) {
      const int id = tid + 256 * it; const int row = id / 24, cc = id % 24; const int hh = cc / 12, c8 = cc % 12;
      const int m = m0 + row;
      const float* c = Ct + row * ldc + hh * 96;
      const float r2 = r2s[row * 2 + hh];
      float x[8];
      if (c8 < 8) {
#pragma unroll
        for (int jj = 0; jj < 8; jj++) x[jj] = c[c8 * 8 + jj] * r2 * g[c8 * 8 + jj];
      } else {
        const int half = c8 & 1;
        const bool second = c8 >= 10;
        const float2* tab = rope + (size_t)tok_pos(m) * 16 + half * 8;
#pragma unroll
        for (int jj = 0; jj < 8; jj++) {
          const int i = half * 8 + jj;
          const float a = c[64 + i], b = c[80 + i]; const float2 cs = tab[jj];
          const float v = second ? (a * cs.y + b * cs.x) : (a * cs.x - b * cs.y);
          x[jj] = v * r2 * g[(second ? 80 : 64) + i];
        }
      }
      *(uint4*)(q + (size_t)m * 768 + n0 + cc * 8) = pack8(x);
    }
  }
};
struct EpiKV {
  static constexpr int PAD = 1;
  u16* Kb; u16* Vt; const float* krope; const float* g;
  DI void operator()(const float* Ct, int ldc, int m0, int n0, int tid) const {
    const int hd = n0 >> 7;
#pragma unroll
    for (int it = 0; it < 4; it++) {
      int id = tid + 256 * it; int oct = id & 15, e = id >> 4;
      float x[8];
#pragma unroll
      for (int j = 0; j < 8; j++) x[j] = Ct[(16 * (oct >> 1) + 4 * (oct & 1) + (j & 3) + 8 * (j >> 2)) * ldc + 64 + e];
      *(uint4*)(Vt + (size_t)(hd * 64 + e) * LDVT + m0 + oct * 8) = pack8(x);
    }
    float* rrs = (float*)((char*)Ct + 66560);
    {
      const int row = tid >> 1, half = tid & 1;
      const float* c = Ct + row * ldc + half * 32;
      const float* kr = krope + (size_t)(m0 + row) * 32 + half * 16;
      float ss = 0.f;
#pragma unroll 8
      for (int d = 0; d < 32; d++) ss += c[d] * c[d];
#pragma unroll 8
      for (int d = 0; d < 16; d++) ss += kr[d] * kr[d];
      ss += __shfl_xor(ss, 1);
      if (half == 0) rrs[row] = rsqrtf(ss * (1.f / 96.f) + EPS);
    }
    __syncthreads();
    u16* ob = Kb + ((size_t)hd * NROWS + m0) * 96;
#pragma unroll
    for (int it = 0; it < 6; it++) {
      const int id = tid + 256 * it; const int row = id / 12, cc = id % 12;
      const float rr = rrs[row];
      float x[8];
      if (cc < 8) {
        const float* c = Ct + row * ldc + cc * 8;
#pragma unroll
        for (int jj = 0; jj < 8; jj++) x[jj] = c[jj] * rr * g[cc * 8 + jj];
      } else {
        const float* kr = krope + (size_t)(m0 + row) * 32 + (cc - 8) * 8;
#pragma unroll
        for (int jj = 0; jj < 8; jj++) x[jj] = kr[jj] * rr * g[cc * 8 + jj];
      }
      *(uint4*)(ob + (size_t)id * 8) = pack8(x);
    }
  }
};

template <int DQK, int NE, int EV, bool DB, bool QNORM, bool QREG, bool VPERM = false>
DI void flash_item(const u16* Qrow, bool wave_active, int ntb, int ntw, const u16* Kbase, long ldk, const u16* Vtbase, long ldv,
                   int e0, u16* Orow, char* smem) {
  constexpr int LDK = DQK + 8, LDV = 72;
  constexpr int KS = DQK / 16;
  constexpr int KTILE = 64 * LDK, VTILE = EV * LDV;
  constexpr int NKC = 64 * (DQK / 8) / 256;
  constexpr int NVC = EV * 8 / 256;
  u16* sK = (u16*)smem;
  u16* sV = sK + (DB ? 2 : 1) * KTILE;
  const int tid = tidx(), lane = tid & 63, r = lane & 31, h = lane >> 5;
  bf16x8 qf[QREG ? KS : 1];
  float rqs = 1.f;
  if (wave_active) {
    if (QREG) {
#pragma unroll
      for (int ks = 0; ks < KS; ks++) qf[QREG ? ks : 0] = *(const bf16x8*)(Qrow + ks * 16 + h * 8);
    }
    if (QNORM) {
      float ss = 0.f;
#pragma unroll
      for (int ks = 0; ks < KS; ks++) {
        bf16x8 qq = QREG ? qf[QREG ? ks : 0] : *(const bf16x8*)(Qrow + ks * 16 + h * 8);
#pragma unroll
        for (int j = 0; j < 8; j++) { float v = bf2f((u16)qq[j]); ss += v * v; }
      }
      ss += __shfl_xor(ss, 32);
      rqs = rsqrtf(ss * (1.f / DQK) + EPS);
    }
  } else if (QREG) {
#pragma unroll
    for (int ks = 0; ks < KS; ks++)
#pragma unroll
      for (int j = 0; j < 8; j++) qf[QREG ? ks : 0][j] = 0;
  }
  f32x16 o[NE];
#pragma unroll
  for (int et = 0; et < NE; et++)
#pragma unroll
    for (int i = 0; i < 16; i++) o[et][i] = 0.f;
  float mrun = 0.f, lrun = 0.f;
  const float rqinv = __builtin_amdgcn_rcpf(rqs);

  u32x4 rk[DB ? NKC : 1], rv[DB ? NVC : 1];
  auto gload = [&](int t) {
#pragma unroll
    for (int i = 0; i < NKC; i++) {
      int id = tid + 256 * i; int row = id / (DQK / 8), ch = id % (DQK / 8);
      u32x4 v = *(const u32x4*)(Kbase + (long)(t * 64 + row) * ldk + ch * 8);
      if (DB) rk[DB ? i : 0] = v; else *(u32x4*)(sK + row * LDK + ch * 8) = v;
    }
#pragma unroll
    for (int i = 0; i < NVC; i++) {
      int id = tid + 256 * i; int row = id >> 3, ch = id & 7;
      u32x4 v = *(const u32x4*)(Vtbase + (long)row * ldv + t * 64 + ch * 8);
      if (DB) rv[DB ? i : 0] = v; else *(u32x4*)(sV + row * LDV + ch * 8) = v;
    }
  };
  auto sstore = [&](int buf) {
#pragma unroll
    for (int i = 0; i < NKC; i++) { int id = tid + 256 * i; int row = id / (DQK / 8), ch = id % (DQK / 8); *(u32x4*)(sK + buf * KTILE + row * LDK + ch * 8) = rk[DB ? i : 0]; }
#pragma unroll
    for (int i = 0; i < NVC; i++) { int id = tid + 256 * i; int row = id >> 3, ch = id & 7; *(u32x4*)(sV + buf * VTILE + row * LDV + ch * 8) = rv[DB ? i : 0]; }
  };
  auto compute = [&](int buf) {
    const u16* cK = sK + buf * KTILE + r * LDK + h * 8;
    const u16* cV = sV + buf * VTILE + (e0 + r) * LDV + 4 * h;
    const float sinit = QNORM ? -mrun * rqinv : -mrun;
    f32x16 s[2];
#pragma unroll
    for (int sub = 0; sub < 2; sub++) {
#pragma unroll
      for (int i = 0; i < 16; i++) s[sub][i] = sinit;
#pragma unroll
      for (int ks = 0; ks < KS; ks++) {
        bf16x8 a = *(const bf16x8*)(cK + sub * 32 * LDK + ks * 16);
        bf16x8 qq = QREG ? qf[QREG ? ks : 0] : *(const bf16x8*)(Qrow + ks * 16 + h * 8);
        s[sub] = MFMA(a, qq, s[sub]);
      }
    }
    float mx = -1e30f;
#pragma unroll
    for (int sub = 0; sub < 2; sub++)
#pragma unroll
      for (int i = 0; i < 16; i++) { if (QNORM) s[sub][i] *= rqs; mx = fmaxf(mx, s[sub][i]); }
    mx = fmaxf(mx, __shfl_xor(mx, 32));
    if (__any(mx > 8.f)) {
      const float d = fmaxf(mx, 0.f);
      const float alpha = __builtin_amdgcn_exp2f(-d);
      mrun += d;
      lrun *= alpha;
#pragma unroll
      for (int et = 0; et < NE; et++)
#pragma unroll
        for (int i = 0; i < 16; i++) o[et][i] *= alpha;
#pragma unroll
      for (int sub = 0; sub < 2; sub++)
#pragma unroll
        for (int i = 0; i < 16; i++) s[sub][i] -= d;
    }
    float psum = 0.f;
#pragma unroll
    for (int sub = 0; sub < 2; sub++)
#pragma unroll
      for (int i = 0; i < 16; i++) { float pv = __builtin_amdgcn_exp2f(s[sub][i]); s[sub][i] = pv; psum += pv; }
    lrun += psum;
#pragma unroll
    for (int sub = 0; sub < 2; sub++)
#pragma unroll
      for (int st = 0; st < 2; st++) {
        uint4 pp;
        pp.x = pk2(s[sub][8 * st + 0], s[sub][8 * st + 1]); pp.y = pk2(s[sub][8 * st + 2], s[sub][8 * st + 3]);
        pp.z = pk2(s[sub][8 * st + 4], s[sub][8 * st + 5]); pp.w = pk2(s[sub][8 * st + 6], s[sub][8 * st + 7]);
        bf16x8 pb = __builtin_bit_cast(bf16x8, pp);
#pragma unroll
        for (int et = 0; et < NE; et++) {
          bf16x8 a;
          if (VPERM) {
            a = *(const bf16x8*)(sV + buf * VTILE + (e0 + et * 32 + r) * LDV + sub * 32 + st * 16 + 8 * h);
          } else {
            const u16* vp = cV + et * 32 * LDV + sub * 32 + st * 16;
            s16x4 lo = *(const s16x4*)vp;
            s16x4 hi = *(const s16x4*)(vp + 8);
            a = __builtin_shufflevector(lo, hi, 0, 1, 2, 3, 4, 5, 6, 7);
          }
          o[et] = MFMA(a, pb, o[et]);
        }
      }
  };

  __syncthreads();
  if (DB) {
    gload(0);
    sstore(0);
    __syncthreads();
    for (int t = 0; t < ntb; t++) {
      const bool more = (t + 1 < ntb);
      if (more) gload(t + 1);
      __builtin_amdgcn_sched_barrier(0);
      if (wave_active && t < ntw) compute(t & 1);
      if (more) sstore((t + 1) & 1);
      __syncthreads();
    }
  } else {
    for (int t = 0; t < ntb; t++) {
      if (t > 0) __syncthreads();
      gload(t);
      __syncthreads();
      if (wave_active && t < ntw) compute(0);
    }
    __syncthreads();
  }
  if (wave_active) {
    float lt = lrun + __shfl_xor(lrun, 32);
    float inv = __builtin_amdgcn_rcpf(lt);
#pragma unroll
    for (int et = 0; et < NE; et++)
#pragma unroll
      for (int g = 0; g < 4; g++) {
        uint2 v;
        v.x = pk2(o[et][4 * g + 0] * inv, o[et][4 * g + 1] * inv);
        v.y = pk2(o[et][4 * g + 2] * inv, o[et][4 * g + 3] * inv);
        *(uint2*)(Orow + et * 32 + 8 * g + 4 * h) = v;
      }
  }
}

DI void norm_row_wave(const float* src, u16* dst, int lane) {
  float4 v[4]; float ss = 0.f;
#pragma unroll
  for (int i = 0; i < 4; i++) { v[i] = *(const float4*)(src + i * 256 + lane * 4); ss += v[i].x * v[i].x + v[i].y * v[i].y + v[i].z * v[i].z + v[i].w * v[i].w; }
  ss = wave_sum(ss);
  float rr = rsqrtf(ss * (1.f / 1024.f) + EPS);
#pragma unroll
  for (int i = 0; i < 4; i++) {
    uint2 o; o.x = pk2(v[i].x * rr, v[i].y * rr); o.y = pk2(v[i].z * rr, v[i].w * rr);
    *(uint2*)(dst + i * 256 + lane * 4) = o;
  }
}

DI void phase_norm(const Params& p, int l) {
  const int lane = tidx() & 63, w = tidx() >> 6;
  u16* act = wsb(p, WS_ACT);
  for (int t = blockIdx.x * 4 + w; t < NTOK; t += gridDim.x * 4) norm_row_wave(xrow(p, l, t), act + (size_t)t * LDA, lane);
}

DI void wtile(const float* src, const float* gain, int K, int N, u16* dst, int ldd, int k0, int n0, char* smem) {
  u16* T = (u16*)smem;
  const int tid = tidx();
  __syncthreads();
  {
    const int nn = tid & 63, kk0 = tid >> 6;
    const int n = n0 + nn;
#pragma unroll 4
    for (int i = 0; i < 16; i++) {
      int kk = kk0 + 4 * i;
      float v = 0.f;
      if (n < N) { v = src[(size_t)(k0 + kk) * N + n]; if (gain) v *= gain[k0 + kk]; }
      T[nn * 72 + kk] = f2bf(v);
    }
  }
  __syncthreads();
  {
    const int nn = tid >> 2, kq = tid & 3;
    const uint4* s = (const uint4*)(T + nn * 72 + kq * 16);
    uint4* d = (uint4*)(dst + (size_t)(n0 + nn) * ldd + k0 + kq * 16);
    d[0] = s[0]; d[1] = s[1];
  }
}

DI void phase_prep(const Params& p, char* smem) {
  const int tid = tidx(), lane = tid & 63, w = tid >> 6;
  for (int t = blockIdx.x; t < 2 * 4048; t += gridDim.x) {
    int l = t / 4048, u = t % 4048;
    const float* src; const float* gain = nullptr; int K, N, Npad; size_t doff; int ldd = LDW;
    if (u < 640) { src = p.w_in + (size_t)l * 1024 * INC; gain = p.g_mix + l * 1024; K = 1024; N = INC; Npad = 2560; doff = W_IN; }
    else if (u < 688) { u -= 640; src = p.w_q_up + (size_t)l * 256 * 768; gain = p.g_qa + l * 256; K = 256; N = 768; Npad = 768; doff = W_Q; ldd = LDWQ; }
    else if (u < 720) { u -= 688; src = p.w_kv_up + (size_t)l * 128 * 1024; K = 128; N = 1024; Npad = 1024; doff = W_KV; ldd = LDWKV; }
    else if (u < 976) { u -= 720; src = p.w_out + (size_t)l * 1048576; K = 1024; N = 1024; Npad = 1024; doff = W_OUT; }
    else if (u < 1232) { u -= 976; src = p.w_xq + (size_t)l * 1048576; gain = p.g_xattn + l * 1024; K = 1024; N = 1024; Npad = 1024; doff = W_XQ; }
    else if (u < 1488) { u -= 1232; src = p.w_xk + (size_t)l * 1048576; gain = p.g_mem + l * 1024; K = 1024; N = 1024; Npad = 1024; doff = W_XK; }
    else if (u < 1744) { u -= 1488; src = p.w_xv + (size_t)l * 1048576; gain = p.g_mem + l * 1024; K = 1024; N = 1024; Npad = 1024; doff = W_XV; }
    else if (u < 2000) { u -= 1744; src = p.w_xo + (size_t)l * 1048576; K = 1024; N = 1024; Npad = 1024; doff = W_XO; }
    else if (u < 3024) { u -= 2000; src = p.w_ff1 + (size_t)l * 4194304; gain = p.g_mlp + l * 1024; K = 1024; N = 4096; Npad = 4096; doff = W_FF1; }
    else { u -= 3024; src = p.w_ff2 + (size_t)l * 4194304; K = 4096; N = 1024; Npad = 1024; doff = W_FF2; ldd = LDW2; }
    int nt = Npad / 64;
    int kt = u / nt, ntile = u % nt;
    wtile(src, gain, K, N, wsb(p, WS_W) + (size_t)l * W_LAYER + doff, ldd, kt * 64, ntile * 64, smem);
  }
  float2* tab = (float2*)(p.ws + WS_ROPE);
  for (int t = blockIdx.x; t < 1024; t += gridDim.x) {
    int idx = t * 256 + tid; int pos = idx >> 4, i = idx & 15;
    float inv_freq = __builtin_amdgcn_exp2f(-(float)i * 0.830482023721841f);
    float ang = (float)pos * inv_freq;
    double rev = (double)ang * 0.15915494309189535;
    rev -= rint(rev);
    float fr = (float)rev;
    tab[idx] = make_float2(__builtin_amdgcn_cosf(fr), __builtin_amdgcn_sinf(fr));
  }
  u16* hm = wsb(p, WS_HM);
  for (int t = blockIdx.x * 4 + w; t < 512; t += gridDim.x * 4) norm_row_wave(p.mem_prompt + (size_t)t * 1024, hm + (size_t)t * LDA, lane);
  phase_norm(p, 0);
}

template <class Epi>
DI void phase_gemm128(const Sched& sc, const u16* A, long lda, const u16* Bt, long ldb, int K, int MT, int NT, int SN, char* smem, const Epi& epi);
DI void phase_inproj(const Params& p, const Sched& sc, int l, char* smem) {
  const u16* W = wsb(p, WS_W) + (size_t)l * W_LAYER;
  {
    EpiStoreBf16 epi{wsb(p, WS_BIG + B_P), INC, INC, wsf(p, WS_GATES)};
    phase_gemm128(sc, wsb(p, WS_ACT), LDA, W + W_IN, LDW, 1024, 272, 20, 4, smem, epi);
  }
  if (l == 0) {
    for (int u = blockIdx.x; u < 128; u += gridDim.x) {
      int l2 = u >> 6, which = (u >> 5) & 1, mt = (u >> 3) & 3, nt = u & 7;
      const u16* W2 = wsb(p, WS_W) + (size_t)l2 * W_LAYER + (which ? W_XV : W_XK);
      EpiF32 epi{p.out + (which ? O_PMEMV : O_PMEMK) + (size_t)l2 * 524288, 1024};
      gemm_tile<2, 2>(wsb(p, WS_HM), LDA, W2, LDW, 1024, mt * 128, nt * 128, smem, epi);
    }
  }
}

DI void post_token(const Params& p, int l, int tok, int lane) {
  const u16* pr = wsb(p, WS_BIG + B_P) + (size_t)tok * INC;
  {
    uint2 q4 = *(const uint2*)(pr + lane * 4);
    float a = bflo(q4.x), b = bfhi(q4.x), c = bflo(q4.y), d = bfhi(q4.y);
    float ss = wave_sum(a * a + b * b + c * c + d * d);
    if (lane == 0) wsf(p, WS_RQ)[tok] = rsqrtf(ss * (1.f / 256.f) + EPS);
  }
  const bool prompt = tok < NP;
  int b, s, row, pos; float* ckv_out; float* kr_out;
  if (prompt) {
    b = tok >> 14; s = tok & 16383; row = tok; pos = s;
    ckv_out = p.out + O_PCKV + ((size_t)(l * 2 + b) * 16384 + s) * 128;
    kr_out = p.out + O_PKROPE + ((size_t)(l * 2 + b) * 16384 + s) * 32;
  } else {
    int t2 = tok - NP; b = t2 >> 6; s = t2 & 63; row = NP + b * 1088 + 1024 + s; pos = 1024 + s;
    ckv_out = p.out + O_SCKV + ((size_t)(l * 32 + b) * 64 + s) * 128;
    kr_out = p.out + O_SKROPE + ((size_t)(l * 32 + b) * 64 + s) * 32;
  }
  {
    unsigned c2 = *(const unsigned*)(pr + 256 + lane * 2);
    float c0 = bflo(c2), c1 = bfhi(c2);
    float ss = wave_sum(c0 * c0 + c1 * c1);
    float rr = rsqrtf(ss * (1.f / 128.f) + EPS);
    float o0 = c0 * rr * p.g_kva[l * 128 + lane * 2], o1 = c1 * rr * p.g_kva[l * 128 + lane * 2 + 1];
    *(float2*)(ckv_out + lane * 2) = make_float2(o0, o1);
    *(unsigned*)(wsb(p, WS_CKV) + (size_t)row * 128 + lane * 2) = pk2(o0, o1);
  }
  if (lane < 16) {
    float x1 = bf2f(pr[384 + lane]), x2 = bf2f(pr[400 + lane]);
    float2 cs = ((const float2*)(p.ws + WS_ROPE))[(size_t)pos * 16 + lane];
    float o1 = x1 * cs.x - x2 * cs.y, o2 = x1 * cs.y + x2 * cs.x;
    kr_out[lane] = o1; kr_out[16 + lane] = o2;
    float* ka = wsf(p, WS_KROPE) + (size_t)row * 32;
    ka[lane] = o1; ka[16 + lane] = o2;
  }
  const int S = prompt ? 16384 : 64;
  if (s >= S - 3) {
    int j = s - (S - 3);
    float* dst = prompt ? p.out + O_PCONV + ((size_t)(l * 2 + b) * 3 + j) * 1024 : p.out + O_SCONV + ((size_t)(l * 32 + b) * 3 + j) * 1024;
#pragma unroll 4
    for (int i = 0; i < 16; i++) dst[lane + 64 * i] = bf2f(pr[416 + lane + 64 * i]);
  }
}

DI void post_past(const Params& p, int l, int pi, int lane) {
  int b = pi >> 10, t = pi & 1023;
  size_t row = (size_t)NP + b * 1088 + t;
  const float* src = p.cache_ckv + ((size_t)(l * 32 + b) * 1024 + t) * 128;
  float2 v = *(const float2*)(src + lane * 2);
  *(unsigned*)(wsb(p, WS_CKV) + row * 128 + lane * 2) = pk2(v.x, v.y);
  if (lane < 32) wsf(p, WS_KROPE)[row * 32 + lane] = p.cache_krope[((size_t)(l * 32 + b) * 1024 + t) * 32 + lane];
}

struct ChunkInfo { int tok0, b, h, chain, has_prev, sample; };
DI ChunkInfo chunk_info(int item) {
  ChunkInfo ci;
  if (item < 2048) {
    ci.chain = item >> 8; ci.b = ci.chain >> 2; ci.h = ci.chain & 3; int c = item & 255;
    ci.tok0 = ci.b * 16384 + c * 64; ci.has_prev = (c > 0); ci.sample = 0;
  } else {
    int j = item - 2048; ci.chain = 8 + j; ci.b = j >> 2; ci.h = j & 3; ci.tok0 = NP + ci.b * 64; ci.has_prev = 0; ci.sample = 1;
  }
  return ci;
}
DI void load_x8(const Params& p, int l, const ChunkInfo& ci, int tp, int col, float (&x)[8]) {
  if (tp >= 0 || ci.has_prev) {
    uint4 v = *(const uint4*)(wsb(p, WS_BIG + B_P) + (size_t)(ci.tok0 + tp) * INC + col);
    unpack8(v, x);
  } else if (ci.sample) {
    const float* s = p.st_conv + (((size_t)l * 32 + ci.b) * 3 + (3 + tp)) * 1024 + (col - 416);
    float4 a = *(const float4*)s, b = *(const float4*)(s + 4);
    x[0] = a.x; x[1] = a.y; x[2] = a.z; x[3] = a.w; x[4] = b.x; x[5] = b.y; x[6] = b.z; x[7] = b.w;
  } else {
#pragma unroll
    for (int j = 0; j < 8; j++) x[j] = 0.f;
  }
}
template <class Emit>
DI void conv_run(const Params& p, int l, const ChunkInfo& ci, int mat, int chunk, int row0, int nrows, Emit emit) {
  const int ch0 = mat * 512 + ci.h * 128 + chunk * 8;
  const int col = 416 + ch0;
  float w0[8], w1[8], w2[8], w3[8], bias[8];
  {
    const float* wc = p.w_conv + (size_t)l * 4096 + ch0;
    float4 a, b;
    a = *(const float4*)(wc); b = *(const float4*)(wc + 4);
    w0[0] = a.x; w0[1] = a.y; w0[2] = a.z; w0[3] = a.w; w0[4] = b.x; w0[5] = b.y; w0[6] = b.z; w0[7] = b.w;
    a = *(const float4*)(wc + 1024); b = *(const float4*)(wc + 1028);
    w1[0] = a.x; w1[1] = a.y; w1[2] = a.z; w1[3] = a.w; w1[4] = b.x; w1[5] = b.y; w1[6] = b.z; w1[7] = b.w;
    a = *(const float4*)(wc + 2048); b = *(const float4*)(wc + 2052);
    w2[0] = a.x; w2[1] = a.y; w2[2] = a.z; w2[3] = a.w; w2[4] = b.x; w2[5] = b.y; w2[6] = b.z; w2[7] = b.w;
    a = *(const float4*)(wc + 3072); b = *(const float4*)(wc + 3076);
    w3[0] = a.x; w3[1] = a.y; w3[2] = a.z; w3[3] = a.w; w3[4] = b.x; w3[5] = b.y; w3[6] = b.z; w3[7] = b.w;
    const float* bc = p.b_conv + (size_t)l * 1024 + ch0;
    a = *(const float4*)(bc); b = *(const float4*)(bc + 4);
    bias[0] = a.x; bias[1] = a.y; bias[2] = a.z; bias[3] = a.w; bias[4] = b.x; bias[5] = b.y; bias[6] = b.z; bias[7] = b.w;
  }
  float xa[8], xb[8], xc[8], xd[8];
  load_x8(p, l, ci, row0 - 3, col, xa);
  load_x8(p, l, ci, row0 - 2, col, xb);
  load_x8(p, l, ci, row0 - 1, col, xc);
  for (int t = row0; t < row0 + nrows; t++) {
    load_x8(p, l, ci, t, col, xd);
    float y[8];
#pragma unroll
    for (int j = 0; j < 8; j++) {
      float v = bias[j] + xa[j] * w0[j] + xb[j] * w1[j] + xc[j] * w2[j] + xd[j] * w3[j];
      y[j] = v * __builtin_amdgcn_rcpf(1.f + __expf(-v));
      xa[j] = xb[j]; xb[j] = xc[j]; xc[j] = xd[j];
    }
    emit(t, y);
  }
}
DI float logsigmoid(float z) { return fminf(z, 0.f) - log1pf(__expf(-fabsf(z))); }

DI void mlstm_m1(const Params& p, int l, int item, char* smem) {
  const ChunkInfo ci = chunk_info(item);
  const int tid = tidx(), lane = tid & 63, w = tid >> 6, r = lane & 31, h = lane >> 5;
  u16* sVt = (u16*)smem;
  u16* sKt = sVt + 128 * 72;
  float* swk = (float*)(sKt + 128 * 72);
  __syncthreads();
  if (w == 0) {
    const float* g = wsf(p, WS_GATES) + (size_t)(ci.tok0 + lane) * 8;
    float ig = g[ci.h] + p.b_igate[l * 4 + ci.h];
    float lf = logsigmoid(g[4 + ci.h] + p.b_fgate[l * 4 + ci.h]);
    float bcs = lf;
#pragma unroll
    for (int o = 1; o < 64; o <<= 1) { float t = __shfl_up(bcs, o); if (lane >= o) bcs += t; }
    float u = ig - bcs;
    float umax = wave_max(u);
    swk[lane] = __expf(u - umax);
    float blast = __shfl(bcs, 63);
    if (lane == 0) { float* sc = wsf(p, WS_SCAL) + (size_t)item * 2; sc[0] = blast; sc[1] = blast + umax; }
  }
#pragma unroll
  for (int it = 0; it < 4; it++) {
    int id = tid + 256 * it; int s = id >> 4, ch = id & 15;
    uint4 v = *(const uint4*)(wsb(p, WS_BIG + B_P) + (size_t)(ci.tok0 + s) * INC + 1440 + ci.h * 128 + ch * 8);
    const u16* vv = (const u16*)&v;
    unsigned a[4] = {v.x, v.y, v.z, v.w};
#pragma unroll
    for (int j = 0; j < 4; j++) { sVt[(ch * 8 + 2 * j) * 72 + s] = (u16)(a[j] & 0xffffu); sVt[(ch * 8 + 2 * j + 1) * 72 + s] = (u16)(a[j] >> 16); }
    (void)vv;
  }
  __syncthreads();
  {
    const int chunk = tid & 15, rg = tid >> 4;
    conv_run(p, l, ci, 1, chunk, rg * 4, 4, [&](int t, const float (&y)[8]) {
      float sc = 0.08838834764831845f * swk[t];
#pragma unroll
      for (int j = 0; j < 8; j++) sKt[(chunk * 8 + j) * 72 + t] = f2bf(y[j] * sc);
    });
  }
  __syncthreads();
  const int wm = w >> 1, wn = w & 1;
  f32x16 acc[2][2];
#pragma unroll
  for (int a = 0; a < 2; a++)
#pragma unroll
    for (int b = 0; b < 2; b++)
#pragma unroll
      for (int i = 0; i < 16; i++) acc[a][b][i] = 0.f;
#pragma unroll
  for (int ks = 0; ks < 4; ks++) {
    bf16x8 af[2], bfr[2];
#pragma unroll
    for (int tm = 0; tm < 2; tm++) af[tm] = *(const bf16x8*)(sVt + (wm * 64 + tm * 32 + r) * 72 + ks * 16 + h * 8);
#pragma unroll
    for (int tn = 0; tn < 2; tn++) bfr[tn] = *(const bf16x8*)(sKt + (wn * 64 + tn * 32 + r) * 72 + ks * 16 + h * 8);
#pragma unroll
    for (int tm = 0; tm < 2; tm++)
#pragma unroll
      for (int tn = 0; tn < 2; tn++) acc[tm][tn] = MFMA(bfr[tn], af[tm], acc[tm][tn]);
  }
  u16* slot = wsb(p, WS_BIG + B_ST) + (size_t)item * 16384;
#pragma unroll
  for (int tm = 0; tm < 2; tm++)
#pragma unroll
    for (int tn = 0; tn < 2; tn++)
#pragma unroll
      for (int g = 0; g < 4; g++) {
        uint2 v;
        v.x = pk2(acc[tm][tn][4 * g + 0], acc[tm][tn][4 * g + 1]);
        v.y = pk2(acc[tm][tn][4 * g + 2], acc[tm][tn][4 * g + 3]);
        *(uint2*)(slot + (wm * 64 + tm * 32 + r) * 128 + wn * 64 + tn * 32 + 8 * g + 4 * h) = v;
      }
  if (tid < 128) {
    float sum = 0.f;
    const u16* kr = sKt + tid * 72;
#pragma unroll 8
    for (int s = 0; s < 64; s++) sum += bf2f(kr[s]);
    wsf(p, WS_NU)[(size_t)item * 128 + tid] = sum;
  }
}

DI void mlstm_m2(const Params& p, int l, int unit) {
  const int tid = tidx();
  int chain, g, nc, item0, b, h; bool sample;
  if (unit < 256) { chain = unit >> 5; g = unit & 31; nc = 256; item0 = chain * 256; b = chain >> 2; h = chain & 3; sample = false; }
  else { int u = unit - 256; int j = u >> 5; g = u & 31; chain = 8 + j; nc = 1; item0 = 2048 + j; b = j >> 2; h = j & 3; sample = true; }
  const int el = g * 512 + tid * 2; const int e = el >> 7, d = el & 127;
  float c0 = 0.f, c1 = 0.f, nst = 0.f, m = 0.f;
  const bool do_n = (g == 0 && tid < 128);
  if (sample) {
    const float* C0 = p.st_C + ((size_t)(l * 32 + b) * 4 + h) * 16384;
    c0 = C0[d * 128 + e]; c1 = C0[(d + 1) * 128 + e];
    if (do_n) nst = p.st_n[((size_t)(l * 32 + b) * 4 + h) * 128 + tid];
    m = p.st_m[(l * 32 + b) * 4 + h];
  }
  u16* slots = wsb(p, WS_BIG + B_ST);
  const float* scal = wsf(p, WS_SCAL);
  float* nu = wsf(p, WS_NU);
  float* mst = wsf(p, WS_MST);
  for (int cb = 0; cb < nc; cb += 8) {
    unsigned uu[8]; float nn[8];
#pragma unroll
    for (int j = 0; j < 8; j++) {
      uu[j] = 0; nn[j] = 0.f;
      if (cb + j < nc) {
        uu[j] = *(const unsigned*)(slots + (size_t)(item0 + cb + j) * 16384 + el);
        if (do_n) nn[j] = nu[(size_t)(item0 + cb + j) * 128 + tid];
      }
    }
#pragma unroll
    for (int j = 0; j < 8; j++) {
      if (cb + j < nc) {
        const int item = item0 + cb + j;
        const float A = scal[item * 2], Cm = scal[item * 2 + 1];
        const float mnew = fmaxf(A + m, Cm);
        const float dec = __expf(A + m - mnew), us = __expf(Cm - mnew);
        *(unsigned*)(slots + (size_t)item * 16384 + el) = pk2(c0, c1);
        c0 = dec * c0 + us * bflo(uu[j]);
        c1 = dec * c1 + us * bfhi(uu[j]);
        if (do_n) { nu[(size_t)item * 128 + tid] = nst; nst = dec * nst + us * nn[j]; }
        if (g == 0 && tid == 0) mst[item] = m;
        m = mnew;
      }
    }
  }
  float* oC = sample ? p.out + O_SC + ((size_t)(l * 32 + b) * 4 + h) * 16384 : p.out + O_PC + ((size_t)(l * 2 + b) * 4 + h) * 16384;
  oC[d * 128 + e] = c0; oC[(d + 1) * 128 + e] = c1;
  if (do_n) { float* on = sample ? p.out + O_SN + ((size_t)(l * 32 + b) * 4 + h) * 128 : p.out + O_PN + ((size_t)(l * 2 + b) * 4 + h) * 128; on[tid] = nst; }
  if (g == 0 && tid == 0) { float* om = sample ? p.out + O_SM + (l * 32 + b) * 4 + h : p.out + O_PM + (l * 2 + b) * 4 + h; *om = m; }
}

DI void mlstm_m3(const Params& p, int l, int item, char* smem) {
  const ChunkInfo ci = chunk_info(item);
  const int tid = tidx(), lane = tid & 63, w = tid >> 6, r = lane & 31, h = lane >> 5;
  u16* sQ = (u16*)smem;
  u16* sK = sQ + 64 * 136;
  u16* sVt = sK + 64 * 136;
  u16* sP = sVt + 128 * 72;
  float* su = (float*)(sP + 64 * 72);
  float* sM = su + 64;
  float* sa = sM + 64;
  float* sden = sa + 64;
  float* sinv = sden + 64;
  float* sn = sinv + 64;
  float* sH = (float*)smem;
  __syncthreads();
  const float m_start = wsf(p, WS_MST)[item];
  if (w == 0) {
    const float* g = wsf(p, WS_GATES) + (size_t)(ci.tok0 + lane) * 8;
    float ig = g[ci.h] + p.b_igate[l * 4 + ci.h];
    float lf = logsigmoid(g[4 + ci.h] + p.b_fgate[l * 4 + ci.h]);
    float bcs = lf;
#pragma unroll
    for (int o = 1; o < 64; o <<= 1) { float t = __shfl_up(bcs, o); if (lane >= o) bcs += t; }
    float u = ig - bcs;
    float cm = u;
#pragma unroll
    for (int o = 1; o < 64; o <<= 1) { float t = __shfl_up(cm, o); if (lane >= o) cm = fmaxf(cm, t); }
    float Mt = fmaxf(m_start, cm);
    su[lane] = u; sM[lane] = Mt; sa[lane] = __expf(m_start - Mt); sden[lane] = __expf(-(bcs + Mt));
  } else if (w == 1) {
    sn[lane] = wsf(p, WS_NU)[(size_t)item * 128 + lane];
    sn[lane + 64] = wsf(p, WS_NU)[(size_t)item * 128 + lane + 64];
  }
#pragma unroll
  for (int it = 0; it < 4; it++) {
    int id = tid + 256 * it; int s = id >> 4, ch = id & 15;
    uint4 v = *(const uint4*)(wsb(p, WS_BIG + B_P) + (size_t)(ci.tok0 + s) * INC + 1440 + ci.h * 128 + ch * 8);
    unsigned a[4] = {v.x, v.y, v.z, v.w};
#pragma unroll
    for (int j = 0; j < 4; j++) { sVt[(ch * 8 + 2 * j) * 72 + s] = (u16)(a[j] & 0xffffu); sVt[(ch * 8 + 2 * j + 1) * 72 + s] = (u16)(a[j] >> 16); }
  }
  {
    const int mc = tid & 31, mat = mc >> 4, chunk = mc & 15, rg = tid >> 5;
    u16* dst = mat ? sK : sQ;
    const float sc = mat ? 0.08838834764831845f : 1.f;
    conv_run(p, l, ci, mat, chunk, rg * 8, 8, [&](int t, const float (&y)[8]) {
      float x[8];
#pragma unroll
      for (int j = 0; j < 8; j++) x[j] = y[j] * sc;
      *(uint4*)(dst + t * 136 + chunk * 8) = pack8(x);
    });
  }
  __syncthreads();
  {
    const int tq = w >> 1, ts = w & 1;
    f32x16 s;
#pragma unroll
    for (int i = 0; i < 16; i++) s[i] = 0.f;
#pragma unroll
    for (int ks = 0; ks < 8; ks++) {
      bf16x8 a = *(const bf16x8*)(sQ + (tq * 32 + r) * 136 + ks * 16 + h * 8);
      bf16x8 b = *(const bf16x8*)(sK + (ts * 32 + r) * 136 + ks * 16 + h * 8);
      s = MFMA(a, b, s);
    }
    const int sidx = ts * 32 + r;
    const float us = su[sidx];
#pragma unroll
    for (int i = 0; i < 16; i++) {
      int t = tq * 32 + crow(i, h);
      float v = (sidx <= t) ? s[i] * __expf(us - sM[t]) : 0.f;
      sP[t * 72 + sidx] = f2bf(v);
    }
  }
  __syncthreads();
  if (tid < 64) {
    float rs = 0.f, qd = 0.f;
    const u16* pr = sP + tid * 72;
#pragma unroll 8
    for (int s = 0; s < 64; s++) rs += bf2f(pr[s]);
    const u16* qr = sQ + tid * 136;
#pragma unroll 8
    for (int d = 0; d < 128; d++) qd += bf2f(qr[d]) * sn[d];
    float qn = sa[tid] * qd + rs;
    sinv[tid] = __builtin_amdgcn_rcpf(fmaxf(fabsf(qn), sden[tid]));
  }
  const int tq = w & 1, eb = (w >> 1) * 2;
  f32x16 a1[2], a2[2];
#pragma unroll
  for (int et = 0; et < 2; et++)
#pragma unroll
    for (int i = 0; i < 16; i++) { a1[et][i] = 0.f; a2[et][i] = 0.f; }
  const u16* slot = wsb(p, WS_BIG + B_ST) + (size_t)item * 16384;
#pragma unroll
  for (int ks = 0; ks < 8; ks++) {
    bf16x8 a = *(const bf16x8*)(sQ + (tq * 32 + r) * 136 + ks * 16 + h * 8);
#pragma unroll
    for (int et = 0; et < 2; et++) {
      bf16x8 b = *(const bf16x8*)(slot + ((eb + et) * 32 + r) * 128 + ks * 16 + h * 8);
      a1[et] = MFMA(a, b, a1[et]);
    }
  }
#pragma unroll
  for (int ks = 0; ks < 4; ks++) {
    bf16x8 a = *(const bf16x8*)(sP + (tq * 32 + r) * 72 + ks * 16 + h * 8);
#pragma unroll
    for (int et = 0; et < 2; et++) {
      bf16x8 b = *(const bf16x8*)(sVt + ((eb + et) * 32 + r) * 72 + ks * 16 + h * 8);
      a2[et] = MFMA(a, b, a2[et]);
    }
  }
  __syncthreads();
#pragma unroll
  for (int et = 0; et < 2; et++)
#pragma unroll
    for (int i = 0; i < 16; i++) {
      int t = tq * 32 + crow(i, h);
      sH[t * 132 + (eb + et) * 32 + r] = (sa[t] * a1[et][i] + a2[et][i]) * sinv[t];
    }
  __syncthreads();
  {
    const int t = tid >> 2, part = tid & 3;
    const float* hr = sH + t * 132 + part * 32;
    float ss = 0.f;
#pragma unroll 8
    for (int j = 0; j < 32; j++) ss += hr[j] * hr[j];
    ss += __shfl_xor(ss, 1); ss += __shfl_xor(ss, 2);
    const float rr = rsqrtf(ss * (1.f / 128.f) + EPS);
    const int tok = ci.tok0 + t;
    const u16* og = wsb(p, WS_BIG + B_P) + (size_t)tok * INC + 1960 + ci.h * 128 + part * 32;
    const float* gm = p.g_mhead + (size_t)l * 512 + ci.h * 128 + part * 32;
    u16* o = wsb(p, WS_ACT) + (size_t)tok * LDA + 512 + ci.h * 128 + part * 32;
#pragma unroll
    for (int c8 = 0; c8 < 4; c8++) {
      float gv[8], x[8];
      unpack8(*(const uint4*)(og + c8 * 8), gv);
#pragma unroll
      for (int j = 0; j < 8; j++) x[j] = hr[c8 * 8 + j] * rr * gm[c8 * 8 + j] * __builtin_amdgcn_rcpf(1.f + __expf(-gv[j]));
      *(uint4*)(o + c8 * 8) = pack8(x);
    }
  }
}

DI void xkv_item(const Params& p, int l, int item, char* smem) {
  const int tid = tidx();
  const int kg = item & 3, hh = (item >> 2) & 3, bidx = item >> 4;
  u16* T = (u16*)smem;
  __syncthreads();
  const int key = tid >> 2, qt = tid & 3;
  const int mem = kg * 64 + key;
  const bool prompt = bidx < 2;
  float* kp; const float* vp;
  if (prompt) {
    kp = p.out + O_PMEMK + (((size_t)(l * 2 + bidx) * 256 + mem) * 4 + hh) * 256 + qt * 64;
    vp = p.out + O_PMEMV + (((size_t)(l * 2 + bidx) * 256 + mem) * 4 + hh) * 256 + qt * 64;
  } else {
    kp = (float*)(p.cache_mem_k + (((size_t)(l * 32 + bidx - 2) * 256 + mem) * 4 + hh) * 256 + qt * 64);
    vp = p.cache_mem_v + (((size_t)(l * 32 + bidx - 2) * 256 + mem) * 4 + hh) * 256 + qt * 64;
  }
  float rr = 1.f;
  if (prompt) {
    float ss = 0.f;
#pragma unroll 4
    for (int j = 0; j < 16; j++) { float4 v = *(const float4*)(kp + j * 4); ss += v.x * v.x + v.y * v.y + v.z * v.z + v.w * v.w; }
    ss += __shfl_xor(ss, 1); ss += __shfl_xor(ss, 2);
    rr = rsqrtf(ss * (1.f / 256.f) + EPS);
  }
  const float* gk = p.g_xk + l * 256 + qt * 64;
  const float* gq = p.g_xq + l * 256 + qt * 64;
  u16* xk = wsb(p, WS_BIG + B_XK) + ((size_t)(bidx * 4 + hh) * 256 + mem) * 256 + qt * 64;
#pragma unroll 2
  for (int c8 = 0; c8 < 8; c8++) {
    float4 a = *(const float4*)(kp + c8 * 8), b = *(const float4*)(kp + c8 * 8 + 4);
    float x[8] = {a.x, a.y, a.z, a.w, b.x, b.y, b.z, b.w};
    if (prompt) {
#pragma unroll
      for (int j = 0; j < 8; j++) x[j] = x[j] * rr * gk[c8 * 8 + j];
      *(float4*)(kp + c8 * 8) = make_float4(x[0], x[1], x[2], x[3]);
      *(float4*)(kp + c8 * 8 + 4) = make_float4(x[4], x[5], x[6], x[7]);
    }
#pragma unroll
    for (int j = 0; j < 8; j++) x[j] = x[j] * gq[c8 * 8 + j] * (0.0625f * LOG2E);
    *(uint4*)(xk + c8 * 8) = pack8(x);
    float4 va = *(const float4*)(vp + c8 * 8), vb = *(const float4*)(vp + c8 * 8 + 4);
    float y[8] = {va.x, va.y, va.z, va.w, vb.x, vb.y, vb.z, vb.w};
    *(uint4*)(T + key * 264 + qt * 64 + c8 * 8) = pack8(y);
  }
  __syncthreads();
  {
    const int e = tid;
    u16* xv = wsb(p, WS_BIG + B_XVT) + ((size_t)(bidx * 4 + hh) * 256 + e) * LDXV + kg * 64;
#pragma unroll 2
    for (int oct = 0; oct < 8; oct++) {
      uint4 v;
      v.x = (unsigned)T[(oct * 8 + 0) * 264 + e] | ((unsigned)T[(oct * 8 + 1) * 264 + e] << 16);
      v.y = (unsigned)T[(oct * 8 + 2) * 264 + e] | ((unsigned)T[(oct * 8 + 3) * 264 + e] << 16);
      v.z = (unsigned)T[(oct * 8 + 4) * 264 + e] | ((unsigned)T[(oct * 8 + 5) * 264 + e] << 16);
      v.w = (unsigned)T[(oct * 8 + 6) * 264 + e] | ((unsigned)T[(oct * 8 + 7) * 264 + e] << 16);
      *(uint4*)(xv + oct * 8) = v;
    }
  }
}

DI void phase_C2(const Params& p, int l, char* smem) {
  for (int t = blockIdx.x; t < 544; t += gridDim.x) xkv_item(p, l, t, smem);
}
DI void phase_C1(const Params& p, int l, char* smem) {
  const int lane = tidx() & 63, w = tidx() >> 6;
  for (int t = blockIdx.x; t < NITEM; t += gridDim.x) mlstm_m1(p, l, t, smem);
  for (int t = blockIdx.x * 4 + w; t < NTOK + 32768; t += gridDim.x * 4) {
    if (t < NTOK) post_token(p, l, t, lane); else post_past(p, l, t - NTOK, lane);
  }
}

DI void phase_D(const Params& p, int l, char* smem) {
  const int n_scan = 256 + 4096;
  const int n_q = 544 * 4;
  const u16* W = wsb(p, WS_W) + (size_t)l * W_LAYER;
  for (int t = blockIdx.x; t < n_scan + n_q; t += gridDim.x) {
    if (t < n_scan) mlstm_m2(p, l, t);
    else {
      int u = t - n_scan; int mt = u >> 2, nt = u & 3;
      EpiQ epi{wsb(p, WS_BIG + B_Q), wsf(p, WS_RQ), (const float2*)(p.ws + WS_ROPE), p.g_qnorm + l * 96};
      gemm_tile<1, 3>(wsb(p, WS_BIG + B_P), INC, W + W_Q, LDWQ, 256, mt * 64, nt * 192, smem, epi);
    }
  }
}

DI void phase_E(const Params& p, int l, char* smem) {
  for (int t = blockIdx.x; t < NITEM; t += gridDim.x) mlstm_m3(p, l, t, smem);
}

DI void phase_F(const Params& p, int l, char* smem) {
  const u16* W = wsb(p, WS_W) + (size_t)l * W_LAYER;
  for (int t = blockIdx.x; t < 528 * 8; t += gridDim.x) {
    int mt = t >> 3, nt = t & 7;
    EpiKV epi{wsb(p, WS_BIG + B_K), wsb(p, WS_BIG + B_VT), wsf(p, WS_KROPE), p.g_knorm + l * 96};
    gemm_tile<2, 2>(wsb(p, WS_CKV), 128, W + W_KV, LDWKV, 128, mt * 128, nt * 128, smem, epi);
  }
}

DI void phase_G(const Params& p, const Sched& sc, char* smem) {
  const int G = gridDim.x, j = blockIdx.x;
  const int lane = tidx() & 63, w = tidx() >> 6, r = lane & 31;
  const int NIT = 2048 + 256;
  const u16* qb = wsb(p, WS_BIG + B_Q);
  const u16* Kb = wsb(p, WS_BIG + B_K);
  const u16* Vt = wsb(p, WS_BIG + B_VT);
  u16* act = wsb(p, WS_ACT);
  auto run_prompt = [&](int bh, int bi) {
    int b = bh >> 3, hd = bh & 7;
    int tok = b * 16384 + bi * 128 + w * 32 + r;
    flash_item<96, 2, 64, true, false, true, true>(qb + (size_t)tok * 768 + hd * 96, true, 2 * bi + 2, 2 * bi + 1 + (w >> 1),
                                             Kb + ((size_t)hd * NROWS + b * 16384) * 96, 96, Vt + (size_t)hd * 64 * LDVT + b * 16384, LDVT, 0,
                                             act + (size_t)tok * LDA + hd * 64, smem);
  };
  auto run_sample = [&](int u) {
    int b = u >> 3, hd = u & 7;
    int tok = NP + b * 64 + (w & 1) * 32 + r;
    size_t row0 = (size_t)NP + b * 1088;
    flash_item<96, 2, 64, true, false, true, true>(qb + (size_t)tok * 768 + hd * 96, w < 2, 17, 17, Kb + ((size_t)hd * NROWS + row0) * 96, 96,
                                             Vt + (size_t)hd * 64 * LDVT + row0, LDVT, 0, act + (size_t)tok * LDA + hd * 64, smem);
  };
  if (sc.ok) {
    const int xg = sc.xg, xi = sc.xi;
    for (int pass = 0; pass < 2; pass++) {
      const int bh = xg + 8 * pass;
      run_prompt(bh, xi);
      run_prompt(bh, 127 - xi);
    }
    if ((j & 1) == 0) run_sample(j >> 1);
  } else {
    for (int k = 0; k * G < NIT; k++) {
      int it = (k & 1) ? (k * G + (G - 1 - j)) : (k * G + j);
      if (it >= NIT) continue;
      if (it < 2048) run_prompt(it & 15, 127 - (it >> 4)); else run_sample(it - 2048);
    }
  }
}

DI void phase_K(const Params& p, char* smem) {
  const int lane = tidx() & 63, w = tidx() >> 6, r = lane & 31;
  const u16* qx = wsb(p, WS_BIG + B_QX);
  u16* act = wsb(p, WS_ACT);
  for (int t = blockIdx.x; t < 2176; t += gridDim.x) {
    int bidx, hh, tok0;
    if (t < 2048) { bidx = t >> 10; hh = (t >> 8) & 3; tok0 = bidx * 16384 + (t & 255) * 64; }
    else { int u = t - 2048; bidx = 2 + (u >> 2); hh = u & 3; tok0 = NP + (u >> 2) * 64; }
    int tok = tok0 + (w & 1) * 32 + r;
    int e0 = (w >> 1) * 128;
    const u16* Kb = wsb(p, WS_BIG + B_XK) + (size_t)(bidx * 4 + hh) * 65536;
    const u16* Vt = wsb(p, WS_BIG + B_XVT) + (size_t)(bidx * 4 + hh) * 256 * LDXV;
    flash_item<256, 4, 256, false, true, false>(qx + (size_t)tok * LDA + hh * 256, true, 4, 4, Kb, 256, Vt, LDXV, e0,
                                         act + (size_t)tok * LDA + hh * 256 + e0, smem);
  }
}

template <class Epi>
DI void phase_gemm128(const Sched& sc, const u16* A, long lda, const u16* Bt, long ldb, int K, int MT, int NT, int SN, char* smem, const Epi& epi) {
  if (sc.ok) {
    const int xg = sc.xg, xi = sc.xi;
    const int SM = 64 / SN;
    const int sng = NT / SN, smg = MT / SM;
    for (int st = xg; st < smg * sng; st += 8) {
      int sm = st / sng, sn = st % sng;
      int mt = sm * SM + xi / SN, nt = sn * SN + xi % SN;
      gemm_tile<2, 2>(A, lda, Bt, ldb, K, mt * 128, nt * 128, smem, epi);
    }
  } else {
    for (int t = blockIdx.x; t < MT * NT; t += gridDim.x) {
      int mt = t / NT, nt = t % NT;
      gemm_tile<2, 2>(A, lda, Bt, ldb, K, mt * 128, nt * 128, smem, epi);
    }
  }
}

#if defined(__HIP_DEVICE_COMPILE__)
typedef const __attribute__((address_space(4))) Params* KargPtr;
#define KARG_LOAD KargPtr pp4 = (KargPtr)__builtin_amdgcn_kernarg_segment_ptr(); asm volatile("" : "+s"(pp4)); const Params p = *pp4;
#else
#define KARG_LOAD const Params p{};
#endif
template <int L>
DI void run_layer(const Sched& sc, int ph_begin, int ph_end, char* smem, cg::grid_group& grid) {
  const int base = 1 + 15 * L;
#define RUN_PHASE(S, ...)  RUN_PHASE_R(S, 1, __VA_ARGS__)
#define RUN_PHASE_R(S, R, ...)                                    \
  {                                                          \
    const int ph = base + (S);                               \
    if (ph >= ph_begin && ph < ph_end) {                     \
      for (int rep_ = 0; rep_ < (R); rep_++) {               \
        KARG_LOAD                                            \
        const u16* W = wsb(p, WS_W) + (size_t)L * W_LAYER;   \
        const float* xs0 = (L == 0) ? p.x_prompt : p.out;    \
        const float* xs1 = (L == 0) ? p.x_sample : p.out + (size_t)NP * 1024; \
        (void)W; (void)xs0; (void)xs1;                       \
        __VA_ARGS__;                                         \
        if (ph + 1 < ph_end) grid.sync();                    \
      }                                                      \
    }                                                        \
  }
  if (L > 0) RUN_PHASE(0, phase_norm(p, L))
  RUN_PHASE_R(1, REP_INPROJ, phase_inproj(p, sc, L, smem))
  RUN_PHASE_R(2, REP_C, { phase_C1(p, L, smem); phase_C2(p, L, smem); })
  RUN_PHASE(3, phase_D(p, L, smem))
  RUN_PHASE_R(4, REP_E, phase_E(p, L, smem))
  RUN_PHASE_R(5, REP_F, phase_F(p, L, smem))
  RUN_PHASE_R(6, REP_G, phase_G(p, sc, smem))
  RUN_PHASE(7, { EpiRes epi{xs0, xs1, p.out}; phase_gemm128(sc, wsb(p, WS_ACT), LDA, W + W_OUT, LDW, 1024, 272, 8, 8, smem, epi); })
  RUN_PHASE_R(8, REP_NORM, phase_norm(p, 1))
  RUN_PHASE(9, { EpiStoreBf16 epi{wsb(p, WS_BIG + B_QX), LDA, 1024, nullptr}; phase_gemm128(sc, wsb(p, WS_ACT), LDA, W + W_XQ, LDW, 1024, 272, 8, 8, smem, epi); })
  RUN_PHASE_R(10, REP_K, phase_K(p, smem))
  RUN_PHASE(11, { EpiRes epi{p.out, p.out + (size_t)NP * 1024, p.out}; phase_gemm128(sc, wsb(p, WS_ACT), LDA, W + W_XO, LDW, 1024, 272, 8, 8, smem, epi); })
  RUN_PHASE(12, phase_norm(p, 1))
  RUN_PHASE_R(13, REP_FF1, { EpiRelu2 epi{wsb(p, WS_BIG + B_H1), LDH1}; phase_gemm128(sc, wsb(p, WS_ACT), LDA, W + W_FF1, LDW, 1024, 272, 32, 8, smem, epi); })
  RUN_PHASE(14, { EpiRes epi{p.out, p.out + (size_t)NP * 1024, p.out}; phase_gemm128(sc, wsb(p, WS_BIG + B_H1), LDH1, W + W_FF2, LDW2, 4096, 272, 8, 8, smem, epi); })
#undef RUN_PHASE
#undef RUN_PHASE_R
}

__global__ void __launch_bounds__(256, 2) fwd_megakernel(Params p, int ph_begin, int ph_end) {
  __shared__ __attribute__((aligned(16))) char smem[SMEM_BYTES];
  cg::grid_group grid = cg::this_grid();
  __shared__ int s_rank;
  Sched sc;
  sc.xg = (int)((unsigned)__builtin_amdgcn_s_getreg((3 << 11) | 20) & 7u);
  unsigned* cnt = (unsigned*)(p.ws + WS_CNT);
  if (tidx() == 0) s_rank = (int)atomicAdd(&cnt[sc.xg], 1u);
  __syncthreads();
  sc.xi = __builtin_amdgcn_readfirstlane(s_rank);
  sc.ok = 0;
  if (ph_begin <= 0 && 0 < ph_end) {
    phase_prep(p, smem);
    if (1 < ph_end) grid.sync();
  }
  {
    int ok = (gridDim.x == 512);
#pragma unroll
    for (int i = 0; i < 8; i++) ok &= (__atomic_load_n(&cnt[i], __ATOMIC_RELAXED) == 64u);
    sc.ok = ok;
  }
  run_layer<0>(sc, ph_begin, ph_end, smem, grid);
  run_layer<1>(sc, ph_begin, ph_end, smem, grid);
}

extern "C" void kernel_launch(void* const* d_in, const int* in_sizes, int n_in, void* d_out, int out_size, void* d_ws, size_t ws_size,
                              hipStream_t stream) {
  static int grid_blocks = 0;
  if (!grid_blocks) {
    int dev = 0, cus = 0, per_cu = 0;
    (void)hipGetDevice(&dev);
    (void)hipDeviceGetAttribute(&cus, hipDeviceAttributeMultiprocessorCount, dev);
    (void)hipOccupancyMaxActiveBlocksPerMultiprocessor(&per_cu, fwd_megakernel, 256, 0);
    per_cu = 2;
    grid_blocks = cus * per_cu;
  }
  Params p{};
  const float** pp = (const float**)&p;
  for (int i = 0; i < 36; i++) pp[i] = (const float*)d_in[i];
  p.out = (float*)d_out;
  p.ws = (char*)d_ws;
  int ph_begin = 0, ph_end = 31;
  (void)hipMemsetAsync((char*)d_ws + WS_CNT, 0, 256, stream);
  void* args[] = {&p, &ph_begin, &ph_end};
  hipError_t e = hipLaunchCooperativeKernel((void*)fwd_megakernel, dim3(grid_blocks), dim3(256), args, 0, stream);
  if (e != hipSuccess) fprintf(stderr, "cooperative launch failed: %s (grid %d)\n", hipGetErrorString(e), grid_blocks);
}
```

```cpp
#include <hip/hip_runtime.h>
#include <hip/hip_cooperative_groups.h>
#include <stdint.h>
#include <stdio.h>
namespace cg = cooperative_groups;

typedef unsigned short u16;
typedef short bf16x8 __attribute__((ext_vector_type(8)));
typedef short s16x4 __attribute__((ext_vector_type(4)));
typedef float f32x16 __attribute__((ext_vector_type(16)));
typedef __bf16 bfv2 __attribute__((ext_vector_type(2)));
typedef float fv2 __attribute__((ext_vector_type(2)));
typedef unsigned u32x4 __attribute__((ext_vector_type(4)));
#define DI __device__ __forceinline__
#define MFMA(a, b, c) __builtin_amdgcn_mfma_f32_32x32x16_bf16((a), (b), (c), 0, 0, 0)

constexpr int NP = 32768;
constexpr int NS = 2048;
constexpr int NTOK = NP + NS;
constexpr int NROWS = NP + 32 * 1088;
constexpr int INC = 2472;
constexpr float EPS = 1e-6f;
constexpr float LOG2E = 1.4426950408889634f;
constexpr int NITEM = 2048 + 128;
constexpr int LDA = 1088;
constexpr int LDW = 1088;
constexpr int LDW2 = 4160;
constexpr int LDWQ = 320;
constexpr int LDWKV = 192;
constexpr int LDH1 = 4160;
constexpr int LDVT = NROWS + 64;
constexpr int LDXV = 320;

constexpr size_t O_Y = 0;
constexpr size_t O_PCKV = 35651584;
constexpr size_t O_PKROPE = O_PCKV + 8388608;
constexpr size_t O_PC = O_PKROPE + 2097152;
constexpr size_t O_PN = O_PC + 262144;
constexpr size_t O_PM = O_PN + 2048;
constexpr size_t O_PCONV = O_PM + 16;
constexpr size_t O_PMEMK = O_PCONV + 12288;
constexpr size_t O_PMEMV = O_PMEMK + 1048576;
constexpr size_t O_SCKV = O_PMEMV + 1048576;
constexpr size_t O_SKROPE = O_SCKV + 524288;
constexpr size_t O_SC = O_SKROPE + 131072;
constexpr size_t O_SN = O_SC + 4194304;
constexpr size_t O_SM = O_SN + 32768;
constexpr size_t O_SCONV = O_SM + 256;

constexpr size_t W_IN = 0;
constexpr size_t W_Q = W_IN + 2560 * LDW;
constexpr size_t W_KV = W_Q + 768 * LDWQ;
constexpr size_t W_OUT = W_KV + 1024 * LDWKV;
constexpr size_t W_XQ = W_OUT + 1024 * LDW;
constexpr size_t W_XK = W_XQ + 1024 * LDW;
constexpr size_t W_XV = W_XK + 1024 * LDW;
constexpr size_t W_XO = W_XV + 1024 * LDW;
constexpr size_t W_FF1 = W_XO + 1024 * LDW;
constexpr size_t W_FF2 = W_FF1 + 4096 * LDW;
constexpr size_t W_LAYER = W_FF2 + 1024 * LDW2;

constexpr size_t WS_W = 0;
constexpr size_t WS_ACT = WS_W + 2 * W_LAYER * 2;
constexpr size_t WS_CKV = WS_ACT + (size_t)NTOK * LDA * 2;
constexpr size_t WS_KROPE = WS_CKV + (size_t)NROWS * 128 * 2;
constexpr size_t WS_RQ = WS_KROPE + (size_t)NROWS * 32 * 4;
constexpr size_t WS_GATES = WS_RQ + (size_t)NTOK * 4;
constexpr size_t WS_ROPE = WS_GATES + (size_t)NTOK * 8 * 4;
constexpr size_t WS_SCAL = WS_ROPE + (size_t)16384 * 16 * 8;
constexpr size_t WS_MST = WS_SCAL + (size_t)NITEM * 2 * 4;
constexpr size_t WS_NU = WS_MST + (size_t)NITEM * 4 + 256;
constexpr size_t WS_CNT = WS_NU + (size_t)NITEM * 128 * 4;
constexpr size_t WS_HM = WS_CNT + 256;
constexpr size_t WS_BIG = WS_HM + (size_t)512 * LDA * 2;
constexpr size_t B_P = 0;
constexpr size_t B_K = 0;
constexpr size_t B_VT = B_K + (size_t)8 * NROWS * 96 * 2;
constexpr size_t B_Q = B_VT + (size_t)8 * 64 * LDVT * 2;
constexpr size_t B_ST = B_Q + (size_t)NTOK * 768 * 2;
constexpr size_t B_XK = B_ST + (size_t)NITEM * 16384 * 2;
constexpr size_t B_XVT = B_XK + (size_t)34 * 4 * 256 * 256 * 2;
constexpr size_t B_END = B_XVT + (size_t)34 * 4 * 256 * LDXV * 2;
constexpr size_t B_QX = 0;
constexpr size_t B_H1 = 0;
static_assert((size_t)NTOK * INC * 2 <= B_Q, "p overlaps q");
static_assert((size_t)NTOK * LDH1 * 2 <= B_XK, "h1 overlaps xkv");
static_assert((size_t)NTOK * LDA * 2 <= B_Q, "qx overlaps q");
static_assert(WS_BIG + B_END <= (size_t)536870912, "workspace too large");
static_assert(WS_BIG % 256 == 0 && B_Q % 256 == 0 && B_ST % 256 == 0 && B_VT % 256 == 0, "align");

constexpr int SMEM_BYTES = 73728;
#ifndef REP_INPROJ
#define REP_INPROJ 1
#endif
#ifndef REP_C
#define REP_C 1
#endif
#ifndef REP_E
#define REP_E 1
#endif
#ifndef REP_F
#define REP_F 1
#endif
#ifndef REP_G
#define REP_G 1
#endif
#ifndef REP_K
#define REP_K 1
#endif
#ifndef REP_FF1
#define REP_FF1 1
#endif
#ifndef REP_NORM
#define REP_NORM 1
#endif

struct Params {
  const float* x_prompt; const float* x_sample; const float* cache_ckv; const float* cache_krope;
  const float* st_C; const float* st_n; const float* st_m; const float* st_conv;
  const float* cache_mem_k; const float* cache_mem_v; const float* mem_prompt;
  const float* g_mix; const float* w_in; const float* g_qa; const float* w_q_up; const float* g_qnorm; const float* g_kva;
  const float* w_kv_up; const float* g_knorm; const float* w_conv; const float* b_conv; const float* b_igate; const float* b_fgate;
  const float* g_mhead; const float* w_out; const float* g_xattn; const float* g_mem; const float* w_xq; const float* w_xk; const float* w_xv;
  const float* g_xq; const float* g_xk; const float* w_xo; const float* g_mlp; const float* w_ff1; const float* w_ff2;
  float* out; char* ws;
};

struct Sched { int xg, xi, ok; };
DI int tidx() { int t = (int)threadIdx.x; asm volatile("" : "+v"(t)); return t; }
DI unsigned pk2(float a, float b) { fv2 v = {a, b}; bfv2 r = __builtin_convertvector(v, bfv2); return __builtin_bit_cast(unsigned, r); }
DI u16 f2bf(float a) { return (u16)(pk2(a, 0.f) & 0xffffu); }
DI float bf2f(u16 v) { return __uint_as_float(((unsigned)v) << 16); }
DI float bflo(unsigned v) { return __uint_as_float(v << 16); }
DI float bfhi(unsigned v) { return __uint_as_float(v & 0xffff0000u); }
DI int crow(int i, int h) { return (i & 3) + 8 * (i >> 2) + 4 * h; }
DI float xhalf_max(float v) {
  unsigned u = __float_as_uint(v);
  auto rr = __builtin_amdgcn_permlane32_swap(u, u, false, false);
  return fmaxf(__uint_as_float(rr[0]), __uint_as_float(rr[1]));
}
DI float xhalf_sum(float v) {
  unsigned u = __float_as_uint(v);
  auto rr = __builtin_amdgcn_permlane32_swap(u, u, false, false);
  return __uint_as_float(rr[0]) + __uint_as_float(rr[1]);
}
DI float wave_sum(float v) {
#pragma unroll
  for (int o = 32; o >= 1; o >>= 1) v += __shfl_xor(v, o);
  return v;
}
DI float wave_max(float v) {
#pragma unroll
  for (int o = 32; o >= 1; o >>= 1) v = fmaxf(v, __shfl_xor(v, o));
  return v;
}
DI void unpack8(uint4 v, float (&x)[8]) {
  x[0] = bflo(v.x); x[1] = bfhi(v.x); x[2] = bflo(v.y); x[3] = bfhi(v.y);
  x[4] = bflo(v.z); x[5] = bfhi(v.z); x[6] = bflo(v.w); x[7] = bfhi(v.w);
}
DI uint4 pack8(const float (&x)[8]) {
  uint4 v; v.x = pk2(x[0], x[1]); v.y = pk2(x[2], x[3]); v.z = pk2(x[4], x[5]); v.w = pk2(x[6], x[7]); return v;
}
DI u16* wsb(const Params& p, size_t off) { return (u16*)(p.ws + off); }
DI float* wsf(const Params& p, size_t off) { return (float*)(p.ws + off); }
DI const float* xrow(const Params& p, int l, int tok) {
  if (l == 0) return tok < NP ? p.x_prompt + (size_t)tok * 1024 : p.x_sample + (size_t)(tok - NP) * 1024;
  return p.out + (size_t)tok * 1024;
}
DI int tok_pos(int tok) { return tok < NP ? (tok & 16383) : 1024 + ((tok - NP) & 63); }

template <int TM, int TN>
DI void gemm_mainloop(const u16* __restrict__ A, long lda, const u16* __restrict__ Bt, long ldb, int K, char* smem,
                      f32x16 (&acc)[TM][TN]) {
  constexpr int BM = 64 * TM, BN = 64 * TN, LD = 72;
  u16* sA = (u16*)smem;
  u16* sB = sA + 2 * BM * LD;
  const int tid = tidx(), lane = tid & 63, w = tid >> 6, r = lane & 31, h = lane >> 5;
  const int wm = w >> 1, wn = w & 1;
  constexpr int NA = BM / 32, NB = BN / 32;
  u32x4 ra[NA], rb[NB];
#pragma unroll
  for (int tm = 0; tm < TM; tm++)
#pragma unroll
    for (int tn = 0; tn < TN; tn++)
#pragma unroll
      for (int i = 0; i < 16; i++) acc[tm][tn][i] = 0.f;
  const int nk = K / 64;
  const int lrow = tid >> 3, lch = (tid & 7) * 8;
  const u16* gA = A + (long)lrow * lda + lch;
  const u16* gB = Bt + (long)lrow * ldb + lch;
  const int soff = lrow * LD + lch;
#define GEMM_GLOAD(k0)                                                                   \
  {                                                                                      \
    _Pragma("unroll") for (int i = 0; i < NA; i++) ra[i] = *(const u32x4*)(gA + (long)(32 * i) * lda + (k0)); \
    _Pragma("unroll") for (int i = 0; i < NB; i++) rb[i] = *(const u32x4*)(gB + (long)(32 * i) * ldb + (k0)); \
  }
#define GEMM_SSTORE(buf)                                                                 \
  {                                                                                      \
    _Pragma("unroll") for (int i = 0; i < NA; i++) *(u32x4*)(sA + (buf) * BM * LD + soff + 32 * i * LD) = ra[i]; \
    _Pragma("unroll") for (int i = 0; i < NB; i++) *(u32x4*)(sB + (buf) * BN * LD + soff + 32 * i * LD) = rb[i]; \
  }
  GEMM_GLOAD(0)
  __syncthreads();
  GEMM_SSTORE(0)
  if (nk > 1) GEMM_GLOAD(64)
  __syncthreads();
  for (int kt = 0; kt < nk; kt++) {
    const int buf = kt & 1;
    const u16* cA = sA + buf * BM * LD + (wm * 32 * TM + r) * LD + h * 8;
    const u16* cB = sB + buf * BN * LD + (wn * 32 * TN + r) * LD + h * 8;
    bf16x8 af[TM], bfr[TN];
#pragma unroll
    for (int tm = 0; tm < TM; tm++) af[tm] = *(const bf16x8*)(cA + tm * 32 * LD);
#pragma unroll
    for (int tn = 0; tn < TN; tn++) bfr[tn] = *(const bf16x8*)(cB + tn * 32 * LD);
    if (kt + 1 < nk) GEMM_SSTORE(buf ^ 1)
    __builtin_amdgcn_sched_barrier(0);
    __builtin_amdgcn_s_setprio(1);
#pragma unroll
    for (int tm = 0; tm < TM; tm++)
#pragma unroll
      for (int tn = 0; tn < TN; tn++) acc[tm][tn] = MFMA(af[tm], bfr[tn], acc[tm][tn]);
#pragma unroll
    for (int tm = 0; tm < TM; tm++) af[tm] = *(const bf16x8*)(cA + tm * 32 * LD + 16);
#pragma unroll
    for (int tn = 0; tn < TN; tn++) bfr[tn] = *(const bf16x8*)(cB + tn * 32 * LD + 16);
#pragma unroll
    for (int tm = 0; tm < TM; tm++)
#pragma unroll
      for (int tn = 0; tn < TN; tn++) acc[tm][tn] = MFMA(af[tm], bfr[tn], acc[tm][tn]);
    __builtin_amdgcn_sched_barrier(0);
    if (kt + 2 < nk) GEMM_GLOAD((kt + 2) * 64)
    __builtin_amdgcn_sched_barrier(0);
#pragma unroll
    for (int ks = 2; ks < 4; ks++) {
#pragma unroll
      for (int tm = 0; tm < TM; tm++) af[tm] = *(const bf16x8*)(cA + tm * 32 * LD + ks * 16);
#pragma unroll
      for (int tn = 0; tn < TN; tn++) bfr[tn] = *(const bf16x8*)(cB + tn * 32 * LD + ks * 16);
#pragma unroll
      for (int tm = 0; tm < TM; tm++)
#pragma unroll
        for (int tn = 0; tn < TN; tn++) acc[tm][tn] = MFMA(af[tm], bfr[tn], acc[tm][tn]);
    }
    __builtin_amdgcn_s_setprio(0);
    __syncthreads();
  }
#undef GEMM_GLOAD
#undef GEMM_SSTORE
}

template <int TM, int TN, class Epi>
DI void gemm_tile(const u16* A, long lda, const u16* Bt, long ldb, int K, int m0, int n0, char* smem, const Epi& epi) {
  constexpr int BM = 64 * TM, BN = 64 * TN, LDC = BN + Epi::PAD;
  f32x16 acc[TM][TN];
  gemm_mainloop<TM, TN>(A + (long)m0 * lda, lda, Bt + (long)n0 * ldb, ldb, K, smem, acc);
  const int tid = tidx(), lane = tid & 63, w = tid >> 6, r = lane & 31, h = lane >> 5;
  const int wm = w >> 1, wn = w & 1;
  float* Ct = (float*)smem;
#pragma unroll
  for (int tm = 0; tm < TM; tm++)
#pragma unroll
    for (int tn = 0; tn < TN; tn++)
#pragma unroll
      for (int i = 0; i < 16; i++)
        Ct[(wm * 32 * TM + tm * 32 + crow(i, h)) * LDC + wn * 32 * TN + tn * 32 + r] = acc[tm][tn][i];
  __syncthreads();
  epi(Ct, LDC, m0, n0, tid);
  __syncthreads();
  (void)BM;
}

struct EpiStoreBf16 {
  static constexpr int PAD = 4;
  u16* out; long ldo; int nmax; float* gates;
  DI void operator()(const float* Ct, int ldc, int m0, int n0, int tid) const {
#pragma unroll
    for (int it = 0; it < 8; it++) {
      int id = tid + 256 * it; int row = id >> 4, c8 = (id & 15) * 8;
      int n = n0 + c8;
      if (n < nmax) {
        const float* c = Ct + row * ldc + c8;
        float4 a = *(const float4*)c, b = *(const float4*)(c + 4);
        uint4 v; v.x = pk2(a.x, a.y); v.y = pk2(a.z, a.w); v.z = pk2(b.x, b.y); v.w = pk2(b.z, b.w);
        *(uint4*)(out + (long)(m0 + row) * ldo + n) = v;
        if (gates != nullptr && n == 1952) {
          float* g = gates + (long)(m0 + row) * 8;
          *(float4*)g = a; *(float4*)(g + 4) = b;
        }
      }
    }
  }
};
struct EpiRelu2 {
  static constexpr int PAD = 4;
  u16* out; long ldo;
  DI void operator()(const float* Ct, int ldc, int m0, int n0, int tid) const {
#pragma unroll
    for (int it = 0; it < 8; it++) {
      int id = tid + 256 * it; int row = id >> 4, c8 = (id & 15) * 8;
      const float* c = Ct + row * ldc + c8;
      float x[8];
#pragma unroll
      for (int j = 0; j < 8; j++) { float v = fmaxf(c[j], 0.f); x[j] = v * v; }
      *(uint4*)(out + (long)(m0 + row) * ldo + n0 + c8) = pack8(x);
    }
  }
};
struct EpiF32 {
  static constexpr int PAD = 4;
  float* out; long ldo;
  DI void operator()(const float* Ct, int ldc, int m0, int n0, int tid) const {
#pragma unroll
    for (int it = 0; it < 8; it++) {
      int id = tid + 256 * it; int row = id >> 4, c8 = (id & 15) * 8;
      const float* c = Ct + row * ldc + c8;
      float* o = out + (long)(m0 + row) * ldo + n0 + c8;
      *(float4*)o = *(const float4*)c; *(float4*)(o + 4) = *(const float4*)(c + 4);
    }
  }
};
struct EpiRes {
  static constexpr int PAD = 4;
  const float* src0; const float* src1; float* dst;
  DI void operator()(const float* Ct, int ldc, int m0, int n0, int tid) const {
#pragma unroll
    for (int it = 0; it < 8; it++) {
      int id = tid + 256 * it; int row = id >> 4, c8 = (id & 15) * 8;
      int m = m0 + row;
      const float* s = (m < NP ? src0 + (size_t)m * 1024 : src1 + (size_t)(m - NP) * 1024) + n0 + c8;
      const float* c = Ct + row * ldc + c8;
      float4 a = *(const float4*)c, b = *(const float4*)(c + 4);
      float4 sa = *(const float4*)s, sb = *(const float4*)(s + 4);
      a.x += sa.x; a.y += sa.y; a.z += sa.z; a.w += sa.w; b.x += sb.x; b.y += sb.y; b.z += sb.z; b.w += sb.w;
      float* o = dst + (size_t)m * 1024 + n0 + c8;
      *(float4*)o = a; *(float4*)(o + 4) = b;
    }
  }
};
struct EpiQ {
  static constexpr int PAD = 1;
  u16* q; const float* rq; const float2* rope; const float* g;
  DI void operator()(const float* Ct, int ldc, int m0, int n0, int tid) const {
    float* r2s = (float*)((char*)Ct + 60000);
    {
      const int row = tid >> 2, hh = (tid >> 1) & 1, half = tid & 1; const int m = m0 + row;
      const float* c = Ct + row * ldc + hh * 96 + half * 48;
      float ss = 0.f;
#pragma unroll 8
      for (int d = 0; d < 48; d++) ss += c[d] * c[d];
      ss += __shfl_xor(ss, 1);
      const float rqv = rq[m];
      ss *= rqv * rqv;
      if (half == 0) r2s[row * 2 + hh] = rsqrtf(ss * (1.f / 96.f) + EPS) * rqv * (0.10206207261596575f * LOG2E);
    }
    __syncthreads();
#pragma unroll
    for (int it = 0; it < 6; it++) {
      const int id = tid + 256 * it; const int row = id / 24, cc = id % 24; const int hh = cc / 12, c8 = cc % 12;
      const int m = m0 + row;
      const float* c = Ct + row * ldc + hh * 96;
      const float r2 = r2s[row * 2 + hh];
      float x[8];
      if (c8 < 8) {
#pragma unroll
        for (int jj = 0; jj < 8; jj++) x[jj] = c[c8 * 8 + jj] * r2 * g[c8 * 8 + jj];
      } else {
        const int half = c8 & 1;
        const bool second = c8 >= 10;
        const float2* tab = rope + (size_t)tok_pos(m) * 16 + half * 8;
#pragma unroll
        for (int jj = 0; jj < 8; jj++) {
          const int i = half * 8 + jj;
          const float a = c[64 + i], b = c[80 + i]; const float2 cs = tab[jj];
          const float v = second ? (a * cs.y + b * cs.x) : (a * cs.x - b * cs.y);
          x[jj] = v * r2 * g[(second ? 80 : 64) + i];
        }
      }
      *(uint4*)(q + (size_t)m * 768 + n0 + cc * 8) = pack8(x);
    }
  }
};
struct EpiKV {
  static constexpr int PAD = 1;
  u16* Kb; u16* Vt; const float* krope; const float* g;
  DI void operator()(const float* Ct, int ldc, int m0, int n0, int tid) const {
    const int hd = n0 >> 7;
#pragma unroll
    for (int it = 0; it < 4; it++) {
      int id = tid + 256 * it; int oct = id & 15, e = id >> 4;
      float x[8];
#pragma unroll
      for (int j = 0; j < 8; j++) x[j] = Ct[(16 * (oct >> 1) + 4 * (oct & 1) + (j & 3) + 8 * (j >> 2)) * ldc + 64 + e];
      *(uint4*)(Vt + (size_t)(hd * 64 + e) * LDVT + m0 + oct * 8) = pack8(x);
    }
    float* rrs = (float*)((char*)Ct + 66560);
    {
      const int row = tid >> 1, half = tid & 1;
      const float* c = Ct + row * ldc + half * 32;
      const float* kr = krope + (size_t)(m0 + row) * 32 + half * 16;
      float ss = 0.f;
#pragma unroll 8
      for (int d = 0; d < 32; d++) ss += c[d] * c[d];
#pragma unroll 8
      for (int d = 0; d < 16; d++) ss += kr[d] * kr[d];
      ss += __shfl_xor(ss, 1);
      if (half == 0) rrs[row] = rsqrtf(ss * (1.f / 96.f) + EPS);
    }
    __syncthreads();
    u16* ob = Kb + ((size_t)hd * NROWS + m0) * 96;
#pragma unroll
    for (int it = 0; it < 6; it++) {
      const int id = tid + 256 * it; const int row = id / 12, cc = id % 12;
      const float rr = rrs[row];
      float x[8];
      if (cc < 8) {
        const float* c = Ct + row * ldc + cc * 8;
#pragma unroll
        for (int jj = 0; jj < 8; jj++) x[jj] = c[jj] * rr * g[cc * 8 + jj];
      } else {
        const float* kr = krope + (size_t)(m0 + row) * 32 + (cc - 8) * 8;
#pragma unroll
        for (int jj = 0; jj < 8; jj++) x[jj] = kr[jj] * rr * g[cc * 8 + jj];
      }
      *(uint4*)(ob + (size_t)id * 8) = pack8(x);
    }
  }
};

template <int DQK, int NE, int EV, bool DB, bool QNORM, bool QREG, bool VPERM = false>
DI void flash_item(const u16* Qrow, bool wave_active, int ntb, int ntw, const u16* Kbase, long ldk, const u16* Vtbase, long ldv,
                   int e0, u16* Orow, char* smem) {
  constexpr int LDK = DQK + 8, LDV = 72;
  constexpr int KS = DQK / 16;
  constexpr int KTILE = 64 * LDK, VTILE = EV * LDV;
  constexpr int NKC = 64 * (DQK / 8) / 256;
  constexpr int NVC = EV * 8 / 256;
  u16* sK = (u16*)smem;
  u16* sV = sK + (DB ? 2 : 1) * KTILE;
  const int tid = tidx(), lane = tid & 63, r = lane & 31, h = lane >> 5;
  bf16x8 qf[QREG ? KS : 1];
  float rqs = 1.f;
  if (wave_active) {
    if (QREG) {
#pragma unroll
      for (int ks = 0; ks < KS; ks++) qf[QREG ? ks : 0] = *(const bf16x8*)(Qrow + ks * 16 + h * 8);
    }
    if (QNORM) {
      float ss = 0.f;
#pragma unroll
      for (int ks = 0; ks < KS; ks++) {
        bf16x8 qq = QREG ? qf[QREG ? ks : 0] : *(const bf16x8*)(Qrow + ks * 16 + h * 8);
#pragma unroll
        for (int j = 0; j < 8; j++) { float v = bf2f((u16)qq[j]); ss += v * v; }
      }
      ss = xhalf_sum(ss);
      rqs = rsqrtf(ss * (1.f / DQK) + EPS);
    }
  } else if (QREG) {
#pragma unroll
    for (int ks = 0; ks < KS; ks++)
#pragma unroll
      for (int j = 0; j < 8; j++) qf[QREG ? ks : 0][j] = 0;
  }
  f32x16 o[NE];
#pragma unroll
  for (int et = 0; et < NE; et++)
#pragma unroll
    for (int i = 0; i < 16; i++) o[et][i] = 0.f;
  float mrun = 0.f, lrun = 0.f;
  const float rqinv = __builtin_amdgcn_rcpf(rqs);

  u32x4 rk[DB ? NKC : 1], rv[DB ? NVC : 1];
  auto gload = [&](int t) {
#pragma unroll
    for (int i = 0; i < NKC; i++) {
      int id = tid + 256 * i; int row = id / (DQK / 8), ch = id % (DQK / 8);
      u32x4 v = *(const u32x4*)(Kbase + (long)(t * 64 + row) * ldk + ch * 8);
      if (DB) rk[DB ? i : 0] = v; else *(u32x4*)(sK + row * LDK + ch * 8) = v;
    }
#pragma unroll
    for (int i = 0; i < NVC; i++) {
      int id = tid + 256 * i; int row = id >> 3, ch = id & 7;
      u32x4 v = *(const u32x4*)(Vtbase + (long)row * ldv + t * 64 + ch * 8);
      if (DB) rv[DB ? i : 0] = v; else *(u32x4*)(sV + row * LDV + ch * 8) = v;
    }
  };
  auto sstore = [&](int buf) {
#pragma unroll
    for (int i = 0; i < NKC; i++) { int id = tid + 256 * i; int row = id / (DQK / 8), ch = id % (DQK / 8); *(u32x4*)(sK + buf * KTILE + row * LDK + ch * 8) = rk[DB ? i : 0]; }
#pragma unroll
    for (int i = 0; i < NVC; i++) { int id = tid + 256 * i; int row = id >> 3, ch = id & 7; *(u32x4*)(sV + buf * VTILE + row * LDV + ch * 8) = rv[DB ? i : 0]; }
  };
  auto compute = [&](int buf) {
    const u16* cK = sK + buf * KTILE + r * LDK + h * 8;
    const u16* cV = sV + buf * VTILE + (e0 + r) * LDV + 4 * h;
    const float sinit = QNORM ? -mrun * rqinv : -mrun;
    f32x16 s[2];
#pragma unroll
    for (int sub = 0; sub < 2; sub++) {
#pragma unroll
      for (int i = 0; i < 16; i++) s[sub][i] = sinit;
#pragma unroll
      for (int ks = 0; ks < KS; ks++) {
        bf16x8 a = *(const bf16x8*)(cK + sub * 32 * LDK + ks * 16);
        bf16x8 qq = QREG ? qf[QREG ? ks : 0] : *(const bf16x8*)(Qrow + ks * 16 + h * 8);
        s[sub] = MFMA(a, qq, s[sub]);
      }
    }
    float mx = -1e30f;
#pragma unroll
    for (int sub = 0; sub < 2; sub++)
#pragma unroll
      for (int i = 0; i < 16; i++) { if (QNORM) s[sub][i] *= rqs; mx = fmaxf(mx, s[sub][i]); }
    mx = xhalf_max(mx);
    if (__any(mx > 8.f)) {
      const float d = fmaxf(mx, 0.f);
      const float alpha = __builtin_amdgcn_exp2f(-d);
      mrun += d;
      lrun *= alpha;
#pragma unroll
      for (int et = 0; et < NE; et++)
#pragma unroll
        for (int i = 0; i < 16; i++) o[et][i] *= alpha;
#pragma unroll
      for (int sub = 0; sub < 2; sub++)
#pragma unroll
        for (int i = 0; i < 16; i++) s[sub][i] -= d;
    }
    float psum = 0.f;
#pragma unroll
    for (int sub = 0; sub < 2; sub++)
#pragma unroll
      for (int i = 0; i < 16; i++) { float pv = __builtin_amdgcn_exp2f(s[sub][i]); s[sub][i] = pv; psum += pv; }
    lrun += psum;
#pragma unroll
    for (int sub = 0; sub < 2; sub++)
#pragma unroll
      for (int st = 0; st < 2; st++) {
        uint4 pp;
        pp.x = pk2(s[sub][8 * st + 0], s[sub][8 * st + 1]); pp.y = pk2(s[sub][8 * st + 2], s[sub][8 * st + 3]);
        pp.z = pk2(s[sub][8 * st + 4], s[sub][8 * st + 5]); pp.w = pk2(s[sub][8 * st + 6], s[sub][8 * st + 7]);
        bf16x8 pb = __builtin_bit_cast(bf16x8, pp);
#pragma unroll
        for (int et = 0; et < NE; et++) {
          bf16x8 a;
          if (VPERM) {
            a = *(const bf16x8*)(sV + buf * VTILE + (e0 + et * 32 + r) * LDV + sub * 32 + st * 16 + 8 * h);
          } else {
            const u16* vp = cV + et * 32 * LDV + sub * 32 + st * 16;
            s16x4 lo = *(const s16x4*)vp;
            s16x4 hi = *(const s16x4*)(vp + 8);
            a = __builtin_shufflevector(lo, hi, 0, 1, 2, 3, 4, 5, 6, 7);
          }
          o[et] = MFMA(a, pb, o[et]);
        }
      }
  };

  __syncthreads();
  if (DB) {
    gload(0);
    sstore(0);
    __syncthreads();
    for (int t = 0; t < ntb; t++) {
      const bool more = (t + 1 < ntb);
      if (more) gload(t + 1);
      __builtin_amdgcn_sched_barrier(0);
      if (wave_active && t < ntw) { __builtin_amdgcn_s_setprio(1); compute(t & 1); __builtin_amdgcn_s_setprio(0); }
      if (more) sstore((t + 1) & 1);
      __syncthreads();
    }
  } else {
    for (int t = 0; t < ntb; t++) {
      if (t > 0) __syncthreads();
      gload(t);
      __syncthreads();
      if (wave_active && t < ntw) compute(0);
    }
    __syncthreads();
  }
  if (wave_active) {
    float lt = xhalf_sum(lrun);
    float inv = __builtin_amdgcn_rcpf(lt);
#pragma unroll
    for (int et = 0; et < NE; et++)
#pragma unroll
      for (int g = 0; g < 4; g++) {
        uint2 v;
        v.x = pk2(o[et][4 * g + 0] * inv, o[et][4 * g + 1] * inv);
        v.y = pk2(o[et][4 * g + 2] * inv, o[et][4 * g + 3] * inv);
        *(uint2*)(Orow + et * 32 + 8 * g + 4 * h) = v;
      }
  }
}

DI void norm_row_wave(const float* src, u16* dst, int lane) {
  float4 v[4]; float ss = 0.f;
#pragma unroll
  for (int i = 0; i < 4; i++) { v[i] = *(const float4*)(src + i * 256 + lane * 4); ss += v[i].x * v[i].x + v[i].y * v[i].y + v[i].z * v[i].z + v[i].w * v[i].w; }
  ss = wave_sum(ss);
  float rr = rsqrtf(ss * (1.f / 1024.f) + EPS);
#pragma unroll
  for (int i = 0; i < 4; i++) {
    uint2 o; o.x = pk2(v[i].x * rr, v[i].y * rr); o.y = pk2(v[i].z * rr, v[i].w * rr);
    *(uint2*)(dst + i * 256 + lane * 4) = o;
  }
}

DI void phase_norm(const Params& p, int l) {
  const int lane = tidx() & 63, w = tidx() >> 6;
  u16* act = wsb(p, WS_ACT);
  for (int t = blockIdx.x * 4 + w; t < NTOK; t += gridDim.x * 4) norm_row_wave(xrow(p, l, t), act + (size_t)t * LDA, lane);
}

DI void wtile(const float* src, const float* gain, int K, int N, u16* dst, int ldd, int k0, int n0, char* smem) {
  u16* T = (u16*)smem;
  const int tid = tidx();
  __syncthreads();
  {
    const int nn = tid & 63, kk0 = tid >> 6;
    const int n = n0 + nn;
#pragma unroll 4
    for (int i = 0; i < 16; i++) {
      int kk = kk0 + 4 * i;
      float v = 0.f;
      if (n < N) { v = src[(size_t)(k0 + kk) * N + n]; if (gain) v *= gain[k0 + kk]; }
      T[nn * 72 + kk] = f2bf(v);
    }
  }
  __syncthreads();
  {
    const int nn = tid >> 2, kq = tid & 3;
    const uint4* s = (const uint4*)(T + nn * 72 + kq * 16);
    uint4* d = (uint4*)(dst + (size_t)(n0 + nn) * ldd + k0 + kq * 16);
    d[0] = s[0]; d[1] = s[1];
  }
}

DI void phase_prep(const Params& p, char* smem) {
  const int tid = tidx(), lane = tid & 63, w = tid >> 6;
  for (int t = blockIdx.x; t < 2 * 4048; t += gridDim.x) {
    int l = t / 4048, u = t % 4048;
    const float* src; const float* gain = nullptr; int K, N, Npad; size_t doff; int ldd = LDW;
    if (u < 640) { src = p.w_in + (size_t)l * 1024 * INC; gain = p.g_mix + l * 1024; K = 1024; N = INC; Npad = 2560; doff = W_IN; }
    else if (u < 688) { u -= 640; src = p.w_q_up + (size_t)l * 256 * 768; gain = p.g_qa + l * 256; K = 256; N = 768; Npad = 768; doff = W_Q; ldd = LDWQ; }
    else if (u < 720) { u -= 688; src = p.w_kv_up + (size_t)l * 128 * 1024; K = 128; N = 1024; Npad = 1024; doff = W_KV; ldd = LDWKV; }
    else if (u < 976) { u -= 720; src = p.w_out + (size_t)l * 1048576; K = 1024; N = 1024; Npad = 1024; doff = W_OUT; }
    else if (u < 1232) { u -= 976; src = p.w_xq + (size_t)l * 1048576; gain = p.g_xattn + l * 1024; K = 1024; N = 1024; Npad = 1024; doff = W_XQ; }
    else if (u < 1488) { u -= 1232; src = p.w_xk + (size_t)l * 1048576; gain = p.g_mem + l * 1024; K = 1024; N = 1024; Npad = 1024; doff = W_XK; }
    else if (u < 1744) { u -= 1488; src = p.w_xv + (size_t)l * 1048576; gain = p.g_mem + l * 1024; K = 1024; N = 1024; Npad = 1024; doff = W_XV; }
    else if (u < 2000) { u -= 1744; src = p.w_xo + (size_t)l * 1048576; K = 1024; N = 1024; Npad = 1024; doff = W_XO; }
    else if (u < 3024) { u -= 2000; src = p.w_ff1 + (size_t)l * 4194304; gain = p.g_mlp + l * 1024; K = 1024; N = 4096; Npad = 4096; doff = W_FF1; }
    else { u -= 3024; src = p.w_ff2 + (size_t)l * 4194304; K = 4096; N = 1024; Npad = 1024; doff = W_FF2; ldd = LDW2; }
    int nt = Npad / 64;
    int kt = u / nt, ntile = u % nt;
    wtile(src, gain, K, N, wsb(p, WS_W) + (size_t)l * W_LAYER + doff, ldd, kt * 64, ntile * 64, smem);
  }
  float2* tab = (float2*)(p.ws + WS_ROPE);
  for (int t = blockIdx.x; t < 1024; t += gridDim.x) {
    int idx = t * 256 + tid; int pos = idx >> 4, i = idx & 15;
    float inv_freq = __builtin_amdgcn_exp2f(-(float)i * 0.830482023721841f);
    float ang = (float)pos * inv_freq;
    double rev = (double)ang * 0.15915494309189535;
    rev -= rint(rev);
    float fr = (float)rev;
    tab[idx] = make_float2(__builtin_amdgcn_cosf(fr), __builtin_amdgcn_sinf(fr));
  }
  u16* hm = wsb(p, WS_HM);
  for (int t = blockIdx.x * 4 + w; t < 512; t += gridDim.x * 4) norm_row_wave(p.mem_prompt + (size_t)t * 1024, hm + (size_t)t * LDA, lane);
  phase_norm(p, 0);
}

template <class Epi>
DI void phase_gemm128(const Sched& sc, const u16* A, long lda, const u16* Bt, long ldb, int K, int MT, int NT, int SN, char* smem, const Epi& epi);
DI void phase_inproj(const Params& p, const Sched& sc, int l, char* smem) {
  const u16* W = wsb(p, WS_W) + (size_t)l * W_LAYER;
  {
    EpiStoreBf16 epi{wsb(p, WS_BIG + B_P), INC, INC, wsf(p, WS_GATES)};
    phase_gemm128(sc, wsb(p, WS_ACT), LDA, W + W_IN, LDW, 1024, 272, 20, 4, smem, epi);
  }
  if (l == 0) {
    for (int u = blockIdx.x; u < 128; u += gridDim.x) {
      int l2 = u >> 6, which = (u >> 5) & 1, mt = (u >> 3) & 3, nt = u & 7;
      const u16* W2 = wsb(p, WS_W) + (size_t)l2 * W_LAYER + (which ? W_XV : W_XK);
      EpiF32 epi{p.out + (which ? O_PMEMV : O_PMEMK) + (size_t)l2 * 524288, 1024};
      gemm_tile<2, 2>(wsb(p, WS_HM), LDA, W2, LDW, 1024, mt * 128, nt * 128, smem, epi);
    }
  }
}

DI void post_token(const Params& p, int l, int tok, int lane) {
  const u16* pr = wsb(p, WS_BIG + B_P) + (size_t)tok * INC;
  {
    uint2 q4 = *(const uint2*)(pr + lane * 4);
    float a = bflo(q4.x), b = bfhi(q4.x), c = bflo(q4.y), d = bfhi(q4.y);
    float ss = wave_sum(a * a + b * b + c * c + d * d);
    if (lane == 0) wsf(p, WS_RQ)[tok] = rsqrtf(ss * (1.f / 256.f) + EPS);
  }
  const bool prompt = tok < NP;
  int b, s, row, pos; float* ckv_out; float* kr_out;
  if (prompt) {
    b = tok >> 14; s = tok & 16383; row = tok; pos = s;
    ckv_out = p.out + O_PCKV + ((size_t)(l * 2 + b) * 16384 + s) * 128;
    kr_out = p.out + O_PKROPE + ((size_t)(l * 2 + b) * 16384 + s) * 32;
  } else {
    int t2 = tok - NP; b = t2 >> 6; s = t2 & 63; row = NP + b * 1088 + 1024 + s; pos = 1024 + s;
    ckv_out = p.out + O_SCKV + ((size_t)(l * 32 + b) * 64 + s) * 128;
    kr_out = p.out + O_SKROPE + ((size_t)(l * 32 + b) * 64 + s) * 32;
  }
  {
    unsigned c2 = *(const unsigned*)(pr + 256 + lane * 2);
    float c0 = bflo(c2), c1 = bfhi(c2);
    float ss = wave_sum(c0 * c0 + c1 * c1);
    float rr = rsqrtf(ss * (1.f / 128.f) + EPS);
    float o0 = c0 * rr * p.g_kva[l * 128 + lane * 2], o1 = c1 * rr * p.g_kva[l * 128 + lane * 2 + 1];
    *(float2*)(ckv_out + lane * 2) = make_float2(o0, o1);
    *(unsigned*)(wsb(p, WS_CKV) + (size_t)row * 128 + lane * 2) = pk2(o0, o1);
  }
  if (lane < 16) {
    float x1 = bf2f(pr[384 + lane]), x2 = bf2f(pr[400 + lane]);
    float2 cs = ((const float2*)(p.ws + WS_ROPE))[(size_t)pos * 16 + lane];
    float o1 = x1 * cs.x - x2 * cs.y, o2 = x1 * cs.y + x2 * cs.x;
    kr_out[lane] = o1; kr_out[16 + lane] = o2;
    float* ka = wsf(p, WS_KROPE) + (size_t)row * 32;
    ka[lane] = o1; ka[16 + lane] = o2;
  }
  const int S = prompt ? 16384 : 64;
  if (s >= S - 3) {
    int j = s - (S - 3);
    float* dst = prompt ? p.out + O_PCONV + ((size_t)(l * 2 + b) * 3 + j) * 1024 : p.out + O_SCONV + ((size_t)(l * 32 + b) * 3 + j) * 1024;
#pragma unroll 4
    for (int i = 0; i < 16; i++) dst[lane + 64 * i] = bf2f(pr[416 + lane + 64 * i]);
  }
}

DI void post_past(const Params& p, int l, int pi, int lane) {
  int b = pi >> 10, t = pi & 1023;
  size_t row = (size_t)NP + b * 1088 + t;
  const float* src = p.cache_ckv + ((size_t)(l * 32 + b) * 1024 + t) * 128;
  float2 v = *(const float2*)(src + lane * 2);
  *(unsigned*)(wsb(p, WS_CKV) + row * 128 + lane * 2) = pk2(v.x, v.y);
  if (lane < 32) wsf(p, WS_KROPE)[row * 32 + lane] = p.cache_krope[((size_t)(l * 32 + b) * 1024 + t) * 32 + lane];
}

struct ChunkInfo { int tok0, b, h, chain, has_prev, sample; };
DI ChunkInfo chunk_info(int item) {
  ChunkInfo ci;
  if (item < 2048) {
    ci.chain = item >> 8; ci.b = ci.chain >> 2; ci.h = ci.chain & 3; int c = item & 255;
    ci.tok0 = ci.b * 16384 + c * 64; ci.has_prev = (c > 0); ci.sample = 0;
  } else {
    int j = item - 2048; ci.chain = 8 + j; ci.b = j >> 2; ci.h = j & 3; ci.tok0 = NP + ci.b * 64; ci.has_prev = 0; ci.sample = 1;
  }
  return ci;
}
DI void load_x8(const Params& p, int l, const ChunkInfo& ci, int tp, int col, float (&x)[8]) {
  if (tp >= 0 || ci.has_prev) {
    uint4 v = *(const uint4*)(wsb(p, WS_BIG + B_P) + (size_t)(ci.tok0 + tp) * INC + col);
    unpack8(v, x);
  } else if (ci.sample) {
    const float* s = p.st_conv + (((size_t)l * 32 + ci.b) * 3 + (3 + tp)) * 1024 + (col - 416);
    float4 a = *(const float4*)s, b = *(const float4*)(s + 4);
    x[0] = a.x; x[1] = a.y; x[2] = a.z; x[3] = a.w; x[4] = b.x; x[5] = b.y; x[6] = b.z; x[7] = b.w;
  } else {
#pragma unroll
    for (int j = 0; j < 8; j++) x[j] = 0.f;
  }
}
template <class Emit>
DI void conv_run(const Params& p, int l, const ChunkInfo& ci, int mat, int chunk, int row0, int nrows, Emit emit) {
  const int ch0 = mat * 512 + ci.h * 128 + chunk * 8;
  const int col = 416 + ch0;
  float w0[8], w1[8], w2[8], w3[8], bias[8];
  {
    const float* wc = p.w_conv + (size_t)l * 4096 + ch0;
    float4 a, b;
    a = *(const float4*)(wc); b = *(const float4*)(wc + 4);
    w0[0] = a.x; w0[1] = a.y; w0[2] = a.z; w0[3] = a.w; w0[4] = b.x; w0[5] = b.y; w0[6] = b.z; w0[7] = b.w;
    a = *(const float4*)(wc + 1024); b = *(const float4*)(wc + 1028);
    w1[0] = a.x; w1[1] = a.y; w1[2] = a.z; w1[3] = a.w; w1[4] = b.x; w1[5] = b.y; w1[6] = b.z; w1[7] = b.w;
    a = *(const float4*)(wc + 2048); b = *(const float4*)(wc + 2052);
    w2[0] = a.x; w2[1] = a.y; w2[2] = a.z; w2[3] = a.w; w2[4] = b.x; w2[5] = b.y; w2[6] = b.z; w2[7] = b.w;
    a = *(const float4*)(wc + 3072); b = *(const float4*)(wc + 3076);
    w3[0] = a.x; w3[1] = a.y; w3[2] = a.z; w3[3] = a.w; w3[4] = b.x; w3[5] = b.y; w3[6] = b.z; w3[7] = b.w;
    const float* bc = p.b_conv + (size_t)l * 1024 + ch0;
    a = *(const float4*)(bc); b = *(const float4*)(bc + 4);
    bias[0] = a.x; bias[1] = a.y; bias[2] = a.z; bias[3] = a.w; bias[4] = b.x; bias[5] = b.y; bias[6] = b.z; bias[7] = b.w;
  }
  float xa[8], xb[8], xc[8], xd[8];
  load_x8(p, l, ci, row0 - 3, col, xa);
  load_x8(p, l, ci, row0 - 2, col, xb);
  load_x8(p, l, ci, row0 - 1, col, xc);
  for (int t = row0; t < row0 + nrows; t++) {
    load_x8(p, l, ci, t, col, xd);
    float y[8];
#pragma unroll
    for (int j = 0; j < 8; j++) {
      float v = bias[j] + xa[j] * w0[j] + xb[j] * w1[j] + xc[j] * w2[j] + xd[j] * w3[j];
      y[j] = v * __builtin_amdgcn_rcpf(1.f + __expf(-v));
      xa[j] = xb[j]; xb[j] = xc[j]; xc[j] = xd[j];
    }
    emit(t, y);
  }
}
DI float logsigmoid(float z) { return fminf(z, 0.f) - log1pf(__expf(-fabsf(z))); }

DI void mlstm_m1(const Params& p, int l, int item, char* smem) {
  const ChunkInfo ci = chunk_info(item);
  const int tid = tidx(), lane = tid & 63, w = tid >> 6, r = lane & 31, h = lane >> 5;
  u16* sVt = (u16*)smem;
  u16* sKt = sVt + 128 * 72;
  float* swk = (float*)(sKt + 128 * 72);
  __syncthreads();
  if (w == 0) {
    const float* g = wsf(p, WS_GATES) + (size_t)(ci.tok0 + lane) * 8;
    float ig = g[ci.h] + p.b_igate[l * 4 + ci.h];
    float lf = logsigmoid(g[4 + ci.h] + p.b_fgate[l * 4 + ci.h]);
    float bcs = lf;
#pragma unroll
    for (int o = 1; o < 64; o <<= 1) { float t = __shfl_up(bcs, o); if (lane >= o) bcs += t; }
    float u = ig - bcs;
    float umax = wave_max(u);
    swk[lane] = __expf(u - umax);
    float blast = __shfl(bcs, 63);
    if (lane == 0) { float* sc = wsf(p, WS_SCAL) + (size_t)item * 2; sc[0] = blast; sc[1] = blast + umax; }
  }
#pragma unroll
  for (int it = 0; it < 4; it++) {
    int id = tid + 256 * it; int s = id >> 4, ch = id & 15;
    uint4 v = *(const uint4*)(wsb(p, WS_BIG + B_P) + (size_t)(ci.tok0 + s) * INC + 1440 + ci.h * 128 + ch * 8);
    const u16* vv = (const u16*)&v;
    unsigned a[4] = {v.x, v.y, v.z, v.w};
#pragma unroll
    for (int j = 0; j < 4; j++) { sVt[(ch * 8 + 2 * j) * 72 + s] = (u16)(a[j] & 0xffffu); sVt[(ch * 8 + 2 * j + 1) * 72 + s] = (u16)(a[j] >> 16); }
    (void)vv;
  }
  __syncthreads();
  {
    const int chunk = tid & 15, rg = tid >> 4;
    conv_run(p, l, ci, 1, chunk, rg * 4, 4, [&](int t, const float (&y)[8]) {
      float sc = 0.08838834764831845f * swk[t];
#pragma unroll
      for (int j = 0; j < 8; j++) sKt[(chunk * 8 + j) * 72 + t] = f2bf(y[j] * sc);
    });
  }
  __syncthreads();
  const int wm = w >> 1, wn = w & 1;
  f32x16 acc[2][2];
#pragma unroll
  for (int a = 0; a < 2; a++)
#pragma unroll
    for (int b = 0; b < 2; b++)
#pragma unroll
      for (int i = 0; i < 16; i++) acc[a][b][i] = 0.f;
#pragma unroll
  for (int ks = 0; ks < 4; ks++) {
    bf16x8 af[2], bfr[2];
#pragma unroll
    for (int tm = 0; tm < 2; tm++) af[tm] = *(const bf16x8*)(sVt + (wm * 64 + tm * 32 + r) * 72 + ks * 16 + h * 8);
#pragma unroll
    for (int tn = 0; tn < 2; tn++) bfr[tn] = *(const bf16x8*)(sKt + (wn * 64 + tn * 32 + r) * 72 + ks * 16 + h * 8);
#pragma unroll
    for (int tm = 0; tm < 2; tm++)
#pragma unroll
      for (int tn = 0; tn < 2; tn++) acc[tm][tn] = MFMA(bfr[tn], af[tm], acc[tm][tn]);
  }
  u16* slot = wsb(p, WS_BIG + B_ST) + (size_t)item * 16384;
#pragma unroll
  for (int tm = 0; tm < 2; tm++)
#pragma unroll
    for (int tn = 0; tn < 2; tn++)
#pragma unroll
      for (int g = 0; g < 4; g++) {
        uint2 v;
        v.x = pk2(acc[tm][tn][4 * g + 0], acc[tm][tn][4 * g + 1]);
        v.y = pk2(acc[tm][tn][4 * g + 2], acc[tm][tn][4 * g + 3]);
        *(uint2*)(slot + (wm * 64 + tm * 32 + r) * 128 + wn * 64 + tn * 32 + 8 * g + 4 * h) = v;
      }
  if (tid < 128) {
    float sum = 0.f;
    const u16* kr = sKt + tid * 72;
#pragma unroll 8
    for (int s = 0; s < 64; s++) sum += bf2f(kr[s]);
    wsf(p, WS_NU)[(size_t)item * 128 + tid] = sum;
  }
}

DI void mlstm_m2(const Params& p, int l, int unit) {
  const int tid = tidx();
  int chain, g, nc, item0, b, h; bool sample;
  if (unit < 256) { chain = unit >> 5; g = unit & 31; nc = 256; item0 = chain * 256; b = chain >> 2; h = chain & 3; sample = false; }
  else { int u = unit - 256; int j = u >> 5; g = u & 31; chain = 8 + j; nc = 1; item0 = 2048 + j; b = j >> 2; h = j & 3; sample = true; }
  const int el = g * 512 + tid * 2; const int e = el >> 7, d = el & 127;
  float c0 = 0.f, c1 = 0.f, nst = 0.f, m = 0.f;
  const bool do_n = (g == 0 && tid < 128);
  if (sample) {
    const float* C0 = p.st_C + ((size_t)(l * 32 + b) * 4 + h) * 16384;
    c0 = C0[d * 128 + e]; c1 = C0[(d + 1) * 128 + e];
    if (do_n) nst = p.st_n[((size_t)(l * 32 + b) * 4 + h) * 128 + tid];
    m = p.st_m[(l * 32 + b) * 4 + h];
  }
  u16* slots = wsb(p, WS_BIG + B_ST);
  const float* scal = wsf(p, WS_SCAL);
  float* nu = wsf(p, WS_NU);
  float* mst = wsf(p, WS_MST);
  for (int cb = 0; cb < nc; cb += 8) {
    unsigned uu[8]; float nn[8];
#pragma unroll
    for (int j = 0; j < 8; j++) {
      uu[j] = 0; nn[j] = 0.f;
      if (cb + j < nc) {
        uu[j] = *(const unsigned*)(slots + (size_t)(item0 + cb + j) * 16384 + el);
        if (do_n) nn[j] = nu[(size_t)(item0 + cb + j) * 128 + tid];
      }
    }
#pragma unroll
    for (int j = 0; j < 8; j++) {
      if (cb + j < nc) {
        const int item = item0 + cb + j;
        const float A = scal[item * 2], Cm = scal[item * 2 + 1];
        const float mnew = fmaxf(A + m, Cm);
        const float dec = __expf(A + m - mnew), us = __expf(Cm - mnew);
        *(unsigned*)(slots + (size_t)item * 16384 + el) = pk2(c0, c1);
        c0 = dec * c0 + us * bflo(uu[j]);
        c1 = dec * c1 + us * bfhi(uu[j]);
        if (do_n) { nu[(size_t)item * 128 + tid] = nst; nst = dec * nst + us * nn[j]; }
        if (g == 0 && tid == 0) mst[item] = m;
        m = mnew;
      }
    }
  }
  float* oC = sample ? p.out + O_SC + ((size_t)(l * 32 + b) * 4 + h) * 16384 : p.out + O_PC + ((size_t)(l * 2 + b) * 4 + h) * 16384;
  oC[d * 128 + e] = c0; oC[(d + 1) * 128 + e] = c1;
  if (do_n) { float* on = sample ? p.out + O_SN + ((size_t)(l * 32 + b) * 4 + h) * 128 : p.out + O_PN + ((size_t)(l * 2 + b) * 4 + h) * 128; on[tid] = nst; }
  if (g == 0 && tid == 0) { float* om = sample ? p.out + O_SM + (l * 32 + b) * 4 + h : p.out + O_PM + (l * 2 + b) * 4 + h; *om = m; }
}

DI void mlstm_m3(const Params& p, int l, int item, char* smem) {
  const ChunkInfo ci = chunk_info(item);
  const int tid = tidx(), lane = tid & 63, w = tid >> 6, r = lane & 31, h = lane >> 5;
  u16* sQ = (u16*)smem;
  u16* sK = sQ + 64 * 136;
  u16* sVt = sK + 64 * 136;
  u16* sP = sVt + 128 * 72;
  float* su = (float*)(sP + 64 * 72);
  float* sM = su + 64;
  float* sa = sM + 64;
  float* sden = sa + 64;
  float* sinv = sden + 64;
  float* sn = sinv + 64;
  float* sH = (float*)smem;
  __syncthreads();
  const float m_start = wsf(p, WS_MST)[item];
  if (w == 0) {
    const float* g = wsf(p, WS_GATES) + (size_t)(ci.tok0 + lane) * 8;
    float ig = g[ci.h] + p.b_igate[l * 4 + ci.h];
    float lf = logsigmoid(g[4 + ci.h] + p.b_fgate[l * 4 + ci.h]);
    float bcs = lf;
#pragma unroll
    for (int o = 1; o < 64; o <<= 1) { float t = __shfl_up(bcs, o); if (lane >= o) bcs += t; }
    float u = ig - bcs;
    float cm = u;
#pragma unroll
    for (int o = 1; o < 64; o <<= 1) { float t = __shfl_up(cm, o); if (lane >= o) cm = fmaxf(cm, t); }
    float Mt = fmaxf(m_start, cm);
    su[lane] = u; sM[lane] = Mt; sa[lane] = __expf(m_start - Mt); sden[lane] = __expf(-(bcs + Mt));
  } else if (w == 1) {
    sn[lane] = wsf(p, WS_NU)[(size_t)item * 128 + lane];
    sn[lane + 64] = wsf(p, WS_NU)[(size_t)item * 128 + lane + 64];
  }
#pragma unroll
  for (int it = 0; it < 4; it++) {
    int id = tid + 256 * it; int s = id >> 4, ch = id & 15;
    uint4 v = *(const uint4*)(wsb(p, WS_BIG + B_P) + (size_t)(ci.tok0 + s) * INC + 1440 + ci.h * 128 + ch * 8);
    unsigned a[4] = {v.x, v.y, v.z, v.w};
#pragma unroll
    for (int j = 0; j < 4; j++) { sVt[(ch * 8 + 2 * j) * 72 + s] = (u16)(a[j] & 0xffffu); sVt[(ch * 8 + 2 * j + 1) * 72 + s] = (u16)(a[j] >> 16); }
  }
  {
    const int mc = tid & 31, mat = mc >> 4, chunk = mc & 15, rg = tid >> 5;
    u16* dst = mat ? sK : sQ;
    const float sc = mat ? 0.08838834764831845f : 1.f;
    conv_run(p, l, ci, mat, chunk, rg * 8, 8, [&](int t, const float (&y)[8]) {
      float x[8];
#pragma unroll
      for (int j = 0; j < 8; j++) x[j] = y[j] * sc;
      *(uint4*)(dst + t * 136 + chunk * 8) = pack8(x);
    });
  }
  __syncthreads();
  {
    const int tq = w >> 1, ts = w & 1;
    f32x16 s;
#pragma unroll
    for (int i = 0; i < 16; i++) s[i] = 0.f;
#pragma unroll
    for (int ks = 0; ks < 8; ks++) {
      bf16x8 a = *(const bf16x8*)(sQ + (tq * 32 + r) * 136 + ks * 16 + h * 8);
      bf16x8 b = *(const bf16x8*)(sK + (ts * 32 + r) * 136 + ks * 16 + h * 8);
      s = MFMA(a, b, s);
    }
    const int sidx = ts * 32 + r;
    const float us = su[sidx];
#pragma unroll
    for (int i = 0; i < 16; i++) {
      int t = tq * 32 + crow(i, h);
      float v = (sidx <= t) ? s[i] * __expf(us - sM[t]) : 0.f;
      sP[t * 72 + sidx] = f2bf(v);
    }
  }
  __syncthreads();
  if (tid < 64) {
    float rs = 0.f, qd = 0.f;
    const u16* pr = sP + tid * 72;
#pragma unroll 8
    for (int s = 0; s < 64; s++) rs += bf2f(pr[s]);
    const u16* qr = sQ + tid * 136;
#pragma unroll 8
    for (int d = 0; d < 128; d++) qd += bf2f(qr[d]) * sn[d];
    float qn = sa[tid] * qd + rs;
    sinv[tid] = __builtin_amdgcn_rcpf(fmaxf(fabsf(qn), sden[tid]));
  }
  const int tq = w & 1, eb = (w >> 1) * 2;
  f32x16 a1[2], a2[2];
#pragma unroll
  for (int et = 0; et < 2; et++)
#pragma unroll
    for (int i = 0; i < 16; i++) { a1[et][i] = 0.f; a2[et][i] = 0.f; }
  const u16* slot = wsb(p, WS_BIG + B_ST) + (size_t)item * 16384;
#pragma unroll
  for (int ks = 0; ks < 8; ks++) {
    bf16x8 a = *(const bf16x8*)(sQ + (tq * 32 + r) * 136 + ks * 16 + h * 8);
#pragma unroll
    for (int et = 0; et < 2; et++) {
      bf16x8 b = *(const bf16x8*)(slot + ((eb + et) * 32 + r) * 128 + ks * 16 + h * 8);
      a1[et] = MFMA(a, b, a1[et]);
    }
  }
#pragma unroll
  for (int ks = 0; ks < 4; ks++) {
    bf16x8 a = *(const bf16x8*)(sP + (tq * 32 + r) * 72 + ks * 16 + h * 8);
#pragma unroll
    for (int et = 0; et < 2; et++) {
      bf16x8 b = *(const bf16x8*)(sVt + ((eb + et) * 32 + r) * 72 + ks * 16 + h * 8);
      a2[et] = MFMA(a, b, a2[et]);
    }
  }
  __syncthreads();
#pragma unroll
  for (int et = 0; et < 2; et++)
#pragma unroll
    for (int i = 0; i < 16; i++) {
      int t = tq * 32 + crow(i, h);
      sH[t * 132 + (eb + et) * 32 + r] = (sa[t] * a1[et][i] + a2[et][i]) * sinv[t];
    }
  __syncthreads();
  {
    const int t = tid >> 2, part = tid & 3;
    const float* hr = sH + t * 132 + part * 32;
    float ss = 0.f;
#pragma unroll 8
    for (int j = 0; j < 32; j++) ss += hr[j] * hr[j];
    ss += __shfl_xor(ss, 1); ss += __shfl_xor(ss, 2);
    const float rr = rsqrtf(ss * (1.f / 128.f) + EPS);
    const int tok = ci.tok0 + t;
    const u16* og = wsb(p, WS_BIG + B_P) + (size_t)tok * INC + 1960 + ci.h * 128 + part * 32;
    const float* gm = p.g_mhead + (size_t)l * 512 + ci.h * 128 + part * 32;
    u16* o = wsb(p, WS_ACT) + (size_t)tok * LDA + 512 + ci.h * 128 + part * 32;
#pragma unroll
    for (int c8 = 0; c8 < 4; c8++) {
      float gv[8], x[8];
      unpack8(*(const uint4*)(og + c8 * 8), gv);
#pragma unroll
      for (int j = 0; j < 8; j++) x[j] = hr[c8 * 8 + j] * rr * gm[c8 * 8 + j] * __builtin_amdgcn_rcpf(1.f + __expf(-gv[j]));
      *(uint4*)(o + c8 * 8) = pack8(x);
    }
  }
}

DI void xkv_item(const Params& p, int l, int item, char* smem) {
  const int tid = tidx();
  const int kg = item & 3, hh = (item >> 2) & 3, bidx = item >> 4;
  u16* T = (u16*)smem;
  __syncthreads();
  const int key = tid >> 2, qt = tid & 3;
  const int mem = kg * 64 + key;
  const bool prompt = bidx < 2;
  float* kp; const float* vp;
  if (prompt) {
    kp = p.out + O_PMEMK + (((size_t)(l * 2 + bidx) * 256 + mem) * 4 + hh) * 256 + qt * 64;
    vp = p.out + O_PMEMV + (((size_t)(l * 2 + bidx) * 256 + mem) * 4 + hh) * 256 + qt * 64;
  } else {
    kp = (float*)(p.cache_mem_k + (((size_t)(l * 32 + bidx - 2) * 256 + mem) * 4 + hh) * 256 + qt * 64);
    vp = p.cache_mem_v + (((size_t)(l * 32 + bidx - 2) * 256 + mem) * 4 + hh) * 256 + qt * 64;
  }
  float rr = 1.f;
  if (prompt) {
    float ss = 0.f;
#pragma unroll 4
    for (int j = 0; j < 16; j++) { float4 v = *(const float4*)(kp + j * 4); ss += v.x * v.x + v.y * v.y + v.z * v.z + v.w * v.w; }
    ss += __shfl_xor(ss, 1); ss += __shfl_xor(ss, 2);
    rr = rsqrtf(ss * (1.f / 256.f) + EPS);
  }
  const float* gk = p.g_xk + l * 256 + qt * 64;
  const float* gq = p.g_xq + l * 256 + qt * 64;
  u16* xk = wsb(p, WS_BIG + B_XK) + ((size_t)(bidx * 4 + hh) * 256 + mem) * 256 + qt * 64;
#pragma unroll 2
  for (int c8 = 0; c8 < 8; c8++) {
    float4 a = *(const float4*)(kp + c8 * 8), b = *(const float4*)(kp + c8 * 8 + 4);
    float x[8] = {a.x, a.y, a.z, a.w, b.x, b.y, b.z, b.w};
    if (prompt) {
#pragma unroll
      for (int j = 0; j < 8; j++) x[j] = x[j] * rr * gk[c8 * 8 + j];
      *(float4*)(kp + c8 * 8) = make_float4(x[0], x[1], x[2], x[3]);
      *(float4*)(kp + c8 * 8 + 4) = make_float4(x[4], x[5], x[6], x[7]);
    }
#pragma unroll
    for (int j = 0; j < 8; j++) x[j] = x[j] * gq[c8 * 8 + j] * (0.0625f * LOG2E);
    *(uint4*)(xk + c8 * 8) = pack8(x);
    float4 va = *(const float4*)(vp + c8 * 8), vb = *(const float4*)(vp + c8 * 8 + 4);
    float y[8] = {va.x, va.y, va.z, va.w, vb.x, vb.y, vb.z, vb.w};
    *(uint4*)(T + key * 264 + qt * 64 + c8 * 8) = pack8(y);
  }
  __syncthreads();
  {
    const int e = tid;
    u16* xv = wsb(p, WS_BIG + B_XVT) + ((size_t)(bidx * 4 + hh) * 256 + e) * LDXV + kg * 64;
#pragma unroll 2
    for (int oct = 0; oct < 8; oct++) {
      uint4 v;
      const int kb = 16 * (oct >> 1) + 4 * (oct & 1);
      v.x = (unsigned)T[(kb + 0) * 264 + e] | ((unsigned)T[(kb + 1) * 264 + e] << 16);
      v.y = (unsigned)T[(kb + 2) * 264 + e] | ((unsigned)T[(kb + 3) * 264 + e] << 16);
      v.z = (unsigned)T[(kb + 8) * 264 + e] | ((unsigned)T[(kb + 9) * 264 + e] << 16);
      v.w = (unsigned)T[(kb + 10) * 264 + e] | ((unsigned)T[(kb + 11) * 264 + e] << 16);
      *(uint4*)(xv + oct * 8) = v;
    }
  }
}

DI void phase_C2(const Params& p, int l, char* smem) {
  for (int t = blockIdx.x; t < 544; t += gridDim.x) xkv_item(p, l, t, smem);
}
DI void phase_C1(const Params& p, int l, char* smem) {
  const int lane = tidx() & 63, w = tidx() >> 6;
  for (int t = blockIdx.x; t < NITEM; t += gridDim.x) mlstm_m1(p, l, t, smem);
  for (int t = blockIdx.x * 4 + w; t < NTOK + 32768; t += gridDim.x * 4) {
    if (t < NTOK) post_token(p, l, t, lane); else post_past(p, l, t - NTOK, lane);
  }
}

DI void phase_D(const Params& p, int l, char* smem) {
  const int n_scan = 256 + 4096;
  const int n_q = 544 * 4;
  const u16* W = wsb(p, WS_W) + (size_t)l * W_LAYER;
  for (int t = blockIdx.x; t < n_scan + n_q; t += gridDim.x) {
    if (t < n_scan) mlstm_m2(p, l, t);
    else {
      int u = t - n_scan; int mt = u >> 2, nt = u & 3;
      EpiQ epi{wsb(p, WS_BIG + B_Q), wsf(p, WS_RQ), (const float2*)(p.ws + WS_ROPE), p.g_qnorm + l * 96};
      gemm_tile<1, 3>(wsb(p, WS_BIG + B_P), INC, W + W_Q, LDWQ, 256, mt * 64, nt * 192, smem, epi);
    }
  }
}

DI void phase_E(const Params& p, int l, char* smem) {
  for (int t = blockIdx.x; t < NITEM; t += gridDim.x) mlstm_m3(p, l, t, smem);
}

DI void phase_F(const Params& p, int l, char* smem) {
  const u16* W = wsb(p, WS_W) + (size_t)l * W_LAYER;
  for (int t = blockIdx.x; t < 528 * 8; t += gridDim.x) {
    int mt = t >> 3, nt = t & 7;
    EpiKV epi{wsb(p, WS_BIG + B_K), wsb(p, WS_BIG + B_VT), wsf(p, WS_KROPE), p.g_knorm + l * 96};
    gemm_tile<2, 2>(wsb(p, WS_CKV), 128, W + W_KV, LDWKV, 128, mt * 128, nt * 128, smem, epi);
  }
}

DI void phase_G(const Params& p, const Sched& sc, char* smem) {
  const int G = gridDim.x, j = blockIdx.x;
  const int lane = tidx() & 63, w = tidx() >> 6, r = lane & 31;
  const int NIT = 2048 + 256;
  const u16* qb = wsb(p, WS_BIG + B_Q);
  const u16* Kb = wsb(p, WS_BIG + B_K);
  const u16* Vt = wsb(p, WS_BIG + B_VT);
  u16* act = wsb(p, WS_ACT);
  auto run_prompt = [&](int bh, int bi) {
    int b = bh >> 3, hd = bh & 7;
    int tok = b * 16384 + bi * 128 + w * 32 + r;
    flash_item<96, 2, 64, true, false, true, true>(qb + (size_t)tok * 768 + hd * 96, true, 2 * bi + 2, 2 * bi + 1 + (w >> 1),
                                             Kb + ((size_t)hd * NROWS + b * 16384) * 96, 96, Vt + (size_t)hd * 64 * LDVT + b * 16384, LDVT, 0,
                                             act + (size_t)tok * LDA + hd * 64, smem);
  };
  auto run_sample = [&](int u) {
    int b = u >> 3, hd = u & 7;
    int tok = NP + b * 64 + (w & 1) * 32 + r;
    size_t row0 = (size_t)NP + b * 1088;
    flash_item<96, 2, 64, true, false, true, true>(qb + (size_t)tok * 768 + hd * 96, w < 2, 17, 17, Kb + ((size_t)hd * NROWS + row0) * 96, 96,
                                             Vt + (size_t)hd * 64 * LDVT + row0, LDVT, 0, act + (size_t)tok * LDA + hd * 64, smem);
  };
  if (sc.ok) {
    const int xg = sc.xg, xi = sc.xi;
    for (int pass = 0; pass < 2; pass++) {
      const int bh = xg + 8 * pass;
      run_prompt(bh, xi);
      run_prompt(bh, 127 - xi);
    }
    if ((j & 1) == 0) run_sample(j >> 1);
  } else {
    for (int k = 0; k * G < NIT; k++) {
      int it = (k & 1) ? (k * G + (G - 1 - j)) : (k * G + j);
      if (it >= NIT) continue;
      if (it < 2048) run_prompt(it & 15, 127 - (it >> 4)); else run_sample(it - 2048);
    }
  }
}

DI void phase_K(const Params& p, char* smem) {
  const int lane = tidx() & 63, w = tidx() >> 6, r = lane & 31;
  const u16* qx = wsb(p, WS_BIG + B_QX);
  u16* act = wsb(p, WS_ACT);
  for (int t = blockIdx.x; t < 2176; t += gridDim.x) {
    int bidx, hh, tok0;
    if (t < 2048) { bidx = t >> 10; hh = (t >> 8) & 3; tok0 = bidx * 16384 + (t & 255) * 64; }
    else { int u = t - 2048; bidx = 2 + (u >> 2); hh = u & 3; tok0 = NP + (u >> 2) * 64; }
    int tok = tok0 + (w & 1) * 32 + r;
    int e0 = (w >> 1) * 128;
    const u16* Kb = wsb(p, WS_BIG + B_XK) + (size_t)(bidx * 4 + hh) * 65536;
    const u16* Vt = wsb(p, WS_BIG + B_XVT) + (size_t)(bidx * 4 + hh) * 256 * LDXV;
    flash_item<256, 4, 256, false, true, false, true>(qx + (size_t)tok * LDA + hh * 256, true, 4, 4, Kb, 256, Vt, LDXV, e0,
                                         act + (size_t)tok * LDA + hh * 256 + e0, smem);
  }
}

template <class Epi>
DI void phase_gemm128(const Sched& sc, const u16* A, long lda, const u16* Bt, long ldb, int K, int MT, int NT, int SN, char* smem, const Epi& epi) {
  if (sc.ok) {
    const int xg = sc.xg, xi = sc.xi;
    const int SM = 64 / SN;
    const int sng = NT / SN, smg = MT / SM;
    for (int st = xg; st < smg * sng; st += 8) {
      int sm = st / sng, sn = st % sng;
      int mt = sm * SM + xi / SN, nt = sn * SN + xi % SN;
      gemm_tile<2, 2>(A, lda, Bt, ldb, K, mt * 128, nt * 128, smem, epi);
    }
  } else {
    for (int t = blockIdx.x; t < MT * NT; t += gridDim.x) {
      int mt = t / NT, nt = t % NT;
      gemm_tile<2, 2>(A, lda, Bt, ldb, K, mt * 128, nt * 128, smem, epi);
    }
  }
}

#if defined(__HIP_DEVICE_COMPILE__)
typedef const __attribute__((address_space(4))) Params* KargPtr;
#define KARG_LOAD KargPtr pp4 = (KargPtr)__builtin_amdgcn_kernarg_segment_ptr(); asm volatile("" : "+s"(pp4)); const Params p = *pp4;
#else
#define KARG_LOAD const Params p{};
#endif
template <int L>
DI void run_layer(const Sched& sc, int ph_begin, int ph_end, char* smem, cg::grid_group& grid) {
  const int base = 1 + 15 * L;
#define RUN_PHASE(S, ...)  RUN_PHASE_R(S, 1, __VA_ARGS__)
#define RUN_PHASE_R(S, R, ...)                                    \
  {                                                          \
    const int ph = base + (S);                               \
    if (ph >= ph_begin && ph < ph_end) {                     \
      for (int rep_ = 0; rep_ < (R); rep_++) {               \
        KARG_LOAD                                            \
        const u16* W = wsb(p, WS_W) + (size_t)L * W_LAYER;   \
        const float* xs0 = (L == 0) ? p.x_prompt : p.out;    \
        const float* xs1 = (L == 0) ? p.x_sample : p.out + (size_t)NP * 1024; \
        (void)W; (void)xs0; (void)xs1;                       \
        __VA_ARGS__;                                         \
        if (ph + 1 < ph_end) grid.sync();                    \
      }                                                      \
    }                                                        \
  }
  if (L > 0) RUN_PHASE(0, phase_norm(p, L))
  RUN_PHASE_R(1, REP_INPROJ, phase_inproj(p, sc, L, smem))
  RUN_PHASE_R(2, REP_C, { phase_C1(p, L, smem); phase_C2(p, L, smem); })
  RUN_PHASE(3, phase_D(p, L, smem))
  RUN_PHASE_R(4, REP_E, phase_E(p, L, smem))
  RUN_PHASE_R(5, REP_F, phase_F(p, L, smem))
  RUN_PHASE_R(6, REP_G, phase_G(p, sc, smem))
  RUN_PHASE(7, { EpiRes epi{xs0, xs1, p.out}; phase_gemm128(sc, wsb(p, WS_ACT), LDA, W + W_OUT, LDW, 1024, 272, 8, 8, smem, epi); })
  RUN_PHASE_R(8, REP_NORM, phase_norm(p, 1))
  RUN_PHASE(9, { EpiStoreBf16 epi{wsb(p, WS_BIG + B_QX), LDA, 1024, nullptr}; phase_gemm128(sc, wsb(p, WS_ACT), LDA, W + W_XQ, LDW, 1024, 272, 8, 8, smem, epi); })
  RUN_PHASE_R(10, REP_K, phase_K(p, smem))
  RUN_PHASE(11, { EpiRes epi{p.out, p.out + (size_t)NP * 1024, p.out}; phase_gemm128(sc, wsb(p, WS_ACT), LDA, W + W_XO, LDW, 1024, 272, 8, 8, smem, epi); })
  RUN_PHASE(12, phase_norm(p, 1))
  RUN_PHASE_R(13, REP_FF1, { EpiRelu2 epi{wsb(p, WS_BIG + B_H1), LDH1}; phase_gemm128(sc, wsb(p, WS_ACT), LDA, W + W_FF1, LDW, 1024, 272, 32, 8, smem, epi); })
  RUN_PHASE(14, { EpiRes epi{p.out, p.out + (size_t)NP * 1024, p.out}; phase_gemm128(sc, wsb(p, WS_BIG + B_H1), LDH1, W + W_FF2, LDW2, 4096, 272, 8, 8, smem, epi); })
#undef RUN_PHASE
#undef RUN_PHASE_R
}

__global__ void __launch_bounds__(256, 2) fwd_megakernel(Params p, int ph_begin, int ph_end) {
  __shared__ __attribute__((aligned(16))) char smem[SMEM_BYTES];
  cg::grid_group grid = cg::this_grid();
  __shared__ int s_rank;
  Sched sc;
  sc.xg = (int)((unsigned)__builtin_amdgcn_s_getreg((3 << 11) | 20) & 7u);
  unsigned* cnt = (unsigned*)(p.ws + WS_CNT);
  if (tidx() == 0) s_rank = (int)atomicAdd(&cnt[sc.xg], 1u);
  __syncthreads();
  sc.xi = __builtin_amdgcn_readfirstlane(s_rank);
  sc.ok = 0;
  if (ph_begin <= 0 && 0 < ph_end) {
    phase_prep(p, smem);
    if (1 < ph_end) grid.sync();
  }
  {
    int ok = (gridDim.x == 512);
#pragma unroll
    for (int i = 0; i < 8; i++) ok &= (__atomic_load_n(&cnt[i], __ATOMIC_RELAXED) == 64u);
    sc.ok = ok;
  }
  run_layer<0>(sc, ph_begin, ph_end, smem, grid);
  run_layer<1>(sc, ph_begin, ph_end, smem, grid);
}

extern "C" void kernel_launch(void* const* d_in, const int* in_sizes, int n_in, void* d_out, int out_size, void* d_ws, size_t ws_size,
                              hipStream_t stream) {
  static int grid_blocks = 0;
  if (!grid_blocks) {
    int dev = 0, cus = 0, per_cu = 0;
    (void)hipGetDevice(&dev);
    (void)hipDeviceGetAttribute(&cus, hipDeviceAttributeMultiprocessorCount, dev);
    (void)hipOccupancyMaxActiveBlocksPerMultiprocessor(&per_cu, fwd_megakernel, 256, 0);
    per_cu = 2;
    grid_blocks = cus * per_cu;
  }
  Params p{};
  const float** pp = (const float**)&p;
  for (int i = 0; i < 36; i++) pp[i] = (const float*)d_in[i];
  p.out = (float*)d_out;
  p.ws = (char*)d_ws;
  int ph_begin = 0, ph_end = 31;
  (void)hipMemsetAsync((char*)d_ws + WS_CNT, 0, 256, stream);
  void* args[] = {&p, &ph_begin, &ph_end};
  hipError_t e = hipLaunchCooperativeKernel((void*)fwd_megakernel, dim3(grid_blocks), dim3(256), args, 0, stream);
  if (e != hipSuccess) fprintf(stderr, "cooperative launch failed: %s (grid %d)\n", hipGetErrorString(e), grid_blocks);
}
```

```cpp
#include <hip/hip_runtime.h>
#include <hip/hip_cooperative_groups.h>
#include <stdint.h>
#include <stdio.h>
namespace cg = cooperative_groups;

typedef unsigned short u16;
typedef short bf16x8 __attribute__((ext_vector_type(8)));
typedef short s16x4 __attribute__((ext_vector_type(4)));
typedef float f32x16 __attribute__((ext_vector_type(16)));
typedef __bf16 bfv2 __attribute__((ext_vector_type(2)));
typedef float fv2 __attribute__((ext_vector_type(2)));
typedef unsigned u32x4 __attribute__((ext_vector_type(4)));
#define DI __device__ __forceinline__
#define MFMA(a, b, c) __builtin_amdgcn_mfma_f32_32x32x16_bf16((a), (b), (c), 0, 0, 0)

constexpr int NP = 32768;
constexpr int NS = 2048;
constexpr int NTOK = NP + NS;
constexpr int NROWS = NP + 32 * 1088;
constexpr int INC = 2472;
constexpr float EPS = 1e-6f;
constexpr float LOG2E = 1.4426950408889634f;
constexpr int NITEM = 2048 + 128;
constexpr int LDA = 1088;
constexpr int LDW = 1088;
constexpr int LDW2 = 4160;
constexpr int LDWQ = 320;
constexpr int LDWKV = 192;
constexpr int LDH1 = 4160;
constexpr int LDVT = NROWS + 64;
constexpr int LDXV = 320;

constexpr size_t O_Y = 0;
constexpr size_t O_PCKV = 35651584;
constexpr size_t O_PKROPE = O_PCKV + 8388608;
constexpr size_t O_PC = O_PKROPE + 2097152;
constexpr size_t O_PN = O_PC + 262144;
constexpr size_t O_PM = O_PN + 2048;
constexpr size_t O_PCONV = O_PM + 16;
constexpr size_t O_PMEMK = O_PCONV + 12288;
constexpr size_t O_PMEMV = O_PMEMK + 1048576;
constexpr size_t O_SCKV = O_PMEMV + 1048576;
constexpr size_t O_SKROPE = O_SCKV + 524288;
constexpr size_t O_SC = O_SKROPE + 131072;
constexpr size_t O_SN = O_SC + 4194304;
constexpr size_t O_SM = O_SN + 32768;
constexpr size_t O_SCONV = O_SM + 256;

constexpr size_t W_IN = 0;
constexpr size_t W_Q = W_IN + 2560 * LDW;
constexpr size_t W_KV = W_Q + 768 * LDWQ;
constexpr size_t W_OUT = W_KV + 1024 * LDWKV;
constexpr size_t W_XQ = W_OUT + 1024 * LDW;
constexpr size_t W_XK = W_XQ + 1024 * LDW;
constexpr size_t W_XV = W_XK + 1024 * LDW;
constexpr size_t W_XO = W_XV + 1024 * LDW;
constexpr size_t W_FF1 = W_XO + 1024 * LDW;
constexpr size_t W_FF2 = W_FF1 + 4096 * LDW;
constexpr size_t W_LAYER = W_FF2 + 1024 * LDW2;

constexpr size_t WS_W = 0;
constexpr size_t WS_ACT = WS_W + 2 * W_LAYER * 2;
constexpr size_t WS_CKV = WS_ACT + (size_t)NTOK * LDA * 2;
constexpr size_t WS_KROPE = WS_CKV + (size_t)NROWS * 128 * 2;
constexpr size_t WS_RQ = WS_KROPE + (size_t)NROWS * 32 * 4;
constexpr size_t WS_GATES = WS_RQ + (size_t)NTOK * 4;
constexpr size_t WS_ROPE = WS_GATES + (size_t)NTOK * 8 * 4;
constexpr size_t WS_SCAL = WS_ROPE + (size_t)16384 * 16 * 8;
constexpr size_t WS_MST = WS_SCAL + (size_t)NITEM * 2 * 4;
constexpr size_t WS_NU = WS_MST + (size_t)NITEM * 4 + 256;
constexpr size_t WS_CNT = WS_NU + (size_t)NITEM * 128 * 4;
constexpr size_t WS_BAR = WS_CNT + 256;
constexpr size_t WS_HM = WS_BAR + 16384;
constexpr size_t WS_BIG = WS_HM + (size_t)512 * LDA * 2;
constexpr size_t B_P = 0;
constexpr size_t B_K = 0;
constexpr size_t B_VT = B_K + (size_t)8 * NROWS * 96 * 2;
constexpr size_t B_Q = B_VT + (size_t)8 * 64 * LDVT * 2;
constexpr size_t B_ST = B_Q + (size_t)NTOK * 768 * 2;
constexpr size_t B_XK = B_ST + (size_t)NITEM * 16384 * 2;
constexpr size_t B_XVT = B_XK + (size_t)34 * 4 * 256 * 256 * 2;
constexpr size_t B_END = B_XVT + (size_t)34 * 4 * 256 * LDXV * 2;
constexpr size_t B_QX = 0;
constexpr size_t B_H1 = 0;
static_assert((size_t)NTOK * INC * 2 <= B_Q, "p overlaps q");
static_assert((size_t)NTOK * LDH1 * 2 <= B_XK, "h1 overlaps xkv");
static_assert((size_t)NTOK * LDA * 2 <= B_Q, "qx overlaps q");
static_assert(WS_BIG + B_END <= (size_t)536870912, "workspace too large");
static_assert(WS_BIG % 256 == 0 && B_Q % 256 == 0 && B_ST % 256 == 0 && B_VT % 256 == 0, "align");

constexpr int SMEM_BYTES = 73728;
#ifndef REP_INPROJ
#define REP_INPROJ 1
#endif
#ifndef REP_C
#define REP_C 1
#endif
#ifndef REP_E
#define REP_E 1
#endif
#ifndef REP_F
#define REP_F 1
#endif
#ifndef REP_G
#define REP_G 1
#endif
#ifndef REP_K
#define REP_K 1
#endif
#ifndef REP_FF1
#define REP_FF1 1
#endif
#ifndef REP_NORM
#define REP_NORM 1
#endif

struct Params {
  const float* x_prompt; const float* x_sample; const float* cache_ckv; const float* cache_krope;
  const float* st_C; const float* st_n; const float* st_m; const float* st_conv;
  const float* cache_mem_k; const float* cache_mem_v; const float* mem_prompt;
  const float* g_mix; const float* w_in; const float* g_qa; const float* w_q_up; const float* g_qnorm; const float* g_kva;
  const float* w_kv_up; const float* g_knorm; const float* w_conv; const float* b_conv; const float* b_igate; const float* b_fgate;
  const float* g_mhead; const float* w_out; const float* g_xattn; const float* g_mem; const float* w_xq; const float* w_xk; const float* w_xv;
  const float* g_xq; const float* g_xk; const float* w_xo; const float* g_mlp; const float* w_ff1; const float* w_ff2;
  float* out; char* ws;
};

#define XB_TMO      128
#define XB_XCNT(j)  (256  + 64 * (j))
#define XB_XSUB(j)  (1280 + 64 * (j))
#define XB_XGEN(j)  (2304 + 64 * (j))
#define XB_TOP      3328
#define XB_TOPGEN   3392
#define XCD_BAR_WORDS 3456
#define XB_SPIN_CAP (1u << 18)
#define LAS __attribute__((address_space(3)))

__device__ __forceinline__ unsigned xb_ld(unsigned* p)              { return __hip_atomic_load(p, __ATOMIC_RELAXED, __HIP_MEMORY_SCOPE_AGENT); }
__device__ __forceinline__ unsigned xb_add(unsigned* p, unsigned v) { return __hip_atomic_fetch_add(p, v, __ATOMIC_RELAXED, __HIP_MEMORY_SCOPE_AGENT); }
__device__ __forceinline__ unsigned xb_xcc_id() { return (unsigned)__builtin_amdgcn_s_getreg((3 << 11) | 20) & 0xFu; }
#define XB_SPIN(cond, bar) do { unsigned _sp = 0; while (cond) { __builtin_amdgcn_s_sleep(1); \
    if ((++_sp & 255u) == 0u) { if (xb_ld(&(bar)[XB_TMO])) break; if (_sp > XB_SPIN_CAP) { atomicAdd(&(bar)[XB_TMO], 1u); break; } } } } while (0)

struct XcdBarrier {
    unsigned* bar; unsigned x;
    volatile LAS unsigned* st;
};

__device__ __forceinline__ XcdBarrier xcd_barrier_post(unsigned* bar, volatile LAS unsigned* st) {
    XcdBarrier b; b.bar = bar; b.x = xb_xcc_id(); b.st = st;
    if (threadIdx.x == 0) (void)xb_add(&bar[XB_XCNT(b.x)], 1u);
    return b;
}
__device__ __forceinline__ void xcd_barrier_complete(unsigned* bar, unsigned x, unsigned& nloc, unsigned& nx) {
    const unsigned G = gridDim.x * gridDim.y * gridDim.z;
    unsigned sum, cnt, mine, sp = 0u;
    for (;;) {
        sum = 0u; cnt = 0u; mine = 0u;
#pragma unroll
        for (unsigned j = 0; j < 16; ++j) { const unsigned c = xb_ld(&bar[XB_XCNT(j)]); sum += c; cnt += (c > 0u) ? 1u : 0u; mine = (j == x) ? c : mine; }
        if (sum == G) break;
        __builtin_amdgcn_s_sleep(1);
        if ((++sp & 255u) == 0u) { if (xb_ld(&bar[XB_TMO])) break; if (sp > XB_SPIN_CAP) { atomicAdd(&bar[XB_TMO], 1u); break; } }
    }
    nloc = mine > 0u ? mine : 1u; nx = cnt > 0u ? cnt : 1u;
}

__device__ __forceinline__ void xcd_barrier(const XcdBarrier& b) {
    asm volatile("s_waitcnt vmcnt(0)" ::: "memory");
    __syncthreads();
    if (threadIdx.x == 0) {
        unsigned* bar = b.bar;
        __builtin_amdgcn_s_waitcnt(0);
        unsigned nloc = b.st[0], nx = b.st[1];
        if (nloc == 0u) { xcd_barrier_complete(bar, b.x, nloc, nx); b.st[0] = nloc; b.st[1] = nx; }
        const unsigned old = xb_add(&bar[XB_XSUB(b.x)], 1u);
        const unsigned gen = old / nloc;
        if (old + 1u == (gen + 1u) * nloc) {
            __builtin_amdgcn_fence(__ATOMIC_RELEASE, "agent");
            asm volatile("s_waitcnt vmcnt(0)" ::: "memory");
            const unsigned og = xb_add(&bar[XB_TOP], 1u);
            const unsigned tg = og / nx;
            if (og + 1u == (tg + 1u) * nx) xb_add(&bar[XB_TOPGEN], 1u);
            else XB_SPIN(xb_ld(&bar[XB_TOPGEN]) == tg, bar);
            __builtin_amdgcn_fence(__ATOMIC_ACQUIRE, "agent");
            xb_add(&bar[XB_XGEN(b.x)], 1u);
            asm volatile("s_waitcnt vmcnt(0)" ::: "memory");
        } else {
            XB_SPIN(xb_ld(&bar[XB_XGEN(b.x)]) == gen, bar);
            __builtin_amdgcn_fence(__ATOMIC_ACQUIRE, "agent");
            asm volatile("s_waitcnt vmcnt(0)" ::: "memory");
        }
    }
    __syncthreads();
}


struct Sched { int xg, xi, ok; };
DI int tidx() { int t = (int)threadIdx.x; asm volatile("" : "+v"(t)); return t; }
DI unsigned pk2(float a, float b) { fv2 v = {a, b}; bfv2 r = __builtin_convertvector(v, bfv2); return __builtin_bit_cast(unsigned, r); }
DI u16 f2bf(float a) { return (u16)(pk2(a, 0.f) & 0xffffu); }
DI float bf2f(u16 v) { return __uint_as_float(((unsigned)v) << 16); }
DI float bflo(unsigned v) { return __uint_as_float(v << 16); }
DI float bfhi(unsigned v) { return __uint_as_float(v & 0xffff0000u); }
DI int crow(int i, int h) { return (i & 3) + 8 * (i >> 2) + 4 * h; }
DI float xhalf_max(float v) {
  unsigned u = __float_as_uint(v);
  auto rr = __builtin_amdgcn_permlane32_swap(u, u, false, false);
  return fmaxf(__uint_as_float(rr[0]), __uint_as_float(rr[1]));
}
DI float xhalf_sum(float v) {
  unsigned u = __float_as_uint(v);
  auto rr = __builtin_amdgcn_permlane32_swap(u, u, false, false);
  return __uint_as_float(rr[0]) + __uint_as_float(rr[1]);
}
DI float wave_sum(float v) {
#pragma unroll
  for (int o = 32; o >= 1; o >>= 1) v += __shfl_xor(v, o);
  return v;
}
DI float wave_max(float v) {
#pragma unroll
  for (int o = 32; o >= 1; o >>= 1) v = fmaxf(v, __shfl_xor(v, o));
  return v;
}
DI void unpack8(uint4 v, float (&x)[8]) {
  x[0] = bflo(v.x); x[1] = bfhi(v.x); x[2] = bflo(v.y); x[3] = bfhi(v.y);
  x[4] = bflo(v.z); x[5] = bfhi(v.z); x[6] = bflo(v.w); x[7] = bfhi(v.w);
}
DI uint4 pack8(const float (&x)[8]) {
  uint4 v; v.x = pk2(x[0], x[1]); v.y = pk2(x[2], x[3]); v.z = pk2(x[4], x[5]); v.w = pk2(x[6], x[7]); return v;
}
DI u16* wsb(const Params& p, size_t off) { return (u16*)(p.ws + off); }
DI float* wsf(const Params& p, size_t off) { return (float*)(p.ws + off); }
DI const float* xrow(const Params& p, int l, int tok) {
  if (l == 0) return tok < NP ? p.x_prompt + (size_t)tok * 1024 : p.x_sample + (size_t)(tok - NP) * 1024;
  return p.out + (size_t)tok * 1024;
}
DI int tok_pos(int tok) { return tok < NP ? (tok & 16383) : 1024 + ((tok - NP) & 63); }

template <int TM, int TN>
DI void gemm_mainloop(const u16* __restrict__ A, long lda, const u16* __restrict__ Bt, long ldb, int K, char* smem,
                      f32x16 (&acc)[TM][TN]) {
  constexpr int BM = 64 * TM, BN = 64 * TN, LD = 72;
  u16* sA = (u16*)smem;
  u16* sB = sA + 2 * BM * LD;
  const int tid = tidx(), lane = tid & 63, w = tid >> 6, r = lane & 31, h = lane >> 5;
  const int wm = w >> 1, wn = w & 1;
  constexpr int NA = BM / 32, NB = BN / 32;
  u32x4 ra[NA], rb[NB];
#pragma unroll
  for (int tm = 0; tm < TM; tm++)
#pragma unroll
    for (int tn = 0; tn < TN; tn++)
#pragma unroll
      for (int i = 0; i < 16; i++) acc[tm][tn][i] = 0.f;
  const int nk = K / 64;
  const int lrow = tid >> 3, lch = (tid & 7) * 8;
  const u16* gA = A + (long)lrow * lda + lch;
  const u16* gB = Bt + (long)lrow * ldb + lch;
  const int soff = lrow * LD + lch;
#define GEMM_GLOAD(k0)                                                                   \
  {                                                                                      \
    _Pragma("unroll") for (int i = 0; i < NA; i++) ra[i] = *(const u32x4*)(gA + (long)(32 * i) * lda + (k0)); \
    _Pragma("unroll") for (int i = 0; i < NB; i++) rb[i] = *(const u32x4*)(gB + (long)(32 * i) * ldb + (k0)); \
  }
#define GEMM_SSTORE(buf)                                                                 \
  {                                                                                      \
    _Pragma("unroll") for (int i = 0; i < NA; i++) *(u32x4*)(sA + (buf) * BM * LD + soff + 32 * i * LD) = ra[i]; \
    _Pragma("unroll") for (int i = 0; i < NB; i++) *(u32x4*)(sB + (buf) * BN * LD + soff + 32 * i * LD) = rb[i]; \
  }
  GEMM_GLOAD(0)
  __syncthreads();
  GEMM_SSTORE(0)
  if (nk > 1) GEMM_GLOAD(64)
  __syncthreads();
  for (int kt = 0; kt < nk; kt++) {
    const int buf = kt & 1;
    const u16* cA = sA + buf * BM * LD + (wm * 32 * TM + r) * LD + h * 8;
    const u16* cB = sB + buf * BN * LD + (wn * 32 * TN + r) * LD + h * 8;
    bf16x8 af[TM], bfr[TN];
#pragma unroll
    for (int tm = 0; tm < TM; tm++) af[tm] = *(const bf16x8*)(cA + tm * 32 * LD);
#pragma unroll
    for (int tn = 0; tn < TN; tn++) bfr[tn] = *(const bf16x8*)(cB + tn * 32 * LD);
    if (kt + 1 < nk) GEMM_SSTORE(buf ^ 1)
    __builtin_amdgcn_sched_barrier(0);
    __builtin_amdgcn_s_setprio(1);
#pragma unroll
    for (int tm = 0; tm < TM; tm++)
#pragma unroll
      for (int tn = 0; tn < TN; tn++) acc[tm][tn] = MFMA(af[tm], bfr[tn], acc[tm][tn]);
#pragma unroll
    for (int tm = 0; tm < TM; tm++) af[tm] = *(const bf16x8*)(cA + tm * 32 * LD + 16);
#pragma unroll
    for (int tn = 0; tn < TN; tn++) bfr[tn] = *(const bf16x8*)(cB + tn * 32 * LD + 16);
#pragma unroll
    for (int tm = 0; tm < TM; tm++)
#pragma unroll
      for (int tn = 0; tn < TN; tn++) acc[tm][tn] = MFMA(af[tm], bfr[tn], acc[tm][tn]);
    __builtin_amdgcn_sched_barrier(0);
    if (kt + 2 < nk) GEMM_GLOAD((kt + 2) * 64)
    __builtin_amdgcn_sched_barrier(0);
#pragma unroll
    for (int ks = 2; ks < 4; ks++) {
#pragma unroll
      for (int tm = 0; tm < TM; tm++) af[tm] = *(const bf16x8*)(cA + tm * 32 * LD + ks * 16);
#pragma unroll
      for (int tn = 0; tn < TN; tn++) bfr[tn] = *(const bf16x8*)(cB + tn * 32 * LD + ks * 16);
#pragma unroll
      for (int tm = 0; tm < TM; tm++)
#pragma unroll
        for (int tn = 0; tn < TN; tn++) acc[tm][tn] = MFMA(af[tm], bfr[tn], acc[tm][tn]);
    }
    __builtin_amdgcn_s_setprio(0);
    __syncthreads();
  }
#undef GEMM_GLOAD
#undef GEMM_SSTORE
}

template <int TM, int TN, class Epi>
DI void gemm_tile(const u16* A, long lda, const u16* Bt, long ldb, int K, int m0, int n0, char* smem, const Epi& epi) {
  constexpr int BM = 64 * TM, BN = 64 * TN, LDC = BN + Epi::PAD;
  f32x16 acc[TM][TN];
  gemm_mainloop<TM, TN>(A + (long)m0 * lda, lda, Bt + (long)n0 * ldb, ldb, K, smem, acc);
  const int tid = tidx(), lane = tid & 63, w = tid >> 6, r = lane & 31, h = lane >> 5;
  const int wm = w >> 1, wn = w & 1;
  float* Ct = (float*)smem;
#pragma unroll
  for (int tm = 0; tm < TM; tm++)
#pragma unroll
    for (int tn = 0; tn < TN; tn++)
#pragma unroll
      for (int i = 0; i < 16; i++)
        Ct[(wm * 32 * TM + tm * 32 + crow(i, h)) * LDC + wn * 32 * TN + tn * 32 + r] = acc[tm][tn][i];
  __syncthreads();
  epi(Ct, LDC, m0, n0, tid);
  __syncthreads();
  (void)BM;
}

struct EpiStoreBf16 {
  static constexpr int PAD = 4;
  u16* out; long ldo; int nmax; float* gates;
  DI void operator()(const float* Ct, int ldc, int m0, int n0, int tid) const {
#pragma unroll
    for (int it = 0; it < 8; it++) {
      int id = tid + 256 * it; int row = id >> 4, c8 = (id & 15) * 8;
      int n = n0 + c8;
      if (n < nmax) {
        const float* c = Ct + row * ldc + c8;
        float4 a = *(const float4*)c, b = *(const float4*)(c + 4);
        uint4 v; v.x = pk2(a.x, a.y); v.y = pk2(a.z, a.w); v.z = pk2(b.x, b.y); v.w = pk2(b.z, b.w);
        *(uint4*)(out + (long)(m0 + row) * ldo + n) = v;
        if (gates != nullptr && n == 1952) {
          float* g = gates + (long)(m0 + row) * 8;
          *(float4*)g = a; *(float4*)(g + 4) = b;
        }
      }
    }
  }
};
struct EpiRelu2 {
  static constexpr int PAD = 4;
  u16* out; long ldo;
  DI void operator()(const float* Ct, int ldc, int m0, int n0, int tid) const {
#pragma unroll
    for (int it = 0; it < 8; it++) {
      int id = tid + 256 * it; int row = id >> 4, c8 = (id & 15) * 8;
      const float* c = Ct + row * ldc + c8;
      float x[8];
#pragma unroll
      for (int j = 0; j < 8; j++) { float v = fmaxf(c[j], 0.f); x[j] = v * v; }
      *(uint4*)(out + (long)(m0 + row) * ldo + n0 + c8) = pack8(x);
    }
  }
};
struct EpiF32 {
  static constexpr int PAD = 4;
  float* out; long ldo;
  DI void operator()(const float* Ct, int ldc, int m0, int n0, int tid) const {
#pragma unroll
    for (int it = 0; it < 8; it++) {
      int id = tid + 256 * it; int row = id >> 4, c8 = (id & 15) * 8;
      const float* c = Ct + row * ldc + c8;
      float* o = out + (long)(m0 + row) * ldo + n0 + c8;
      *(float4*)o = *(const float4*)c; *(float4*)(o + 4) = *(const float4*)(c + 4);
    }
  }
};
struct EpiRes {
  static constexpr int PAD = 4;
  const float* src0; const float* src1; float* dst;
  DI void operator()(const float* Ct, int ldc, int m0, int n0, int tid) const {
#pragma unroll
    for (int it = 0; it < 8; it++) {
      int id = tid + 256 * it; int row = id >> 4, c8 = (id & 15) * 8;
      int m = m0 + row;
      const float* s = (m < NP ? src0 + (size_t)m * 1024 : src1 + (size_t)(m - NP) * 1024) + n0 + c8;
      const float* c = Ct + row * ldc + c8;
      float4 a = *(const float4*)c, b = *(const float4*)(c + 4);
      float4 sa = *(const float4*)s, sb = *(const float4*)(s + 4);
      a.x += sa.x; a.y += sa.y; a.z += sa.z; a.w += sa.w; b.x += sb.x; b.y += sb.y; b.z += sb.z; b.w += sb.w;
      float* o = dst + (size_t)m * 1024 + n0 + c8;
      *(float4*)o = a; *(float4*)(o + 4) = b;
    }
  }
};
struct EpiQ {
  static constexpr int PAD = 1;
  u16* q; const float* rq; const float2* rope; const float* g;
  DI void operator()(const float* Ct, int ldc, int m0, int n0, int tid) const {
    float* r2s = (float*)((char*)Ct + 60000);
    {
      const int row = tid >> 2, hh = (tid >> 1) & 1, half = tid & 1; const int m = m0 + row;
      const float* c = Ct + row * ldc + hh * 96 + half * 48;
      float ss = 0.f;
#pragma unroll 8
      for (int d = 0; d < 48; d++) ss += c[d] * c[d];
      ss += __shfl_xor(ss, 1);
      const float rqv = rq[m];
      ss *= rqv * rqv;
      if (half == 0) r2s[row * 2 + hh] = rsqrtf(ss * (1.f / 96.f) + EPS) * rqv * (0.10206207261596575f * LOG2E);
    }
    __syncthreads();
#pragma unroll
    for (int it = 0; it < 6; it++) {
      const int id = tid + 256 * it; const int row = id / 24, cc = id % 24; const int hh = cc / 12, c8 = cc % 12;
      const int m = m0 + row;
      const float* c = Ct + row * ldc + hh * 96;
      const float r2 = r2s[row * 2 + hh];
      float x[8];
      if (c8 < 8) {
#pragma unroll
        for (int jj = 0; jj < 8; jj++) x[jj] = c[c8 * 8 + jj] * r2 * g[c8 * 8 + jj];
      } else {
        const int half = c8 & 1;
        const bool second = c8 >= 10;
        const float2* tab = rope + (size_t)tok_pos(m) * 16 + half * 8;
#pragma unroll
        for (int jj = 0; jj < 8; jj++) {
          const int i = half * 8 + jj;
          const float a = c[64 + i], b = c[80 + i]; const float2 cs = tab[jj];
          const float v = second ? (a * cs.y + b * cs.x) : (a * cs.x - b * cs.y);
          x[jj] = v * r2 * g[(second ? 80 : 64) + i];
        }
      }
      *(uint4*)(q + (size_t)m * 768 + n0 + cc * 8) = pack8(x);
    }
  }
};
struct EpiKV {
  static constexpr int PAD = 1;
  u16* Kb; u16* Vt; const float* krope; const float* g;
  DI void operator()(const float* Ct, int ldc, int m0, int n0, int tid) const {
    const int hd = n0 >> 7;
#pragma unroll
    for (int it = 0; it < 4; it++) {
      int id = tid + 256 * it; int oct = id & 15, e = id >> 4;
      float x[8];
#pragma unroll
      for (int j = 0; j < 8; j++) x[j] = Ct[(16 * (oct >> 1) + 4 * (oct & 1) + (j & 3) + 8 * (j >> 2)) * ldc + 64 + e];
      *(uint4*)(Vt + (size_t)(hd * 64 + e) * LDVT + m0 + oct * 8) = pack8(x);
    }
    float* rrs = (float*)((char*)Ct + 66560);
    {
      const int row = tid >> 1, half = tid & 1;
      const float* c = Ct + row * ldc + half * 32;
      const float* kr = krope + (size_t)(m0 + row) * 32 + half * 16;
      float ss = 0.f;
#pragma unroll 8
      for (int d = 0; d < 32; d++) ss += c[d] * c[d];
#pragma unroll 8
      for (int d = 0; d < 16; d++) ss += kr[d] * kr[d];
      ss += __shfl_xor(ss, 1);
      if (half == 0) rrs[row] = rsqrtf(ss * (1.f / 96.f) + EPS);
    }
    __syncthreads();
    u16* ob = Kb + ((size_t)hd * NROWS + m0) * 96;
#pragma unroll
    for (int it = 0; it < 6; it++) {
      const int id = tid + 256 * it; const int row = id / 12, cc = id % 12;
      const float rr = rrs[row];
      float x[8];
      if (cc < 8) {
        const float* c = Ct + row * ldc + cc * 8;
#pragma unroll
        for (int jj = 0; jj < 8; jj++) x[jj] = c[jj] * rr * g[cc * 8 + jj];
      } else {
        const float* kr = krope + (size_t)(m0 + row) * 32 + (cc - 8) * 8;
#pragma unroll
        for (int jj = 0; jj < 8; jj++) x[jj] = kr[jj] * rr * g[cc * 8 + jj];
      }
      *(uint4*)(ob + (size_t)id * 8) = pack8(x);
    }
  }
};

template <int DQK, int NE, int EV, bool DB, bool QNORM, bool QREG, bool VPERM = false>
DI void flash_item(const u16* Qrow, bool wave_active, int ntb, int ntw, const u16* Kbase, long ldk, const u16* Vtbase, long ldv,
                   int e0, u16* Orow, char* smem) {
  constexpr int LDK = DQK + 8, LDV = 72;
  constexpr int KS = DQK / 16;
  constexpr int KTILE = 64 * LDK, VTILE = EV * LDV;
  constexpr int NKC = 64 * (DQK / 8) / 256;
  constexpr int NVC = EV * 8 / 256;
  u16* sK = (u16*)smem;
  u16* sV = sK + (DB ? 2 : 1) * KTILE;
  const int tid = tidx(), lane = tid & 63, r = lane & 31, h = lane >> 5;
  bf16x8 qf[QREG ? KS : 1];
  float rqs = 1.f;
  if (wave_active) {
    if (QREG) {
#pragma unroll
      for (int ks = 0; ks < KS; ks++) qf[QREG ? ks : 0] = *(const bf16x8*)(Qrow + ks * 16 + h * 8);
    }
    if (QNORM) {
      float ss = 0.f;
#pragma unroll
      for (int ks = 0; ks < KS; ks++) {
        bf16x8 qq = QREG ? qf[QREG ? ks : 0] : *(const bf16x8*)(Qrow + ks * 16 + h * 8);
#pragma unroll
        for (int j = 0; j < 8; j++) { float v = bf2f((u16)qq[j]); ss += v * v; }
      }
      ss = xhalf_sum(ss);
      rqs = rsqrtf(ss * (1.f / DQK) + EPS);
    }
  } else if (QREG) {
#pragma unroll
    for (int ks = 0; ks < KS; ks++)
#pragma unroll
      for (int j = 0; j < 8; j++) qf[QREG ? ks : 0][j] = 0;
  }
  f32x16 o[NE];
#pragma unroll
  for (int et = 0; et < NE; et++)
#pragma unroll
    for (int i = 0; i < 16; i++) o[et][i] = 0.f;
  float mrun = 0.f, lrun = 0.f;
  const float rqinv = __builtin_amdgcn_rcpf(rqs);

  u32x4 rk[DB ? NKC : 1], rv[DB ? NVC : 1];
  auto gload = [&](int t) {
#pragma unroll
    for (int i = 0; i < NKC; i++) {
      int id = tid + 256 * i; int row = id / (DQK / 8), ch = id % (DQK / 8);
      u32x4 v = *(const u32x4*)(Kbase + (long)(t * 64 + row) * ldk + ch * 8);
      if (DB) rk[DB ? i : 0] = v; else *(u32x4*)(sK + row * LDK + ch * 8) = v;
    }
#pragma unroll
    for (int i = 0; i < NVC; i++) {
      int id = tid + 256 * i; int row = id >> 3, ch = id & 7;
      u32x4 v = *(const u32x4*)(Vtbase + (long)row * ldv + t * 64 + ch * 8);
      if (DB) rv[DB ? i : 0] = v; else *(u32x4*)(sV + row * LDV + ch * 8) = v;
    }
  };
  auto sstore = [&](int buf) {
#pragma unroll
    for (int i = 0; i < NKC; i++) { int id = tid + 256 * i; int row = id / (DQK / 8), ch = id % (DQK / 8); *(u32x4*)(sK + buf * KTILE + row * LDK + ch * 8) = rk[DB ? i : 0]; }
#pragma unroll
    for (int i = 0; i < NVC; i++) { int id = tid + 256 * i; int row = id >> 3, ch = id & 7; *(u32x4*)(sV + buf * VTILE + row * LDV + ch * 8) = rv[DB ? i : 0]; }
  };
  auto compute = [&](int buf) {
    const u16* cK = sK + buf * KTILE + r * LDK + h * 8;
    const u16* cV = sV + buf * VTILE + (e0 + r) * LDV + 4 * h;
    const float sinit = QNORM ? -mrun * rqinv : -mrun;
    f32x16 s[2];
#pragma unroll
    for (int sub = 0; sub < 2; sub++) {
#pragma unroll
      for (int i = 0; i < 16; i++) s[sub][i] = sinit;
#pragma unroll
      for (int ks = 0; ks < KS; ks++) {
        bf16x8 a = *(const bf16x8*)(cK + sub * 32 * LDK + ks * 16);
        bf16x8 qq = QREG ? qf[QREG ? ks : 0] : *(const bf16x8*)(Qrow + ks * 16 + h * 8);
        s[sub] = MFMA(a, qq, s[sub]);
      }
    }
    float mx = -1e30f;
#pragma unroll
    for (int sub = 0; sub < 2; sub++)
#pragma unroll
      for (int i = 0; i < 16; i++) { if (QNORM) s[sub][i] *= rqs; mx = fmaxf(mx, s[sub][i]); }
    mx = xhalf_max(mx);
    if (__any(mx > 8.f)) {
      const float d = fmaxf(mx, 0.f);
      const float alpha = __builtin_amdgcn_exp2f(-d);
      mrun += d;
      lrun *= alpha;
#pragma unroll
      for (int et = 0; et < NE; et++)
#pragma unroll
        for (int i = 0; i < 16; i++) o[et][i] *= alpha;
#pragma unroll
      for (int sub = 0; sub < 2; sub++)
#pragma unroll
        for (int i = 0; i < 16; i++) s[sub][i] -= d;
    }
    float psum = 0.f;
#pragma unroll
    for (int sub = 0; sub < 2; sub++)
#pragma unroll
      for (int i = 0; i < 16; i++) { float pv = __builtin_amdgcn_exp2f(s[sub][i]); s[sub][i] = pv; psum += pv; }
    lrun += psum;
#pragma unroll
    for (int sub = 0; sub < 2; sub++)
#pragma unroll
      for (int st = 0; st < 2; st++) {
        uint4 pp;
        pp.x = pk2(s[sub][8 * st + 0], s[sub][8 * st + 1]); pp.y = pk2(s[sub][8 * st + 2], s[sub][8 * st + 3]);
        pp.z = pk2(s[sub][8 * st + 4], s[sub][8 * st + 5]); pp.w = pk2(s[sub][8 * st + 6], s[sub][8 * st + 7]);
        bf16x8 pb = __builtin_bit_cast(bf16x8, pp);
#pragma unroll
        for (int et = 0; et < NE; et++) {
          bf16x8 a;
          if (VPERM) {
            a = *(const bf16x8*)(sV + buf * VTILE + (e0 + et * 32 + r) * LDV + sub * 32 + st * 16 + 8 * h);
          } else {
            const u16* vp = cV + et * 32 * LDV + sub * 32 + st * 16;
            s16x4 lo = *(const s16x4*)vp;
            s16x4 hi = *(const s16x4*)(vp + 8);
            a = __builtin_shufflevector(lo, hi, 0, 1, 2, 3, 4, 5, 6, 7);
          }
          o[et] = MFMA(a, pb, o[et]);
        }
      }
  };

  __syncthreads();
  if (DB) {
    gload(0);
    sstore(0);
    __syncthreads();
    for (int t = 0; t < ntb; t++) {
      const bool more = (t + 1 < ntb);
      if (more) gload(t + 1);
      __builtin_amdgcn_sched_barrier(0);
      if (wave_active && t < ntw) { __builtin_amdgcn_s_setprio(1); compute(t & 1); __builtin_amdgcn_s_setprio(0); }
      if (more) sstore((t + 1) & 1);
      __syncthreads();
    }
  } else {
    for (int t = 0; t < ntb; t++) {
      if (t > 0) __syncthreads();
      gload(t);
      __syncthreads();
      if (wave_active && t < ntw) compute(0);
    }
    __syncthreads();
  }
  if (wave_active) {
    float lt = xhalf_sum(lrun);
    float inv = __builtin_amdgcn_rcpf(lt);
#pragma unroll
    for (int et = 0; et < NE; et++)
#pragma unroll
      for (int g = 0; g < 4; g++) {
        uint2 v;
        v.x = pk2(o[et][4 * g + 0] * inv, o[et][4 * g + 1] * inv);
        v.y = pk2(o[et][4 * g + 2] * inv, o[et][4 * g + 3] * inv);
        *(uint2*)(Orow + et * 32 + 8 * g + 4 * h) = v;
      }
  }
}

DI void norm_row_wave(const float* src, u16* dst, int lane) {
  float4 v[4]; float ss = 0.f;
#pragma unroll
  for (int i = 0; i < 4; i++) { v[i] = *(const float4*)(src + i * 256 + lane * 4); ss += v[i].x * v[i].x + v[i].y * v[i].y + v[i].z * v[i].z + v[i].w * v[i].w; }
  ss = wave_sum(ss);
  float rr = rsqrtf(ss * (1.f / 1024.f) + EPS);
#pragma unroll
  for (int i = 0; i < 4; i++) {
    uint2 o; o.x = pk2(v[i].x * rr, v[i].y * rr); o.y = pk2(v[i].z * rr, v[i].w * rr);
    *(uint2*)(dst + i * 256 + lane * 4) = o;
  }
}

DI void phase_norm(const Params& p, int l) {
  const int lane = tidx() & 63, w = tidx() >> 6;
  u16* act = wsb(p, WS_ACT);
  for (int t = blockIdx.x * 4 + w; t < NTOK; t += gridDim.x * 4) norm_row_wave(xrow(p, l, t), act + (size_t)t * LDA, lane);
}

DI void wtile(const float* src, const float* gain, int K, int N, u16* dst, int ldd, int k0, int n0, char* smem) {
  u16* T = (u16*)smem;
  const int tid = tidx();
  __syncthreads();
  {
    const int nn = tid & 63, kk0 = tid >> 6;
    const int n = n0 + nn;
#pragma unroll 4
    for (int i = 0; i < 16; i++) {
      int kk = kk0 + 4 * i;
      float v = 0.f;
      if (n < N) { v = src[(size_t)(k0 + kk) * N + n]; if (gain) v *= gain[k0 + kk]; }
      T[nn * 72 + kk] = f2bf(v);
    }
  }
  __syncthreads();
  {
    const int nn = tid >> 2, kq = tid & 3;
    const uint4* s = (const uint4*)(T + nn * 72 + kq * 16);
    uint4* d = (uint4*)(dst + (size_t)(n0 + nn) * ldd + k0 + kq * 16);
    d[0] = s[0]; d[1] = s[1];
  }
}

DI void phase_prep(const Params& p, char* smem) {
  const int tid = tidx(), lane = tid & 63, w = tid >> 6;
  for (int t = blockIdx.x; t < 2 * 4048; t += gridDim.x) {
    int l = t / 4048, u = t % 4048;
    const float* src; const float* gain = nullptr; int K, N, Npad; size_t doff; int ldd = LDW;
    if (u < 640) { src = p.w_in + (size_t)l * 1024 * INC; gain = p.g_mix + l * 1024; K = 1024; N = INC; Npad = 2560; doff = W_IN; }
    else if (u < 688) { u -= 640; src = p.w_q_up + (size_t)l * 256 * 768; gain = p.g_qa + l * 256; K = 256; N = 768; Npad = 768; doff = W_Q; ldd = LDWQ; }
    else if (u < 720) { u -= 688; src = p.w_kv_up + (size_t)l * 128 * 1024; K = 128; N = 1024; Npad = 1024; doff = W_KV; ldd = LDWKV; }
    else if (u < 976) { u -= 720; src = p.w_out + (size_t)l * 1048576; K = 1024; N = 1024; Npad = 1024; doff = W_OUT; }
    else if (u < 1232) { u -= 976; src = p.w_xq + (size_t)l * 1048576; gain = p.g_xattn + l * 1024; K = 1024; N = 1024; Npad = 1024; doff = W_XQ; }
    else if (u < 1488) { u -= 1232; src = p.w_xk + (size_t)l * 1048576; gain = p.g_mem + l * 1024; K = 1024; N = 1024; Npad = 1024; doff = W_XK; }
    else if (u < 1744) { u -= 1488; src = p.w_xv + (size_t)l * 1048576; gain = p.g_mem + l * 1024; K = 1024; N = 1024; Npad = 1024; doff = W_XV; }
    else if (u < 2000) { u -= 1744; src = p.w_xo + (size_t)l * 1048576; K = 1024; N = 1024; Npad = 1024; doff = W_XO; }
    else if (u < 3024) { u -= 2000; src = p.w_ff1 + (size_t)l * 4194304; gain = p.g_mlp + l * 1024; K = 1024; N = 4096; Npad = 4096; doff = W_FF1; }
    else { u -= 3024; src = p.w_ff2 + (size_t)l * 4194304; K = 4096; N = 1024; Npad = 1024; doff = W_FF2; ldd = LDW2; }
    int nt = Npad / 64;
    int kt = u / nt, ntile = u % nt;
    wtile(src, gain, K, N, wsb(p, WS_W) + (size_t)l * W_LAYER + doff, ldd, kt * 64, ntile * 64, smem);
  }
  float2* tab = (float2*)(p.ws + WS_ROPE);
  for (int t = blockIdx.x; t < 1024; t += gridDim.x) {
    int idx = t * 256 + tid; int pos = idx >> 4, i = idx & 15;
    float inv_freq = __builtin_amdgcn_exp2f(-(float)i * 0.830482023721841f);
    float ang = (float)pos * inv_freq;
    double rev = (double)ang * 0.15915494309189535;
    rev -= rint(rev);
    float fr = (float)rev;
    tab[idx] = make_float2(__builtin_amdgcn_cosf(fr), __builtin_amdgcn_sinf(fr));
  }
  u16* hm = wsb(p, WS_HM);
  for (int t = blockIdx.x * 4 + w; t < 512; t += gridDim.x * 4) norm_row_wave(p.mem_prompt + (size_t)t * 1024, hm + (size_t)t * LDA, lane);
  phase_norm(p, 0);
}

template <class Epi>
DI void phase_gemm128(const Sched& sc, const u16* A, long lda, const u16* Bt, long ldb, int K, int MT, int NT, int SN, char* smem, const Epi& epi);
DI void phase_inproj(const Params& p, const Sched& sc, int l, char* smem) {
  const u16* W = wsb(p, WS_W) + (size_t)l * W_LAYER;
  {
    EpiStoreBf16 epi{wsb(p, WS_BIG + B_P), INC, INC, wsf(p, WS_GATES)};
    phase_gemm128(sc, wsb(p, WS_ACT), LDA, W + W_IN, LDW, 1024, 272, 20, 4, smem, epi);
  }
  if (l == 0) {
    for (int u = blockIdx.x; u < 128; u += gridDim.x) {
      int l2 = u >> 6, which = (u >> 5) & 1, mt = (u >> 3) & 3, nt = u & 7;
      const u16* W2 = wsb(p, WS_W) + (size_t)l2 * W_LAYER + (which ? W_XV : W_XK);
      EpiF32 epi{p.out + (which ? O_PMEMV : O_PMEMK) + (size_t)l2 * 524288, 1024};
      gemm_tile<2, 2>(wsb(p, WS_HM), LDA, W2, LDW, 1024, mt * 128, nt * 128, smem, epi);
    }
  }
}

DI void post_token(const Params& p, int l, int tok, int lane) {
  const u16* pr = wsb(p, WS_BIG + B_P) + (size_t)tok * INC;
  {
    uint2 q4 = *(const uint2*)(pr + lane * 4);
    float a = bflo(q4.x), b = bfhi(q4.x), c = bflo(q4.y), d = bfhi(q4.y);
    float ss = wave_sum(a * a + b * b + c * c + d * d);
    if (lane == 0) wsf(p, WS_RQ)[tok] = rsqrtf(ss * (1.f / 256.f) + EPS);
  }
  const bool prompt = tok < NP;
  int b, s, row, pos; float* ckv_out; float* kr_out;
  if (prompt) {
    b = tok >> 14; s = tok & 16383; row = tok; pos = s;
    ckv_out = p.out + O_PCKV + ((size_t)(l * 2 + b) * 16384 + s) * 128;
    kr_out = p.out + O_PKROPE + ((size_t)(l * 2 + b) * 16384 + s) * 32;
  } else {
    int t2 = tok - NP; b = t2 >> 6; s = t2 & 63; row = NP + b * 1088 + 1024 + s; pos = 1024 + s;
    ckv_out = p.out + O_SCKV + ((size_t)(l * 32 + b) * 64 + s) * 128;
    kr_out = p.out + O_SKROPE + ((size_t)(l * 32 + b) * 64 + s) * 32;
  }
  {
    unsigned c2 = *(const unsigned*)(pr + 256 + lane * 2);
    float c0 = bflo(c2), c1 = bfhi(c2);
    float ss = wave_sum(c0 * c0 + c1 * c1);
    float rr = rsqrtf(ss * (1.f / 128.f) + EPS);
    float o0 = c0 * rr * p.g_kva[l * 128 + lane * 2], o1 = c1 * rr * p.g_kva[l * 128 + lane * 2 + 1];
    *(float2*)(ckv_out + lane * 2) = make_float2(o0, o1);
    *(unsigned*)(wsb(p, WS_CKV) + (size_t)row * 128 + lane * 2) = pk2(o0, o1);
  }
  if (lane < 16) {
    float x1 = bf2f(pr[384 + lane]), x2 = bf2f(pr[400 + lane]);
    float2 cs = ((const float2*)(p.ws + WS_ROPE))[(size_t)pos * 16 + lane];
    float o1 = x1 * cs.x - x2 * cs.y, o2 = x1 * cs.y + x2 * cs.x;
    kr_out[lane] = o1; kr_out[16 + lane] = o2;
    float* ka = wsf(p, WS_KROPE) + (size_t)row * 32;
    ka[lane] = o1; ka[16 + lane] = o2;
  }
  const int S = prompt ? 16384 : 64;
  if (s >= S - 3) {
    int j = s - (S - 3);
    float* dst = prompt ? p.out + O_PCONV + ((size_t)(l * 2 + b) * 3 + j) * 1024 : p.out + O_SCONV + ((size_t)(l * 32 + b) * 3 + j) * 1024;
#pragma unroll 4
    for (int i = 0; i < 16; i++) dst[lane + 64 * i] = bf2f(pr[416 + lane + 64 * i]);
  }
}

DI void post_past(const Params& p, int l, int pi, int lane) {
  int b = pi >> 10, t = pi & 1023;
  size_t row = (size_t)NP + b * 1088 + t;
  const float* src = p.cache_ckv + ((size_t)(l * 32 + b) * 1024 + t) * 128;
  float2 v = *(const float2*)(src + lane * 2);
  *(unsigned*)(wsb(p, WS_CKV) + row * 128 + lane * 2) = pk2(v.x, v.y);
  if (lane < 32) wsf(p, WS_KROPE)[row * 32 + lane] = p.cache_krope[((size_t)(l * 32 + b) * 1024 + t) * 32 + lane];
}

struct ChunkInfo { int tok0, b, h, chain, has_prev, sample; };
DI ChunkInfo chunk_info(int item) {
  ChunkInfo ci;
  if (item < 2048) {
    ci.chain = item >> 8; ci.b = ci.chain >> 2; ci.h = ci.chain & 3; int c = item & 255;
    ci.tok0 = ci.b * 16384 + c * 64; ci.has_prev = (c > 0); ci.sample = 0;
  } else {
    int j = item - 2048; ci.chain = 8 + j; ci.b = j >> 2; ci.h = j & 3; ci.tok0 = NP + ci.b * 64; ci.has_prev = 0; ci.sample = 1;
  }
  return ci;
}
DI void load_x8(const Params& p, int l, const ChunkInfo& ci, int tp, int col, float (&x)[8]) {
  if (tp >= 0 || ci.has_prev) {
    uint4 v = *(const uint4*)(wsb(p, WS_BIG + B_P) + (size_t)(ci.tok0 + tp) * INC + col);
    unpack8(v, x);
  } else if (ci.sample) {
    const float* s = p.st_conv + (((size_t)l * 32 + ci.b) * 3 + (3 + tp)) * 1024 + (col - 416);
    float4 a = *(const float4*)s, b = *(const float4*)(s + 4);
    x[0] = a.x; x[1] = a.y; x[2] = a.z; x[3] = a.w; x[4] = b.x; x[5] = b.y; x[6] = b.z; x[7] = b.w;
  } else {
#pragma unroll
    for (int j = 0; j < 8; j++) x[j] = 0.f;
  }
}
template <class Emit>
DI void conv_run(const Params& p, int l, const ChunkInfo& ci, int mat, int chunk, int row0, int nrows, Emit emit) {
  const int ch0 = mat * 512 + ci.h * 128 + chunk * 8;
  const int col = 416 + ch0;
  float w0[8], w1[8], w2[8], w3[8], bias[8];
  {
    const float* wc = p.w_conv + (size_t)l * 4096 + ch0;
    float4 a, b;
    a = *(const float4*)(wc); b = *(const float4*)(wc + 4);
    w0[0] = a.x; w0[1] = a.y; w0[2] = a.z; w0[3] = a.w; w0[4] = b.x; w0[5] = b.y; w0[6] = b.z; w0[7] = b.w;
    a = *(const float4*)(wc + 1024); b = *(const float4*)(wc + 1028);
    w1[0] = a.x; w1[1] = a.y; w1[2] = a.z; w1[3] = a.w; w1[4] = b.x; w1[5] = b.y; w1[6] = b.z; w1[7] = b.w;
    a = *(const float4*)(wc + 2048); b = *(const float4*)(wc + 2052);
    w2[0] = a.x; w2[1] = a.y; w2[2] = a.z; w2[3] = a.w; w2[4] = b.x; w2[5] = b.y; w2[6] = b.z; w2[7] = b.w;
    a = *(const float4*)(wc + 3072); b = *(const float4*)(wc + 3076);
    w3[0] = a.x; w3[1] = a.y; w3[2] = a.z; w3[3] = a.w; w3[4] = b.x; w3[5] = b.y; w3[6] = b.z; w3[7] = b.w;
    const float* bc = p.b_conv + (size_t)l * 1024 + ch0;
    a = *(const float4*)(bc); b = *(const float4*)(bc + 4);
    bias[0] = a.x; bias[1] = a.y; bias[2] = a.z; bias[3] = a.w; bias[4] = b.x; bias[5] = b.y; bias[6] = b.z; bias[7] = b.w;
  }
  float xa[8], xb[8], xc[8], xd[8];
  load_x8(p, l, ci, row0 - 3, col, xa);
  load_x8(p, l, ci, row0 - 2, col, xb);
  load_x8(p, l, ci, row0 - 1, col, xc);
  for (int t = row0; t < row0 + nrows; t++) {
    load_x8(p, l, ci, t, col, xd);
    float y[8];
#pragma unroll
    for (int j = 0; j < 8; j++) {
      float v = bias[j] + xa[j] * w0[j] + xb[j] * w1[j] + xc[j] * w2[j] + xd[j] * w3[j];
      y[j] = v * __builtin_amdgcn_rcpf(1.f + __expf(-v));
      xa[j] = xb[j]; xb[j] = xc[j]; xc[j] = xd[j];
    }
    emit(t, y);
  }
}
DI float logsigmoid(float z) { return fminf(z, 0.f) - log1pf(__expf(-fabsf(z))); }

DI void mlstm_m1(const Params& p, int l, int item, char* smem) {
  const ChunkInfo ci = chunk_info(item);
  const int tid = tidx(), lane = tid & 63, w = tid >> 6, r = lane & 31, h = lane >> 5;
  u16* sVt = (u16*)smem;
  u16* sKt = sVt + 128 * 72;
  float* swk = (float*)(sKt + 128 * 72);
  __syncthreads();
  if (w == 0) {
    const float* g = wsf(p, WS_GATES) + (size_t)(ci.tok0 + lane) * 8;
    float ig = g[ci.h] + p.b_igate[l * 4 + ci.h];
    float lf = logsigmoid(g[4 + ci.h] + p.b_fgate[l * 4 + ci.h]);
    float bcs = lf;
#pragma unroll
    for (int o = 1; o < 64; o <<= 1) { float t = __shfl_up(bcs, o); if (lane >= o) bcs += t; }
    float u = ig - bcs;
    float umax = wave_max(u);
    swk[lane] = __expf(u - umax);
    float blast = __shfl(bcs, 63);
    if (lane == 0) { float* sc = wsf(p, WS_SCAL) + (size_t)item * 2; sc[0] = blast; sc[1] = blast + umax; }
  }
#pragma unroll
  for (int it = 0; it < 4; it++) {
    int id = tid + 256 * it; int s = id >> 4, ch = id & 15;
    uint4 v = *(const uint4*)(wsb(p, WS_BIG + B_P) + (size_t)(ci.tok0 + s) * INC + 1440 + ci.h * 128 + ch * 8);
    const u16* vv = (const u16*)&v;
    unsigned a[4] = {v.x, v.y, v.z, v.w};
#pragma unroll
    for (int j = 0; j < 4; j++) { sVt[(ch * 8 + 2 * j) * 72 + s] = (u16)(a[j] & 0xffffu); sVt[(ch * 8 + 2 * j + 1) * 72 + s] = (u16)(a[j] >> 16); }
    (void)vv;
  }
  __syncthreads();
  {
    const int chunk = tid & 15, rg = tid >> 4;
    conv_run(p, l, ci, 1, chunk, rg * 4, 4, [&](int t, const float (&y)[8]) {
      float sc = 0.08838834764831845f * swk[t];
#pragma unroll
      for (int j = 0; j < 8; j++) sKt[(chunk * 8 + j) * 72 + t] = f2bf(y[j] * sc);
    });
  }
  __syncthreads();
  const int wm = w >> 1, wn = w & 1;
  f32x16 acc[2][2];
#pragma unroll
  for (int a = 0; a < 2; a++)
#pragma unroll
    for (int b = 0; b < 2; b++)
#pragma unroll
      for (int i = 0; i < 16; i++) acc[a][b][i] = 0.f;
#pragma unroll
  for (int ks = 0; ks < 4; ks++) {
    bf16x8 af[2], bfr[2];
#pragma unroll
    for (int tm = 0; tm < 2; tm++) af[tm] = *(const bf16x8*)(sVt + (wm * 64 + tm * 32 + r) * 72 + ks * 16 + h * 8);
#pragma unroll
    for (int tn = 0; tn < 2; tn++) bfr[tn] = *(const bf16x8*)(sKt + (wn * 64 + tn * 32 + r) * 72 + ks * 16 + h * 8);
#pragma unroll
    for (int tm = 0; tm < 2; tm++)
#pragma unroll
      for (int tn = 0; tn < 2; tn++) acc[tm][tn] = MFMA(bfr[tn], af[tm], acc[tm][tn]);
  }
  u16* slot = wsb(p, WS_BIG + B_ST) + (size_t)item * 16384;
#pragma unroll
  for (int tm = 0; tm < 2; tm++)
#pragma unroll
    for (int tn = 0; tn < 2; tn++)
#pragma unroll
      for (int g = 0; g < 4; g++) {
        uint2 v;
        v.x = pk2(acc[tm][tn][4 * g + 0], acc[tm][tn][4 * g + 1]);
        v.y = pk2(acc[tm][tn][4 * g + 2], acc[tm][tn][4 * g + 3]);
        *(uint2*)(slot + (wm * 64 + tm * 32 + r) * 128 + wn * 64 + tn * 32 + 8 * g + 4 * h) = v;
      }
  if (tid < 128) {
    float sum = 0.f;
    const u16* kr = sKt + tid * 72;
#pragma unroll 8
    for (int s = 0; s < 64; s++) sum += bf2f(kr[s]);
    wsf(p, WS_NU)[(size_t)item * 128 + tid] = sum;
  }
}

DI void mlstm_m2(const Params& p, int l, int unit) {
  const int tid = tidx();
  int chain, g, nc, item0, b, h; bool sample;
  if (unit < 256) { chain = unit >> 5; g = unit & 31; nc = 256; item0 = chain * 256; b = chain >> 2; h = chain & 3; sample = false; }
  else { int u = unit - 256; int j = u >> 5; g = u & 31; chain = 8 + j; nc = 1; item0 = 2048 + j; b = j >> 2; h = j & 3; sample = true; }
  const int el = g * 512 + tid * 2; const int e = el >> 7, d = el & 127;
  float c0 = 0.f, c1 = 0.f, nst = 0.f, m = 0.f;
  const bool do_n = (g == 0 && tid < 128);
  if (sample) {
    const float* C0 = p.st_C + ((size_t)(l * 32 + b) * 4 + h) * 16384;
    c0 = C0[d * 128 + e]; c1 = C0[(d + 1) * 128 + e];
    if (do_n) nst = p.st_n[((size_t)(l * 32 + b) * 4 + h) * 128 + tid];
    m = p.st_m[(l * 32 + b) * 4 + h];
  }
  u16* slots = wsb(p, WS_BIG + B_ST);
  const float* scal = wsf(p, WS_SCAL);
  float* nu = wsf(p, WS_NU);
  float* mst = wsf(p, WS_MST);
  for (int cb = 0; cb < nc; cb += 8) {
    unsigned uu[8]; float nn[8];
#pragma unroll
    for (int j = 0; j < 8; j++) {
      uu[j] = 0; nn[j] = 0.f;
      if (cb + j < nc) {
        uu[j] = *(const unsigned*)(slots + (size_t)(item0 + cb + j) * 16384 + el);
        if (do_n) nn[j] = nu[(size_t)(item0 + cb + j) * 128 + tid];
      }
    }
#pragma unroll
    for (int j = 0; j < 8; j++) {
      if (cb + j < nc) {
        const int item = item0 + cb + j;
        const float A = scal[item * 2], Cm = scal[item * 2 + 1];
        const float mnew = fmaxf(A + m, Cm);
        const float dec = __expf(A + m - mnew), us = __expf(Cm - mnew);
        *(unsigned*)(slots + (size_t)item * 16384 + el) = pk2(c0, c1);
        c0 = dec * c0 + us * bflo(uu[j]);
        c1 = dec * c1 + us * bfhi(uu[j]);
        if (do_n) { nu[(size_t)item * 128 + tid] = nst; nst = dec * nst + us * nn[j]; }
        if (g == 0 && tid == 0) mst[item] = m;
        m = mnew;
      }
    }
  }
  float* oC = sample ? p.out + O_SC + ((size_t)(l * 32 + b) * 4 + h) * 16384 : p.out + O_PC + ((size_t)(l * 2 + b) * 4 + h) * 16384;
  oC[d * 128 + e] = c0; oC[(d + 1) * 128 + e] = c1;
  if (do_n) { float* on = sample ? p.out + O_SN + ((size_t)(l * 32 + b) * 4 + h) * 128 : p.out + O_PN + ((size_t)(l * 2 + b) * 4 + h) * 128; on[tid] = nst; }
  if (g == 0 && tid == 0) { float* om = sample ? p.out + O_SM + (l * 32 + b) * 4 + h : p.out + O_PM + (l * 2 + b) * 4 + h; *om = m; }
}

DI void mlstm_m3(const Params& p, int l, int item, char* smem) {
  const ChunkInfo ci = chunk_info(item);
  const int tid = tidx(), lane = tid & 63, w = tid >> 6, r = lane & 31, h = lane >> 5;
  u16* sQ = (u16*)smem;
  u16* sK = sQ + 64 * 136;
  u16* sVt = sK + 64 * 136;
  u16* sP = sVt + 128 * 72;
  float* su = (float*)(sP + 64 * 72);
  float* sM = su + 64;
  float* sa = sM + 64;
  float* sden = sa + 64;
  float* sinv = sden + 64;
  float* sn = sinv + 64;
  float* sH = (float*)smem;
  __syncthreads();
  const float m_start = wsf(p, WS_MST)[item];
  if (w == 0) {
    const float* g = wsf(p, WS_GATES) + (size_t)(ci.tok0 + lane) * 8;
    float ig = g[ci.h] + p.b_igate[l * 4 + ci.h];
    float lf = logsigmoid(g[4 + ci.h] + p.b_fgate[l * 4 + ci.h]);
    float bcs = lf;
#pragma unroll
    for (int o = 1; o < 64; o <<= 1) { float t = __shfl_up(bcs, o); if (lane >= o) bcs += t; }
    float u = ig - bcs;
    float cm = u;
#pragma unroll
    for (int o = 1; o < 64; o <<= 1) { float t = __shfl_up(cm, o); if (lane >= o) cm = fmaxf(cm, t); }
    float Mt = fmaxf(m_start, cm);
    su[lane] = u; sM[lane] = Mt; sa[lane] = __expf(m_start - Mt); sden[lane] = __expf(-(bcs + Mt));
  } else if (w == 1) {
    sn[lane] = wsf(p, WS_NU)[(size_t)item * 128 + lane];
    sn[lane + 64] = wsf(p, WS_NU)[(size_t)item * 128 + lane + 64];
  }
#pragma unroll
  for (int it = 0; it < 4; it++) {
    int id = tid + 256 * it; int s = id >> 4, ch = id & 15;
    uint4 v = *(const uint4*)(wsb(p, WS_BIG + B_P) + (size_t)(ci.tok0 + s) * INC + 1440 + ci.h * 128 + ch * 8);
    unsigned a[4] = {v.x, v.y, v.z, v.w};
#pragma unroll
    for (int j = 0; j < 4; j++) { sVt[(ch * 8 + 2 * j) * 72 + s] = (u16)(a[j] & 0xffffu); sVt[(ch * 8 + 2 * j + 1) * 72 + s] = (u16)(a[j] >> 16); }
  }
  {
    const int mc = tid & 31, mat = mc >> 4, chunk = mc & 15, rg = tid >> 5;
    u16* dst = mat ? sK : sQ;
    const float sc = mat ? 0.08838834764831845f : 1.f;
    conv_run(p, l, ci, mat, chunk, rg * 8, 8, [&](int t, const float (&y)[8]) {
      float x[8];
#pragma unroll
      for (int j = 0; j < 8; j++) x[j] = y[j] * sc;
      *(uint4*)(dst + t * 136 + chunk * 8) = pack8(x);
    });
  }
  __syncthreads();
  {
    const int tq = w >> 1, ts = w & 1;
    f32x16 s;
#pragma unroll
    for (int i = 0; i < 16; i++) s[i] = 0.f;
#pragma unroll
    for (int ks = 0; ks < 8; ks++) {
      bf16x8 a = *(const bf16x8*)(sQ + (tq * 32 + r) * 136 + ks * 16 + h * 8);
      bf16x8 b = *(const bf16x8*)(sK + (ts * 32 + r) * 136 + ks * 16 + h * 8);
      s = MFMA(a, b, s);
    }
    const int sidx = ts * 32 + r;
    const float us = su[sidx];
#pragma unroll
    for (int i = 0; i < 16; i++) {
      int t = tq * 32 + crow(i, h);
      float v = (sidx <= t) ? s[i] * __expf(us - sM[t]) : 0.f;
      sP[t * 72 + sidx] = f2bf(v);
    }
  }
  __syncthreads();
  if (tid < 64) {
    float rs = 0.f, qd = 0.f;
    const u16* pr = sP + tid * 72;
#pragma unroll 8
    for (int s = 0; s < 64; s++) rs += bf2f(pr[s]);
    const u16* qr = sQ + tid * 136;
#pragma unroll 8
    for (int d = 0; d < 128; d++) qd += bf2f(qr[d]) * sn[d];
    float qn = sa[tid] * qd + rs;
    sinv[tid] = __builtin_amdgcn_rcpf(fmaxf(fabsf(qn), sden[tid]));
  }
  const int tq = w & 1, eb = (w >> 1) * 2;
  f32x16 a1[2], a2[2];
#pragma unroll
  for (int et = 0; et < 2; et++)
#pragma unroll
    for (int i = 0; i < 16; i++) { a1[et][i] = 0.f; a2[et][i] = 0.f; }
  const u16* slot = wsb(p, WS_BIG + B_ST) + (size_t)item * 16384;
#pragma unroll
  for (int ks = 0; ks < 8; ks++) {
    bf16x8 a = *(const bf16x8*)(sQ + (tq * 32 + r) * 136 + ks * 16 + h * 8);
#pragma unroll
    for (int et = 0; et < 2; et++) {
      bf16x8 b = *(const bf16x8*)(slot + ((eb + et) * 32 + r) * 128 + ks * 16 + h * 8);
      a1[et] = MFMA(a, b, a1[et]);
    }
  }
#pragma unroll
  for (int ks = 0; ks < 4; ks++) {
    bf16x8 a = *(const bf16x8*)(sP + (tq * 32 + r) * 72 + ks * 16 + h * 8);
#pragma unroll
    for (int et = 0; et < 2; et++) {
      bf16x8 b = *(const bf16x8*)(sVt + ((eb + et) * 32 + r) * 72 + ks * 16 + h * 8);
      a2[et] = MFMA(a, b, a2[et]);
    }
  }
  __syncthreads();
#pragma unroll
  for (int et = 0; et < 2; et++)
#pragma unroll
    for (int i = 0; i < 16; i++) {
      int t = tq * 32 + crow(i, h);
      sH[t * 132 + (eb + et) * 32 + r] = (sa[t] * a1[et][i] + a2[et][i]) * sinv[t];
    }
  __syncthreads();
  {
    const int t = tid >> 2, part = tid & 3;
    const float* hr = sH + t * 132 + part * 32;
    float ss = 0.f;
#pragma unroll 8
    for (int j = 0; j < 32; j++) ss += hr[j] * hr[j];
    ss += __shfl_xor(ss, 1); ss += __shfl_xor(ss, 2);
    const float rr = rsqrtf(ss * (1.f / 128.f) + EPS);
    const int tok = ci.tok0 + t;
    const u16* og = wsb(p, WS_BIG + B_P) + (size_t)tok * INC + 1960 + ci.h * 128 + part * 32;
    const float* gm = p.g_mhead + (size_t)l * 512 + ci.h * 128 + part * 32;
    u16* o = wsb(p, WS_ACT) + (size_t)tok * LDA + 512 + ci.h * 128 + part * 32;
#pragma unroll
    for (int c8 = 0; c8 < 4; c8++) {
      float gv[8], x[8];
      unpack8(*(const uint4*)(og + c8 * 8), gv);
#pragma unroll
      for (int j = 0; j < 8; j++) x[j] = hr[c8 * 8 + j] * rr * gm[c8 * 8 + j] * __builtin_amdgcn_rcpf(1.f + __expf(-gv[j]));
      *(uint4*)(o + c8 * 8) = pack8(x);
    }
  }
}

DI void xkv_item(const Params& p, int l, int item, char* smem) {
  const int tid = tidx();
  const int kg = item & 3, hh = (item >> 2) & 3, bidx = item >> 4;
  u16* T = (u16*)smem;
  __syncthreads();
  const int key = tid >> 2, qt = tid & 3;
  const int mem = kg * 64 + key;
  const bool prompt = bidx < 2;
  float* kp; const float* vp;
  if (prompt) {
    kp = p.out + O_PMEMK + (((size_t)(l * 2 + bidx) * 256 + mem) * 4 + hh) * 256 + qt * 64;
    vp = p.out + O_PMEMV + (((size_t)(l * 2 + bidx) * 256 + mem) * 4 + hh) * 256 + qt * 64;
  } else {
    kp = (float*)(p.cache_mem_k + (((size_t)(l * 32 + bidx - 2) * 256 + mem) * 4 + hh) * 256 + qt * 64);
    vp = p.cache_mem_v + (((size_t)(l * 32 + bidx - 2) * 256 + mem) * 4 + hh) * 256 + qt * 64;
  }
  float rr = 1.f;
  if (prompt) {
    float ss = 0.f;
#pragma unroll 4
    for (int j = 0; j < 16; j++) { float4 v = *(const float4*)(kp + j * 4); ss += v.x * v.x + v.y * v.y + v.z * v.z + v.w * v.w; }
    ss += __shfl_xor(ss, 1); ss += __shfl_xor(ss, 2);
    rr = rsqrtf(ss * (1.f / 256.f) + EPS);
  }
  const float* gk = p.g_xk + l * 256 + qt * 64;
  const float* gq = p.g_xq + l * 256 + qt * 64;
  u16* xk = wsb(p, WS_BIG + B_XK) + ((size_t)(bidx * 4 + hh) * 256 + mem) * 256 + qt * 64;
#pragma unroll 2
  for (int c8 = 0; c8 < 8; c8++) {
    float4 a = *(const float4*)(kp + c8 * 8), b = *(const float4*)(kp + c8 * 8 + 4);
    float x[8] = {a.x, a.y, a.z, a.w, b.x, b.y, b.z, b.w};
    if (prompt) {
#pragma unroll
      for (int j = 0; j < 8; j++) x[j] = x[j] * rr * gk[c8 * 8 + j];
      *(float4*)(kp + c8 * 8) = make_float4(x[0], x[1], x[2], x[3]);
      *(float4*)(kp + c8 * 8 + 4) = make_float4(x[4], x[5], x[6], x[7]);
    }
#pragma unroll
    for (int j = 0; j < 8; j++) x[j] = x[j] * gq[c8 * 8 + j] * (0.0625f * LOG2E);
    *(uint4*)(xk + c8 * 8) = pack8(x);
    float4 va = *(const float4*)(vp + c8 * 8), vb = *(const float4*)(vp + c8 * 8 + 4);
    float y[8] = {va.x, va.y, va.z, va.w, vb.x, vb.y, vb.z, vb.w};
    *(uint4*)(T + key * 264 + qt * 64 + c8 * 8) = pack8(y);
  }
  __syncthreads();
  {
    const int e = tid;
    u16* xv = wsb(p, WS_BIG + B_XVT) + ((size_t)(bidx * 4 + hh) * 256 + e) * LDXV + kg * 64;
#pragma unroll 2
    for (int oct = 0; oct < 8; oct++) {
      uint4 v;
      const int kb = 16 * (oct >> 1) + 4 * (oct & 1);
      v.x = (unsigned)T[(kb + 0) * 264 + e] | ((unsigned)T[(kb + 1) * 264 + e] << 16);
      v.y = (unsigned)T[(kb + 2) * 264 + e] | ((unsigned)T[(kb + 3) * 264 + e] << 16);
      v.z = (unsigned)T[(kb + 8) * 264 + e] | ((unsigned)T[(kb + 9) * 264 + e] << 16);
      v.w = (unsigned)T[(kb + 10) * 264 + e] | ((unsigned)T[(kb + 11) * 264 + e] << 16);
      *(uint4*)(xv + oct * 8) = v;
    }
  }
}

DI void phase_C2(const Params& p, int l, char* smem) {
  for (int t = blockIdx.x; t < 544; t += gridDim.x) xkv_item(p, l, t, smem);
}
DI void phase_C1(const Params& p, int l, char* smem) {
  const int lane = tidx() & 63, w = tidx() >> 6;
  for (int t = blockIdx.x; t < NITEM; t += gridDim.x) mlstm_m1(p, l, t, smem);
  for (int t = blockIdx.x * 4 + w; t < NTOK + 32768; t += gridDim.x * 4) {
    if (t < NTOK) post_token(p, l, t, lane); else post_past(p, l, t - NTOK, lane);
  }
}

DI void phase_D(const Params& p, int l, char* smem) {
  const int n_scan = 256 + 4096;
  const int n_q = 544 * 4;
  const u16* W = wsb(p, WS_W) + (size_t)l * W_LAYER;
  for (int t = blockIdx.x; t < n_scan + n_q; t += gridDim.x) {
    if (t < n_scan) mlstm_m2(p, l, t);
    else {
      int u = t - n_scan; int mt = u >> 2, nt = u & 3;
      EpiQ epi{wsb(p, WS_BIG + B_Q), wsf(p, WS_RQ), (const float2*)(p.ws + WS_ROPE), p.g_qnorm + l * 96};
      gemm_tile<1, 3>(wsb(p, WS_BIG + B_P), INC, W + W_Q, LDWQ, 256, mt * 64, nt * 192, smem, epi);
    }
  }
}

DI void phase_E(const Params& p, int l, char* smem) {
  for (int t = blockIdx.x; t < NITEM; t += gridDim.x) mlstm_m3(p, l, t, smem);
}

DI void phase_F(const Params& p, int l, char* smem) {
  const u16* W = wsb(p, WS_W) + (size_t)l * W_LAYER;
  for (int t = blockIdx.x; t < 528 * 8; t += gridDim.x) {
    int mt = t >> 3, nt = t & 7;
    EpiKV epi{wsb(p, WS_BIG + B_K), wsb(p, WS_BIG + B_VT), wsf(p, WS_KROPE), p.g_knorm + l * 96};
    gemm_tile<2, 2>(wsb(p, WS_CKV), 128, W + W_KV, LDWKV, 128, mt * 128, nt * 128, smem, epi);
  }
}

DI void phase_G(const Params& p, const Sched& sc, char* smem) {
  const int G = gridDim.x, j = blockIdx.x;
  const int lane = tidx() & 63, w = tidx() >> 6, r = lane & 31;
  const int NIT = 2048 + 256;
  const u16* qb = wsb(p, WS_BIG + B_Q);
  const u16* Kb = wsb(p, WS_BIG + B_K);
  const u16* Vt = wsb(p, WS_BIG + B_VT);
  u16* act = wsb(p, WS_ACT);
  auto run_prompt = [&](int bh, int bi) {
    int b = bh >> 3, hd = bh & 7;
    int tok = b * 16384 + bi * 128 + w * 32 + r;
    flash_item<96, 2, 64, true, false, true, true>(qb + (size_t)tok * 768 + hd * 96, true, 2 * bi + 2, 2 * bi + 1 + (w >> 1),
                                             Kb + ((size_t)hd * NROWS + b * 16384) * 96, 96, Vt + (size_t)hd * 64 * LDVT + b * 16384, LDVT, 0,
                                             act + (size_t)tok * LDA + hd * 64, smem);
  };
  auto run_sample = [&](int u) {
    int b = u >> 3, hd = u & 7;
    int tok = NP + b * 64 + (w & 1) * 32 + r;
    size_t row0 = (size_t)NP + b * 1088;
    flash_item<96, 2, 64, true, false, true, true>(qb + (size_t)tok * 768 + hd * 96, w < 2, 17, 17, Kb + ((size_t)hd * NROWS + row0) * 96, 96,
                                             Vt + (size_t)hd * 64 * LDVT + row0, LDVT, 0, act + (size_t)tok * LDA + hd * 64, smem);
  };
  if (sc.ok) {
    const int xg = sc.xg, xi = sc.xi;
    for (int pass = 0; pass < 2; pass++) {
      const int bh = xg + 8 * pass;
      run_prompt(bh, xi);
      run_prompt(bh, 127 - xi);
    }
    if ((j & 1) == 0) run_sample(j >> 1);
  } else {
    for (int k = 0; k * G < NIT; k++) {
      int it = (k & 1) ? (k * G + (G - 1 - j)) : (k * G + j);
      if (it >= NIT) continue;
      if (it < 2048) run_prompt(it & 15, 127 - (it >> 4)); else run_sample(it - 2048);
    }
  }
}

DI void xattn_item(const u16* Qtile  , const u16* Kbase, const u16* Vtbase, u16* Otile, char* smem) {
  constexpr int LDQ = 264, LDV = 40;
  u16* sQ = (u16*)smem;
  u16* sK = sQ + 64 * LDQ;
  u16* sV = sK + 32 * LDQ;
  const int tid = tidx(), lane = tid & 63, w = tid >> 6, r = lane & 31, h = lane >> 5;
  const int qrow = 32 * (w & 1) + r, e0 = 128 * (w >> 1);
  u32x4 rk[4], rv[4];
  auto gload = [&](int t) {
#pragma unroll
    for (int i = 0; i < 4; i++) {
      int id = tid + 256 * i;
      rk[i] = *(const u32x4*)(Kbase + (long)(t * 32 + (id >> 5)) * 256 + (id & 31) * 8);
      rv[i] = *(const u32x4*)(Vtbase + (long)(id >> 2) * LDXV + t * 32 + (id & 3) * 8);
    }
  };
  auto sstore = [&]() {
#pragma unroll
    for (int i = 0; i < 4; i++) {
      int id = tid + 256 * i;
      *(u32x4*)(sK + (id >> 5) * LDQ + (id & 31) * 8) = rk[i];
      *(u32x4*)(sV + (id >> 2) * LDV + (id & 3) * 8) = rv[i];
    }
  };
  __syncthreads();
  gload(0);
#pragma unroll
  for (int i = 0; i < 8; i++) {
    int id = tid + 256 * i;
    *(u32x4*)(sQ + (id >> 5) * LDQ + (id & 31) * 8) = *(const u32x4*)(Qtile + (long)(id >> 5) * LDA + (id & 31) * 8);
  }
  sstore();
  __syncthreads();
  float rqs;
  {
    float ss = 0.f;
#pragma unroll
    for (int ks = 0; ks < 16; ks++) {
      bf16x8 qq = *(const bf16x8*)(sQ + qrow * LDQ + ks * 16 + h * 8);
#pragma unroll
      for (int j = 0; j < 8; j++) { float v = bf2f((u16)qq[j]); ss += v * v; }
    }
    ss = xhalf_sum(ss);
    rqs = rsqrtf(ss * (1.f / 256.f) + EPS);
  }
  const float rqinv = __builtin_amdgcn_rcpf(rqs);
  f32x16 o[4];
#pragma unroll
  for (int et = 0; et < 4; et++)
#pragma unroll
    for (int i = 0; i < 16; i++) o[et][i] = 0.f;
  float mrun = 0.f, lrun = 0.f;
  for (int t = 0; t < 8; t++) {
    if (t + 1 < 8) gload(t + 1);
    __builtin_amdgcn_sched_barrier(0);
    __builtin_amdgcn_s_setprio(1);
    {
      f32x16 s;
      const float sinit = -mrun * rqinv;
#pragma unroll
      for (int i = 0; i < 16; i++) s[i] = sinit;
#pragma unroll
      for (int ks = 0; ks < 16; ks++) {
        bf16x8 a = *(const bf16x8*)(sK + r * LDQ + ks * 16 + h * 8);
        bf16x8 b = *(const bf16x8*)(sQ + qrow * LDQ + ks * 16 + h * 8);
        s = MFMA(a, b, s);
      }
      float mx = -1e30f;
#pragma unroll
      for (int i = 0; i < 16; i++) { s[i] *= rqs; mx = fmaxf(mx, s[i]); }
      mx = xhalf_max(mx);
      if (__any(mx > 8.f)) {
        const float d = fmaxf(mx, 0.f);
        const float alpha = __builtin_amdgcn_exp2f(-d);
        mrun += d;
        lrun *= alpha;
#pragma unroll
        for (int et = 0; et < 4; et++)
#pragma unroll
          for (int i = 0; i < 16; i++) o[et][i] *= alpha;
#pragma unroll
        for (int i = 0; i < 16; i++) s[i] -= d;
      }
      float psum = 0.f;
#pragma unroll
      for (int i = 0; i < 16; i++) { float pv = __builtin_amdgcn_exp2f(s[i]); s[i] = pv; psum += pv; }
      lrun += psum;
#pragma unroll
      for (int st = 0; st < 2; st++) {
        uint4 pp;
        pp.x = pk2(s[8 * st + 0], s[8 * st + 1]); pp.y = pk2(s[8 * st + 2], s[8 * st + 3]);
        pp.z = pk2(s[8 * st + 4], s[8 * st + 5]); pp.w = pk2(s[8 * st + 6], s[8 * st + 7]);
        bf16x8 pb = __builtin_bit_cast(bf16x8, pp);
#pragma unroll
        for (int et = 0; et < 4; et++) {
          bf16x8 a = *(const bf16x8*)(sV + (e0 + et * 32 + r) * LDV + st * 16 + 8 * h);
          o[et] = MFMA(a, pb, o[et]);
        }
      }
    }
    __builtin_amdgcn_s_setprio(0);
    __builtin_amdgcn_sched_barrier(0);
    __syncthreads();
    if (t + 1 < 8) { sstore(); __syncthreads(); }
  }
  {
    float lt = xhalf_sum(lrun);
    float inv = __builtin_amdgcn_rcpf(lt);
    u16* Orow = Otile + (long)qrow * LDA + e0;
#pragma unroll
    for (int et = 0; et < 4; et++)
#pragma unroll
      for (int g = 0; g < 4; g++) {
        uint2 v;
        v.x = pk2(o[et][4 * g + 0] * inv, o[et][4 * g + 1] * inv);
        v.y = pk2(o[et][4 * g + 2] * inv, o[et][4 * g + 3] * inv);
        *(uint2*)(Orow + et * 32 + 8 * g + 4 * h) = v;
      }
  }
}

DI void phase_K(const Params& p, char* smem) {
  const int lane = tidx() & 63, w = tidx() >> 6, r = lane & 31;
  const u16* qx = wsb(p, WS_BIG + B_QX);
  u16* act = wsb(p, WS_ACT);
  for (int t = blockIdx.x; t < 2176; t += gridDim.x) {
    int bidx, hh, tok0;
    if (t < 2048) { bidx = t >> 10; hh = (t >> 8) & 3; tok0 = bidx * 16384 + (t & 255) * 64; }
    else { int u = t - 2048; bidx = 2 + (u >> 2); hh = u & 3; tok0 = NP + (u >> 2) * 64; }
    const u16* Kb = wsb(p, WS_BIG + B_XK) + (size_t)(bidx * 4 + hh) * 65536;
    const u16* Vt = wsb(p, WS_BIG + B_XVT) + (size_t)(bidx * 4 + hh) * 256 * LDXV;
    xattn_item(qx + (size_t)tok0 * LDA + hh * 256, Kb, Vt, act + (size_t)tok0 * LDA + hh * 256, smem);
  }
  (void)lane; (void)w; (void)r;
}

template <class Epi>
DI void phase_gemm128(const Sched& sc, const u16* A, long lda, const u16* Bt, long ldb, int K, int MT, int NT, int SN, char* smem, const Epi& epi) {
  if (sc.ok) {
    const int xg = sc.xg, xi = sc.xi;
    const int SM = 64 / SN;
    const int sng = NT / SN, smg = MT / SM;
    for (int st = xg; st < smg * sng; st += 8) {
      int sm = st / sng, sn = st % sng;
      int mt = sm * SM + xi / SN, nt = sn * SN + xi % SN;
      gemm_tile<2, 2>(A, lda, Bt, ldb, K, mt * 128, nt * 128, smem, epi);
    }
  } else {
    for (int t = blockIdx.x; t < MT * NT; t += gridDim.x) {
      int mt = t / NT, nt = t % NT;
      gemm_tile<2, 2>(A, lda, Bt, ldb, K, mt * 128, nt * 128, smem, epi);
    }
  }
}

#if defined(__HIP_DEVICE_COMPILE__)
typedef const __attribute__((address_space(4))) Params* KargPtr;
#define KARG_LOAD KargPtr pp4 = (KargPtr)__builtin_amdgcn_kernarg_segment_ptr(); asm volatile("" : "+s"(pp4)); const Params p = *pp4;
#else
#define KARG_LOAD const Params p{};
#endif
template <int L>
DI void run_layer(const Sched& sc, int ph_begin, int ph_end, char* smem, const XcdBarrier& xb) {
  const int base = 1 + 15 * L;
#define RUN_PHASE(S, ...)  RUN_PHASE_R(S, 1, __VA_ARGS__)
#define RUN_PHASE_R(S, R, ...)                                    \
  {                                                          \
    const int ph = base + (S);                               \
    if (ph >= ph_begin && ph < ph_end) {                     \
      for (int rep_ = 0; rep_ < (R); rep_++) {               \
        KARG_LOAD                                            \
        const u16* W = wsb(p, WS_W) + (size_t)L * W_LAYER;   \
        const float* xs0 = (L == 0) ? p.x_prompt : p.out;    \
        const float* xs1 = (L == 0) ? p.x_sample : p.out + (size_t)NP * 1024; \
        (void)W; (void)xs0; (void)xs1;                       \
        __VA_ARGS__;                                         \
        if (ph + 1 < ph_end) xcd_barrier(xb);                \
      }                                                      \
    }                                                        \
  }
  if (L > 0) RUN_PHASE(0, phase_norm(p, L))
  RUN_PHASE_R(1, REP_INPROJ, phase_inproj(p, sc, L, smem))
  RUN_PHASE_R(2, REP_C, { phase_C1(p, L, smem); phase_C2(p, L, smem); })
  RUN_PHASE(3, phase_D(p, L, smem))
  RUN_PHASE_R(4, REP_E, phase_E(p, L, smem))
  RUN_PHASE_R(5, REP_F, phase_F(p, L, smem))
  RUN_PHASE_R(6, REP_G, phase_G(p, sc, smem))
  RUN_PHASE(7, { EpiRes epi{xs0, xs1, p.out}; phase_gemm128(sc, wsb(p, WS_ACT), LDA, W + W_OUT, LDW, 1024, 272, 8, 8, smem, epi); })
  RUN_PHASE_R(8, REP_NORM, phase_norm(p, 1))
  RUN_PHASE(9, { EpiStoreBf16 epi{wsb(p, WS_BIG + B_QX), LDA, 1024, nullptr}; phase_gemm128(sc, wsb(p, WS_ACT), LDA, W + W_XQ, LDW, 1024, 272, 8, 8, smem, epi); })
  RUN_PHASE_R(10, REP_K, phase_K(p, smem))
  RUN_PHASE(11, { EpiRes epi{p.out, p.out + (size_t)NP * 1024, p.out}; phase_gemm128(sc, wsb(p, WS_ACT), LDA, W + W_XO, LDW, 1024, 272, 8, 8, smem, epi); })
  RUN_PHASE(12, phase_norm(p, 1))
  RUN_PHASE_R(13, REP_FF1, { EpiRelu2 epi{wsb(p, WS_BIG + B_H1), LDH1}; phase_gemm128(sc, wsb(p, WS_ACT), LDA, W + W_FF1, LDW, 1024, 272, 32, 8, smem, epi); })
  RUN_PHASE(14, { EpiRes epi{p.out, p.out + (size_t)NP * 1024, p.out}; phase_gemm128(sc, wsb(p, WS_BIG + B_H1), LDH1, W + W_FF2, LDW2, 4096, 272, 8, 8, smem, epi); })
#undef RUN_PHASE
#undef RUN_PHASE_R
}

__global__ void __launch_bounds__(256, 2) fwd_megakernel(Params p, int ph_begin, int ph_end) {
  __shared__ __attribute__((aligned(16))) char smem[SMEM_BYTES];
  cg::grid_group grid = cg::this_grid();
  __shared__ int s_rank;
  __shared__ __attribute__((aligned(16))) unsigned xb_words[4];
  if (tidx() < 4) xb_words[tidx()] = 0u;
  __syncthreads();
  const XcdBarrier xb = xcd_barrier_post((unsigned*)(p.ws + WS_BAR), (volatile LAS unsigned*)&xb_words);
  Sched sc;
  sc.xg = (int)((unsigned)__builtin_amdgcn_s_getreg((3 << 11) | 20) & 7u);
  unsigned* cnt = (unsigned*)(p.ws + WS_CNT);
  if (tidx() == 0) s_rank = (int)atomicAdd(&cnt[sc.xg], 1u);
  __syncthreads();
  sc.xi = __builtin_amdgcn_readfirstlane(s_rank);
  sc.ok = 0;
  if (ph_begin <= 0 && 0 < ph_end) {
    phase_prep(p, smem);
    if (1 < ph_end) grid.sync();
  }
  {
    int ok = (gridDim.x == 512);
#pragma unroll
    for (int i = 0; i < 8; i++) ok &= (__atomic_load_n(&cnt[i], __ATOMIC_RELAXED) == 64u);
    sc.ok = ok;
  }
  run_layer<0>(sc, ph_begin, ph_end, smem, xb);
  run_layer<1>(sc, ph_begin, ph_end, smem, xb);
}

extern "C" void kernel_launch(void* const* d_in, const int* in_sizes, int n_in, void* d_out, int out_size, void* d_ws, size_t ws_size,
                              hipStream_t stream) {
  static int grid_blocks = 0;
  if (!grid_blocks) {
    int dev = 0, cus = 0, per_cu = 0;
    (void)hipGetDevice(&dev);
    (void)hipDeviceGetAttribute(&cus, hipDeviceAttributeMultiprocessorCount, dev);
    (void)hipOccupancyMaxActiveBlocksPerMultiprocessor(&per_cu, fwd_megakernel, 256, 0);
    per_cu = 2;
    grid_blocks = cus * per_cu;
  }
  Params p{};
  const float** pp = (const float**)&p;
  for (int i = 0; i < 36; i++) pp[i] = (const float*)d_in[i];
  p.out = (float*)d_out;
  p.ws = (char*)d_ws;
  int ph_begin = 0, ph_end = 31;
  (void)hipMemsetAsync((char*)d_ws + WS_CNT, 0, 256 + 16384, stream);
  void* args[] = {&p, &ph_begin, &ph_end};
  hipError_t e = hipLaunchCooperativeKernel((void*)fwd_megakernel, dim3(grid_blocks), dim3(256), args, 0, stream);
  if (e != hipSuccess) fprintf(stderr, "cooperative launch failed: %s (grid %d)\n", hipGetErrorString(e), grid_blocks);
}
```

```cpp
#include <hip/hip_runtime.h>
#include <hip/hip_cooperative_groups.h>
#include <stdint.h>
#include <stdio.h>
namespace cg = cooperative_groups;

typedef unsigned short u16;
typedef short bf16x8 __attribute__((ext_vector_type(8)));
typedef short s16x4 __attribute__((ext_vector_type(4)));
typedef float f32x16 __attribute__((ext_vector_type(16)));
typedef __bf16 bfv2 __attribute__((ext_vector_type(2)));
typedef float fv2 __attribute__((ext_vector_type(2)));
typedef unsigned u32x4 __attribute__((ext_vector_type(4)));
#define DI __device__ __forceinline__
#define MFMA(a, b, c) __builtin_amdgcn_mfma_f32_32x32x16_bf16((a), (b), (c), 0, 0, 0)

constexpr int NP = 32768;
constexpr int NS = 2048;
constexpr int NTOK = NP + NS;
constexpr int NROWS = NP + 32 * 1088;
constexpr int INC = 2472;
constexpr float EPS = 1e-6f;
constexpr float LOG2E = 1.4426950408889634f;
constexpr int NITEM = 2048 + 128;
constexpr int LDA = 1088;
constexpr int LDW = 1088;
constexpr int LDW2 = 4160;
constexpr int LDWQ = 320;
constexpr int LDWKV = 192;
constexpr int LDH1 = 4160;
constexpr int LDVT = NROWS + 64;
constexpr int LDXV = 320;

constexpr size_t O_Y = 0;
constexpr size_t O_PCKV = 35651584;
constexpr size_t O_PKROPE = O_PCKV + 8388608;
constexpr size_t O_PC = O_PKROPE + 2097152;
constexpr size_t O_PN = O_PC + 262144;
constexpr size_t O_PM = O_PN + 2048;
constexpr size_t O_PCONV = O_PM + 16;
constexpr size_t O_PMEMK = O_PCONV + 12288;
constexpr size_t O_PMEMV = O_PMEMK + 1048576;
constexpr size_t O_SCKV = O_PMEMV + 1048576;
constexpr size_t O_SKROPE = O_SCKV + 524288;
constexpr size_t O_SC = O_SKROPE + 131072;
constexpr size_t O_SN = O_SC + 4194304;
constexpr size_t O_SM = O_SN + 32768;
constexpr size_t O_SCONV = O_SM + 256;

constexpr size_t W_IN = 0;
constexpr size_t W_Q = W_IN + 2560 * LDW;
constexpr size_t W_KV = W_Q + 768 * LDWQ;
constexpr size_t W_OUT = W_KV + 1024 * LDWKV;
constexpr size_t W_XQ = W_OUT + 1024 * LDW;
constexpr size_t W_XK = W_XQ + 1024 * LDW;
constexpr size_t W_XV = W_XK + 1024 * LDW;
constexpr size_t W_XO = W_XV + 1024 * LDW;
constexpr size_t W_FF1 = W_XO + 1024 * LDW;
constexpr size_t W_FF2 = W_FF1 + 4096 * LDW;
constexpr size_t W_LAYER = W_FF2 + 1024 * LDW2;

constexpr size_t WS_W = 0;
constexpr size_t WS_ACT = WS_W + 2 * W_LAYER * 2;
constexpr size_t WS_CKV = WS_ACT + (size_t)NTOK * LDA * 2;
constexpr size_t WS_KROPE = WS_CKV + (size_t)NROWS * 128 * 2;
constexpr size_t WS_RQ = WS_KROPE + (size_t)NROWS * 32 * 4;
constexpr size_t WS_GATES = WS_RQ + (size_t)NTOK * 4;
constexpr size_t WS_ROPE = WS_GATES + (size_t)NTOK * 8 * 4;
constexpr size_t WS_SCAL = WS_ROPE + (size_t)16384 * 16 * 8;
constexpr size_t WS_MST = WS_SCAL + (size_t)NITEM * 2 * 4;
constexpr size_t WS_NU = WS_MST + (size_t)NITEM * 4 + 256;
constexpr size_t WS_CNT = WS_NU + (size_t)NITEM * 128 * 4;
constexpr size_t WS_BAR = WS_CNT + 256;
constexpr size_t WS_HM = WS_BAR + 16384;
constexpr size_t WS_BIG = WS_HM + (size_t)512 * LDA * 2;
constexpr size_t B_P = 0;
constexpr size_t B_K = 0;
constexpr size_t B_VT = B_K + (size_t)8 * NROWS * 96 * 2;
constexpr size_t B_Q = B_VT + (size_t)8 * 64 * LDVT * 2;
constexpr size_t B_ST = B_Q + (size_t)NTOK * 768 * 2;
constexpr size_t B_XK = B_ST + (size_t)NITEM * 16384 * 2;
constexpr size_t B_XVT = B_XK + (size_t)34 * 4 * 256 * 256 * 2;
constexpr size_t B_END = B_XVT + (size_t)34 * 4 * 256 * LDXV * 2;
constexpr size_t B_QX = 0;
constexpr size_t B_H1 = 0;
static_assert((size_t)NTOK * INC * 2 <= B_Q, "p overlaps q");
static_assert((size_t)NTOK * LDH1 * 2 <= B_XK, "h1 overlaps xkv");
static_assert((size_t)NTOK * LDA * 2 <= B_Q, "qx overlaps q");
static_assert(WS_BIG + B_END <= (size_t)536870912, "workspace too large");
static_assert(WS_BIG % 256 == 0 && B_Q % 256 == 0 && B_ST % 256 == 0 && B_VT % 256 == 0, "align");

constexpr int SMEM_BYTES = 73728;
#ifndef REP_INPROJ
#define REP_INPROJ 1
#endif
#ifndef REP_C
#define REP_C 1
#endif
#ifndef REP_E
#define REP_E 1
#endif
#ifndef REP_F
#define REP_F 1
#endif
#ifndef REP_G
#define REP_G 1
#endif
#ifndef REP_K
#define REP_K 1
#endif
#ifndef REP_FF1
#define REP_FF1 1
#endif
#ifndef REP_NORM
#define REP_NORM 1
#endif

struct Params {
  const float* x_prompt; const float* x_sample; const float* cache_ckv; const float* cache_krope;
  const float* st_C; const float* st_n; const float* st_m; const float* st_conv;
  const float* cache_mem_k; const float* cache_mem_v; const float* mem_prompt;
  const float* g_mix; const float* w_in; const float* g_qa; const float* w_q_up; const float* g_qnorm; const float* g_kva;
  const float* w_kv_up; const float* g_knorm; const float* w_conv; const float* b_conv; const float* b_igate; const float* b_fgate;
  const float* g_mhead; const float* w_out; const float* g_xattn; const float* g_mem; const float* w_xq; const float* w_xk; const float* w_xv;
  const float* g_xq; const float* g_xk; const float* w_xo; const float* g_mlp; const float* w_ff1; const float* w_ff2;
  float* out; char* ws;
};

#define XB_TMO      128
#define XB_XCNT(j)  (256  + 64 * (j))
#define XB_XSUB(j)  (1280 + 64 * (j))
#define XB_XGEN(j)  (2304 + 64 * (j))
#define XB_TOP      3328
#define XB_TOPGEN   3392
#define XCD_BAR_WORDS 3456
#define XB_SPIN_CAP (1u << 18)
#define LAS __attribute__((address_space(3)))

__device__ __forceinline__ unsigned xb_ld(unsigned* p)              { return __hip_atomic_load(p, __ATOMIC_RELAXED, __HIP_MEMORY_SCOPE_AGENT); }
__device__ __forceinline__ unsigned xb_add(unsigned* p, unsigned v) { return __hip_atomic_fetch_add(p, v, __ATOMIC_RELAXED, __HIP_MEMORY_SCOPE_AGENT); }
__device__ __forceinline__ unsigned xb_xcc_id() { return (unsigned)__builtin_amdgcn_s_getreg((3 << 11) | 20) & 0xFu; }
#define XB_SPIN(cond, bar) do { unsigned _sp = 0; while (cond) { __builtin_amdgcn_s_sleep(1); \
    if ((++_sp & 255u) == 0u) { if (xb_ld(&(bar)[XB_TMO])) break; if (_sp > XB_SPIN_CAP) { atomicAdd(&(bar)[XB_TMO], 1u); break; } } } } while (0)

struct XcdBarrier {
    unsigned* bar; unsigned x;
    volatile LAS unsigned* st;
};

__device__ __forceinline__ XcdBarrier xcd_barrier_post(unsigned* bar, volatile LAS unsigned* st) {
    XcdBarrier b; b.bar = bar; b.x = xb_xcc_id(); b.st = st;
    if (threadIdx.x == 0) (void)xb_add(&bar[XB_XCNT(b.x)], 1u);
    return b;
}
__device__ __forceinline__ void xcd_barrier_complete(unsigned* bar, unsigned x, unsigned& nloc, unsigned& nx) {
    const unsigned G = gridDim.x * gridDim.y * gridDim.z;
    unsigned sum, cnt, mine, sp = 0u;
    for (;;) {
        sum = 0u; cnt = 0u; mine = 0u;
#pragma unroll
        for (unsigned j = 0; j < 16; ++j) { const unsigned c = xb_ld(&bar[XB_XCNT(j)]); sum += c; cnt += (c > 0u) ? 1u : 0u; mine = (j == x) ? c : mine; }
        if (sum == G) break;
        __builtin_amdgcn_s_sleep(1);
        if ((++sp & 255u) == 0u) { if (xb_ld(&bar[XB_TMO])) break; if (sp > XB_SPIN_CAP) { atomicAdd(&bar[XB_TMO], 1u); break; } }
    }
    nloc = mine > 0u ? mine : 1u; nx = cnt > 0u ? cnt : 1u;
}

__device__ __forceinline__ void xcd_barrier(const XcdBarrier& b) {
    asm volatile("s_waitcnt vmcnt(0)" ::: "memory");
    __syncthreads();
    if (threadIdx.x == 0) {
        unsigned* bar = b.bar;
        __builtin_amdgcn_s_waitcnt(0);
        unsigned nloc = b.st[0], nx = b.st[1];
        if (nloc == 0u) { xcd_barrier_complete(bar, b.x, nloc, nx); b.st[0] = nloc; b.st[1] = nx; }
        const unsigned old = xb_add(&bar[XB_XSUB(b.x)], 1u);
        const unsigned gen = old / nloc;
        if (old + 1u == (gen + 1u) * nloc) {
            __builtin_amdgcn_fence(__ATOMIC_RELEASE, "agent");
            asm volatile("s_waitcnt vmcnt(0)" ::: "memory");
            const unsigned og = xb_add(&bar[XB_TOP], 1u);
            const unsigned tg = og / nx;
            if (og + 1u == (tg + 1u) * nx) xb_add(&bar[XB_TOPGEN], 1u);
            else XB_SPIN(xb_ld(&bar[XB_TOPGEN]) == tg, bar);
            __builtin_amdgcn_fence(__ATOMIC_ACQUIRE, "agent");
            xb_add(&bar[XB_XGEN(b.x)], 1u);
            asm volatile("s_waitcnt vmcnt(0)" ::: "memory");
        } else {
            XB_SPIN(xb_ld(&bar[XB_XGEN(b.x)]) == gen, bar);
            __builtin_amdgcn_fence(__ATOMIC_ACQUIRE, "agent");
            asm volatile("s_waitcnt vmcnt(0)" ::: "memory");
        }
    }
    __syncthreads();
}


struct Sched { int xg, xi, ok; };
DI int tidx() { int t = (int)threadIdx.x; asm volatile("" : "+v"(t)); return t; }
DI unsigned pk2(float a, float b) { fv2 v = {a, b}; bfv2 r = __builtin_convertvector(v, bfv2); return __builtin_bit_cast(unsigned, r); }
DI u16 f2bf(float a) { return (u16)(pk2(a, 0.f) & 0xffffu); }
DI float bf2f(u16 v) { return __uint_as_float(((unsigned)v) << 16); }
DI float bflo(unsigned v) { return __uint_as_float(v << 16); }
DI float bfhi(unsigned v) { return __uint_as_float(v & 0xffff0000u); }
DI int crow(int i, int h) { return (i & 3) + 8 * (i >> 2) + 4 * h; }
DI float xhalf_max(float v) {
  unsigned u = __float_as_uint(v);
  auto rr = __builtin_amdgcn_permlane32_swap(u, u, false, false);
  return fmaxf(__uint_as_float(rr[0]), __uint_as_float(rr[1]));
}
DI float xhalf_sum(float v) {
  unsigned u = __float_as_uint(v);
  auto rr = __builtin_amdgcn_permlane32_swap(u, u, false, false);
  return __uint_as_float(rr[0]) + __uint_as_float(rr[1]);
}
DI float wave_sum(float v) {
#pragma unroll
  for (int o = 32; o >= 1; o >>= 1) v += __shfl_xor(v, o);
  return v;
}
DI float wave_max(float v) {
#pragma unroll
  for (int o = 32; o >= 1; o >>= 1) v = fmaxf(v, __shfl_xor(v, o));
  return v;
}
DI void unpack8(uint4 v, float (&x)[8]) {
  x[0] = bflo(v.x); x[1] = bfhi(v.x); x[2] = bflo(v.y); x[3] = bfhi(v.y);
  x[4] = bflo(v.z); x[5] = bfhi(v.z); x[6] = bflo(v.w); x[7] = bfhi(v.w);
}
DI uint4 pack8(const float (&x)[8]) {
  uint4 v; v.x = pk2(x[0], x[1]); v.y = pk2(x[2], x[3]); v.z = pk2(x[4], x[5]); v.w = pk2(x[6], x[7]); return v;
}
DI u16* wsb(const Params& p, size_t off) { return (u16*)(p.ws + off); }
DI float* wsf(const Params& p, size_t off) { return (float*)(p.ws + off); }
DI const float* xrow(const Params& p, int l, int tok) {
  if (l == 0) return tok < NP ? p.x_prompt + (size_t)tok * 1024 : p.x_sample + (size_t)(tok - NP) * 1024;
  return p.out + (size_t)tok * 1024;
}
DI int tok_pos(int tok) { return tok < NP ? (tok & 16383) : 1024 + ((tok - NP) & 63); }

template <int TM, int TN>
DI void gemm_mainloop(const u16* __restrict__ A, long lda, const u16* __restrict__ Bt, long ldb, int K, char* smem,
                      f32x16 (&acc)[TM][TN]) {
  constexpr int BM = 64 * TM, BN = 64 * TN, LD = 72;
  u16* sA = (u16*)smem;
  u16* sB = sA + 2 * BM * LD;
  const int tid = tidx(), lane = tid & 63, w = tid >> 6, r = lane & 31, h = lane >> 5;
  const int wm = w >> 1, wn = w & 1;
  constexpr int NA = BM / 32, NB = BN / 32;
  u32x4 ra[NA], rb[NB];
#pragma unroll
  for (int tm = 0; tm < TM; tm++)
#pragma unroll
    for (int tn = 0; tn < TN; tn++)
#pragma unroll
      for (int i = 0; i < 16; i++) acc[tm][tn][i] = 0.f;
  const int nk = K / 64;
  const int lrow = tid >> 3, lch = (tid & 7) * 8;
  const u16* gA = A + (long)lrow * lda + lch;
  const u16* gB = Bt + (long)lrow * ldb + lch;
  const int soff = lrow * LD + lch;
#define GEMM_GLOAD(k0)                                                                   \
  {                                                                                      \
    _Pragma("unroll") for (int i = 0; i < NA; i++) ra[i] = *(const u32x4*)(gA + (long)(32 * i) * lda + (k0)); \
    _Pragma("unroll") for (int i = 0; i < NB; i++) rb[i] = *(const u32x4*)(gB + (long)(32 * i) * ldb + (k0)); \
  }
#define GEMM_SSTORE(buf)                                                                 \
  {                                                                                      \
    _Pragma("unroll") for (int i = 0; i < NA; i++) *(u32x4*)(sA + (buf) * BM * LD + soff + 32 * i * LD) = ra[i]; \
    _Pragma("unroll") for (int i = 0; i < NB; i++) *(u32x4*)(sB + (buf) * BN * LD + soff + 32 * i * LD) = rb[i]; \
  }
  GEMM_GLOAD(0)
  __syncthreads();
  GEMM_SSTORE(0)
  if (nk > 1) GEMM_GLOAD(64)
  __syncthreads();
  for (int kt = 0; kt < nk; kt++) {
    const int buf = kt & 1;
    const u16* cA = sA + buf * BM * LD + (wm * 32 * TM + r) * LD + h * 8;
    const u16* cB = sB + buf * BN * LD + (wn * 32 * TN + r) * LD + h * 8;
    bf16x8 af[TM], bfr[TN];
#pragma unroll
    for (int tm = 0; tm < TM; tm++) af[tm] = *(const bf16x8*)(cA + tm * 32 * LD);
#pragma unroll
    for (int tn = 0; tn < TN; tn++) bfr[tn] = *(const bf16x8*)(cB + tn * 32 * LD);
    if (kt + 1 < nk) GEMM_SSTORE(buf ^ 1)
    __builtin_amdgcn_sched_barrier(0);
    __builtin_amdgcn_s_setprio(1);
#pragma unroll
    for (int tm = 0; tm < TM; tm++)
#pragma unroll
      for (int tn = 0; tn < TN; tn++) acc[tm][tn] = MFMA(af[tm], bfr[tn], acc[tm][tn]);
#pragma unroll
    for (int tm = 0; tm < TM; tm++) af[tm] = *(const bf16x8*)(cA + tm * 32 * LD + 16);
#pragma unroll
    for (int tn = 0; tn < TN; tn++) bfr[tn] = *(const bf16x8*)(cB + tn * 32 * LD + 16);
#pragma unroll
    for (int tm = 0; tm < TM; tm++)
#pragma unroll
      for (int tn = 0; tn < TN; tn++) acc[tm][tn] = MFMA(af[tm], bfr[tn], acc[tm][tn]);
    __builtin_amdgcn_sched_barrier(0);
    if (kt + 2 < nk) GEMM_GLOAD((kt + 2) * 64)
    __builtin_amdgcn_sched_barrier(0);
#pragma unroll
    for (int ks = 2; ks < 4; ks++) {
#pragma unroll
      for (int tm = 0; tm < TM; tm++) af[tm] = *(const bf16x8*)(cA + tm * 32 * LD + ks * 16);
#pragma unroll
      for (int tn = 0; tn < TN; tn++) bfr[tn] = *(const bf16x8*)(cB + tn * 32 * LD + ks * 16);
#pragma unroll
      for (int tm = 0; tm < TM; tm++)
#pragma unroll
        for (int tn = 0; tn < TN; tn++) acc[tm][tn] = MFMA(af[tm], bfr[tn], acc[tm][tn]);
    }
    __builtin_amdgcn_s_setprio(0);
    __syncthreads();
  }
#undef GEMM_GLOAD
#undef GEMM_SSTORE
}

template <int TM, int TN, class Epi>
DI void gemm_tile(const u16* A, long lda, const u16* Bt, long ldb, int K, int m0, int n0, char* smem, const Epi& epi) {
  constexpr int BM = 64 * TM, BN = 64 * TN, LDC = BN + Epi::PAD;
  f32x16 acc[TM][TN];
  gemm_mainloop<TM, TN>(A + (long)m0 * lda, lda, Bt + (long)n0 * ldb, ldb, K, smem, acc);
  const int tid = tidx(), lane = tid & 63, w = tid >> 6, r = lane & 31, h = lane >> 5;
  const int wm = w >> 1, wn = w & 1;
  float* Ct = (float*)smem;
#pragma unroll
  for (int tm = 0; tm < TM; tm++)
#pragma unroll
    for (int tn = 0; tn < TN; tn++)
#pragma unroll
      for (int i = 0; i < 16; i++)
        Ct[(wm * 32 * TM + tm * 32 + crow(i, h)) * LDC + wn * 32 * TN + tn * 32 + r] = acc[tm][tn][i];
  __syncthreads();
  epi(Ct, LDC, m0, n0, tid);
  __syncthreads();
  (void)BM;
}

struct EpiStoreBf16 {
  static constexpr int PAD = 4;
  u16* out; long ldo; int nmax; float* gates;
  DI void operator()(const float* Ct, int ldc, int m0, int n0, int tid) const {
#pragma unroll
    for (int it = 0; it < 8; it++) {
      int id = tid + 256 * it; int row = id >> 4, c8 = (id & 15) * 8;
      int n = n0 + c8;
      if (n < nmax) {
        const float* c = Ct + row * ldc + c8;
        float4 a = *(const float4*)c, b = *(const float4*)(c + 4);
        uint4 v; v.x = pk2(a.x, a.y); v.y = pk2(a.z, a.w); v.z = pk2(b.x, b.y); v.w = pk2(b.z, b.w);
        *(uint4*)(out + (long)(m0 + row) * ldo + n) = v;
        if (gates != nullptr && n == 1952) {
          float* g = gates + (long)(m0 + row) * 8;
          *(float4*)g = a; *(float4*)(g + 4) = b;
        }
      }
    }
  }
};
struct EpiRelu2 {
  static constexpr int PAD = 4;
  u16* out; long ldo;
  DI void operator()(const float* Ct, int ldc, int m0, int n0, int tid) const {
#pragma unroll
    for (int it = 0; it < 8; it++) {
      int id = tid + 256 * it; int row = id >> 4, c8 = (id & 15) * 8;
      const float* c = Ct + row * ldc + c8;
      float x[8];
#pragma unroll
      for (int j = 0; j < 8; j++) { float v = fmaxf(c[j], 0.f); x[j] = v * v; }
      *(uint4*)(out + (long)(m0 + row) * ldo + n0 + c8) = pack8(x);
    }
  }
};
struct EpiF32 {
  static constexpr int PAD = 4;
  float* out; long ldo;
  DI void operator()(const float* Ct, int ldc, int m0, int n0, int tid) const {
#pragma unroll
    for (int it = 0; it < 8; it++) {
      int id = tid + 256 * it; int row = id >> 4, c8 = (id & 15) * 8;
      const float* c = Ct + row * ldc + c8;
      float* o = out + (long)(m0 + row) * ldo + n0 + c8;
      *(float4*)o = *(const float4*)c; *(float4*)(o + 4) = *(const float4*)(c + 4);
    }
  }
};
struct EpiRes {
  static constexpr int PAD = 4;
  const float* src0; const float* src1; float* dst;
  DI void operator()(const float* Ct, int ldc, int m0, int n0, int tid) const {
#pragma unroll
    for (int it = 0; it < 8; it++) {
      int id = tid + 256 * it; int row = id >> 4, c8 = (id & 15) * 8;
      int m = m0 + row;
      const float* s = (m < NP ? src0 + (size_t)m * 1024 : src1 + (size_t)(m - NP) * 1024) + n0 + c8;
      const float* c = Ct + row * ldc + c8;
      float4 a = *(const float4*)c, b = *(const float4*)(c + 4);
      float4 sa = *(const float4*)s, sb = *(const float4*)(s + 4);
      a.x += sa.x; a.y += sa.y; a.z += sa.z; a.w += sa.w; b.x += sb.x; b.y += sb.y; b.z += sb.z; b.w += sb.w;
      float* o = dst + (size_t)m * 1024 + n0 + c8;
      *(float4*)o = a; *(float4*)(o + 4) = b;
    }
  }
};
struct EpiQ {
  static constexpr int PAD = 1;
  u16* q; const float* rq; const float2* rope; const float* g;
  DI void operator()(const float* Ct, int ldc, int m0, int n0, int tid) const {
    float* r2s = (float*)((char*)Ct + 60000);
    {
      const int row = tid >> 2, hh = (tid >> 1) & 1, half = tid & 1; const int m = m0 + row;
      const float* c = Ct + row * ldc + hh * 96 + half * 48;
      float ss = 0.f;
#pragma unroll 8
      for (int d = 0; d < 48; d++) ss += c[d] * c[d];
      ss += __shfl_xor(ss, 1);
      const float rqv = rq[m];
      ss *= rqv * rqv;
      if (half == 0) r2s[row * 2 + hh] = rsqrtf(ss * (1.f / 96.f) + EPS) * rqv * (0.10206207261596575f * LOG2E);
    }
    __syncthreads();
#pragma unroll
    for (int it = 0; it < 6; it++) {
      const int id = tid + 256 * it; const int row = id / 24, cc = id % 24; const int hh = cc / 12, c8 = cc % 12;
      const int m = m0 + row;
      const float* c = Ct + row * ldc + hh * 96;
      const float r2 = r2s[row * 2 + hh];
      float x[8];
      if (c8 < 8) {
#pragma unroll
        for (int jj = 0; jj < 8; jj++) x[jj] = c[c8 * 8 + jj] * r2 * g[c8 * 8 + jj];
      } else {
        const int half = c8 & 1;
        const bool second = c8 >= 10;
        const float2* tab = rope + (size_t)tok_pos(m) * 16 + half * 8;
#pragma unroll
        for (int jj = 0; jj < 8; jj++) {
          const int i = half * 8 + jj;
          const float a = c[64 + i], b = c[80 + i]; const float2 cs = tab[jj];
          const float v = second ? (a * cs.y + b * cs.x) : (a * cs.x - b * cs.y);
          x[jj] = v * r2 * g[(second ? 80 : 64) + i];
        }
      }
      *(uint4*)(q + (size_t)m * 768 + n0 + cc * 8) = pack8(x);
    }
  }
};
struct EpiKV {
  static constexpr int PAD = 1;
  u16* Kb; u16* Vt; const float* krope; const float* g;
  DI void operator()(const float* Ct, int ldc, int m0, int n0, int tid) const {
    const int hd = n0 >> 7;
#pragma unroll
    for (int it = 0; it < 4; it++) {
      int id = tid + 256 * it; int oct = id & 15, e = id >> 4;
      float x[8];
#pragma unroll
      for (int j = 0; j < 8; j++) x[j] = Ct[(16 * (oct >> 1) + 4 * (oct & 1) + (j & 3) + 8 * (j >> 2)) * ldc + 64 + e];
      *(uint4*)(Vt + (size_t)(hd * 64 + e) * LDVT + m0 + oct * 8) = pack8(x);
    }
    float* rrs = (float*)((char*)Ct + 66560);
    {
      const int row = tid >> 1, half = tid & 1;
      const float* c = Ct + row * ldc + half * 32;
      const float* kr = krope + (size_t)(m0 + row) * 32 + half * 16;
      float ss = 0.f;
#pragma unroll 8
      for (int d = 0; d < 32; d++) ss += c[d] * c[d];
#pragma unroll 8
      for (int d = 0; d < 16; d++) ss += kr[d] * kr[d];
      ss += __shfl_xor(ss, 1);
      if (half == 0) rrs[row] = rsqrtf(ss * (1.f / 96.f) + EPS);
    }
    __syncthreads();
    u16* ob = Kb + ((size_t)hd * NROWS + m0) * 96;
#pragma unroll
    for (int it = 0; it < 6; it++) {
      const int id = tid + 256 * it; const int row = id / 12, cc = id % 12;
      const float rr = rrs[row];
      float x[8];
      if (cc < 8) {
        const float* c = Ct + row * ldc + cc * 8;
#pragma unroll
        for (int jj = 0; jj < 8; jj++) x[jj] = c[jj] * rr * g[cc * 8 + jj];
      } else {
        const float* kr = krope + (size_t)(m0 + row) * 32 + (cc - 8) * 8;
#pragma unroll
        for (int jj = 0; jj < 8; jj++) x[jj] = kr[jj] * rr * g[cc * 8 + jj];
      }
      *(uint4*)(ob + (size_t)id * 8) = pack8(x);
    }
  }
};

template <int DQK, int NE, int EV, bool DB, bool QNORM, bool QREG, bool VPERM = false>
DI void flash_item(const u16* Qrow, bool wave_active, int ntb, int ntw, const u16* Kbase, long ldk, const u16* Vtbase, long ldv,
                   int e0, u16* Orow, char* smem) {
  constexpr int LDK = DQK + 8, LDV = 72;
  constexpr int KS = DQK / 16;
  constexpr int KTILE = 64 * LDK, VTILE = EV * LDV;
  constexpr int NKC = 64 * (DQK / 8) / 256;
  constexpr int NVC = EV * 8 / 256;
  u16* sK = (u16*)smem;
  u16* sV = sK + (DB ? 2 : 1) * KTILE;
  const int tid = tidx(), lane = tid & 63, r = lane & 31, h = lane >> 5;
  bf16x8 qf[QREG ? KS : 1];
  float rqs = 1.f;
  if (wave_active) {
    if (QREG) {
#pragma unroll
      for (int ks = 0; ks < KS; ks++) qf[QREG ? ks : 0] = *(const bf16x8*)(Qrow + ks * 16 + h * 8);
    }
    if (QNORM) {
      float ss = 0.f;
#pragma unroll
      for (int ks = 0; ks < KS; ks++) {
        bf16x8 qq = QREG ? qf[QREG ? ks : 0] : *(const bf16x8*)(Qrow + ks * 16 + h * 8);
#pragma unroll
        for (int j = 0; j < 8; j++) { float v = bf2f((u16)qq[j]); ss += v * v; }
      }
      ss = xhalf_sum(ss);
      rqs = rsqrtf(ss * (1.f / DQK) + EPS);
    }
  } else if (QREG) {
#pragma unroll
    for (int ks = 0; ks < KS; ks++)
#pragma unroll
      for (int j = 0; j < 8; j++) qf[QREG ? ks : 0][j] = 0;
  }
  f32x16 o[NE];
#pragma unroll
  for (int et = 0; et < NE; et++)
#pragma unroll
    for (int i = 0; i < 16; i++) o[et][i] = 0.f;
  float mrun = 0.f, lrun = 0.f;
  const float rqinv = __builtin_amdgcn_rcpf(rqs);

  u32x4 rk[DB ? NKC : 1], rv[DB ? NVC : 1];
  auto gload = [&](int t) {
#pragma unroll
    for (int i = 0; i < NKC; i++) {
      int id = tid + 256 * i; int row = id / (DQK / 8), ch = id % (DQK / 8);
      u32x4 v = *(const u32x4*)(Kbase + (long)(t * 64 + row) * ldk + ch * 8);
      if (DB) rk[DB ? i : 0] = v; else *(u32x4*)(sK + row * LDK + ch * 8) = v;
    }
#pragma unroll
    for (int i = 0; i < NVC; i++) {
      int id = tid + 256 * i; int row = id >> 3, ch = id & 7;
      u32x4 v = *(const u32x4*)(Vtbase + (long)row * ldv + t * 64 + ch * 8);
      if (DB) rv[DB ? i : 0] = v; else *(u32x4*)(sV + row * LDV + ch * 8) = v;
    }
  };
  auto sstore = [&](int buf) {
#pragma unroll
    for (int i = 0; i < NKC; i++) { int id = tid + 256 * i; int row = id / (DQK / 8), ch = id % (DQK / 8); *(u32x4*)(sK + buf * KTILE + row * LDK + ch * 8) = rk[DB ? i : 0]; }
#pragma unroll
    for (int i = 0; i < NVC; i++) { int id = tid + 256 * i; int row = id >> 3, ch = id & 7; *(u32x4*)(sV + buf * VTILE + row * LDV + ch * 8) = rv[DB ? i : 0]; }
  };
  auto compute = [&](int buf) {
    const u16* cK = sK + buf * KTILE + r * LDK + h * 8;
    const u16* cV = sV + buf * VTILE + (e0 + r) * LDV + 4 * h;
    const float sinit = QNORM ? -mrun * rqinv : -mrun;
    f32x16 s[2];
#pragma unroll
    for (int sub = 0; sub < 2; sub++) {
#pragma unroll
      for (int i = 0; i < 16; i++) s[sub][i] = sinit;
#pragma unroll
      for (int ks = 0; ks < KS; ks++) {
        bf16x8 a = *(const bf16x8*)(cK + sub * 32 * LDK + ks * 16);
        bf16x8 qq = QREG ? qf[QREG ? ks : 0] : *(const bf16x8*)(Qrow + ks * 16 + h * 8);
        s[sub] = MFMA(a, qq, s[sub]);
      }
    }
    float mx = -1e30f;
#pragma unroll
    for (int sub = 0; sub < 2; sub++)
#pragma unroll
      for (int i = 0; i < 16; i++) { if (QNORM) s[sub][i] *= rqs; mx = fmaxf(mx, s[sub][i]); }
    mx = xhalf_max(mx);
    if (__any(mx > 8.f)) {
      const float d = fmaxf(mx, 0.f);
      const float alpha = __builtin_amdgcn_exp2f(-d);
      mrun += d;
      lrun *= alpha;
#pragma unroll
      for (int et = 0; et < NE; et++)
#pragma unroll
        for (int i = 0; i < 16; i++) o[et][i] *= alpha;
#pragma unroll
      for (int sub = 0; sub < 2; sub++)
#pragma unroll
        for (int i = 0; i < 16; i++) s[sub][i] -= d;
    }
    float psum = 0.f;
#pragma unroll
    for (int sub = 0; sub < 2; sub++)
#pragma unroll
      for (int i = 0; i < 16; i++) { float pv = __builtin_amdgcn_exp2f(s[sub][i]); s[sub][i] = pv; psum += pv; }
    lrun += psum;
#pragma unroll
    for (int sub = 0; sub < 2; sub++)
#pragma unroll
      for (int st = 0; st < 2; st++) {
        uint4 pp;
        pp.x = pk2(s[sub][8 * st + 0], s[sub][8 * st + 1]); pp.y = pk2(s[sub][8 * st + 2], s[sub][8 * st + 3]);
        pp.z = pk2(s[sub][8 * st + 4], s[sub][8 * st + 5]); pp.w = pk2(s[sub][8 * st + 6], s[sub][8 * st + 7]);
        bf16x8 pb = __builtin_bit_cast(bf16x8, pp);
#pragma unroll
        for (int et = 0; et < NE; et++) {
          bf16x8 a;
          if (VPERM) {
            a = *(const bf16x8*)(sV + buf * VTILE + (e0 + et * 32 + r) * LDV + sub * 32 + st * 16 + 8 * h);
          } else {
            const u16* vp = cV + et * 32 * LDV + sub * 32 + st * 16;
            s16x4 lo = *(const s16x4*)vp;
            s16x4 hi = *(const s16x4*)(vp + 8);
            a = __builtin_shufflevector(lo, hi, 0, 1, 2, 3, 4, 5, 6, 7);
          }
          o[et] = MFMA(a, pb, o[et]);
        }
      }
  };

  __syncthreads();
  if (DB) {
    gload(0);
    sstore(0);
    __syncthreads();
    for (int t = 0; t < ntb; t++) {
      const bool more = (t + 1 < ntb);
      if (more) gload(t + 1);
      __builtin_amdgcn_sched_barrier(0);
      if (wave_active && t < ntw) { __builtin_amdgcn_s_setprio(1); compute(t & 1); __builtin_amdgcn_s_setprio(0); }
      if (more) sstore((t + 1) & 1);
      __syncthreads();
    }
  } else {
    for (int t = 0; t < ntb; t++) {
      if (t > 0) __syncthreads();
      gload(t);
      __syncthreads();
      if (wave_active && t < ntw) compute(0);
    }
    __syncthreads();
  }
  if (wave_active) {
    float lt = xhalf_sum(lrun);
    float inv = __builtin_amdgcn_rcpf(lt);
#pragma unroll
    for (int et = 0; et < NE; et++)
#pragma unroll
      for (int g = 0; g < 4; g++) {
        uint2 v;
        v.x = pk2(o[et][4 * g + 0] * inv, o[et][4 * g + 1] * inv);
        v.y = pk2(o[et][4 * g + 2] * inv, o[et][4 * g + 3] * inv);
        *(uint2*)(Orow + et * 32 + 8 * g + 4 * h) = v;
      }
  }
}

DI void norm_row_wave(const float* src, u16* dst, int lane) {
  float4 v[4]; float ss = 0.f;
#pragma unroll
  for (int i = 0; i < 4; i++) { v[i] = *(const float4*)(src + i * 256 + lane * 4); ss += v[i].x * v[i].x + v[i].y * v[i].y + v[i].z * v[i].z + v[i].w * v[i].w; }
  ss = wave_sum(ss);
  float rr = rsqrtf(ss * (1.f / 1024.f) + EPS);
#pragma unroll
  for (int i = 0; i < 4; i++) {
    uint2 o; o.x = pk2(v[i].x * rr, v[i].y * rr); o.y = pk2(v[i].z * rr, v[i].w * rr);
    *(uint2*)(dst + i * 256 + lane * 4) = o;
  }
}

DI void phase_norm(const Params& p, int l) {
  const int lane = tidx() & 63, w = tidx() >> 6;
  u16* act = wsb(p, WS_ACT);
  for (int t = blockIdx.x * 4 + w; t < NTOK; t += gridDim.x * 4) norm_row_wave(xrow(p, l, t), act + (size_t)t * LDA, lane);
}

DI void wtile(const float* src, const float* gain, int K, int N, u16* dst, int ldd, int k0, int n0, char* smem) {
  u16* T = (u16*)smem;
  const int tid = tidx();
  __syncthreads();
  {
    const int nn = tid & 63, kk0 = tid >> 6;
    const int n = n0 + nn;
#pragma unroll 4
    for (int i = 0; i < 16; i++) {
      int kk = kk0 + 4 * i;
      float v = 0.f;
      if (n < N) { v = src[(size_t)(k0 + kk) * N + n]; if (gain) v *= gain[k0 + kk]; }
      T[nn * 72 + kk] = f2bf(v);
    }
  }
  __syncthreads();
  {
    const int nn = tid >> 2, kq = tid & 3;
    const uint4* s = (const uint4*)(T + nn * 72 + kq * 16);
    uint4* d = (uint4*)(dst + (size_t)(n0 + nn) * ldd + k0 + kq * 16);
    d[0] = s[0]; d[1] = s[1];
  }
}

DI void phase_prep(const Params& p, char* smem) {
  const int tid = tidx(), lane = tid & 63, w = tid >> 6;
  for (int t = blockIdx.x; t < 2 * 4048; t += gridDim.x) {
    int l = t / 4048, u = t % 4048;
    const float* src; const float* gain = nullptr; int K, N, Npad; size_t doff; int ldd = LDW;
    if (u < 640) { src = p.w_in + (size_t)l * 1024 * INC; gain = p.g_mix + l * 1024; K = 1024; N = INC; Npad = 2560; doff = W_IN; }
    else if (u < 688) { u -= 640; src = p.w_q_up + (size_t)l * 256 * 768; gain = p.g_qa + l * 256; K = 256; N = 768; Npad = 768; doff = W_Q; ldd = LDWQ; }
    else if (u < 720) { u -= 688; src = p.w_kv_up + (size_t)l * 128 * 1024; K = 128; N = 1024; Npad = 1024; doff = W_KV; ldd = LDWKV; }
    else if (u < 976) { u -= 720; src = p.w_out + (size_t)l * 1048576; K = 1024; N = 1024; Npad = 1024; doff = W_OUT; }
    else if (u < 1232) { u -= 976; src = p.w_xq + (size_t)l * 1048576; gain = p.g_xattn + l * 1024; K = 1024; N = 1024; Npad = 1024; doff = W_XQ; }
    else if (u < 1488) { u -= 1232; src = p.w_xk + (size_t)l * 1048576; gain = p.g_mem + l * 1024; K = 1024; N = 1024; Npad = 1024; doff = W_XK; }
    else if (u < 1744) { u -= 1488; src = p.w_xv + (size_t)l * 1048576; gain = p.g_mem + l * 1024; K = 1024; N = 1024; Npad = 1024; doff = W_XV; }
    else if (u < 2000) { u -= 1744; src = p.w_xo + (size_t)l * 1048576; K = 1024; N = 1024; Npad = 1024; doff = W_XO; }
    else if (u < 3024) { u -= 2000; src = p.w_ff1 + (size_t)l * 4194304; gain = p.g_mlp + l * 1024; K = 1024; N = 4096; Npad = 4096; doff = W_FF1; }
    else { u -= 3024; src = p.w_ff2 + (size_t)l * 4194304; K = 4096; N = 1024; Npad = 1024; doff = W_FF2; ldd = LDW2; }
    int nt = Npad / 64;
    int kt = u / nt, ntile = u % nt;
    wtile(src, gain, K, N, wsb(p, WS_W) + (size_t)l * W_LAYER + doff, ldd, kt * 64, ntile * 64, smem);
  }
  float2* tab = (float2*)(p.ws + WS_ROPE);
  for (int t = blockIdx.x; t < 1024; t += gridDim.x) {
    int idx = t * 256 + tid; int pos = idx >> 4, i = idx & 15;
    float inv_freq = __builtin_amdgcn_exp2f(-(float)i * 0.830482023721841f);
    float ang = (float)pos * inv_freq;
    double rev = (double)ang * 0.15915494309189535;
    rev -= rint(rev);
    float fr = (float)rev;
    tab[idx] = make_float2(__builtin_amdgcn_cosf(fr), __builtin_amdgcn_sinf(fr));
  }
  u16* hm = wsb(p, WS_HM);
  for (int t = blockIdx.x * 4 + w; t < 512; t += gridDim.x * 4) norm_row_wave(p.mem_prompt + (size_t)t * 1024, hm + (size_t)t * LDA, lane);
  phase_norm(p, 0);
}

template <class Epi>
DI void phase_gemm128(const Sched& sc, const u16* A, long lda, const u16* Bt, long ldb, int K, int MT, int NT, int SN, char* smem, const Epi& epi);
DI void phase_inproj(const Params& p, const Sched& sc, int l, char* smem) {
  const u16* W = wsb(p, WS_W) + (size_t)l * W_LAYER;
  {
    EpiStoreBf16 epi{wsb(p, WS_BIG + B_P), INC, INC, wsf(p, WS_GATES)};
    phase_gemm128(sc, wsb(p, WS_ACT), LDA, W + W_IN, LDW, 1024, 272, 20, 4, smem, epi);
  }
  if (l == 0) {
    for (int u = blockIdx.x; u < 128; u += gridDim.x) {
      int l2 = u >> 6, which = (u >> 5) & 1, mt = (u >> 3) & 3, nt = u & 7;
      const u16* W2 = wsb(p, WS_W) + (size_t)l2 * W_LAYER + (which ? W_XV : W_XK);
      EpiF32 epi{p.out + (which ? O_PMEMV : O_PMEMK) + (size_t)l2 * 524288, 1024};
      gemm_tile<2, 2>(wsb(p, WS_HM), LDA, W2, LDW, 1024, mt * 128, nt * 128, smem, epi);
    }
  }
}

DI void post_token(const Params& p, int l, int tok, int lane) {
  const u16* pr = wsb(p, WS_BIG + B_P) + (size_t)tok * INC;
  {
    uint2 q4 = *(const uint2*)(pr + lane * 4);
    float a = bflo(q4.x), b = bfhi(q4.x), c = bflo(q4.y), d = bfhi(q4.y);
    float ss = wave_sum(a * a + b * b + c * c + d * d);
    if (lane == 0) wsf(p, WS_RQ)[tok] = rsqrtf(ss * (1.f / 256.f) + EPS);
  }
  const bool prompt = tok < NP;
  int b, s, row, pos; float* ckv_out; float* kr_out;
  if (prompt) {
    b = tok >> 14; s = tok & 16383; row = tok; pos = s;
    ckv_out = p.out + O_PCKV + ((size_t)(l * 2 + b) * 16384 + s) * 128;
    kr_out = p.out + O_PKROPE + ((size_t)(l * 2 + b) * 16384 + s) * 32;
  } else {
    int t2 = tok - NP; b = t2 >> 6; s = t2 & 63; row = NP + b * 1088 + 1024 + s; pos = 1024 + s;
    ckv_out = p.out + O_SCKV + ((size_t)(l * 32 + b) * 64 + s) * 128;
    kr_out = p.out + O_SKROPE + ((size_t)(l * 32 + b) * 64 + s) * 32;
  }
  {
    unsigned c2 = *(const unsigned*)(pr + 256 + lane * 2);
    float c0 = bflo(c2), c1 = bfhi(c2);
    float ss = wave_sum(c0 * c0 + c1 * c1);
    float rr = rsqrtf(ss * (1.f / 128.f) + EPS);
    float o0 = c0 * rr * p.g_kva[l * 128 + lane * 2], o1 = c1 * rr * p.g_kva[l * 128 + lane * 2 + 1];
    *(float2*)(ckv_out + lane * 2) = make_float2(o0, o1);
    *(unsigned*)(wsb(p, WS_CKV) + (size_t)row * 128 + lane * 2) = pk2(o0, o1);
  }
  if (lane < 16) {
    float x1 = bf2f(pr[384 + lane]), x2 = bf2f(pr[400 + lane]);
    float2 cs = ((const float2*)(p.ws + WS_ROPE))[(size_t)pos * 16 + lane];
    float o1 = x1 * cs.x - x2 * cs.y, o2 = x1 * cs.y + x2 * cs.x;
    kr_out[lane] = o1; kr_out[16 + lane] = o2;
    float* ka = wsf(p, WS_KROPE) + (size_t)row * 32;
    ka[lane] = o1; ka[16 + lane] = o2;
  }
  const int S = prompt ? 16384 : 64;
  if (s >= S - 3) {
    int j = s - (S - 3);
    float* dst = prompt ? p.out + O_PCONV + ((size_t)(l * 2 + b) * 3 + j) * 1024 : p.out + O_SCONV + ((size_t)(l * 32 + b) * 3 + j) * 1024;
#pragma unroll 4
    for (int i = 0; i < 16; i++) dst[lane + 64 * i] = bf2f(pr[416 + lane + 64 * i]);
  }
}

DI void post_past(const Params& p, int l, int pi, int lane) {
  int b = pi >> 10, t = pi & 1023;
  size_t row = (size_t)NP + b * 1088 + t;
  const float* src = p.cache_ckv + ((size_t)(l * 32 + b) * 1024 + t) * 128;
  float2 v = *(const float2*)(src + lane * 2);
  *(unsigned*)(wsb(p, WS_CKV) + row * 128 + lane * 2) = pk2(v.x, v.y);
  if (lane < 32) wsf(p, WS_KROPE)[row * 32 + lane] = p.cache_krope[((size_t)(l * 32 + b) * 1024 + t) * 32 + lane];
}

struct ChunkInfo { int tok0, b, h, chain, has_prev, sample; };
DI ChunkInfo chunk_info(int item) {
  ChunkInfo ci;
  if (item < 2048) {
    ci.chain = item >> 8; ci.b = ci.chain >> 2; ci.h = ci.chain & 3; int c = item & 255;
    ci.tok0 = ci.b * 16384 + c * 64; ci.has_prev = (c > 0); ci.sample = 0;
  } else {
    int j = item - 2048; ci.chain = 8 + j; ci.b = j >> 2; ci.h = j & 3; ci.tok0 = NP + ci.b * 64; ci.has_prev = 0; ci.sample = 1;
  }
  return ci;
}
DI void load_x8(const Params& p, int l, const ChunkInfo& ci, int tp, int col, float (&x)[8]) {
  if (tp >= 0 || ci.has_prev) {
    uint4 v = *(const uint4*)(wsb(p, WS_BIG + B_P) + (size_t)(ci.tok0 + tp) * INC + col);
    unpack8(v, x);
  } else if (ci.sample) {
    const float* s = p.st_conv + (((size_t)l * 32 + ci.b) * 3 + (3 + tp)) * 1024 + (col - 416);
    float4 a = *(const float4*)s, b = *(const float4*)(s + 4);
    x[0] = a.x; x[1] = a.y; x[2] = a.z; x[3] = a.w; x[4] = b.x; x[5] = b.y; x[6] = b.z; x[7] = b.w;
  } else {
#pragma unroll
    for (int j = 0; j < 8; j++) x[j] = 0.f;
  }
}
template <class Emit>
DI void conv_run(const Params& p, int l, const ChunkInfo& ci, int mat, int chunk, int row0, int nrows, Emit emit) {
  const int ch0 = mat * 512 + ci.h * 128 + chunk * 8;
  const int col = 416 + ch0;
  float w0[8], w1[8], w2[8], w3[8], bias[8];
  {
    const float* wc = p.w_conv + (size_t)l * 4096 + ch0;
    float4 a, b;
    a = *(const float4*)(wc); b = *(const float4*)(wc + 4);
    w0[0] = a.x; w0[1] = a.y; w0[2] = a.z; w0[3] = a.w; w0[4] = b.x; w0[5] = b.y; w0[6] = b.z; w0[7] = b.w;
    a = *(const float4*)(wc + 1024); b = *(const float4*)(wc + 1028);
    w1[0] = a.x; w1[1] = a.y; w1[2] = a.z; w1[3] = a.w; w1[4] = b.x; w1[5] = b.y; w1[6] = b.z; w1[7] = b.w;
    a = *(const float4*)(wc + 2048); b = *(const float4*)(wc + 2052);
    w2[0] = a.x; w2[1] = a.y; w2[2] = a.z; w2[3] = a.w; w2[4] = b.x; w2[5] = b.y; w2[6] = b.z; w2[7] = b.w;
    a = *(const float4*)(wc + 3072); b = *(const float4*)(wc + 3076);
    w3[0] = a.x; w3[1] = a.y; w3[2] = a.z; w3[3] = a.w; w3[4] = b.x; w3[5] = b.y; w3[6] = b.z; w3[7] = b.w;
    const float* bc = p.b_conv + (size_t)l * 1024 + ch0;
    a = *(const float4*)(bc); b = *(const float4*)(bc + 4);
    bias[0] = a.x; bias[1] = a.y; bias[2] = a.z; bias[3] = a.w; bias[4] = b.x; bias[5] = b.y; bias[6] = b.z; bias[7] = b.w;
  }
  float xa[8], xb[8], xc[8], xd[8];
  load_x8(p, l, ci, row0 - 3, col, xa);
  load_x8(p, l, ci, row0 - 2, col, xb);
  load_x8(p, l, ci, row0 - 1, col, xc);
  for (int t = row0; t < row0 + nrows; t++) {
    load_x8(p, l, ci, t, col, xd);
    float y[8];
#pragma unroll
    for (int j = 0; j < 8; j++) {
      float v = bias[j] + xa[j] * w0[j] + xb[j] * w1[j] + xc[j] * w2[j] + xd[j] * w3[j];
      y[j] = v * __builtin_amdgcn_rcpf(1.f + __expf(-v));
      xa[j] = xb[j]; xb[j] = xc[j]; xc[j] = xd[j];
    }
    emit(t, y);
  }
}
DI float logsigmoid(float z) { return fminf(z, 0.f) - log1pf(__expf(-fabsf(z))); }

DI void mlstm_m1(const Params& p, int l, int item, char* smem) {
  const ChunkInfo ci = chunk_info(item);
  const int tid = tidx(), lane = tid & 63, w = tid >> 6, r = lane & 31, h = lane >> 5;
  u16* sVt = (u16*)smem;
  u16* sKt = sVt + 128 * 72;
  float* swk = (float*)(sKt + 128 * 72);
  __syncthreads();
  if (w == 0) {
    const float* g = wsf(p, WS_GATES) + (size_t)(ci.tok0 + lane) * 8;
    float ig = g[ci.h] + p.b_igate[l * 4 + ci.h];
    float lf = logsigmoid(g[4 + ci.h] + p.b_fgate[l * 4 + ci.h]);
    float bcs = lf;
#pragma unroll
    for (int o = 1; o < 64; o <<= 1) { float t = __shfl_up(bcs, o); if (lane >= o) bcs += t; }
    float u = ig - bcs;
    float umax = wave_max(u);
    swk[lane] = __expf(u - umax);
    float blast = __shfl(bcs, 63);
    if (lane == 0) { float* sc = wsf(p, WS_SCAL) + (size_t)item * 2; sc[0] = blast; sc[1] = blast + umax; }
  }
#pragma unroll
  for (int it = 0; it < 4; it++) {
    int id = tid + 256 * it; int s = id >> 4, ch = id & 15;
    uint4 v = *(const uint4*)(wsb(p, WS_BIG + B_P) + (size_t)(ci.tok0 + s) * INC + 1440 + ci.h * 128 + ch * 8);
    const u16* vv = (const u16*)&v;
    unsigned a[4] = {v.x, v.y, v.z, v.w};
#pragma unroll
    for (int j = 0; j < 4; j++) { sVt[(ch * 8 + 2 * j) * 72 + s] = (u16)(a[j] & 0xffffu); sVt[(ch * 8 + 2 * j + 1) * 72 + s] = (u16)(a[j] >> 16); }
    (void)vv;
  }
  __syncthreads();
  {
    const int chunk = tid & 15, rg = tid >> 4;
    conv_run(p, l, ci, 1, chunk, rg * 4, 4, [&](int t, const float (&y)[8]) {
      float sc = 0.08838834764831845f * swk[t];
#pragma unroll
      for (int j = 0; j < 8; j++) sKt[(chunk * 8 + j) * 72 + t] = f2bf(y[j] * sc);
    });
  }
  __syncthreads();
  const int wm = w >> 1, wn = w & 1;
  f32x16 acc[2][2];
#pragma unroll
  for (int a = 0; a < 2; a++)
#pragma unroll
    for (int b = 0; b < 2; b++)
#pragma unroll
      for (int i = 0; i < 16; i++) acc[a][b][i] = 0.f;
#pragma unroll
  for (int ks = 0; ks < 4; ks++) {
    bf16x8 af[2], bfr[2];
#pragma unroll
    for (int tm = 0; tm < 2; tm++) af[tm] = *(const bf16x8*)(sVt + (wm * 64 + tm * 32 + r) * 72 + ks * 16 + h * 8);
#pragma unroll
    for (int tn = 0; tn < 2; tn++) bfr[tn] = *(const bf16x8*)(sKt + (wn * 64 + tn * 32 + r) * 72 + ks * 16 + h * 8);
#pragma unroll
    for (int tm = 0; tm < 2; tm++)
#pragma unroll
      for (int tn = 0; tn < 2; tn++) acc[tm][tn] = MFMA(bfr[tn], af[tm], acc[tm][tn]);
  }
  u16* slot = wsb(p, WS_BIG + B_ST) + (size_t)item * 16384;
#pragma unroll
  for (int tm = 0; tm < 2; tm++)
#pragma unroll
    for (int tn = 0; tn < 2; tn++)
#pragma unroll
      for (int g = 0; g < 4; g++) {
        uint2 v;
        v.x = pk2(acc[tm][tn][4 * g + 0], acc[tm][tn][4 * g + 1]);
        v.y = pk2(acc[tm][tn][4 * g + 2], acc[tm][tn][4 * g + 3]);
        *(uint2*)(slot + (wm * 64 + tm * 32 + r) * 128 + wn * 64 + tn * 32 + 8 * g + 4 * h) = v;
      }
  if (tid < 128) {
    float sum = 0.f;
    const u16* kr = sKt + tid * 72;
#pragma unroll 8
    for (int s = 0; s < 64; s++) sum += bf2f(kr[s]);
    wsf(p, WS_NU)[(size_t)item * 128 + tid] = sum;
  }
}

DI void mlstm_m2(const Params& p, int l, int unit, char* smem) {
  const int tid = tidx();
  int chain, g, nc, item0, b, h; bool sample;
  if (unit < 256) { chain = unit >> 5; g = unit & 31; nc = 256; item0 = chain * 256; b = chain >> 2; h = chain & 3; sample = false; }
  else { int u = unit - 256; int j = u >> 5; g = u & 31; chain = 8 + j; nc = 1; item0 = 2048 + j; b = j >> 2; h = j & 3; sample = true; }
  const int el = g * 512 + tid * 2; const int e = el >> 7, d = el & 127;
  float c0 = 0.f, c1 = 0.f, nst = 0.f, m0 = 0.f;
  const bool do_n = (g == 0 && tid < 128);
  if (sample) {
    const float* C0 = p.st_C + ((size_t)(l * 32 + b) * 4 + h) * 16384;
    c0 = C0[d * 128 + e]; c1 = C0[(d + 1) * 128 + e];
    if (do_n) nst = p.st_n[((size_t)(l * 32 + b) * 4 + h) * 128 + tid];
    m0 = p.st_m[(l * 32 + b) * 4 + h];
  }
  u16* slots = wsb(p, WS_BIG + B_ST);
  const float* scal = wsf(p, WS_SCAL);
  float* nu = wsf(p, WS_NU);
  float* mst = wsf(p, WS_MST);
  float* sA = (float*)smem; float* sC = sA + 256; float* sdec = sC + 256; float* sus = sdec + 256; float* smst = sus + 256;
  __syncthreads();
  if (tid < nc) { sA[tid] = scal[(size_t)(item0 + tid) * 2]; sC[tid] = scal[(size_t)(item0 + tid) * 2 + 1]; }
  __syncthreads();
  if (tid == 0) {
    float m = m0;
    for (int c = 0; c < nc; c++) {
      const float A = sA[c], Cm = sC[c];
      const float mnew = fmaxf(A + m, Cm);
      sdec[c] = __expf(A + m - mnew); sus[c] = __expf(Cm - mnew); smst[c] = m;
      m = mnew;
    }
    smst[256] = m;
  }
  __syncthreads();
  unsigned uu[8], un[8]; float nn[8], nx[8];
#pragma unroll
  for (int j = 0; j < 8; j++) {
    uu[j] = 0; nn[j] = 0.f;
    if (j < nc) {
      uu[j] = *(const unsigned*)(slots + (size_t)(item0 + j) * 16384 + el);
      if (do_n) nn[j] = nu[(size_t)(item0 + j) * 128 + tid];
    }
  }
  for (int cb = 0; cb < nc; cb += 8) {
#pragma unroll
    for (int j = 0; j < 8; j++) {
      un[j] = 0; nx[j] = 0.f;
      if (cb + 8 + j < nc) {
        un[j] = *(const unsigned*)(slots + (size_t)(item0 + cb + 8 + j) * 16384 + el);
        if (do_n) nx[j] = nu[(size_t)(item0 + cb + 8 + j) * 128 + tid];
      }
    }
#pragma unroll
    for (int j = 0; j < 8; j++) {
      if (cb + j < nc) {
        const int item = item0 + cb + j;
        const float dec = sdec[cb + j], us = sus[cb + j];
        *(unsigned*)(slots + (size_t)item * 16384 + el) = pk2(c0, c1);
        c0 = dec * c0 + us * bflo(uu[j]);
        c1 = dec * c1 + us * bfhi(uu[j]);
        if (do_n) { nu[(size_t)item * 128 + tid] = nst; nst = dec * nst + us * nn[j]; }
        if (g == 0 && tid == 0) mst[item] = smst[cb + j];
      }
    }
#pragma unroll
    for (int j = 0; j < 8; j++) { uu[j] = un[j]; nn[j] = nx[j]; }
  }
  float* oC = sample ? p.out + O_SC + ((size_t)(l * 32 + b) * 4 + h) * 16384 : p.out + O_PC + ((size_t)(l * 2 + b) * 4 + h) * 16384;
  oC[d * 128 + e] = c0; oC[(d + 1) * 128 + e] = c1;
  if (do_n) { float* on = sample ? p.out + O_SN + ((size_t)(l * 32 + b) * 4 + h) * 128 : p.out + O_PN + ((size_t)(l * 2 + b) * 4 + h) * 128; on[tid] = nst; }
  if (g == 0 && tid == 0) { float* om = sample ? p.out + O_SM + (l * 32 + b) * 4 + h : p.out + O_PM + (l * 2 + b) * 4 + h; *om = smst[256]; }
}

DI void mlstm_m3(const Params& p, int l, int item, char* smem) {
  const ChunkInfo ci = chunk_info(item);
  const int tid = tidx(), lane = tid & 63, w = tid >> 6, r = lane & 31, h = lane >> 5;
  u16* sQ = (u16*)smem;
  u16* sK = sQ + 64 * 136;
  u16* sVt = sK + 64 * 136;
  u16* sP = sVt + 128 * 72;
  float* su = (float*)(sP + 64 * 72);
  float* sM = su + 64;
  float* sa = sM + 64;
  float* sden = sa + 64;
  float* sinv = sden + 64;
  float* sn = sinv + 64;
  float* sH = (float*)smem;
  __syncthreads();
  const float m_start = wsf(p, WS_MST)[item];
  if (w == 0) {
    const float* g = wsf(p, WS_GATES) + (size_t)(ci.tok0 + lane) * 8;
    float ig = g[ci.h] + p.b_igate[l * 4 + ci.h];
    float lf = logsigmoid(g[4 + ci.h] + p.b_fgate[l * 4 + ci.h]);
    float bcs = lf;
#pragma unroll
    for (int o = 1; o < 64; o <<= 1) { float t = __shfl_up(bcs, o); if (lane >= o) bcs += t; }
    float u = ig - bcs;
    float cm = u;
#pragma unroll
    for (int o = 1; o < 64; o <<= 1) { float t = __shfl_up(cm, o); if (lane >= o) cm = fmaxf(cm, t); }
    float Mt = fmaxf(m_start, cm);
    su[lane] = u; sM[lane] = Mt; sa[lane] = __expf(m_start - Mt); sden[lane] = __expf(-(bcs + Mt));
  } else if (w == 1) {
    sn[lane] = wsf(p, WS_NU)[(size_t)item * 128 + lane];
    sn[lane + 64] = wsf(p, WS_NU)[(size_t)item * 128 + lane + 64];
  }
#pragma unroll
  for (int it = 0; it < 4; it++) {
    int id = tid + 256 * it; int s = id >> 4, ch = id & 15;
    uint4 v = *(const uint4*)(wsb(p, WS_BIG + B_P) + (size_t)(ci.tok0 + s) * INC + 1440 + ci.h * 128 + ch * 8);
    unsigned a[4] = {v.x, v.y, v.z, v.w};
#pragma unroll
    for (int j = 0; j < 4; j++) { sVt[(ch * 8 + 2 * j) * 72 + s] = (u16)(a[j] & 0xffffu); sVt[(ch * 8 + 2 * j + 1) * 72 + s] = (u16)(a[j] >> 16); }
  }
  {
    const int mc = tid & 31, mat = mc >> 4, chunk = mc & 15, rg = tid >> 5;
    u16* dst = mat ? sK : sQ;
    const float sc = mat ? 0.08838834764831845f : 1.f;
    conv_run(p, l, ci, mat, chunk, rg * 8, 8, [&](int t, const float (&y)[8]) {
      float x[8];
#pragma unroll
      for (int j = 0; j < 8; j++) x[j] = y[j] * sc;
      *(uint4*)(dst + t * 136 + chunk * 8) = pack8(x);
    });
  }
  __syncthreads();
  {
    const int tq = w >> 1, ts = w & 1;
    f32x16 s;
#pragma unroll
    for (int i = 0; i < 16; i++) s[i] = 0.f;
#pragma unroll
    for (int ks = 0; ks < 8; ks++) {
      bf16x8 a = *(const bf16x8*)(sQ + (tq * 32 + r) * 136 + ks * 16 + h * 8);
      bf16x8 b = *(const bf16x8*)(sK + (ts * 32 + r) * 136 + ks * 16 + h * 8);
      s = MFMA(a, b, s);
    }
    const int sidx = ts * 32 + r;
    const float us = su[sidx];
#pragma unroll
    for (int i = 0; i < 16; i++) {
      int t = tq * 32 + crow(i, h);
      float v = (sidx <= t) ? s[i] * __expf(us - sM[t]) : 0.f;
      sP[t * 72 + sidx] = f2bf(v);
    }
  }
  __syncthreads();
  if (tid < 64) {
    float rs = 0.f, qd = 0.f;
    const u16* pr = sP + tid * 72;
#pragma unroll 8
    for (int s = 0; s < 64; s++) rs += bf2f(pr[s]);
    const u16* qr = sQ + tid * 136;
#pragma unroll 8
    for (int d = 0; d < 128; d++) qd += bf2f(qr[d]) * sn[d];
    float qn = sa[tid] * qd + rs;
    sinv[tid] = __builtin_amdgcn_rcpf(fmaxf(fabsf(qn), sden[tid]));
  }
  const int tq = w & 1, eb = (w >> 1) * 2;
  f32x16 a1[2], a2[2];
#pragma unroll
  for (int et = 0; et < 2; et++)
#pragma unroll
    for (int i = 0; i < 16; i++) { a1[et][i] = 0.f; a2[et][i] = 0.f; }
  const u16* slot = wsb(p, WS_BIG + B_ST) + (size_t)item * 16384;
#pragma unroll
  for (int ks = 0; ks < 8; ks++) {
    bf16x8 a = *(const bf16x8*)(sQ + (tq * 32 + r) * 136 + ks * 16 + h * 8);
#pragma unroll
    for (int et = 0; et < 2; et++) {
      bf16x8 b = *(const bf16x8*)(slot + ((eb + et) * 32 + r) * 128 + ks * 16 + h * 8);
      a1[et] = MFMA(a, b, a1[et]);
    }
  }
#pragma unroll
  for (int ks = 0; ks < 4; ks++) {
    bf16x8 a = *(const bf16x8*)(sP + (tq * 32 + r) * 72 + ks * 16 + h * 8);
#pragma unroll
    for (int et = 0; et < 2; et++) {
      bf16x8 b = *(const bf16x8*)(sVt + ((eb + et) * 32 + r) * 72 + ks * 16 + h * 8);
      a2[et] = MFMA(a, b, a2[et]);
    }
  }
  __syncthreads();
#pragma unroll
  for (int et = 0; et < 2; et++)
#pragma unroll
    for (int i = 0; i < 16; i++) {
      int t = tq * 32 + crow(i, h);
      sH[t * 132 + (eb + et) * 32 + r] = (sa[t] * a1[et][i] + a2[et][i]) * sinv[t];
    }
  __syncthreads();
  {
    const int t = tid >> 2, part = tid & 3;
    const float* hr = sH + t * 132 + part * 32;
    float ss = 0.f;
#pragma unroll 8
    for (int j = 0; j < 32; j++) ss += hr[j] * hr[j];
    ss += __shfl_xor(ss, 1); ss += __shfl_xor(ss, 2);
    const float rr = rsqrtf(ss * (1.f / 128.f) + EPS);
    const int tok = ci.tok0 + t;
    const u16* og = wsb(p, WS_BIG + B_P) + (size_t)tok * INC + 1960 + ci.h * 128 + part * 32;
    const float* gm = p.g_mhead + (size_t)l * 512 + ci.h * 128 + part * 32;
    u16* o = wsb(p, WS_ACT) + (size_t)tok * LDA + 512 + ci.h * 128 + part * 32;
#pragma unroll
    for (int c8 = 0; c8 < 4; c8++) {
      float gv[8], x[8];
      unpack8(*(const uint4*)(og + c8 * 8), gv);
#pragma unroll
      for (int j = 0; j < 8; j++) x[j] = hr[c8 * 8 + j] * rr * gm[c8 * 8 + j] * __builtin_amdgcn_rcpf(1.f + __expf(-gv[j]));
      *(uint4*)(o + c8 * 8) = pack8(x);
    }
  }
}

DI void xkv_item(const Params& p, int l, int item, char* smem) {
  const int tid = tidx();
  const int kg = item & 3, hh = (item >> 2) & 3, bidx = item >> 4;
  u16* T = (u16*)smem;
  __syncthreads();
  const int key = tid >> 2, qt = tid & 3;
  const int mem = kg * 64 + key;
  const bool prompt = bidx < 2;
  float* kp; const float* vp;
  if (prompt) {
    kp = p.out + O_PMEMK + (((size_t)(l * 2 + bidx) * 256 + mem) * 4 + hh) * 256 + qt * 64;
    vp = p.out + O_PMEMV + (((size_t)(l * 2 + bidx) * 256 + mem) * 4 + hh) * 256 + qt * 64;
  } else {
    kp = (float*)(p.cache_mem_k + (((size_t)(l * 32 + bidx - 2) * 256 + mem) * 4 + hh) * 256 + qt * 64);
    vp = p.cache_mem_v + (((size_t)(l * 32 + bidx - 2) * 256 + mem) * 4 + hh) * 256 + qt * 64;
  }
  float rr = 1.f;
  if (prompt) {
    float ss = 0.f;
#pragma unroll 4
    for (int j = 0; j < 16; j++) { float4 v = *(const float4*)(kp + j * 4); ss += v.x * v.x + v.y * v.y + v.z * v.z + v.w * v.w; }
    ss += __shfl_xor(ss, 1); ss += __shfl_xor(ss, 2);
    rr = rsqrtf(ss * (1.f / 256.f) + EPS);
  }
  const float* gk = p.g_xk + l * 256 + qt * 64;
  const float* gq = p.g_xq + l * 256 + qt * 64;
  u16* xk = wsb(p, WS_BIG + B_XK) + ((size_t)(bidx * 4 + hh) * 256 + mem) * 256 + qt * 64;
#pragma unroll 2
  for (int c8 = 0; c8 < 8; c8++) {
    float4 a = *(const float4*)(kp + c8 * 8), b = *(const float4*)(kp + c8 * 8 + 4);
    float x[8] = {a.x, a.y, a.z, a.w, b.x, b.y, b.z, b.w};
    if (prompt) {
#pragma unroll
      for (int j = 0; j < 8; j++) x[j] = x[j] * rr * gk[c8 * 8 + j];
      *(float4*)(kp + c8 * 8) = make_float4(x[0], x[1], x[2], x[3]);
      *(float4*)(kp + c8 * 8 + 4) = make_float4(x[4], x[5], x[6], x[7]);
    }
#pragma unroll
    for (int j = 0; j < 8; j++) x[j] = x[j] * gq[c8 * 8 + j] * (0.0625f * LOG2E);
    *(uint4*)(xk + c8 * 8) = pack8(x);
    float4 va = *(const float4*)(vp + c8 * 8), vb = *(const float4*)(vp + c8 * 8 + 4);
    float y[8] = {va.x, va.y, va.z, va.w, vb.x, vb.y, vb.z, vb.w};
    *(uint4*)(T + key * 264 + qt * 64 + c8 * 8) = pack8(y);
  }
  __syncthreads();
  {
    const int e = tid;
    u16* xv = wsb(p, WS_BIG + B_XVT) + ((size_t)(bidx * 4 + hh) * 256 + e) * LDXV + kg * 64;
#pragma unroll 2
    for (int oct = 0; oct < 8; oct++) {
      uint4 v;
      const int kb = 16 * (oct >> 1) + 4 * (oct & 1);
      v.x = (unsigned)T[(kb + 0) * 264 + e] | ((unsigned)T[(kb + 1) * 264 + e] << 16);
      v.y = (unsigned)T[(kb + 2) * 264 + e] | ((unsigned)T[(kb + 3) * 264 + e] << 16);
      v.z = (unsigned)T[(kb + 8) * 264 + e] | ((unsigned)T[(kb + 9) * 264 + e] << 16);
      v.w = (unsigned)T[(kb + 10) * 264 + e] | ((unsigned)T[(kb + 11) * 264 + e] << 16);
      *(uint4*)(xv + oct * 8) = v;
    }
  }
}

DI void phase_C2(const Params& p, int l, char* smem) {
  for (int t = blockIdx.x; t < 544; t += gridDim.x) xkv_item(p, l, t, smem);
}
DI void phase_C1(const Params& p, int l, char* smem) {
  const int lane = tidx() & 63, w = tidx() >> 6;
  for (int t = blockIdx.x; t < NITEM; t += gridDim.x) mlstm_m1(p, l, t, smem);
  for (int t = blockIdx.x * 4 + w; t < NTOK + 32768; t += gridDim.x * 4) {
    if (t < NTOK) post_token(p, l, t, lane); else post_past(p, l, t - NTOK, lane);
  }
}

DI void phase_D(const Params& p, int l, char* smem) {
  const int n_scan = 256 + 4096;
  const int n_q = 544 * 4;
  const u16* W = wsb(p, WS_W) + (size_t)l * W_LAYER;
  for (int t = blockIdx.x; t < n_scan + n_q; t += gridDim.x) {
    if (t < n_scan) mlstm_m2(p, l, t, smem);
    else {
      int u = t - n_scan; int mt = u >> 2, nt = u & 3;
      EpiQ epi{wsb(p, WS_BIG + B_Q), wsf(p, WS_RQ), (const float2*)(p.ws + WS_ROPE), p.g_qnorm + l * 96};
      gemm_tile<1, 3>(wsb(p, WS_BIG + B_P), INC, W + W_Q, LDWQ, 256, mt * 64, nt * 192, smem, epi);
    }
  }
}

DI void phase_E(const Params& p, int l, char* smem) {
  for (int t = blockIdx.x; t < NITEM; t += gridDim.x) mlstm_m3(p, l, t, smem);
}

DI void phase_F(const Params& p, int l, char* smem) {
  const u16* W = wsb(p, WS_W) + (size_t)l * W_LAYER;
  for (int t = blockIdx.x; t < 528 * 8; t += gridDim.x) {
    int mt = t >> 3, nt = t & 7;
    EpiKV epi{wsb(p, WS_BIG + B_K), wsb(p, WS_BIG + B_VT), wsf(p, WS_KROPE), p.g_knorm + l * 96};
    gemm_tile<2, 2>(wsb(p, WS_CKV), 128, W + W_KV, LDWKV, 128, mt * 128, nt * 128, smem, epi);
  }
}

DI void phase_G(const Params& p, const Sched& sc, char* smem) {
  const int G = gridDim.x, j = blockIdx.x;
  const int lane = tidx() & 63, w = tidx() >> 6, r = lane & 31;
  const int NIT = 2048 + 256;
  const u16* qb = wsb(p, WS_BIG + B_Q);
  const u16* Kb = wsb(p, WS_BIG + B_K);
  const u16* Vt = wsb(p, WS_BIG + B_VT);
  u16* act = wsb(p, WS_ACT);
  auto run_prompt = [&](int bh, int bi) {
    int b = bh >> 3, hd = bh & 7;
    int tok = b * 16384 + bi * 128 + w * 32 + r;
    flash_item<96, 2, 64, true, false, true, true>(qb + (size_t)tok * 768 + hd * 96, true, 2 * bi + 2, 2 * bi + 1 + (w >> 1),
                                             Kb + ((size_t)hd * NROWS + b * 16384) * 96, 96, Vt + (size_t)hd * 64 * LDVT + b * 16384, LDVT, 0,
                                             act + (size_t)tok * LDA + hd * 64, smem);
  };
  auto run_sample = [&](int u) {
    int b = u >> 3, hd = u & 7;
    int tok = NP + b * 64 + (w & 1) * 32 + r;
    size_t row0 = (size_t)NP + b * 1088;
    flash_item<96, 2, 64, true, false, true, true>(qb + (size_t)tok * 768 + hd * 96, w < 2, 17, 17, Kb + ((size_t)hd * NROWS + row0) * 96, 96,
                                             Vt + (size_t)hd * 64 * LDVT + row0, LDVT, 0, act + (size_t)tok * LDA + hd * 64, smem);
  };
  if (sc.ok) {
    const int xg = sc.xg, xi = sc.xi;
    for (int pass = 0; pass < 2; pass++) {
      const int bh = xg + 8 * pass;
      run_prompt(bh, xi);
      run_prompt(bh, 127 - xi);
    }
    if ((j & 1) == 0) run_sample(j >> 1);
  } else {
    for (int k = 0; k * G < NIT; k++) {
      int it = (k & 1) ? (k * G + (G - 1 - j)) : (k * G + j);
      if (it >= NIT) continue;
      if (it < 2048) run_prompt(it & 15, 127 - (it >> 4)); else run_sample(it - 2048);
    }
  }
}

DI void xattn_item(const u16* Qtile  , const u16* Kbase, const u16* Vtbase, u16* Otile, char* smem) {
  constexpr int LDQ = 264, LDV = 40;
  u16* sQ = (u16*)smem;
  u16* sK = sQ + 64 * LDQ;
  u16* sV = sK + 32 * LDQ;
  const int tid = tidx(), lane = tid & 63, w = tid >> 6, r = lane & 31, h = lane >> 5;
  const int qrow = 32 * (w & 1) + r, e0 = 128 * (w >> 1);
  u32x4 rk[4], rv[4];
  auto gload = [&](int t) {
#pragma unroll
    for (int i = 0; i < 4; i++) {
      int id = tid + 256 * i;
      rk[i] = *(const u32x4*)(Kbase + (long)(t * 32 + (id >> 5)) * 256 + (id & 31) * 8);
      rv[i] = *(const u32x4*)(Vtbase + (long)(id >> 2) * LDXV + t * 32 + (id & 3) * 8);
    }
  };
  auto sstore = [&]() {
#pragma unroll
    for (int i = 0; i < 4; i++) {
      int id = tid + 256 * i;
      *(u32x4*)(sK + (id >> 5) * LDQ + (id & 31) * 8) = rk[i];
      *(u32x4*)(sV + (id >> 2) * LDV + (id & 3) * 8) = rv[i];
    }
  };
  __syncthreads();
  gload(0);
#pragma unroll
  for (int i = 0; i < 8; i++) {
    int id = tid + 256 * i;
    *(u32x4*)(sQ + (id >> 5) * LDQ + (id & 31) * 8) = *(const u32x4*)(Qtile + (long)(id >> 5) * LDA + (id & 31) * 8);
  }
  sstore();
  __syncthreads();
  float rqs;
  {
    float ss = 0.f;
#pragma unroll
    for (int ks = 0; ks < 16; ks++) {
      bf16x8 qq = *(const bf16x8*)(sQ + qrow * LDQ + ks * 16 + h * 8);
#pragma unroll
      for (int j = 0; j < 8; j++) { float v = bf2f((u16)qq[j]); ss += v * v; }
    }
    ss = xhalf_sum(ss);
    rqs = rsqrtf(ss * (1.f / 256.f) + EPS);
  }
  const float rqinv = __builtin_amdgcn_rcpf(rqs);
  f32x16 o[4];
#pragma unroll
  for (int et = 0; et < 4; et++)
#pragma unroll
    for (int i = 0; i < 16; i++) o[et][i] = 0.f;
  float mrun = 0.f, lrun = 0.f;
  for (int t = 0; t < 8; t++) {
    if (t + 1 < 8) gload(t + 1);
    __builtin_amdgcn_sched_barrier(0);
    __builtin_amdgcn_s_setprio(1);
    {
      f32x16 s;
      const float sinit = -mrun * rqinv;
#pragma unroll
      for (int i = 0; i < 16; i++) s[i] = sinit;
#pragma unroll
      for (int ks = 0; ks < 16; ks++) {
        bf16x8 a = *(const bf16x8*)(sK + r * LDQ + ks * 16 + h * 8);
        bf16x8 b = *(const bf16x8*)(sQ + qrow * LDQ + ks * 16 + h * 8);
        s = MFMA(a, b, s);
      }
      float mx = -1e30f;
#pragma unroll
      for (int i = 0; i < 16; i++) { s[i] *= rqs; mx = fmaxf(mx, s[i]); }
      mx = xhalf_max(mx);
      if (__any(mx > 8.f)) {
        const float d = fmaxf(mx, 0.f);
        const float alpha = __builtin_amdgcn_exp2f(-d);
        mrun += d;
        lrun *= alpha;
#pragma unroll
        for (int et = 0; et < 4; et++)
#pragma unroll
          for (int i = 0; i < 16; i++) o[et][i] *= alpha;
#pragma unroll
        for (int i = 0; i < 16; i++) s[i] -= d;
      }
      float psum = 0.f;
#pragma unroll
      for (int i = 0; i < 16; i++) { float pv = __builtin_amdgcn_exp2f(s[i]); s[i] = pv; psum += pv; }
      lrun += psum;
#pragma unroll
      for (int st = 0; st < 2; st++) {
        uint4 pp;
        pp.x = pk2(s[8 * st + 0], s[8 * st + 1]); pp.y = pk2(s[8 * st + 2], s[8 * st + 3]);
        pp.z = pk2(s[8 * st + 4], s[8 * st + 5]); pp.w = pk2(s[8 * st + 6], s[8 * st + 7]);
        bf16x8 pb = __builtin_bit_cast(bf16x8, pp);
#pragma unroll
        for (int et = 0; et < 4; et++) {
          bf16x8 a = *(const bf16x8*)(sV + (e0 + et * 32 + r) * LDV + st * 16 + 8 * h);
          o[et] = MFMA(a, pb, o[et]);
        }
      }
    }
    __builtin_amdgcn_s_setprio(0);
    __builtin_amdgcn_sched_barrier(0);
    __syncthreads();
    if (t + 1 < 8) { sstore(); __syncthreads(); }
  }
  {
    float lt = xhalf_sum(lrun);
    float inv = __builtin_amdgcn_rcpf(lt);
    u16* Orow = Otile + (long)qrow * LDA + e0;
#pragma unroll
    for (int et = 0; et < 4; et++)
#pragma unroll
      for (int g = 0; g < 4; g++) {
        uint2 v;
        v.x = pk2(o[et][4 * g + 0] * inv, o[et][4 * g + 1] * inv);
        v.y = pk2(o[et][4 * g + 2] * inv, o[et][4 * g + 3] * inv);
        *(uint2*)(Orow + et * 32 + 8 * g + 4 * h) = v;
      }
  }
}

DI void phase_K(const Params& p, char* smem) {
  const int lane = tidx() & 63, w = tidx() >> 6, r = lane & 31;
  const u16* qx = wsb(p, WS_BIG + B_QX);
  u16* act = wsb(p, WS_ACT);
  for (int t = blockIdx.x; t < 2176; t += gridDim.x) {
    int bidx, hh, tok0;
    if (t < 2048) { bidx = t >> 10; hh = (t >> 8) & 3; tok0 = bidx * 16384 + (t & 255) * 64; }
    else { int u = t - 2048; bidx = 2 + (u >> 2); hh = u & 3; tok0 = NP + (u >> 2) * 64; }
    const u16* Kb = wsb(p, WS_BIG + B_XK) + (size_t)(bidx * 4 + hh) * 65536;
    const u16* Vt = wsb(p, WS_BIG + B_XVT) + (size_t)(bidx * 4 + hh) * 256 * LDXV;
    xattn_item(qx + (size_t)tok0 * LDA + hh * 256, Kb, Vt, act + (size_t)tok0 * LDA + hh * 256, smem);
  }
  (void)lane; (void)w; (void)r;
}

template <class Epi>
DI void phase_gemm128(const Sched& sc, const u16* A, long lda, const u16* Bt, long ldb, int K, int MT, int NT, int SN, char* smem, const Epi& epi) {
  if (sc.ok) {
    const int xg = sc.xg, xi = sc.xi;
    const int SM = 64 / SN;
    const int sng = NT / SN, smg = MT / SM;
    for (int st = xg; st < smg * sng; st += 8) {
      int sm = st / sng, sn = st % sng;
      int mt = sm * SM + xi / SN, nt = sn * SN + xi % SN;
      gemm_tile<2, 2>(A, lda, Bt, ldb, K, mt * 128, nt * 128, smem, epi);
    }
  } else {
    for (int t = blockIdx.x; t < MT * NT; t += gridDim.x) {
      int mt = t / NT, nt = t % NT;
      gemm_tile<2, 2>(A, lda, Bt, ldb, K, mt * 128, nt * 128, smem, epi);
    }
  }
}

#if defined(__HIP_DEVICE_COMPILE__)
typedef const __attribute__((address_space(4))) Params* KargPtr;
#define KARG_LOAD KargPtr pp4 = (KargPtr)__builtin_amdgcn_kernarg_segment_ptr(); asm volatile("" : "+s"(pp4)); const Params p = *pp4;
#else
#define KARG_LOAD const Params p{};
#endif
template <int L>
DI void run_layer(const Sched& sc, int ph_begin, int ph_end, char* smem, const XcdBarrier& xb) {
  const int base = 1 + 15 * L;
#define RUN_PHASE(S, ...)  RUN_PHASE_R(S, 1, __VA_ARGS__)
#define RUN_PHASE_R(S, R, ...)                                    \
  {                                                          \
    const int ph = base + (S);                               \
    if (ph >= ph_begin && ph < ph_end) {                     \
      for (int rep_ = 0; rep_ < (R); rep_++) {               \
        KARG_LOAD                                            \
        const u16* W = wsb(p, WS_W) + (size_t)L * W_LAYER;   \
        const float* xs0 = (L == 0) ? p.x_prompt : p.out;    \
        const float* xs1 = (L == 0) ? p.x_sample : p.out + (size_t)NP * 1024; \
        (void)W; (void)xs0; (void)xs1;                       \
        __VA_ARGS__;                                         \
        if (ph + 1 < ph_end) xcd_barrier(xb);                \
      }                                                      \
    }                                                        \
  }
  if (L > 0) RUN_PHASE(0, phase_norm(p, L))
  RUN_PHASE_R(1, REP_INPROJ, phase_inproj(p, sc, L, smem))
  RUN_PHASE_R(2, REP_C, { phase_C1(p, L, smem); phase_C2(p, L, smem); })
  RUN_PHASE(3, phase_D(p, L, smem))
  RUN_PHASE_R(4, REP_E, phase_E(p, L, smem))
  RUN_PHASE_R(5, REP_F, phase_F(p, L, smem))
  RUN_PHASE_R(6, REP_G, phase_G(p, sc, smem))
  RUN_PHASE(7, { EpiRes epi{xs0, xs1, p.out}; phase_gemm128(sc, wsb(p, WS_ACT), LDA, W + W_OUT, LDW, 1024, 272, 8, 8, smem, epi); })
  RUN_PHASE_R(8, REP_NORM, phase_norm(p, 1))
  RUN_PHASE(9, { EpiStoreBf16 epi{wsb(p, WS_BIG + B_QX), LDA, 1024, nullptr}; phase_gemm128(sc, wsb(p, WS_ACT), LDA, W + W_XQ, LDW, 1024, 272, 8, 8, smem, epi); })
  RUN_PHASE_R(10, REP_K, phase_K(p, smem))
  RUN_PHASE(11, { EpiRes epi{p.out, p.out + (size_t)NP * 1024, p.out}; phase_gemm128(sc, wsb(p, WS_ACT), LDA, W + W_XO, LDW, 1024, 272, 8, 8, smem, epi); })
  RUN_PHASE(12, phase_norm(p, 1))
  RUN_PHASE_R(13, REP_FF1, { EpiRelu2 epi{wsb(p, WS_BIG + B_H1), LDH1}; phase_gemm128(sc, wsb(p, WS_ACT), LDA, W + W_FF1, LDW, 1024, 272, 32, 8, smem, epi); })
  RUN_PHASE(14, { EpiRes epi{p.out, p.out + (size_t)NP * 1024, p.out}; phase_gemm128(sc, wsb(p, WS_BIG + B_H1), LDH1, W + W_FF2, LDW2, 4096, 272, 8, 8, smem, epi); })
#undef RUN_PHASE
#undef RUN_PHASE_R
}

__global__ void __launch_bounds__(256, 2) fwd_megakernel(Params p, int ph_begin, int ph_end) {
  __shared__ __attribute__((aligned(16))) char smem[SMEM_BYTES];
  cg::grid_group grid = cg::this_grid();
  __shared__ int s_rank;
  __shared__ __attribute__((aligned(16))) unsigned xb_words[4];
  if (tidx() < 4) xb_words[tidx()] = 0u;
  __syncthreads();
  const XcdBarrier xb = xcd_barrier_post((unsigned*)(p.ws + WS_BAR), (volatile LAS unsigned*)&xb_words);
  Sched sc;
  sc.xg = (int)((unsigned)__builtin_amdgcn_s_getreg((3 << 11) | 20) & 7u);
  unsigned* cnt = (unsigned*)(p.ws + WS_CNT);
  if (tidx() == 0) s_rank = (int)atomicAdd(&cnt[sc.xg], 1u);
  __syncthreads();
  sc.xi = __builtin_amdgcn_readfirstlane(s_rank);
  sc.ok = 0;
  if (ph_begin <= 0 && 0 < ph_end) {
    phase_prep(p, smem);
    if (ph_end < 0) grid.sync();
    if (1 < ph_end) xcd_barrier(xb);
  }
  {
    int ok = (gridDim.x == 512);
#pragma unroll
    for (int i = 0; i < 8; i++) ok &= (__atomic_load_n(&cnt[i], __ATOMIC_RELAXED) == 64u);
    sc.ok = ok;
  }
  run_layer<0>(sc, ph_begin, ph_end, smem, xb);
  run_layer<1>(sc, ph_begin, ph_end, smem, xb);
}

extern "C" void kernel_launch(void* const* d_in, const int* in_sizes, int n_in, void* d_out, int out_size, void* d_ws, size_t ws_size,
                              hipStream_t stream) {
  static int grid_blocks = 0;
  if (!grid_blocks) {
    int dev = 0, cus = 0, per_cu = 0;
    (void)hipGetDevice(&dev);
    (void)hipDeviceGetAttribute(&cus, hipDeviceAttributeMultiprocessorCount, dev);
    (void)hipOccupancyMaxActiveBlocksPerMultiprocessor(&per_cu, fwd_megakernel, 256, 0);
    per_cu = 2;
    grid_blocks = cus * per_cu;
  }
  Params p{};
  const float** pp = (const float**)&p;
  for (int i = 0; i < 36; i++) pp[i] = (const float*)d_in[i];
  p.out = (float*)d_out;
  p.ws = (char*)d_ws;
  int ph_begin = 0, ph_end = 31;
  (void)hipMemsetAsync((char*)d_ws + WS_CNT, 0, 256 + 16384, stream);
  void* args[] = {&p, &ph_begin, &ph_end};
  hipError_t e = hipLaunchCooperativeKernel((void*)fwd_megakernel, dim3(grid_blocks), dim3(256), args, 0, stream);
  if (e != hipSuccess) fprintf(stderr, "cooperative launch failed: %s (grid %d)\n", hipGetErrorString(e), grid_blocks);
}
```

```cpp
#include <hip/hip_runtime.h>
#include <hip/hip_cooperative_groups.h>
#include <stdint.h>
#include <stdio.h>
namespace cg = cooperative_groups;

typedef unsigned short u16;
typedef short bf16x8 __attribute__((ext_vector_type(8)));
typedef short s16x4 __attribute__((ext_vector_type(4)));
typedef float f32x16 __attribute__((ext_vector_type(16)));
typedef __bf16 bfv2 __attribute__((ext_vector_type(2)));
typedef float fv2 __attribute__((ext_vector_type(2)));
typedef unsigned u32x4 __attribute__((ext_vector_type(4)));
#define DI __device__ __forceinline__
#define MFMA(a, b, c) __builtin_amdgcn_mfma_f32_32x32x16_bf16((a), (b), (c), 0, 0, 0)

constexpr int NP = 32768;
constexpr int NS = 2048;
constexpr int NTOK = NP + NS;
constexpr int NROWS = NP + 32 * 1088;
constexpr int INC = 2472;
constexpr float EPS = 1e-6f;
constexpr float LOG2E = 1.4426950408889634f;
constexpr int NITEM = 2048 + 128;
constexpr int LDA = 1088;
constexpr int LDW = 1088;
constexpr int LDW2 = 4160;
constexpr int LDWQ = 320;
constexpr int LDWKV = 192;
constexpr int LDH1 = 4160;
constexpr int LDVT = NROWS + 64;
constexpr int LDXV = 320;

constexpr size_t O_Y = 0;
constexpr size_t O_PCKV = 35651584;
constexpr size_t O_PKROPE = O_PCKV + 8388608;
constexpr size_t O_PC = O_PKROPE + 2097152;
constexpr size_t O_PN = O_PC + 262144;
constexpr size_t O_PM = O_PN + 2048;
constexpr size_t O_PCONV = O_PM + 16;
constexpr size_t O_PMEMK = O_PCONV + 12288;
constexpr size_t O_PMEMV = O_PMEMK + 1048576;
constexpr size_t O_SCKV = O_PMEMV + 1048576;
constexpr size_t O_SKROPE = O_SCKV + 524288;
constexpr size_t O_SC = O_SKROPE + 131072;
constexpr size_t O_SN = O_SC + 4194304;
constexpr size_t O_SM = O_SN + 32768;
constexpr size_t O_SCONV = O_SM + 256;

constexpr size_t W_IN = 0;
constexpr size_t W_Q = W_IN + 2560 * LDW;
constexpr size_t W_KV = W_Q + 768 * LDWQ;
constexpr size_t W_OUT = W_KV + 1024 * LDWKV;
constexpr size_t W_XQ = W_OUT + 1024 * LDW;
constexpr size_t W_XK = W_XQ + 1024 * LDW;
constexpr size_t W_XV = W_XK + 1024 * LDW;
constexpr size_t W_XO = W_XV + 1024 * LDW;
constexpr size_t W_FF1 = W_XO + 1024 * LDW;
constexpr size_t W_FF2 = W_FF1 + 4096 * LDW;
constexpr size_t W_LAYER = W_FF2 + 1024 * LDW2;

constexpr size_t WS_W = 0;
constexpr size_t WS_ACT = WS_W + 2 * W_LAYER * 2;
constexpr size_t WS_CKV = WS_ACT + (size_t)NTOK * LDA * 2;
constexpr size_t WS_KROPE = WS_CKV + (size_t)NROWS * 128 * 2;
constexpr size_t WS_RQ = WS_KROPE + (size_t)NROWS * 32 * 4;
constexpr size_t WS_GATES = WS_RQ + (size_t)NTOK * 4;
constexpr size_t WS_ROPE = WS_GATES + (size_t)NTOK * 8 * 4;
constexpr size_t WS_SCAL = WS_ROPE + (size_t)16384 * 16 * 8;
constexpr size_t WS_MST = WS_SCAL + (size_t)NITEM * 2 * 4;
constexpr size_t WS_NU = WS_MST + (size_t)NITEM * 4 + 256;
constexpr size_t WS_CNT = WS_NU + (size_t)NITEM * 128 * 4;
constexpr size_t WS_BAR = WS_CNT + 256;
constexpr size_t WS_HM = WS_BAR + 16384;
constexpr size_t WS_BIG = WS_HM + (size_t)512 * LDA * 2;
constexpr size_t B_P = 0;
constexpr size_t B_K = 0;
constexpr size_t B_VT = B_K + (size_t)8 * NROWS * 96 * 2;
constexpr size_t B_Q = B_VT + (size_t)8 * 64 * LDVT * 2;
constexpr size_t B_ST = B_Q + (size_t)NTOK * 768 * 2;
constexpr size_t B_XK = B_ST + (size_t)NITEM * 16384 * 2;
constexpr size_t B_XVT = B_XK + (size_t)34 * 4 * 256 * 256 * 2;
constexpr size_t B_END = B_XVT + (size_t)34 * 4 * 256 * LDXV * 2;
constexpr size_t B_QX = 0;
constexpr size_t B_H1 = 0;
static_assert((size_t)NTOK * INC * 2 <= B_Q, "p overlaps q");
static_assert((size_t)NTOK * LDH1 * 2 <= B_XK, "h1 overlaps xkv");
static_assert((size_t)NTOK * LDA * 2 <= B_Q, "qx overlaps q");
static_assert(WS_BIG + B_END <= (size_t)536870912, "workspace too large");
static_assert(WS_BIG % 256 == 0 && B_Q % 256 == 0 && B_ST % 256 == 0 && B_VT % 256 == 0, "align");

constexpr int SMEM_BYTES = 73728;
#ifndef REP_INPROJ
#define REP_INPROJ 1
#endif
#ifndef REP_C
#define REP_C 1
#endif
#ifndef REP_E
#define REP_E 1
#endif
#ifndef REP_F
#define REP_F 1
#endif
#ifndef REP_G
#define REP_G 1
#endif
#ifndef REP_K
#define REP_K 1
#endif
#ifndef REP_FF1
#define REP_FF1 1
#endif
#ifndef REP_NORM
#define REP_NORM 1
#endif

struct Params {
  const float* x_prompt; const float* x_sample; const float* cache_ckv; const float* cache_krope;
  const float* st_C; const float* st_n; const float* st_m; const float* st_conv;
  const float* cache_mem_k; const float* cache_mem_v; const float* mem_prompt;
  const float* g_mix; const float* w_in; const float* g_qa; const float* w_q_up; const float* g_qnorm; const float* g_kva;
  const float* w_kv_up; const float* g_knorm; const float* w_conv; const float* b_conv; const float* b_igate; const float* b_fgate;
  const float* g_mhead; const float* w_out; const float* g_xattn; const float* g_mem; const float* w_xq; const float* w_xk; const float* w_xv;
  const float* g_xq; const float* g_xk; const float* w_xo; const float* g_mlp; const float* w_ff1; const float* w_ff2;
  float* out; char* ws;
};

#define XB_TMO      128
#define XB_XCNT(j)  (256  + 64 * (j))
#define XB_XSUB(j)  (1280 + 64 * (j))
#define XB_XGEN(j)  (2304 + 64 * (j))
#define XB_TOP      3328
#define XB_TOPGEN   3392
#define XCD_BAR_WORDS 3456
#define XB_SPIN_CAP (1u << 18)
#define LAS __attribute__((address_space(3)))

__device__ __forceinline__ unsigned xb_ld(unsigned* p)              { return __hip_atomic_load(p, __ATOMIC_RELAXED, __HIP_MEMORY_SCOPE_AGENT); }
__device__ __forceinline__ unsigned xb_add(unsigned* p, unsigned v) { return __hip_atomic_fetch_add(p, v, __ATOMIC_RELAXED, __HIP_MEMORY_SCOPE_AGENT); }
__device__ __forceinline__ unsigned xb_xcc_id() { return (unsigned)__builtin_amdgcn_s_getreg((3 << 11) | 20) & 0xFu; }
#define XB_SPIN(cond, bar) do { unsigned _sp = 0; while (cond) { __builtin_amdgcn_s_sleep(1); \
    if ((++_sp & 255u) == 0u) { if (xb_ld(&(bar)[XB_TMO])) break; if (_sp > XB_SPIN_CAP) { atomicAdd(&(bar)[XB_TMO], 1u); break; } } } } while (0)

struct XcdBarrier {
    unsigned* bar; unsigned x;
    volatile LAS unsigned* st;
};

__device__ __forceinline__ XcdBarrier xcd_barrier_post(unsigned* bar, volatile LAS unsigned* st) {
    XcdBarrier b; b.bar = bar; b.x = xb_xcc_id(); b.st = st;
    if (threadIdx.x == 0) (void)xb_add(&bar[XB_XCNT(b.x)], 1u);
    return b;
}
__device__ __forceinline__ void xcd_barrier_complete(unsigned* bar, unsigned x, unsigned& nloc, unsigned& nx) {
    const unsigned G = gridDim.x * gridDim.y * gridDim.z;
    unsigned sum, cnt, mine, sp = 0u;
    for (;;) {
        sum = 0u; cnt = 0u; mine = 0u;
#pragma unroll
        for (unsigned j = 0; j < 16; ++j) { const unsigned c = xb_ld(&bar[XB_XCNT(j)]); sum += c; cnt += (c > 0u) ? 1u : 0u; mine = (j == x) ? c : mine; }
        if (sum == G) break;
        __builtin_amdgcn_s_sleep(1);
        if ((++sp & 255u) == 0u) { if (xb_ld(&bar[XB_TMO])) break; if (sp > XB_SPIN_CAP) { atomicAdd(&bar[XB_TMO], 1u); break; } }
    }
    nloc = mine > 0u ? mine : 1u; nx = cnt > 0u ? cnt : 1u;
}

__device__ __forceinline__ void xcd_barrier(const XcdBarrier& b) {
    asm volatile("s_waitcnt vmcnt(0)" ::: "memory");
    __syncthreads();
    if (threadIdx.x == 0) {
        unsigned* bar = b.bar;
        __builtin_amdgcn_s_waitcnt(0);
        unsigned nloc = b.st[0], nx = b.st[1];
        if (nloc == 0u) { xcd_barrier_complete(bar, b.x, nloc, nx); b.st[0] = nloc; b.st[1] = nx; }
        const unsigned old = xb_add(&bar[XB_XSUB(b.x)], 1u);
        const unsigned gen = old / nloc;
        if (old + 1u == (gen + 1u) * nloc) {
            __builtin_amdgcn_fence(__ATOMIC_RELEASE, "agent");
            asm volatile("s_waitcnt vmcnt(0)" ::: "memory");
            const unsigned og = xb_add(&bar[XB_TOP], 1u);
            const unsigned tg = og / nx;
            if (og + 1u == (tg + 1u) * nx) xb_add(&bar[XB_TOPGEN], 1u);
            else XB_SPIN(xb_ld(&bar[XB_TOPGEN]) == tg, bar);
            __builtin_amdgcn_fence(__ATOMIC_ACQUIRE, "agent");
            xb_add(&bar[XB_XGEN(b.x)], 1u);
            asm volatile("s_waitcnt vmcnt(0)" ::: "memory");
        } else {
            XB_SPIN(xb_ld(&bar[XB_XGEN(b.x)]) == gen, bar);
            __builtin_amdgcn_fence(__ATOMIC_ACQUIRE, "agent");
            asm volatile("s_waitcnt vmcnt(0)" ::: "memory");
        }
    }
    __syncthreads();
}


struct Sched { int xg, xi, ok; };
DI int tidx() { int t = (int)threadIdx.x; asm volatile("" : "+v"(t)); return t; }
DI unsigned pk2(float a, float b) { fv2 v = {a, b}; bfv2 r = __builtin_convertvector(v, bfv2); return __builtin_bit_cast(unsigned, r); }
DI u16 f2bf(float a) { return (u16)(pk2(a, 0.f) & 0xffffu); }
DI float bf2f(u16 v) { return __uint_as_float(((unsigned)v) << 16); }
DI float bflo(unsigned v) { return __uint_as_float(v << 16); }
DI float bfhi(unsigned v) { return __uint_as_float(v & 0xffff0000u); }
DI int crow(int i, int h) { return (i & 3) + 8 * (i >> 2) + 4 * h; }
DI float xhalf_max(float v) {
  unsigned u = __float_as_uint(v);
  auto rr = __builtin_amdgcn_permlane32_swap(u, u, false, false);
  return fmaxf(__uint_as_float(rr[0]), __uint_as_float(rr[1]));
}
DI float xhalf_sum(float v) {
  unsigned u = __float_as_uint(v);
  auto rr = __builtin_amdgcn_permlane32_swap(u, u, false, false);
  return __uint_as_float(rr[0]) + __uint_as_float(rr[1]);
}
DI float wave_sum(float v) {
#pragma unroll
  for (int o = 32; o >= 1; o >>= 1) v += __shfl_xor(v, o);
  return v;
}
DI float wave_max(float v) {
#pragma unroll
  for (int o = 32; o >= 1; o >>= 1) v = fmaxf(v, __shfl_xor(v, o));
  return v;
}
DI void unpack8(uint4 v, float (&x)[8]) {
  x[0] = bflo(v.x); x[1] = bfhi(v.x); x[2] = bflo(v.y); x[3] = bfhi(v.y);
  x[4] = bflo(v.z); x[5] = bfhi(v.z); x[6] = bflo(v.w); x[7] = bfhi(v.w);
}
DI uint4 pack8(const float (&x)[8]) {
  uint4 v; v.x = pk2(x[0], x[1]); v.y = pk2(x[2], x[3]); v.z = pk2(x[4], x[5]); v.w = pk2(x[6], x[7]); return v;
}
DI u16* wsb(const Params& p, size_t off) { return (u16*)(p.ws + off); }
DI float* wsf(const Params& p, size_t off) { return (float*)(p.ws + off); }
DI const float* xrow(const Params& p, int l, int tok) {
  if (l == 0) return tok < NP ? p.x_prompt + (size_t)tok * 1024 : p.x_sample + (size_t)(tok - NP) * 1024;
  return p.out + (size_t)tok * 1024;
}
DI int tok_pos(int tok) { return tok < NP ? (tok & 16383) : 1024 + ((tok - NP) & 63); }

template <int TM, int TN>
DI void gemm_mainloop(const u16* __restrict__ A, long lda, const u16* __restrict__ Bt, long ldb, int K, char* smem,
                      f32x16 (&acc)[TM][TN]) {
  constexpr int BM = 64 * TM, BN = 64 * TN, LD = 72;
  u16* sA = (u16*)smem;
  u16* sB = sA + 2 * BM * LD;
  const int tid = tidx(), lane = tid & 63, w = tid >> 6, r = lane & 31, h = lane >> 5;
  const int wm = w >> 1, wn = w & 1;
  constexpr int NA = BM / 32, NB = BN / 32;
  u32x4 ra[NA], rb[NB];
#pragma unroll
  for (int tm = 0; tm < TM; tm++)
#pragma unroll
    for (int tn = 0; tn < TN; tn++)
#pragma unroll
      for (int i = 0; i < 16; i++) acc[tm][tn][i] = 0.f;
  const int nk = K / 64;
  const int lrow = tid >> 3, lch = (tid & 7) * 8;
  const u16* gA = A + (long)lrow * lda + lch;
  const u16* gB = Bt + (long)lrow * ldb + lch;
  const int soff = lrow * LD + lch;
#define GEMM_GLOAD(k0)                                                                   \
  {                                                                                      \
    _Pragma("unroll") for (int i = 0; i < NA; i++) ra[i] = *(const u32x4*)(gA + (long)(32 * i) * lda + (k0)); \
    _Pragma("unroll") for (int i = 0; i < NB; i++) rb[i] = *(const u32x4*)(gB + (long)(32 * i) * ldb + (k0)); \
  }
#define GEMM_SSTORE(buf)                                                                 \
  {                                                                                      \
    _Pragma("unroll") for (int i = 0; i < NA; i++) *(u32x4*)(sA + (buf) * BM * LD + soff + 32 * i * LD) = ra[i]; \
    _Pragma("unroll") for (int i = 0; i < NB; i++) *(u32x4*)(sB + (buf) * BN * LD + soff + 32 * i * LD) = rb[i]; \
  }
  GEMM_GLOAD(0)
  __syncthreads();
  GEMM_SSTORE(0)
  if (nk > 1) GEMM_GLOAD(64)
  __syncthreads();
  for (int kt = 0; kt < nk; kt++) {
    const int buf = kt & 1;
    const u16* cA = sA + buf * BM * LD + (wm * 32 * TM + r) * LD + h * 8;
    const u16* cB = sB + buf * BN * LD + (wn * 32 * TN + r) * LD + h * 8;
    bf16x8 af[TM], bfr[TN];
#pragma unroll
    for (int tm = 0; tm < TM; tm++) af[tm] = *(const bf16x8*)(cA + tm * 32 * LD);
#pragma unroll
    for (int tn = 0; tn < TN; tn++) bfr[tn] = *(const bf16x8*)(cB + tn * 32 * LD);
    if (kt + 1 < nk) GEMM_SSTORE(buf ^ 1)
    __builtin_amdgcn_sched_barrier(0);
    __builtin_amdgcn_s_setprio(1);
#pragma unroll
    for (int tm = 0; tm < TM; tm++)
#pragma unroll
      for (int tn = 0; tn < TN; tn++) acc[tm][tn] = MFMA(af[tm], bfr[tn], acc[tm][tn]);
#pragma unroll
    for (int tm = 0; tm < TM; tm++) af[tm] = *(const bf16x8*)(cA + tm * 32 * LD + 16);
#pragma unroll
    for (int tn = 0; tn < TN; tn++) bfr[tn] = *(const bf16x8*)(cB + tn * 32 * LD + 16);
#pragma unroll
    for (int tm = 0; tm < TM; tm++)
#pragma unroll
      for (int tn = 0; tn < TN; tn++) acc[tm][tn] = MFMA(af[tm], bfr[tn], acc[tm][tn]);
    __builtin_amdgcn_sched_barrier(0);
    if (kt + 2 < nk) GEMM_GLOAD((kt + 2) * 64)
    __builtin_amdgcn_sched_barrier(0);
#pragma unroll
    for (int ks = 2; ks < 4; ks++) {
#pragma unroll
      for (int tm = 0; tm < TM; tm++) af[tm] = *(const bf16x8*)(cA + tm * 32 * LD + ks * 16);
#pragma unroll
      for (int tn = 0; tn < TN; tn++) bfr[tn] = *(const bf16x8*)(cB + tn * 32 * LD + ks * 16);
#pragma unroll
      for (int tm = 0; tm < TM; tm++)
#pragma unroll
        for (int tn = 0; tn < TN; tn++) acc[tm][tn] = MFMA(af[tm], bfr[tn], acc[tm][tn]);
    }
    __builtin_amdgcn_s_setprio(0);
    __syncthreads();
  }
#undef GEMM_GLOAD
#undef GEMM_SSTORE
}

template <int TM, int TN, class Epi>
DI void gemm_tile(const u16* A, long lda, const u16* Bt, long ldb, int K, int m0, int n0, char* smem, const Epi& epi) {
  constexpr int BM = 64 * TM, BN = 64 * TN, LDC = BN + Epi::PAD;
  f32x16 acc[TM][TN];
  gemm_mainloop<TM, TN>(A + (long)m0 * lda, lda, Bt + (long)n0 * ldb, ldb, K, smem, acc);
  const int tid = tidx(), lane = tid & 63, w = tid >> 6, r = lane & 31, h = lane >> 5;
  const int wm = w >> 1, wn = w & 1;
  float* Ct = (float*)smem;
#pragma unroll
  for (int tm = 0; tm < TM; tm++)
#pragma unroll
    for (int tn = 0; tn < TN; tn++)
#pragma unroll
      for (int i = 0; i < 16; i++)
        Ct[(wm * 32 * TM + tm * 32 + crow(i, h)) * LDC + wn * 32 * TN + tn * 32 + r] = acc[tm][tn][i];
  __syncthreads();
  epi(Ct, LDC, m0, n0, tid);
  __syncthreads();
  (void)BM;
}

struct EpiStoreBf16 {
  static constexpr int PAD = 4;
  u16* out; long ldo; int nmax; float* gates;
  DI void operator()(const float* Ct, int ldc, int m0, int n0, int tid) const {
#pragma unroll
    for (int it = 0; it < 8; it++) {
      int id = tid + 256 * it; int row = id >> 4, c8 = (id & 15) * 8;
      int n = n0 + c8;
      if (n < nmax) {
        const float* c = Ct + row * ldc + c8;
        float4 a = *(const float4*)c, b = *(const float4*)(c + 4);
        uint4 v; v.x = pk2(a.x, a.y); v.y = pk2(a.z, a.w); v.z = pk2(b.x, b.y); v.w = pk2(b.z, b.w);
        *(uint4*)(out + (long)(m0 + row) * ldo + n) = v;
        if (gates != nullptr && n == 1952) {
          float* g = gates + (long)(m0 + row) * 8;
          *(float4*)g = a; *(float4*)(g + 4) = b;
        }
      }
    }
  }
};
struct EpiRelu2 {
  static constexpr int PAD = 4;
  u16* out; long ldo;
  DI void operator()(const float* Ct, int ldc, int m0, int n0, int tid) const {
#pragma unroll
    for (int it = 0; it < 8; it++) {
      int id = tid + 256 * it; int row = id >> 4, c8 = (id & 15) * 8;
      const float* c = Ct + row * ldc + c8;
      float x[8];
#pragma unroll
      for (int j = 0; j < 8; j++) { float v = fmaxf(c[j], 0.f); x[j] = v * v; }
      *(uint4*)(out + (long)(m0 + row) * ldo + n0 + c8) = pack8(x);
    }
  }
};
struct EpiF32 {
  static constexpr int PAD = 4;
  float* out; long ldo;
  DI void operator()(const float* Ct, int ldc, int m0, int n0, int tid) const {
#pragma unroll
    for (int it = 0; it < 8; it++) {
      int id = tid + 256 * it; int row = id >> 4, c8 = (id & 15) * 8;
      const float* c = Ct + row * ldc + c8;
      float* o = out + (long)(m0 + row) * ldo + n0 + c8;
      *(float4*)o = *(const float4*)c; *(float4*)(o + 4) = *(const float4*)(c + 4);
    }
  }
};
struct EpiRes {
  static constexpr int PAD = 4;
  const float* src0; const float* src1; float* dst;
  DI void operator()(const float* Ct, int ldc, int m0, int n0, int tid) const {
#pragma unroll
    for (int it = 0; it < 8; it++) {
      int id = tid + 256 * it; int row = id >> 4, c8 = (id & 15) * 8;
      int m = m0 + row;
      const float* s = (m < NP ? src0 + (size_t)m * 1024 : src1 + (size_t)(m - NP) * 1024) + n0 + c8;
      const float* c = Ct + row * ldc + c8;
      float4 a = *(const float4*)c, b = *(const float4*)(c + 4);
      float4 sa = *(const float4*)s, sb = *(const float4*)(s + 4);
      a.x += sa.x; a.y += sa.y; a.z += sa.z; a.w += sa.w; b.x += sb.x; b.y += sb.y; b.z += sb.z; b.w += sb.w;
      float* o = dst + (size_t)m * 1024 + n0 + c8;
      *(float4*)o = a; *(float4*)(o + 4) = b;
    }
  }
};
struct EpiQ {
  static constexpr int PAD = 1;
  u16* q; const float* rq; const float2* rope; const float* g;
  DI void operator()(const float* Ct, int ldc, int m0, int n0, int tid) const {
    float* r2s = (float*)((char*)Ct + 60000);
    {
      const int row = tid >> 2, hh = (tid >> 1) & 1, half = tid & 1; const int m = m0 + row;
      const float* c = Ct + row * ldc + hh * 96 + half * 48;
      float ss = 0.f;
#pragma unroll 8
      for (int d = 0; d < 48; d++) ss += c[d] * c[d];
      ss += __shfl_xor(ss, 1);
      const float rqv = rq[m];
      ss *= rqv * rqv;
      if (half == 0) r2s[row * 2 + hh] = rsqrtf(ss * (1.f / 96.f) + EPS) * rqv * (0.10206207261596575f * LOG2E);
    }
    __syncthreads();
#pragma unroll
    for (int it = 0; it < 6; it++) {
      const int id = tid + 256 * it; const int row = id / 24, cc = id % 24; const int hh = cc / 12, c8 = cc % 12;
      const int m = m0 + row;
      const float* c = Ct + row * ldc + hh * 96;
      const float r2 = r2s[row * 2 + hh];
      float x[8];
      if (c8 < 8) {
#pragma unroll
        for (int jj = 0; jj < 8; jj++) x[jj] = c[c8 * 8 + jj] * r2 * g[c8 * 8 + jj];
      } else {
        const int half = c8 & 1;
        const bool second = c8 >= 10;
        const float2* tab = rope + (size_t)tok_pos(m) * 16 + half * 8;
#pragma unroll
        for (int jj = 0; jj < 8; jj++) {
          const int i = half * 8 + jj;
          const float a = c[64 + i], b = c[80 + i]; const float2 cs = tab[jj];
          const float v = second ? (a * cs.y + b * cs.x) : (a * cs.x - b * cs.y);
          x[jj] = v * r2 * g[(second ? 80 : 64) + i];
        }
      }
      *(uint4*)(q + (size_t)m * 768 + n0 + cc * 8) = pack8(x);
    }
  }
};
struct EpiKV {
  static constexpr int PAD = 1;
  u16* Kb; u16* Vt; const float* krope; const float* g;
  DI void operator()(const float* Ct, int ldc, int m0, int n0, int tid) const {
    const int hd = n0 >> 7;
#pragma unroll
    for (int it = 0; it < 4; it++) {
      int id = tid + 256 * it; int oct = id & 15, e = id >> 4;
      float x[8];
#pragma unroll
      for (int j = 0; j < 8; j++) x[j] = Ct[(16 * (oct >> 1) + 4 * (oct & 1) + (j & 3) + 8 * (j >> 2)) * ldc + 64 + e];
      *(uint4*)(Vt + (size_t)(hd * 64 + e) * LDVT + m0 + oct * 8) = pack8(x);
    }
    float* rrs = (float*)((char*)Ct + 66560);
    {
      const int row = tid >> 1, half = tid & 1;
      const float* c = Ct + row * ldc + half * 32;
      const float* kr = krope + (size_t)(m0 + row) * 32 + half * 16;
      float ss = 0.f;
#pragma unroll 8
      for (int d = 0; d < 32; d++) ss += c[d] * c[d];
#pragma unroll 8
      for (int d = 0; d < 16; d++) ss += kr[d] * kr[d];
      ss += __shfl_xor(ss, 1);
      if (half == 0) rrs[row] = rsqrtf(ss * (1.f / 96.f) + EPS);
    }
    __syncthreads();
    u16* ob = Kb + ((size_t)hd * NROWS + m0) * 96;
#pragma unroll
    for (int it = 0; it < 6; it++) {
      const int id = tid + 256 * it; const int row = id / 12, cc = id % 12;
      const float rr = rrs[row];
      float x[8];
      if (cc < 8) {
        const float* c = Ct + row * ldc + cc * 8;
#pragma unroll
        for (int jj = 0; jj < 8; jj++) x[jj] = c[jj] * rr * g[cc * 8 + jj];
      } else {
        const float* kr = krope + (size_t)(m0 + row) * 32 + (cc - 8) * 8;
#pragma unroll
        for (int jj = 0; jj < 8; jj++) x[jj] = kr[jj] * rr * g[cc * 8 + jj];
      }
      *(uint4*)(ob + (size_t)id * 8) = pack8(x);
    }
  }
};

template <int DQK, int NE, int EV, bool DB, bool QNORM, bool QREG, bool VPERM = false>
DI void flash_item(const u16* Qrow, bool wave_active, int ntb, int ntw, const u16* Kbase, long ldk, const u16* Vtbase, long ldv,
                   int e0, u16* Orow, char* smem) {
  constexpr int LDK = DQK + 8, LDV = 72;
  constexpr int KS = DQK / 16;
  constexpr int KTILE = 64 * LDK, VTILE = EV * LDV;
  constexpr int NKC = 64 * (DQK / 8) / 256;
  constexpr int NVC = EV * 8 / 256;
  u16* sK = (u16*)smem;
  u16* sV = sK + (DB ? 2 : 1) * KTILE;
  const int tid = tidx(), lane = tid & 63, r = lane & 31, h = lane >> 5;
  bf16x8 qf[QREG ? KS : 1];
  float rqs = 1.f;
  if (wave_active) {
    if (QREG) {
#pragma unroll
      for (int ks = 0; ks < KS; ks++) qf[QREG ? ks : 0] = *(const bf16x8*)(Qrow + ks * 16 + h * 8);
    }
    if (QNORM) {
      float ss = 0.f;
#pragma unroll
      for (int ks = 0; ks < KS; ks++) {
        bf16x8 qq = QREG ? qf[QREG ? ks : 0] : *(const bf16x8*)(Qrow + ks * 16 + h * 8);
#pragma unroll
        for (int j = 0; j < 8; j++) { float v = bf2f((u16)qq[j]); ss += v * v; }
      }
      ss = xhalf_sum(ss);
      rqs = rsqrtf(ss * (1.f / DQK) + EPS);
    }
  } else if (QREG) {
#pragma unroll
    for (int ks = 0; ks < KS; ks++)
#pragma unroll
      for (int j = 0; j < 8; j++) qf[QREG ? ks : 0][j] = 0;
  }
  f32x16 o[NE];
#pragma unroll
  for (int et = 0; et < NE; et++)
#pragma unroll
    for (int i = 0; i < 16; i++) o[et][i] = 0.f;
  float mrun = 0.f, lrun = 0.f;
  const float rqinv = __builtin_amdgcn_rcpf(rqs);

  u32x4 rk[DB ? NKC : 1], rv[DB ? NVC : 1];
  auto gload = [&](int t) {
#pragma unroll
    for (int i = 0; i < NKC; i++) {
      int id = tid + 256 * i; int row = id / (DQK / 8), ch = id % (DQK / 8);
      u32x4 v = *(const u32x4*)(Kbase + (long)(t * 64 + row) * ldk + ch * 8);
      if (DB) rk[DB ? i : 0] = v; else *(u32x4*)(sK + row * LDK + ch * 8) = v;
    }
#pragma unroll
    for (int i = 0; i < NVC; i++) {
      int id = tid + 256 * i; int row = id >> 3, ch = id & 7;
      u32x4 v = *(const u32x4*)(Vtbase + (long)row * ldv + t * 64 + ch * 8);
      if (DB) rv[DB ? i : 0] = v; else *(u32x4*)(sV + row * LDV + ch * 8) = v;
    }
  };
  auto sstore = [&](int buf) {
#pragma unroll
    for (int i = 0; i < NKC; i++) { int id = tid + 256 * i; int row = id / (DQK / 8), ch = id % (DQK / 8); *(u32x4*)(sK + buf * KTILE + row * LDK + ch * 8) = rk[DB ? i : 0]; }
#pragma unroll
    for (int i = 0; i < NVC; i++) { int id = tid + 256 * i; int row = id >> 3, ch = id & 7; *(u32x4*)(sV + buf * VTILE + row * LDV + ch * 8) = rv[DB ? i : 0]; }
  };
  auto compute = [&](int buf) {
    const u16* cK = sK + buf * KTILE + r * LDK + h * 8;
    const u16* cV = sV + buf * VTILE + (e0 + r) * LDV + 4 * h;
    const float sinit = QNORM ? -mrun * rqinv : -mrun;
    f32x16 s[2];
#pragma unroll
    for (int sub = 0; sub < 2; sub++) {
#pragma unroll
      for (int i = 0; i < 16; i++) s[sub][i] = sinit;
#pragma unroll
      for (int ks = 0; ks < KS; ks++) {
        bf16x8 a = *(const bf16x8*)(cK + sub * 32 * LDK + ks * 16);
        bf16x8 qq = QREG ? qf[QREG ? ks : 0] : *(const bf16x8*)(Qrow + ks * 16 + h * 8);
        s[sub] = MFMA(a, qq, s[sub]);
      }
    }
    float mx = -1e30f;
#pragma unroll
    for (int sub = 0; sub < 2; sub++)
#pragma unroll
      for (int i = 0; i < 16; i++) { if (QNORM) s[sub][i] *= rqs; mx = fmaxf(mx, s[sub][i]); }
    mx = xhalf_max(mx);
    if (__any(mx > 8.f)) {
      const float d = fmaxf(mx, 0.f);
      const float alpha = __builtin_amdgcn_exp2f(-d);
      mrun += d;
      lrun *= alpha;
#pragma unroll
      for (int et = 0; et < NE; et++)
#pragma unroll
        for (int i = 0; i < 16; i++) o[et][i] *= alpha;
#pragma unroll
      for (int sub = 0; sub < 2; sub++)
#pragma unroll
        for (int i = 0; i < 16; i++) s[sub][i] -= d;
    }
    float psum = 0.f;
#pragma unroll
    for (int sub = 0; sub < 2; sub++)
#pragma unroll
      for (int i = 0; i < 16; i++) { float pv = __builtin_amdgcn_exp2f(s[sub][i]); s[sub][i] = pv; psum += pv; }
    lrun += psum;
#pragma unroll
    for (int sub = 0; sub < 2; sub++)
#pragma unroll
      for (int st = 0; st < 2; st++) {
        uint4 pp;
        pp.x = pk2(s[sub][8 * st + 0], s[sub][8 * st + 1]); pp.y = pk2(s[sub][8 * st + 2], s[sub][8 * st + 3]);
        pp.z = pk2(s[sub][8 * st + 4], s[sub][8 * st + 5]); pp.w = pk2(s[sub][8 * st + 6], s[sub][8 * st + 7]);
        bf16x8 pb = __builtin_bit_cast(bf16x8, pp);
#pragma unroll
        for (int et = 0; et < NE; et++) {
          bf16x8 a;
          if (VPERM) {
            a = *(const bf16x8*)(sV + buf * VTILE + (e0 + et * 32 + r) * LDV + sub * 32 + st * 16 + 8 * h);
          } else {
            const u16* vp = cV + et * 32 * LDV + sub * 32 + st * 16;
            s16x4 lo = *(const s16x4*)vp;
            s16x4 hi = *(const s16x4*)(vp + 8);
            a = __builtin_shufflevector(lo, hi, 0, 1, 2, 3, 4, 5, 6, 7);
          }
          o[et] = MFMA(a, pb, o[et]);
        }
      }
  };

  __syncthreads();
  if (DB) {
    gload(0);
    sstore(0);
    __syncthreads();
    for (int t = 0; t < ntb; t++) {
      const bool more = (t + 1 < ntb);
      if (more) gload(t + 1);
      __builtin_amdgcn_sched_barrier(0);
      if (wave_active && t < ntw) { __builtin_amdgcn_s_setprio(1); compute(t & 1); __builtin_amdgcn_s_setprio(0); }
      if (more) sstore((t + 1) & 1);
      __syncthreads();
    }
  } else {
    for (int t = 0; t < ntb; t++) {
      if (t > 0) __syncthreads();
      gload(t);
      __syncthreads();
      if (wave_active && t < ntw) compute(0);
    }
    __syncthreads();
  }
  if (wave_active) {
    float lt = xhalf_sum(lrun);
    float inv = __builtin_amdgcn_rcpf(lt);
#pragma unroll
    for (int et = 0; et < NE; et++)
#pragma unroll
      for (int g = 0; g < 4; g++) {
        uint2 v;
        v.x = pk2(o[et][4 * g + 0] * inv, o[et][4 * g + 1] * inv);
        v.y = pk2(o[et][4 * g + 2] * inv, o[et][4 * g + 3] * inv);
        *(uint2*)(Orow + et * 32 + 8 * g + 4 * h) = v;
      }
  }
}

DI void flash_item64(const u16* Qbase  , int ntb, int ntw, const u16* Kbase, const u16* Vtbase,
                     u16* Obase  , char* smem) {
  constexpr int LDK = 104, LDV = 72, KS = 6, KTILE = 64 * LDK, VTILE = 64 * LDV;
  u16* sK = (u16*)smem;
  u16* sV = sK + 2 * KTILE;
  const int tid = tidx(), lane = tid & 63, r = lane & 31, h = lane >> 5;
  bf16x8 qf[2][KS];
#pragma unroll
  for (int qh = 0; qh < 2; qh++)
#pragma unroll
    for (int ks = 0; ks < KS; ks++) qf[qh][ks] = *(const bf16x8*)(Qbase + (long)(qh * 32 + r) * 768 + ks * 16 + h * 8);
  f32x16 o[2][2];
#pragma unroll
  for (int qh = 0; qh < 2; qh++)
#pragma unroll
    for (int et = 0; et < 2; et++)
#pragma unroll
      for (int i = 0; i < 16; i++) o[qh][et][i] = 0.f;
  float mrun[2] = {0.f, 0.f}, lrun[2] = {0.f, 0.f};
  u32x4 rk[3], rv[2];
  auto gload = [&](int t) {
#pragma unroll
    for (int i = 0; i < 3; i++) { int id = tid + 256 * i; int row = id / 12, ch = id % 12; rk[i] = *(const u32x4*)(Kbase + (long)(t * 64 + row) * 96 + ch * 8); }
#pragma unroll
    for (int i = 0; i < 2; i++) { int id = tid + 256 * i; int row = id >> 3, ch = id & 7; rv[i] = *(const u32x4*)(Vtbase + (long)row * LDVT + t * 64 + ch * 8); }
  };
  auto sstore = [&](int buf) {
#pragma unroll
    for (int i = 0; i < 3; i++) { int id = tid + 256 * i; int row = id / 12, ch = id % 12; *(u32x4*)(sK + buf * KTILE + row * LDK + ch * 8) = rk[i]; }
#pragma unroll
    for (int i = 0; i < 2; i++) { int id = tid + 256 * i; int row = id >> 3, ch = id & 7; *(u32x4*)(sV + buf * VTILE + row * LDV + ch * 8) = rv[i]; }
  };
  auto compute = [&](int buf) {
    const u16* cK = sK + buf * KTILE + r * LDK + h * 8;
    const u16* cV = sV + buf * VTILE + r * LDV + 8 * h;
    f32x16 s[2][2];
#pragma unroll
    for (int sub = 0; sub < 2; sub++)
#pragma unroll
      for (int qh = 0; qh < 2; qh++)
#pragma unroll
        for (int i = 0; i < 16; i++) s[sub][qh][i] = -mrun[qh];
#pragma unroll
    for (int sub = 0; sub < 2; sub++)
#pragma unroll
      for (int ks = 0; ks < KS; ks++) {
        bf16x8 a = *(const bf16x8*)(cK + sub * 32 * LDK + ks * 16);
        s[sub][0] = MFMA(a, qf[0][ks], s[sub][0]);
        s[sub][1] = MFMA(a, qf[1][ks], s[sub][1]);
      }
#pragma unroll
    for (int qh = 0; qh < 2; qh++) {
      float mx = -1e30f;
#pragma unroll
      for (int sub = 0; sub < 2; sub++)
#pragma unroll
        for (int i = 0; i < 16; i++) mx = fmaxf(mx, s[sub][qh][i]);
      mx = xhalf_max(mx);
      if (__any(mx > 8.f)) {
        const float d = fmaxf(mx, 0.f);
        const float alpha = __builtin_amdgcn_exp2f(-d);
        mrun[qh] += d;
        lrun[qh] *= alpha;
#pragma unroll
        for (int et = 0; et < 2; et++)
#pragma unroll
          for (int i = 0; i < 16; i++) o[qh][et][i] *= alpha;
#pragma unroll
        for (int sub = 0; sub < 2; sub++)
#pragma unroll
          for (int i = 0; i < 16; i++) s[sub][qh][i] -= d;
      }
      float psum = 0.f;
#pragma unroll
      for (int sub = 0; sub < 2; sub++)
#pragma unroll
        for (int i = 0; i < 16; i++) { float pv = __builtin_amdgcn_exp2f(s[sub][qh][i]); s[sub][qh][i] = pv; psum += pv; }
      lrun[qh] += psum;
    }
#pragma unroll
    for (int sub = 0; sub < 2; sub++)
#pragma unroll
      for (int st = 0; st < 2; st++) {
        bf16x8 pb[2];
#pragma unroll
        for (int qh = 0; qh < 2; qh++) {
          uint4 pp;
          pp.x = pk2(s[sub][qh][8 * st + 0], s[sub][qh][8 * st + 1]); pp.y = pk2(s[sub][qh][8 * st + 2], s[sub][qh][8 * st + 3]);
          pp.z = pk2(s[sub][qh][8 * st + 4], s[sub][qh][8 * st + 5]); pp.w = pk2(s[sub][qh][8 * st + 6], s[sub][qh][8 * st + 7]);
          pb[qh] = __builtin_bit_cast(bf16x8, pp);
        }
#pragma unroll
        for (int et = 0; et < 2; et++) {
          bf16x8 a = *(const bf16x8*)(cV + et * 32 * LDV + sub * 32 + st * 16);
          o[0][et] = MFMA(a, pb[0], o[0][et]);
          o[1][et] = MFMA(a, pb[1], o[1][et]);
        }
      }
  };
  __syncthreads();
  gload(0);
  sstore(0);
  __syncthreads();
  for (int t = 0; t < ntb; t++) {
    const bool more = (t + 1 < ntb);
    if (more) gload(t + 1);
    __builtin_amdgcn_sched_barrier(0);
    if (t < ntw) { __builtin_amdgcn_s_setprio(1); compute(t & 1); __builtin_amdgcn_s_setprio(0); }
    if (more) sstore((t + 1) & 1);
    __syncthreads();
  }
#pragma unroll
  for (int qh = 0; qh < 2; qh++) {
    const float inv = __builtin_amdgcn_rcpf(xhalf_sum(lrun[qh]));
    u16* Orow = Obase + (long)(qh * 32 + r) * LDA;
#pragma unroll
    for (int et = 0; et < 2; et++)
#pragma unroll
      for (int g = 0; g < 4; g++) {
        uint2 v;
        v.x = pk2(o[qh][et][4 * g + 0] * inv, o[qh][et][4 * g + 1] * inv);
        v.y = pk2(o[qh][et][4 * g + 2] * inv, o[qh][et][4 * g + 3] * inv);
        *(uint2*)(Orow + et * 32 + 8 * g + 4 * h) = v;
      }
  }
}

DI void norm_row_wave(const float* src, u16* dst, int lane) {
  float4 v[4]; float ss = 0.f;
#pragma unroll
  for (int i = 0; i < 4; i++) { v[i] = *(const float4*)(src + i * 256 + lane * 4); ss += v[i].x * v[i].x + v[i].y * v[i].y + v[i].z * v[i].z + v[i].w * v[i].w; }
  ss = wave_sum(ss);
  float rr = rsqrtf(ss * (1.f / 1024.f) + EPS);
#pragma unroll
  for (int i = 0; i < 4; i++) {
    uint2 o; o.x = pk2(v[i].x * rr, v[i].y * rr); o.y = pk2(v[i].z * rr, v[i].w * rr);
    *(uint2*)(dst + i * 256 + lane * 4) = o;
  }
}

DI void phase_norm(const Params& p, int l) {
  const int lane = tidx() & 63, w = tidx() >> 6;
  u16* act = wsb(p, WS_ACT);
  for (int t = blockIdx.x * 4 + w; t < NTOK; t += gridDim.x * 4) norm_row_wave(xrow(p, l, t), act + (size_t)t * LDA, lane);
}

DI void wtile(const float* src, const float* gain, int K, int N, u16* dst, int ldd, int k0, int n0, char* smem) {
  u16* T = (u16*)smem;
  const int tid = tidx();
  __syncthreads();
  {
    const int nn = tid & 63, kk0 = tid >> 6;
    const int n = n0 + nn;
#pragma unroll 4
    for (int i = 0; i < 16; i++) {
      int kk = kk0 + 4 * i;
      float v = 0.f;
      if (n < N) { v = src[(size_t)(k0 + kk) * N + n]; if (gain) v *= gain[k0 + kk]; }
      T[nn * 72 + kk] = f2bf(v);
    }
  }
  __syncthreads();
  {
    const int nn = tid >> 2, kq = tid & 3;
    const uint4* s = (const uint4*)(T + nn * 72 + kq * 16);
    uint4* d = (uint4*)(dst + (size_t)(n0 + nn) * ldd + k0 + kq * 16);
    d[0] = s[0]; d[1] = s[1];
  }
}

DI void phase_prep(const Params& p, char* smem) {
  const int tid = tidx(), lane = tid & 63, w = tid >> 6;
  for (int t = blockIdx.x; t < 2 * 4048; t += gridDim.x) {
    int l = t / 4048, u = t % 4048;
    const float* src; const float* gain = nullptr; int K, N, Npad; size_t doff; int ldd = LDW;
    if (u < 640) { src = p.w_in + (size_t)l * 1024 * INC; gain = p.g_mix + l * 1024; K = 1024; N = INC; Npad = 2560; doff = W_IN; }
    else if (u < 688) { u -= 640; src = p.w_q_up + (size_t)l * 256 * 768; gain = p.g_qa + l * 256; K = 256; N = 768; Npad = 768; doff = W_Q; ldd = LDWQ; }
    else if (u < 720) { u -= 688; src = p.w_kv_up + (size_t)l * 128 * 1024; K = 128; N = 1024; Npad = 1024; doff = W_KV; ldd = LDWKV; }
    else if (u < 976) { u -= 720; src = p.w_out + (size_t)l * 1048576; K = 1024; N = 1024; Npad = 1024; doff = W_OUT; }
    else if (u < 1232) { u -= 976; src = p.w_xq + (size_t)l * 1048576; gain = p.g_xattn + l * 1024; K = 1024; N = 1024; Npad = 1024; doff = W_XQ; }
    else if (u < 1488) { u -= 1232; src = p.w_xk + (size_t)l * 1048576; gain = p.g_mem + l * 1024; K = 1024; N = 1024; Npad = 1024; doff = W_XK; }
    else if (u < 1744) { u -= 1488; src = p.w_xv + (size_t)l * 1048576; gain = p.g_mem + l * 1024; K = 1024; N = 1024; Npad = 1024; doff = W_XV; }
    else if (u < 2000) { u -= 1744; src = p.w_xo + (size_t)l * 1048576; K = 1024; N = 1024; Npad = 1024; doff = W_XO; }
    else if (u < 3024) { u -= 2000; src = p.w_ff1 + (size_t)l * 4194304; gain = p.g_mlp + l * 1024; K = 1024; N = 4096; Npad = 4096; doff = W_FF1; }
    else { u -= 3024; src = p.w_ff2 + (size_t)l * 4194304; K = 4096; N = 1024; Npad = 1024; doff = W_FF2; ldd = LDW2; }
    int nt = Npad / 64;
    int kt = u / nt, ntile = u % nt;
    wtile(src, gain, K, N, wsb(p, WS_W) + (size_t)l * W_LAYER + doff, ldd, kt * 64, ntile * 64, smem);
  }
  float2* tab = (float2*)(p.ws + WS_ROPE);
  for (int t = blockIdx.x; t < 1024; t += gridDim.x) {
    int idx = t * 256 + tid; int pos = idx >> 4, i = idx & 15;
    float inv_freq = __builtin_amdgcn_exp2f(-(float)i * 0.830482023721841f);
    float ang = (float)pos * inv_freq;
    double rev = (double)ang * 0.15915494309189535;
    rev -= rint(rev);
    float fr = (float)rev;
    tab[idx] = make_float2(__builtin_amdgcn_cosf(fr), __builtin_amdgcn_sinf(fr));
  }
  u16* hm = wsb(p, WS_HM);
  for (int t = blockIdx.x * 4 + w; t < 512; t += gridDim.x * 4) norm_row_wave(p.mem_prompt + (size_t)t * 1024, hm + (size_t)t * LDA, lane);
  phase_norm(p, 0);
}

template <class Epi>
DI void phase_gemm128(const Sched& sc, const u16* A, long lda, const u16* Bt, long ldb, int K, int MT, int NT, int SN, char* smem, const Epi& epi);
DI void phase_inproj(const Params& p, const Sched& sc, int l, char* smem) {
  const u16* W = wsb(p, WS_W) + (size_t)l * W_LAYER;
  {
    EpiStoreBf16 epi{wsb(p, WS_BIG + B_P), INC, INC, wsf(p, WS_GATES)};
    phase_gemm128(sc, wsb(p, WS_ACT), LDA, W + W_IN, LDW, 1024, 272, 20, 4, smem, epi);
  }
  if (l == 0) {
    for (int u = blockIdx.x; u < 128; u += gridDim.x) {
      int l2 = u >> 6, which = (u >> 5) & 1, mt = (u >> 3) & 3, nt = u & 7;
      const u16* W2 = wsb(p, WS_W) + (size_t)l2 * W_LAYER + (which ? W_XV : W_XK);
      EpiF32 epi{p.out + (which ? O_PMEMV : O_PMEMK) + (size_t)l2 * 524288, 1024};
      gemm_tile<2, 2>(wsb(p, WS_HM), LDA, W2, LDW, 1024, mt * 128, nt * 128, smem, epi);
    }
  }
}

DI void post_token(const Params& p, int l, int tok, int lane) {
  const u16* pr = wsb(p, WS_BIG + B_P) + (size_t)tok * INC;
  {
    uint2 q4 = *(const uint2*)(pr + lane * 4);
    float a = bflo(q4.x), b = bfhi(q4.x), c = bflo(q4.y), d = bfhi(q4.y);
    float ss = wave_sum(a * a + b * b + c * c + d * d);
    if (lane == 0) wsf(p, WS_RQ)[tok] = rsqrtf(ss * (1.f / 256.f) + EPS);
  }
  const bool prompt = tok < NP;
  int b, s, row, pos; float* ckv_out; float* kr_out;
  if (prompt) {
    b = tok >> 14; s = tok & 16383; row = tok; pos = s;
    ckv_out = p.out + O_PCKV + ((size_t)(l * 2 + b) * 16384 + s) * 128;
    kr_out = p.out + O_PKROPE + ((size_t)(l * 2 + b) * 16384 + s) * 32;
  } else {
    int t2 = tok - NP; b = t2 >> 6; s = t2 & 63; row = NP + b * 1088 + 1024 + s; pos = 1024 + s;
    ckv_out = p.out + O_SCKV + ((size_t)(l * 32 + b) * 64 + s) * 128;
    kr_out = p.out + O_SKROPE + ((size_t)(l * 32 + b) * 64 + s) * 32;
  }
  {
    unsigned c2 = *(const unsigned*)(pr + 256 + lane * 2);
    float c0 = bflo(c2), c1 = bfhi(c2);
    float ss = wave_sum(c0 * c0 + c1 * c1);
    float rr = rsqrtf(ss * (1.f / 128.f) + EPS);
    float o0 = c0 * rr * p.g_kva[l * 128 + lane * 2], o1 = c1 * rr * p.g_kva[l * 128 + lane * 2 + 1];
    *(float2*)(ckv_out + lane * 2) = make_float2(o0, o1);
    *(unsigned*)(wsb(p, WS_CKV) + (size_t)row * 128 + lane * 2) = pk2(o0, o1);
  }
  if (lane < 16) {
    float x1 = bf2f(pr[384 + lane]), x2 = bf2f(pr[400 + lane]);
    float2 cs = ((const float2*)(p.ws + WS_ROPE))[(size_t)pos * 16 + lane];
    float o1 = x1 * cs.x - x2 * cs.y, o2 = x1 * cs.y + x2 * cs.x;
    kr_out[lane] = o1; kr_out[16 + lane] = o2;
    float* ka = wsf(p, WS_KROPE) + (size_t)row * 32;
    ka[lane] = o1; ka[16 + lane] = o2;
  }
  const int S = prompt ? 16384 : 64;
  if (s >= S - 3) {
    int j = s - (S - 3);
    float* dst = prompt ? p.out + O_PCONV + ((size_t)(l * 2 + b) * 3 + j) * 1024 : p.out + O_SCONV + ((size_t)(l * 32 + b) * 3 + j) * 1024;
#pragma unroll 4
    for (int i = 0; i < 16; i++) dst[lane + 64 * i] = bf2f(pr[416 + lane + 64 * i]);
  }
}

DI void post_past(const Params& p, int l, int pi, int lane) {
  int b = pi >> 10, t = pi & 1023;
  size_t row = (size_t)NP + b * 1088 + t;
  const float* src = p.cache_ckv + ((size_t)(l * 32 + b) * 1024 + t) * 128;
  float2 v = *(const float2*)(src + lane * 2);
  *(unsigned*)(wsb(p, WS_CKV) + row * 128 + lane * 2) = pk2(v.x, v.y);
  if (lane < 32) wsf(p, WS_KROPE)[row * 32 + lane] = p.cache_krope[((size_t)(l * 32 + b) * 1024 + t) * 32 + lane];
}

struct ChunkInfo { int tok0, b, h, chain, has_prev, sample; };
DI ChunkInfo chunk_info(int item) {
  ChunkInfo ci;
  if (item < 2048) {
    ci.chain = item >> 8; ci.b = ci.chain >> 2; ci.h = ci.chain & 3; int c = item & 255;
    ci.tok0 = ci.b * 16384 + c * 64; ci.has_prev = (c > 0); ci.sample = 0;
  } else {
    int j = item - 2048; ci.chain = 8 + j; ci.b = j >> 2; ci.h = j & 3; ci.tok0 = NP + ci.b * 64; ci.has_prev = 0; ci.sample = 1;
  }
  return ci;
}
DI void load_x8(const Params& p, int l, const ChunkInfo& ci, int tp, int col, float (&x)[8]) {
  if (tp >= 0 || ci.has_prev) {
    uint4 v = *(const uint4*)(wsb(p, WS_BIG + B_P) + (size_t)(ci.tok0 + tp) * INC + col);
    unpack8(v, x);
  } else if (ci.sample) {
    const float* s = p.st_conv + (((size_t)l * 32 + ci.b) * 3 + (3 + tp)) * 1024 + (col - 416);
    float4 a = *(const float4*)s, b = *(const float4*)(s + 4);
    x[0] = a.x; x[1] = a.y; x[2] = a.z; x[3] = a.w; x[4] = b.x; x[5] = b.y; x[6] = b.z; x[7] = b.w;
  } else {
#pragma unroll
    for (int j = 0; j < 8; j++) x[j] = 0.f;
  }
}
template <class Emit>
DI void conv_run(const Params& p, int l, const ChunkInfo& ci, int mat, int chunk, int row0, int nrows, Emit emit) {
  const int ch0 = mat * 512 + ci.h * 128 + chunk * 8;
  const int col = 416 + ch0;
  float w0[8], w1[8], w2[8], w3[8], bias[8];
  {
    const float* wc = p.w_conv + (size_t)l * 4096 + ch0;
    float4 a, b;
    a = *(const float4*)(wc); b = *(const float4*)(wc + 4);
    w0[0] = a.x; w0[1] = a.y; w0[2] = a.z; w0[3] = a.w; w0[4] = b.x; w0[5] = b.y; w0[6] = b.z; w0[7] = b.w;
    a = *(const float4*)(wc + 1024); b = *(const float4*)(wc + 1028);
    w1[0] = a.x; w1[1] = a.y; w1[2] = a.z; w1[3] = a.w; w1[4] = b.x; w1[5] = b.y; w1[6] = b.z; w1[7] = b.w;
    a = *(const float4*)(wc + 2048); b = *(const float4*)(wc + 2052);
    w2[0] = a.x; w2[1] = a.y; w2[2] = a.z; w2[3] = a.w; w2[4] = b.x; w2[5] = b.y; w2[6] = b.z; w2[7] = b.w;
    a = *(const float4*)(wc + 3072); b = *(const float4*)(wc + 3076);
    w3[0] = a.x; w3[1] = a.y; w3[2] = a.z; w3[3] = a.w; w3[4] = b.x; w3[5] = b.y; w3[6] = b.z; w3[7] = b.w;
    const float* bc = p.b_conv + (size_t)l * 1024 + ch0;
    a = *(const float4*)(bc); b = *(const float4*)(bc + 4);
    bias[0] = a.x; bias[1] = a.y; bias[2] = a.z; bias[3] = a.w; bias[4] = b.x; bias[5] = b.y; bias[6] = b.z; bias[7] = b.w;
  }
  float xa[8], xb[8], xc[8], xd[8];
  load_x8(p, l, ci, row0 - 3, col, xa);
  load_x8(p, l, ci, row0 - 2, col, xb);
  load_x8(p, l, ci, row0 - 1, col, xc);
  for (int t = row0; t < row0 + nrows; t++) {
    load_x8(p, l, ci, t, col, xd);
    float y[8];
#pragma unroll
    for (int j = 0; j < 8; j++) {
      float v = bias[j] + xa[j] * w0[j] + xb[j] * w1[j] + xc[j] * w2[j] + xd[j] * w3[j];
      y[j] = v * __builtin_amdgcn_rcpf(1.f + __expf(-v));
      xa[j] = xb[j]; xb[j] = xc[j]; xc[j] = xd[j];
    }
    emit(t, y);
  }
}
DI float logsigmoid(float z) { return fminf(z, 0.f) - log1pf(__expf(-fabsf(z))); }

DI void mlstm_m1(const Params& p, int l, int item, char* smem) {
  const ChunkInfo ci = chunk_info(item);
  const int tid = tidx(), lane = tid & 63, w = tid >> 6, r = lane & 31, h = lane >> 5;
  u16* sVt = (u16*)smem;
  u16* sKt = sVt + 128 * 72;
  float* swk = (float*)(sKt + 128 * 72);
  __syncthreads();
  if (w == 0) {
    const float* g = wsf(p, WS_GATES) + (size_t)(ci.tok0 + lane) * 8;
    float ig = g[ci.h] + p.b_igate[l * 4 + ci.h];
    float lf = logsigmoid(g[4 + ci.h] + p.b_fgate[l * 4 + ci.h]);
    float bcs = lf;
#pragma unroll
    for (int o = 1; o < 64; o <<= 1) { float t = __shfl_up(bcs, o); if (lane >= o) bcs += t; }
    float u = ig - bcs;
    float umax = wave_max(u);
    swk[lane] = __expf(u - umax);
    float blast = __shfl(bcs, 63);
    if (lane == 0) { float* sc = wsf(p, WS_SCAL) + (size_t)item * 2; sc[0] = blast; sc[1] = blast + umax; }
  }
#pragma unroll
  for (int it = 0; it < 4; it++) {
    int id = tid + 256 * it; int s = id >> 4, ch = id & 15;
    uint4 v = *(const uint4*)(wsb(p, WS_BIG + B_P) + (size_t)(ci.tok0 + s) * INC + 1440 + ci.h * 128 + ch * 8);
    const u16* vv = (const u16*)&v;
    unsigned a[4] = {v.x, v.y, v.z, v.w};
#pragma unroll
    for (int j = 0; j < 4; j++) { sVt[(ch * 8 + 2 * j) * 72 + s] = (u16)(a[j] & 0xffffu); sVt[(ch * 8 + 2 * j + 1) * 72 + s] = (u16)(a[j] >> 16); }
    (void)vv;
  }
  __syncthreads();
  {
    const int chunk = tid & 15, rg = tid >> 4;
    conv_run(p, l, ci, 1, chunk, rg * 4, 4, [&](int t, const float (&y)[8]) {
      float sc = 0.08838834764831845f * swk[t];
#pragma unroll
      for (int j = 0; j < 8; j++) sKt[(chunk * 8 + j) * 72 + t] = f2bf(y[j] * sc);
    });
  }
  __syncthreads();
  const int wm = w >> 1, wn = w & 1;
  f32x16 acc[2][2];
#pragma unroll
  for (int a = 0; a < 2; a++)
#pragma unroll
    for (int b = 0; b < 2; b++)
#pragma unroll
      for (int i = 0; i < 16; i++) acc[a][b][i] = 0.f;
#pragma unroll
  for (int ks = 0; ks < 4; ks++) {
    bf16x8 af[2], bfr[2];
#pragma unroll
    for (int tm = 0; tm < 2; tm++) af[tm] = *(const bf16x8*)(sVt + (wm * 64 + tm * 32 + r) * 72 + ks * 16 + h * 8);
#pragma unroll
    for (int tn = 0; tn < 2; tn++) bfr[tn] = *(const bf16x8*)(sKt + (wn * 64 + tn * 32 + r) * 72 + ks * 16 + h * 8);
#pragma unroll
    for (int tm = 0; tm < 2; tm++)
#pragma unroll
      for (int tn = 0; tn < 2; tn++) acc[tm][tn] = MFMA(bfr[tn], af[tm], acc[tm][tn]);
  }
  u16* slot = wsb(p, WS_BIG + B_ST) + (size_t)item * 16384;
#pragma unroll
  for (int tm = 0; tm < 2; tm++)
#pragma unroll
    for (int tn = 0; tn < 2; tn++)
#pragma unroll
      for (int g = 0; g < 4; g++) {
        uint2 v;
        v.x = pk2(acc[tm][tn][4 * g + 0], acc[tm][tn][4 * g + 1]);
        v.y = pk2(acc[tm][tn][4 * g + 2], acc[tm][tn][4 * g + 3]);
        *(uint2*)(slot + (wm * 64 + tm * 32 + r) * 128 + wn * 64 + tn * 32 + 8 * g + 4 * h) = v;
      }
  if (tid < 128) {
    float sum = 0.f;
    const u16* kr = sKt + tid * 72;
#pragma unroll 8
    for (int s = 0; s < 64; s++) sum += bf2f(kr[s]);
    wsf(p, WS_NU)[(size_t)item * 128 + tid] = sum;
  }
}

DI void mlstm_m2(const Params& p, int l, int unit, char* smem) {
  const int tid = tidx();
  int chain, g, nc, item0, b, h; bool sample;
  if (unit < 256) { chain = unit >> 5; g = unit & 31; nc = 256; item0 = chain * 256; b = chain >> 2; h = chain & 3; sample = false; }
  else { int u = unit - 256; int j = u >> 5; g = u & 31; chain = 8 + j; nc = 1; item0 = 2048 + j; b = j >> 2; h = j & 3; sample = true; }
  const int el = g * 512 + tid * 2; const int e = el >> 7, d = el & 127;
  float c0 = 0.f, c1 = 0.f, nst = 0.f, m0 = 0.f;
  const bool do_n = (g == 0 && tid < 128);
  if (sample) {
    const float* C0 = p.st_C + ((size_t)(l * 32 + b) * 4 + h) * 16384;
    c0 = C0[d * 128 + e]; c1 = C0[(d + 1) * 128 + e];
    if (do_n) nst = p.st_n[((size_t)(l * 32 + b) * 4 + h) * 128 + tid];
    m0 = p.st_m[(l * 32 + b) * 4 + h];
  }
  u16* slots = wsb(p, WS_BIG + B_ST);
  const float* scal = wsf(p, WS_SCAL);
  float* nu = wsf(p, WS_NU);
  float* mst = wsf(p, WS_MST);
  float* sA = (float*)smem; float* sC = sA + 256; float* sdec = sC + 256; float* sus = sdec + 256; float* smst = sus + 256;
  __syncthreads();
  if (tid < nc) { sA[tid] = scal[(size_t)(item0 + tid) * 2]; sC[tid] = scal[(size_t)(item0 + tid) * 2 + 1]; }
  __syncthreads();
  if (tid == 0) {
    float m = m0;
    for (int c = 0; c < nc; c++) {
      const float A = sA[c], Cm = sC[c];
      const float mnew = fmaxf(A + m, Cm);
      sdec[c] = __expf(A + m - mnew); sus[c] = __expf(Cm - mnew); smst[c] = m;
      m = mnew;
    }
    smst[256] = m;
  }
  __syncthreads();
  unsigned uu[8], un[8]; float nn[8], nx[8];
#pragma unroll
  for (int j = 0; j < 8; j++) {
    uu[j] = 0; nn[j] = 0.f;
    if (j < nc) {
      uu[j] = *(const unsigned*)(slots + (size_t)(item0 + j) * 16384 + el);
      if (do_n) nn[j] = nu[(size_t)(item0 + j) * 128 + tid];
    }
  }
  for (int cb = 0; cb < nc; cb += 8) {
#pragma unroll
    for (int j = 0; j < 8; j++) {
      un[j] = 0; nx[j] = 0.f;
      if (cb + 8 + j < nc) {
        un[j] = *(const unsigned*)(slots + (size_t)(item0 + cb + 8 + j) * 16384 + el);
        if (do_n) nx[j] = nu[(size_t)(item0 + cb + 8 + j) * 128 + tid];
      }
    }
#pragma unroll
    for (int j = 0; j < 8; j++) {
      if (cb + j < nc) {
        const int item = item0 + cb + j;
        const float dec = sdec[cb + j], us = sus[cb + j];
        *(unsigned*)(slots + (size_t)item * 16384 + el) = pk2(c0, c1);
        c0 = dec * c0 + us * bflo(uu[j]);
        c1 = dec * c1 + us * bfhi(uu[j]);
        if (do_n) { nu[(size_t)item * 128 + tid] = nst; nst = dec * nst + us * nn[j]; }
        if (g == 0 && tid == 0) mst[item] = smst[cb + j];
      }
    }
#pragma unroll
    for (int j = 0; j < 8; j++) { uu[j] = un[j]; nn[j] = nx[j]; }
  }
  float* oC = sample ? p.out + O_SC + ((size_t)(l * 32 + b) * 4 + h) * 16384 : p.out + O_PC + ((size_t)(l * 2 + b) * 4 + h) * 16384;
  oC[d * 128 + e] = c0; oC[(d + 1) * 128 + e] = c1;
  if (do_n) { float* on = sample ? p.out + O_SN + ((size_t)(l * 32 + b) * 4 + h) * 128 : p.out + O_PN + ((size_t)(l * 2 + b) * 4 + h) * 128; on[tid] = nst; }
  if (g == 0 && tid == 0) { float* om = sample ? p.out + O_SM + (l * 32 + b) * 4 + h : p.out + O_PM + (l * 2 + b) * 4 + h; *om = smst[256]; }
}

DI void mlstm_m3(const Params& p, int l, int item, char* smem) {
  const ChunkInfo ci = chunk_info(item);
  const int tid = tidx(), lane = tid & 63, w = tid >> 6, r = lane & 31, h = lane >> 5;
  u16* sQ = (u16*)smem;
  u16* sK = sQ + 64 * 136;
  u16* sVt = sK + 64 * 136;
  u16* sP = sVt + 128 * 72;
  float* su = (float*)(sP + 64 * 72);
  float* sM = su + 64;
  float* sa = sM + 64;
  float* sden = sa + 64;
  float* sinv = sden + 64;
  float* sn = sinv + 64;
  float* sH = (float*)smem;
  __syncthreads();
  const float m_start = wsf(p, WS_MST)[item];
  if (w == 0) {
    const float* g = wsf(p, WS_GATES) + (size_t)(ci.tok0 + lane) * 8;
    float ig = g[ci.h] + p.b_igate[l * 4 + ci.h];
    float lf = logsigmoid(g[4 + ci.h] + p.b_fgate[l * 4 + ci.h]);
    float bcs = lf;
#pragma unroll
    for (int o = 1; o < 64; o <<= 1) { float t = __shfl_up(bcs, o); if (lane >= o) bcs += t; }
    float u = ig - bcs;
    float cm = u;
#pragma unroll
    for (int o = 1; o < 64; o <<= 1) { float t = __shfl_up(cm, o); if (lane >= o) cm = fmaxf(cm, t); }
    float Mt = fmaxf(m_start, cm);
    su[lane] = u; sM[lane] = Mt; sa[lane] = __expf(m_start - Mt); sden[lane] = __expf(-(bcs + Mt));
  } else if (w == 1) {
    sn[lane] = wsf(p, WS_NU)[(size_t)item * 128 + lane];
    sn[lane + 64] = wsf(p, WS_NU)[(size_t)item * 128 + lane + 64];
  }
#pragma unroll
  for (int it = 0; it < 4; it++) {
    int id = tid + 256 * it; int s = id >> 4, ch = id & 15;
    uint4 v = *(const uint4*)(wsb(p, WS_BIG + B_P) + (size_t)(ci.tok0 + s) * INC + 1440 + ci.h * 128 + ch * 8);
    unsigned a[4] = {v.x, v.y, v.z, v.w};
#pragma unroll
    for (int j = 0; j < 4; j++) { sVt[(ch * 8 + 2 * j) * 72 + s] = (u16)(a[j] & 0xffffu); sVt[(ch * 8 + 2 * j + 1) * 72 + s] = (u16)(a[j] >> 16); }
  }
  {
    const int mc = tid & 31, mat = mc >> 4, chunk = mc & 15, rg = tid >> 5;
    u16* dst = mat ? sK : sQ;
    const float sc = mat ? 0.08838834764831845f : 1.f;
    conv_run(p, l, ci, mat, chunk, rg * 8, 8, [&](int t, const float (&y)[8]) {
      float x[8];
#pragma unroll
      for (int j = 0; j < 8; j++) x[j] = y[j] * sc;
      *(uint4*)(dst + t * 136 + chunk * 8) = pack8(x);
    });
  }
  __syncthreads();
  {
    const int tq = w >> 1, ts = w & 1;
    f32x16 s;
#pragma unroll
    for (int i = 0; i < 16; i++) s[i] = 0.f;
#pragma unroll
    for (int ks = 0; ks < 8; ks++) {
      bf16x8 a = *(const bf16x8*)(sQ + (tq * 32 + r) * 136 + ks * 16 + h * 8);
      bf16x8 b = *(const bf16x8*)(sK + (ts * 32 + r) * 136 + ks * 16 + h * 8);
      s = MFMA(a, b, s);
    }
    const int sidx = ts * 32 + r;
    const float us = su[sidx];
#pragma unroll
    for (int i = 0; i < 16; i++) {
      int t = tq * 32 + crow(i, h);
      float v = (sidx <= t) ? s[i] * __expf(us - sM[t]) : 0.f;
      sP[t * 72 + sidx] = f2bf(v);
    }
  }
  __syncthreads();
  if (tid < 64) {
    float rs = 0.f, qd = 0.f;
    const u16* pr = sP + tid * 72;
#pragma unroll 8
    for (int s = 0; s < 64; s++) rs += bf2f(pr[s]);
    const u16* qr = sQ + tid * 136;
#pragma unroll 8
    for (int d = 0; d < 128; d++) qd += bf2f(qr[d]) * sn[d];
    float qn = sa[tid] * qd + rs;
    sinv[tid] = __builtin_amdgcn_rcpf(fmaxf(fabsf(qn), sden[tid]));
  }
  const int tq = w & 1, eb = (w >> 1) * 2;
  f32x16 a1[2], a2[2];
#pragma unroll
  for (int et = 0; et < 2; et++)
#pragma unroll
    for (int i = 0; i < 16; i++) { a1[et][i] = 0.f; a2[et][i] = 0.f; }
  const u16* slot = wsb(p, WS_BIG + B_ST) + (size_t)item * 16384;
#pragma unroll
  for (int ks = 0; ks < 8; ks++) {
    bf16x8 a = *(const bf16x8*)(sQ + (tq * 32 + r) * 136 + ks * 16 + h * 8);
#pragma unroll
    for (int et = 0; et < 2; et++) {
      bf16x8 b = *(const bf16x8*)(slot + ((eb + et) * 32 + r) * 128 + ks * 16 + h * 8);
      a1[et] = MFMA(a, b, a1[et]);
    }
  }
#pragma unroll
  for (int ks = 0; ks < 4; ks++) {
    bf16x8 a = *(const bf16x8*)(sP + (tq * 32 + r) * 72 + ks * 16 + h * 8);
#pragma unroll
    for (int et = 0; et < 2; et++) {
      bf16x8 b = *(const bf16x8*)(sVt + ((eb + et) * 32 + r) * 72 + ks * 16 + h * 8);
      a2[et] = MFMA(a, b, a2[et]);
    }
  }
  __syncthreads();
#pragma unroll
  for (int et = 0; et < 2; et++)
#pragma unroll
    for (int i = 0; i < 16; i++) {
      int t = tq * 32 + crow(i, h);
      sH[t * 132 + (eb + et) * 32 + r] = (sa[t] * a1[et][i] + a2[et][i]) * sinv[t];
    }
  __syncthreads();
  {
    const int t = tid >> 2, part = tid & 3;
    const float* hr = sH + t * 132 + part * 32;
    float ss = 0.f;
#pragma unroll 8
    for (int j = 0; j < 32; j++) ss += hr[j] * hr[j];
    ss += __shfl_xor(ss, 1); ss += __shfl_xor(ss, 2);
    const float rr = rsqrtf(ss * (1.f / 128.f) + EPS);
    const int tok = ci.tok0 + t;
    const u16* og = wsb(p, WS_BIG + B_P) + (size_t)tok * INC + 1960 + ci.h * 128 + part * 32;
    const float* gm = p.g_mhead + (size_t)l * 512 + ci.h * 128 + part * 32;
    u16* o = wsb(p, WS_ACT) + (size_t)tok * LDA + 512 + ci.h * 128 + part * 32;
#pragma unroll
    for (int c8 = 0; c8 < 4; c8++) {
      float gv[8], x[8];
      unpack8(*(const uint4*)(og + c8 * 8), gv);
#pragma unroll
      for (int j = 0; j < 8; j++) x[j] = hr[c8 * 8 + j] * rr * gm[c8 * 8 + j] * __builtin_amdgcn_rcpf(1.f + __expf(-gv[j]));
      *(uint4*)(o + c8 * 8) = pack8(x);
    }
  }
}

DI void xkv_item(const Params& p, int l, int item, char* smem) {
  const int tid = tidx();
  const int kg = item & 3, hh = (item >> 2) & 3, bidx = item >> 4;
  u16* T = (u16*)smem;
  __syncthreads();
  const int key = tid >> 2, qt = tid & 3;
  const int mem = kg * 64 + key;
  const bool prompt = bidx < 2;
  float* kp; const float* vp;
  if (prompt) {
    kp = p.out + O_PMEMK + (((size_t)(l * 2 + bidx) * 256 + mem) * 4 + hh) * 256 + qt * 64;
    vp = p.out + O_PMEMV + (((size_t)(l * 2 + bidx) * 256 + mem) * 4 + hh) * 256 + qt * 64;
  } else {
    kp = (float*)(p.cache_mem_k + (((size_t)(l * 32 + bidx - 2) * 256 + mem) * 4 + hh) * 256 + qt * 64);
    vp = p.cache_mem_v + (((size_t)(l * 32 + bidx - 2) * 256 + mem) * 4 + hh) * 256 + qt * 64;
  }
  float rr = 1.f;
  if (prompt) {
    float ss = 0.f;
#pragma unroll 4
    for (int j = 0; j < 16; j++) { float4 v = *(const float4*)(kp + j * 4); ss += v.x * v.x + v.y * v.y + v.z * v.z + v.w * v.w; }
    ss += __shfl_xor(ss, 1); ss += __shfl_xor(ss, 2);
    rr = rsqrtf(ss * (1.f / 256.f) + EPS);
  }
  const float* gk = p.g_xk + l * 256 + qt * 64;
  const float* gq = p.g_xq + l * 256 + qt * 64;
  u16* xk = wsb(p, WS_BIG + B_XK) + ((size_t)(bidx * 4 + hh) * 256 + mem) * 256 + qt * 64;
#pragma unroll 2
  for (int c8 = 0; c8 < 8; c8++) {
    float4 a = *(const float4*)(kp + c8 * 8), b = *(const float4*)(kp + c8 * 8 + 4);
    float x[8] = {a.x, a.y, a.z, a.w, b.x, b.y, b.z, b.w};
    if (prompt) {
#pragma unroll
      for (int j = 0; j < 8; j++) x[j] = x[j] * rr * gk[c8 * 8 + j];
      *(float4*)(kp + c8 * 8) = make_float4(x[0], x[1], x[2], x[3]);
      *(float4*)(kp + c8 * 8 + 4) = make_float4(x[4], x[5], x[6], x[7]);
    }
#pragma unroll
    for (int j = 0; j < 8; j++) x[j] = x[j] * gq[c8 * 8 + j] * (0.0625f * LOG2E);
    *(uint4*)(xk + c8 * 8) = pack8(x);
    float4 va = *(const float4*)(vp + c8 * 8), vb = *(const float4*)(vp + c8 * 8 + 4);
    float y[8] = {va.x, va.y, va.z, va.w, vb.x, vb.y, vb.z, vb.w};
    *(uint4*)(T + key * 264 + qt * 64 + c8 * 8) = pack8(y);
  }
  __syncthreads();
  {
    const int e = tid;
    u16* xv = wsb(p, WS_BIG + B_XVT) + ((size_t)(bidx * 4 + hh) * 256 + e) * LDXV + kg * 64;
#pragma unroll 2
    for (int oct = 0; oct < 8; oct++) {
      uint4 v;
      const int kb = 16 * (oct >> 1) + 4 * (oct & 1);
      v.x = (unsigned)T[(kb + 0) * 264 + e] | ((unsigned)T[(kb + 1) * 264 + e] << 16);
      v.y = (unsigned)T[(kb + 2) * 264 + e] | ((unsigned)T[(kb + 3) * 264 + e] << 16);
      v.z = (unsigned)T[(kb + 8) * 264 + e] | ((unsigned)T[(kb + 9) * 264 + e] << 16);
      v.w = (unsigned)T[(kb + 10) * 264 + e] | ((unsigned)T[(kb + 11) * 264 + e] << 16);
      *(uint4*)(xv + oct * 8) = v;
    }
  }
}

DI void phase_C2(const Params& p, int l, char* smem) {
  for (int t = blockIdx.x; t < 544; t += gridDim.x) xkv_item(p, l, t, smem);
}
DI void phase_C1(const Params& p, int l, char* smem) {
  const int lane = tidx() & 63, w = tidx() >> 6;
  for (int t = blockIdx.x; t < NITEM; t += gridDim.x) mlstm_m1(p, l, t, smem);
  for (int t = blockIdx.x * 4 + w; t < NTOK + 32768; t += gridDim.x * 4) {
    if (t < NTOK) post_token(p, l, t, lane); else post_past(p, l, t - NTOK, lane);
  }
}

DI void phase_D(const Params& p, int l, char* smem) {
  const int n_scan = 256 + 4096;
  const int n_q = 544 * 4;
  const u16* W = wsb(p, WS_W) + (size_t)l * W_LAYER;
  for (int t = blockIdx.x; t < n_scan + n_q; t += gridDim.x) {
    if (t < n_scan) mlstm_m2(p, l, t, smem);
    else {
      int u = t - n_scan; int mt = u >> 2, nt = u & 3;
      EpiQ epi{wsb(p, WS_BIG + B_Q), wsf(p, WS_RQ), (const float2*)(p.ws + WS_ROPE), p.g_qnorm + l * 96};
      gemm_tile<1, 3>(wsb(p, WS_BIG + B_P), INC, W + W_Q, LDWQ, 256, mt * 64, nt * 192, smem, epi);
    }
  }
}

DI void phase_E(const Params& p, int l, char* smem) {
  for (int t = blockIdx.x; t < NITEM; t += gridDim.x) mlstm_m3(p, l, t, smem);
}

DI void phase_F(const Params& p, int l, char* smem) {
  const u16* W = wsb(p, WS_W) + (size_t)l * W_LAYER;
  for (int t = blockIdx.x; t < 528 * 8; t += gridDim.x) {
    int mt = t >> 3, nt = t & 7;
    EpiKV epi{wsb(p, WS_BIG + B_K), wsb(p, WS_BIG + B_VT), wsf(p, WS_KROPE), p.g_knorm + l * 96};
    gemm_tile<2, 2>(wsb(p, WS_CKV), 128, W + W_KV, LDWKV, 128, mt * 128, nt * 128, smem, epi);
  }
}

DI void phase_G(const Params& p, const Sched& sc, char* smem) {
  const int G = gridDim.x, j = blockIdx.x;
  const int lane = tidx() & 63, w = tidx() >> 6, r = lane & 31;
  const int NIT = 2048 + 256;
  const u16* qb = wsb(p, WS_BIG + B_Q);
  const u16* Kb = wsb(p, WS_BIG + B_K);
  const u16* Vt = wsb(p, WS_BIG + B_VT);
  u16* act = wsb(p, WS_ACT);
  auto run_prompt = [&](int bh, int bi) {
    int b = bh >> 3, hd = bh & 7;
    int tok = b * 16384 + bi * 128 + w * 32 + r;
    flash_item<96, 2, 64, true, false, true, true>(qb + (size_t)tok * 768 + hd * 96, true, 2 * bi + 2, 2 * bi + 1 + (w >> 1),
                                             Kb + ((size_t)hd * NROWS + b * 16384) * 96, 96, Vt + (size_t)hd * 64 * LDVT + b * 16384, LDVT, 0,
                                             act + (size_t)tok * LDA + hd * 64, smem);
  };
  auto run_sample = [&](int u) {
    int b = u >> 3, hd = u & 7;
    int tok = NP + b * 64 + (w & 1) * 32 + r;
    size_t row0 = (size_t)NP + b * 1088;
    flash_item<96, 2, 64, true, false, true, true>(qb + (size_t)tok * 768 + hd * 96, w < 2, 17, 17, Kb + ((size_t)hd * NROWS + row0) * 96, 96,
                                             Vt + (size_t)hd * 64 * LDVT + row0, LDVT, 0, act + (size_t)tok * LDA + hd * 64, smem);
  };
  if (sc.ok) {
    const int xg = sc.xg, xi = sc.xi;
    for (int pass = 0; pass < 2; pass++) {
      const int bh = xg + 8 * pass, b = bh >> 3, hd = bh & 7;
      const int bi = pass ? 63 - xi : xi;
      const int tok0 = b * 16384 + bi * 256 + w * 64;
      flash_item64(qb + (size_t)tok0 * 768 + hd * 96, 4 * bi + 4, 4 * bi + w + 1, Kb + ((size_t)hd * NROWS + b * 16384) * 96,
                   Vt + (size_t)hd * 64 * LDVT + b * 16384, act + (size_t)tok0 * LDA + hd * 64, smem);
    }
    if ((j & 1) == 0) run_sample(j >> 1);
  } else {
    for (int k = 0; k * G < NIT; k++) {
      int it = (k & 1) ? (k * G + (G - 1 - j)) : (k * G + j);
      if (it >= NIT) continue;
      if (it < 2048) run_prompt(it & 15, 127 - (it >> 4)); else run_sample(it - 2048);
    }
  }
}

DI void xattn_item(const u16* Qtile  , const u16* Kbase, const u16* Vtbase, u16* Otile, char* smem) {
  constexpr int LDQ = 264, LDV = 40;
  u16* sQ = (u16*)smem;
  u16* sK = sQ + 64 * LDQ;
  u16* sV = sK + 32 * LDQ;
  const int tid = tidx(), lane = tid & 63, w = tid >> 6, r = lane & 31, h = lane >> 5;
  const int qrow = 32 * (w & 1) + r, e0 = 128 * (w >> 1);
  u32x4 rk[4], rv[4];
  auto gload = [&](int t) {
#pragma unroll
    for (int i = 0; i < 4; i++) {
      int id = tid + 256 * i;
      rk[i] = *(const u32x4*)(Kbase + (long)(t * 32 + (id >> 5)) * 256 + (id & 31) * 8);
      rv[i] = *(const u32x4*)(Vtbase + (long)(id >> 2) * LDXV + t * 32 + (id & 3) * 8);
    }
  };
  auto sstore = [&]() {
#pragma unroll
    for (int i = 0; i < 4; i++) {
      int id = tid + 256 * i;
      *(u32x4*)(sK + (id >> 5) * LDQ + (id & 31) * 8) = rk[i];
      *(u32x4*)(sV + (id >> 2) * LDV + (id & 3) * 8) = rv[i];
    }
  };
  __syncthreads();
  gload(0);
#pragma unroll
  for (int i = 0; i < 8; i++) {
    int id = tid + 256 * i;
    *(u32x4*)(sQ + (id >> 5) * LDQ + (id & 31) * 8) = *(const u32x4*)(Qtile + (long)(id >> 5) * LDA + (id & 31) * 8);
  }
  sstore();
  __syncthreads();
  float rqs;
  {
    float ss = 0.f;
#pragma unroll
    for (int ks = 0; ks < 16; ks++) {
      bf16x8 qq = *(const bf16x8*)(sQ + qrow * LDQ + ks * 16 + h * 8);
#pragma unroll
      for (int j = 0; j < 8; j++) { float v = bf2f((u16)qq[j]); ss += v * v; }
    }
    ss = xhalf_sum(ss);
    rqs = rsqrtf(ss * (1.f / 256.f) + EPS);
  }
  const float rqinv = __builtin_amdgcn_rcpf(rqs);
  f32x16 o[4];
#pragma unroll
  for (int et = 0; et < 4; et++)
#pragma unroll
    for (int i = 0; i < 16; i++) o[et][i] = 0.f;
  float mrun = 0.f, lrun = 0.f;
  for (int t = 0; t < 8; t++) {
    if (t + 1 < 8) gload(t + 1);
    __builtin_amdgcn_sched_barrier(0);
    __builtin_amdgcn_s_setprio(1);
    {
      f32x16 s;
      const float sinit = -mrun * rqinv;
#pragma unroll
      for (int i = 0; i < 16; i++) s[i] = sinit;
#pragma unroll
      for (int ks = 0; ks < 16; ks++) {
        bf16x8 a = *(const bf16x8*)(sK + r * LDQ + ks * 16 + h * 8);
        bf16x8 b = *(const bf16x8*)(sQ + qrow * LDQ + ks * 16 + h * 8);
        s = MFMA(a, b, s);
      }
      float mx = -1e30f;
#pragma unroll
      for (int i = 0; i < 16; i++) { s[i] *= rqs; mx = fmaxf(mx, s[i]); }
      mx = xhalf_max(mx);
      if (__any(mx > 8.f)) {
        const float d = fmaxf(mx, 0.f);
        const float alpha = __builtin_amdgcn_exp2f(-d);
        mrun += d;
        lrun *= alpha;
#pragma unroll
        for (int et = 0; et < 4; et++)
#pragma unroll
          for (int i = 0; i < 16; i++) o[et][i] *= alpha;
#pragma unroll
        for (int i = 0; i < 16; i++) s[i] -= d;
      }
      float psum = 0.f;
#pragma unroll
      for (int i = 0; i < 16; i++) { float pv = __builtin_amdgcn_exp2f(s[i]); s[i] = pv; psum += pv; }
      lrun += psum;
#pragma unroll
      for (int st = 0; st < 2; st++) {
        uint4 pp;
        pp.x = pk2(s[8 * st + 0], s[8 * st + 1]); pp.y = pk2(s[8 * st + 2], s[8 * st + 3]);
        pp.z = pk2(s[8 * st + 4], s[8 * st + 5]); pp.w = pk2(s[8 * st + 6], s[8 * st + 7]);
        bf16x8 pb = __builtin_bit_cast(bf16x8, pp);
#pragma unroll
        for (int et = 0; et < 4; et++) {
          bf16x8 a = *(const bf16x8*)(sV + (e0 + et * 32 + r) * LDV + st * 16 + 8 * h);
          o[et] = MFMA(a, pb, o[et]);
        }
      }
    }
    __builtin_amdgcn_s_setprio(0);
    __builtin_amdgcn_sched_barrier(0);
    __syncthreads();
    if (t + 1 < 8) { sstore(); __syncthreads(); }
  }
  {
    float lt = xhalf_sum(lrun);
    float inv = __builtin_amdgcn_rcpf(lt);
    u16* Orow = Otile + (long)qrow * LDA + e0;
#pragma unroll
    for (int et = 0; et < 4; et++)
#pragma unroll
      for (int g = 0; g < 4; g++) {
        uint2 v;
        v.x = pk2(o[et][4 * g + 0] * inv, o[et][4 * g + 1] * inv);
        v.y = pk2(o[et][4 * g + 2] * inv, o[et][4 * g + 3] * inv);
        *(uint2*)(Orow + et * 32 + 8 * g + 4 * h) = v;
      }
  }
}

DI void phase_K(const Params& p, char* smem) {
  const int lane = tidx() & 63, w = tidx() >> 6, r = lane & 31;
  const u16* qx = wsb(p, WS_BIG + B_QX);
  u16* act = wsb(p, WS_ACT);
  for (int t = blockIdx.x; t < 2176; t += gridDim.x) {
    int bidx, hh, tok0;
    if (t < 2048) { bidx = t >> 10; hh = (t >> 8) & 3; tok0 = bidx * 16384 + (t & 255) * 64; }
    else { int u = t - 2048; bidx = 2 + (u >> 2); hh = u & 3; tok0 = NP + (u >> 2) * 64; }
    const u16* Kb = wsb(p, WS_BIG + B_XK) + (size_t)(bidx * 4 + hh) * 65536;
    const u16* Vt = wsb(p, WS_BIG + B_XVT) + (size_t)(bidx * 4 + hh) * 256 * LDXV;
    xattn_item(qx + (size_t)tok0 * LDA + hh * 256, Kb, Vt, act + (size_t)tok0 * LDA + hh * 256, smem);
  }
  (void)lane; (void)w; (void)r;
}

template <class Epi>
DI void phase_gemm128(const Sched& sc, const u16* A, long lda, const u16* Bt, long ldb, int K, int MT, int NT, int SN, char* smem, const Epi& epi) {
  if (sc.ok) {
    const int xg = sc.xg, xi = sc.xi;
    const int SM = 64 / SN;
    const int sng = NT / SN, smg = MT / SM;
    for (int st = xg; st < smg * sng; st += 8) {
      int sm = st / sng, sn = st % sng;
      int mt = sm * SM + xi / SN, nt = sn * SN + xi % SN;
      gemm_tile<2, 2>(A, lda, Bt, ldb, K, mt * 128, nt * 128, smem, epi);
    }
  } else {
    for (int t = blockIdx.x; t < MT * NT; t += gridDim.x) {
      int mt = t / NT, nt = t % NT;
      gemm_tile<2, 2>(A, lda, Bt, ldb, K, mt * 128, nt * 128, smem, epi);
    }
  }
}

#if defined(__HIP_DEVICE_COMPILE__)
typedef const __attribute__((address_space(4))) Params* KargPtr;
#define KARG_LOAD KargPtr pp4 = (KargPtr)__builtin_amdgcn_kernarg_segment_ptr(); asm volatile("" : "+s"(pp4)); const Params p = *pp4;
#else
#define KARG_LOAD const Params p{};
#endif
template <int L>
DI void run_layer(const Sched& sc, int ph_begin, int ph_end, char* smem, const XcdBarrier& xb) {
  const int base = 1 + 15 * L;
#define RUN_PHASE(S, ...)  RUN_PHASE_R(S, 1, __VA_ARGS__)
#define RUN_PHASE_R(S, R, ...)                                    \
  {                                                          \
    const int ph = base + (S);                               \
    if (ph >= ph_begin && ph < ph_end) {                     \
      for (int rep_ = 0; rep_ < (R); rep_++) {               \
        KARG_LOAD                                            \
        const u16* W = wsb(p, WS_W) + (size_t)L * W_LAYER;   \
        const float* xs0 = (L == 0) ? p.x_prompt : p.out;    \
        const float* xs1 = (L == 0) ? p.x_sample : p.out + (size_t)NP * 1024; \
        (void)W; (void)xs0; (void)xs1;                       \
        __VA_ARGS__;                                         \
        if (ph + 1 < ph_end) xcd_barrier(xb);                \
      }                                                      \
    }                                                        \
  }
  if (L > 0) RUN_PHASE(0, phase_norm(p, L))
  RUN_PHASE_R(1, REP_INPROJ, phase_inproj(p, sc, L, smem))
  RUN_PHASE_R(2, REP_C, { phase_C1(p, L, smem); phase_C2(p, L, smem); })
  RUN_PHASE(3, phase_D(p, L, smem))
  RUN_PHASE_R(4, REP_E, phase_E(p, L, smem))
  RUN_PHASE_R(5, REP_F, phase_F(p, L, smem))
  RUN_PHASE_R(6, REP_G, phase_G(p, sc, smem))
  RUN_PHASE(7, { EpiRes epi{xs0, xs1, p.out}; phase_gemm128(sc, wsb(p, WS_ACT), LDA, W + W_OUT, LDW, 1024, 272, 8, 8, smem, epi); })
  RUN_PHASE_R(8, REP_NORM, phase_norm(p, 1))
  RUN_PHASE(9, { EpiStoreBf16 epi{wsb(p, WS_BIG + B_QX), LDA, 1024, nullptr}; phase_gemm128(sc, wsb(p, WS_ACT), LDA, W + W_XQ, LDW, 1024, 272, 8, 8, smem, epi); })
  RUN_PHASE_R(10, REP_K, phase_K(p, smem))
  RUN_PHASE(11, { EpiRes epi{p.out, p.out + (size_t)NP * 1024, p.out}; phase_gemm128(sc, wsb(p, WS_ACT), LDA, W + W_XO, LDW, 1024, 272, 8, 8, smem, epi); })
  RUN_PHASE(12, phase_norm(p, 1))
  RUN_PHASE_R(13, REP_FF1, { EpiRelu2 epi{wsb(p, WS_BIG + B_H1), LDH1}; phase_gemm128(sc, wsb(p, WS_ACT), LDA, W + W_FF1, LDW, 1024, 272, 32, 8, smem, epi); })
  RUN_PHASE(14, { EpiRes epi{p.out, p.out + (size_t)NP * 1024, p.out}; phase_gemm128(sc, wsb(p, WS_BIG + B_H1), LDH1, W + W_FF2, LDW2, 4096, 272, 8, 8, smem, epi); })
#undef RUN_PHASE
#undef RUN_PHASE_R
}

__global__ void __launch_bounds__(256, 2) fwd_megakernel(Params p, int ph_begin, int ph_end) {
  __shared__ __attribute__((aligned(16))) char smem[SMEM_BYTES];
  cg::grid_group grid = cg::this_grid();
  __shared__ int s_rank;
  __shared__ __attribute__((aligned(16))) unsigned xb_words[4];
  if (tidx() < 4) xb_words[tidx()] = 0u;
  __syncthreads();
  const XcdBarrier xb = xcd_barrier_post((unsigned*)(p.ws + WS_BAR), (volatile LAS unsigned*)&xb_words);
  Sched sc;
  sc.xg = (int)((unsigned)__builtin_amdgcn_s_getreg((3 << 11) | 20) & 7u);
  unsigned* cnt = (unsigned*)(p.ws + WS_CNT);
  if (tidx() == 0) s_rank = (int)atomicAdd(&cnt[sc.xg], 1u);
  __syncthreads();
  sc.xi = __builtin_amdgcn_readfirstlane(s_rank);
  sc.ok = 0;
  if (ph_begin <= 0 && 0 < ph_end) {
    phase_prep(p, smem);
    if (ph_end < 0) grid.sync();
    if (1 < ph_end) xcd_barrier(xb);
  }
  {
    int ok = (gridDim.x == 512);
#pragma unroll
    for (int i = 0; i < 8; i++) ok &= (__atomic_load_n(&cnt[i], __ATOMIC_RELAXED) == 64u);
    sc.ok = ok;
  }
  run_layer<0>(sc, ph_begin, ph_end, smem, xb);
  run_layer<1>(sc, ph_begin, ph_end, smem, xb);
}

extern "C" void kernel_launch(void* const* d_in, const int* in_sizes, int n_in, void* d_out, int out_size, void* d_ws, size_t ws_size,
                              hipStream_t stream) {
  static int grid_blocks = 0;
  if (!grid_blocks) {
    int dev = 0, cus = 0, per_cu = 0;
    (void)hipGetDevice(&dev);
    (void)hipDeviceGetAttribute(&cus, hipDeviceAttributeMultiprocessorCount, dev);
    (void)hipOccupancyMaxActiveBlocksPerMultiprocessor(&per_cu, fwd_megakernel, 256, 0);
    per_cu = 2;
    grid_blocks = cus * per_cu;
  }
  Params p{};
  const float** pp = (const float**)&p;
  for (int i = 0; i < 36; i++) pp[i] = (const float*)d_in[i];
  p.out = (float*)d_out;
  p.ws = (char*)d_ws;
  int ph_begin = 0, ph_end = 31;
  (void)hipMemsetAsync((char*)d_ws + WS_CNT, 0, 256 + 16384, stream);
  void* args[] = {&p, &ph_begin, &ph_end};
  hipError_t e = hipLaunchCooperativeKernel((void*)fwd_megakernel, dim3(grid_blocks), dim3(256), args, 0, stream);
  if (e != hipSuccess) fprintf(stderr, "cooperative launch failed: %s (grid %d)\n", hipGetErrorString(e), grid_blocks);
}
```

```cpp
#include <hip/hip_runtime.h>
#include <hip/hip_cooperative_groups.h>
#include <stdint.h>
#include <stdio.h>
namespace cg = cooperative_groups;

typedef unsigned short u16;
typedef short bf16x8 __attribute__((ext_vector_type(8)));
typedef short s16x4 __attribute__((ext_vector_type(4)));
typedef float f32x16 __attribute__((ext_vector_type(16)));
typedef __bf16 bfv2 __attribute__((ext_vector_type(2)));
typedef float fv2 __attribute__((ext_vector_type(2)));
typedef unsigned u32x4 __attribute__((ext_vector_type(4)));
#define DI __device__ __forceinline__
#define MFMA(a, b, c) __builtin_amdgcn_mfma_f32_32x32x16_bf16((a), (b), (c), 0, 0, 0)

constexpr int NP = 32768;
constexpr int NS = 2048;
constexpr int NTOK = NP + NS;
constexpr int NROWS = NP + 32 * 1088;
constexpr int INC = 2472;
constexpr float EPS = 1e-6f;
constexpr float LOG2E = 1.4426950408889634f;
constexpr int NITEM = 2048 + 128;
constexpr int LDA = 1088;
constexpr int LDW = 1088;
constexpr int LDW2 = 4160;
constexpr int LDWQ = 320;
constexpr int LDWKV = 192;
constexpr int LDH1 = 4160;
constexpr int LDVT = NROWS + 64;
constexpr int LDXV = 320;

constexpr size_t O_Y = 0;
constexpr size_t O_PCKV = 35651584;
constexpr size_t O_PKROPE = O_PCKV + 8388608;
constexpr size_t O_PC = O_PKROPE + 2097152;
constexpr size_t O_PN = O_PC + 262144;
constexpr size_t O_PM = O_PN + 2048;
constexpr size_t O_PCONV = O_PM + 16;
constexpr size_t O_PMEMK = O_PCONV + 12288;
constexpr size_t O_PMEMV = O_PMEMK + 1048576;
constexpr size_t O_SCKV = O_PMEMV + 1048576;
constexpr size_t O_SKROPE = O_SCKV + 524288;
constexpr size_t O_SC = O_SKROPE + 131072;
constexpr size_t O_SN = O_SC + 4194304;
constexpr size_t O_SM = O_SN + 32768;
constexpr size_t O_SCONV = O_SM + 256;

constexpr size_t W_IN = 0;
constexpr size_t W_Q = W_IN + 2560 * LDW;
constexpr size_t W_KV = W_Q + 768 * LDWQ;
constexpr size_t W_OUT = W_KV + 1024 * LDWKV;
constexpr size_t W_XQ = W_OUT + 1024 * LDW;
constexpr size_t W_XK = W_XQ + 1024 * LDW;
constexpr size_t W_XV = W_XK + 1024 * LDW;
constexpr size_t W_XO = W_XV + 1024 * LDW;
constexpr size_t W_FF1 = W_XO + 1024 * LDW;
constexpr size_t W_FF2 = W_FF1 + 4096 * LDW;
constexpr size_t W_LAYER = W_FF2 + 1024 * LDW2;

constexpr size_t WS_W = 0;
constexpr size_t WS_ACT = WS_W + 2 * W_LAYER * 2;
constexpr size_t WS_CKV = WS_ACT + (size_t)NTOK * LDA * 2;
constexpr size_t WS_KROPE = WS_CKV + (size_t)NROWS * 128 * 2;
constexpr size_t WS_RQ = WS_KROPE + (size_t)NROWS * 32 * 4;
constexpr size_t WS_GATES = WS_RQ + (size_t)NTOK * 4;
constexpr size_t WS_ROPE = WS_GATES + (size_t)NTOK * 8 * 4;
constexpr size_t WS_SCAL = WS_ROPE + (size_t)16384 * 16 * 8;
constexpr size_t WS_MST = WS_SCAL + (size_t)NITEM * 2 * 4;
constexpr size_t WS_NU = WS_MST + (size_t)NITEM * 4 + 256;
constexpr size_t WS_CNT = WS_NU + (size_t)NITEM * 128 * 4;
constexpr size_t WS_BAR = WS_CNT + 256;
constexpr size_t WS_HM = WS_BAR + 16384;
constexpr size_t WS_BIG = WS_HM + (size_t)512 * LDA * 2;
constexpr size_t B_P = 0;
constexpr size_t B_K = 0;
constexpr size_t B_VT = B_K + (size_t)8 * NROWS * 96 * 2;
constexpr size_t B_Q = B_VT + (size_t)8 * 64 * LDVT * 2;
constexpr size_t B_ST = B_Q + (size_t)NTOK * 768 * 2;
constexpr size_t B_XK = B_ST + (size_t)NITEM * 16384 * 2;
constexpr size_t B_XVT = B_XK + (size_t)34 * 4 * 256 * 256 * 2;
constexpr size_t B_END = B_XVT + (size_t)34 * 4 * 256 * LDXV * 2;
constexpr size_t B_QX = 0;
constexpr size_t B_H1 = 0;
static_assert((size_t)NTOK * INC * 2 <= B_Q, "p overlaps q");
static_assert((size_t)NTOK * LDH1 * 2 <= B_XK, "h1 overlaps xkv");
static_assert((size_t)NTOK * LDA * 2 <= B_Q, "qx overlaps q");
static_assert(WS_BIG + B_END <= (size_t)536870912, "workspace too large");
static_assert(WS_BIG % 256 == 0 && B_Q % 256 == 0 && B_ST % 256 == 0 && B_VT % 256 == 0, "align");

constexpr int SMEM_BYTES = 73728;
#ifndef REP_INPROJ
#define REP_INPROJ 1
#endif
#ifndef REP_C
#define REP_C 1
#endif
#ifndef REP_E
#define REP_E 1
#endif
#ifndef REP_F
#define REP_F 1
#endif
#ifndef REP_G
#define REP_G 1
#endif
#ifndef REP_K
#define REP_K 1
#endif
#ifndef REP_FF1
#define REP_FF1 1
#endif
#ifndef REP_NORM
#define REP_NORM 1
#endif

struct Params {
  const float* x_prompt; const float* x_sample; const float* cache_ckv; const float* cache_krope;
  const float* st_C; const float* st_n; const float* st_m; const float* st_conv;
  const float* cache_mem_k; const float* cache_mem_v; const float* mem_prompt;
  const float* g_mix; const float* w_in; const float* g_qa; const float* w_q_up; const float* g_qnorm; const float* g_kva;
  const float* w_kv_up; const float* g_knorm; const float* w_conv; const float* b_conv; const float* b_igate; const float* b_fgate;
  const float* g_mhead; const float* w_out; const float* g_xattn; const float* g_mem; const float* w_xq; const float* w_xk; const float* w_xv;
  const float* g_xq; const float* g_xk; const float* w_xo; const float* g_mlp; const float* w_ff1; const float* w_ff2;
  float* out; char* ws;
};

#define XB_TMO      128
#define XB_XCNT(j)  (256  + 64 * (j))
#define XB_XSUB(j)  (1280 + 64 * (j))
#define XB_XGEN(j)  (2304 + 64 * (j))
#define XB_TOP      3328
#define XB_TOPGEN   3392
#define XCD_BAR_WORDS 3456
#define XB_SPIN_CAP (1u << 18)
#define LAS __attribute__((address_space(3)))

__device__ __forceinline__ unsigned xb_ld(unsigned* p)              { return __hip_atomic_load(p, __ATOMIC_RELAXED, __HIP_MEMORY_SCOPE_AGENT); }
__device__ __forceinline__ unsigned xb_add(unsigned* p, unsigned v) { return __hip_atomic_fetch_add(p, v, __ATOMIC_RELAXED, __HIP_MEMORY_SCOPE_AGENT); }
__device__ __forceinline__ unsigned xb_xcc_id() { return (unsigned)__builtin_amdgcn_s_getreg((3 << 11) | 20) & 0xFu; }
#define XB_SPIN(cond, bar) do { unsigned _sp = 0; while (cond) { __builtin_amdgcn_s_sleep(1); \
    if ((++_sp & 255u) == 0u) { if (xb_ld(&(bar)[XB_TMO])) break; if (_sp > XB_SPIN_CAP) { atomicAdd(&(bar)[XB_TMO], 1u); break; } } } } while (0)

struct XcdBarrier {
    unsigned* bar; unsigned x;
    volatile LAS unsigned* st;
};

__device__ __forceinline__ XcdBarrier xcd_barrier_post(unsigned* bar, volatile LAS unsigned* st) {
    XcdBarrier b; b.bar = bar; b.x = xb_xcc_id(); b.st = st;
    if (threadIdx.x == 0) (void)xb_add(&bar[XB_XCNT(b.x)], 1u);
    return b;
}
__device__ __forceinline__ void xcd_barrier_complete(unsigned* bar, unsigned x, unsigned& nloc, unsigned& nx) {
    const unsigned G = gridDim.x * gridDim.y * gridDim.z;
    unsigned sum, cnt, mine, sp = 0u;
    for (;;) {
        sum = 0u; cnt = 0u; mine = 0u;
#pragma unroll
        for (unsigned j = 0; j < 16; ++j) { const unsigned c = xb_ld(&bar[XB_XCNT(j)]); sum += c; cnt += (c > 0u) ? 1u : 0u; mine = (j == x) ? c : mine; }
        if (sum == G) break;
        __builtin_amdgcn_s_sleep(1);
        if ((++sp & 255u) == 0u) { if (xb_ld(&bar[XB_TMO])) break; if (sp > XB_SPIN_CAP) { atomicAdd(&bar[XB_TMO], 1u); break; } }
    }
    nloc = mine > 0u ? mine : 1u; nx = cnt > 0u ? cnt : 1u;
}

__device__ __forceinline__ void xcd_barrier(const XcdBarrier& b) {
    asm volatile("s_waitcnt vmcnt(0)" ::: "memory");
    __syncthreads();
    if (threadIdx.x == 0) {
        unsigned* bar = b.bar;
        __builtin_amdgcn_s_waitcnt(0);
        unsigned nloc = b.st[0], nx = b.st[1];
        if (nloc == 0u) { xcd_barrier_complete(bar, b.x, nloc, nx); b.st[0] = nloc; b.st[1] = nx; }
        const unsigned old = xb_add(&bar[XB_XSUB(b.x)], 1u);
        const unsigned gen = old / nloc;
        if (old + 1u == (gen + 1u) * nloc) {
            __builtin_amdgcn_fence(__ATOMIC_RELEASE, "agent");
            asm volatile("s_waitcnt vmcnt(0)" ::: "memory");
            const unsigned og = xb_add(&bar[XB_TOP], 1u);
            const unsigned tg = og / nx;
            if (og + 1u == (tg + 1u) * nx) xb_add(&bar[XB_TOPGEN], 1u);
            else XB_SPIN(xb_ld(&bar[XB_TOPGEN]) == tg, bar);
            __builtin_amdgcn_fence(__ATOMIC_ACQUIRE, "agent");
            xb_add(&bar[XB_XGEN(b.x)], 1u);
            asm volatile("s_waitcnt vmcnt(0)" ::: "memory");
        } else {
            XB_SPIN(xb_ld(&bar[XB_XGEN(b.x)]) == gen, bar);
            __builtin_amdgcn_fence(__ATOMIC_ACQUIRE, "agent");
            asm volatile("s_waitcnt vmcnt(0)" ::: "memory");
        }
    }
    __syncthreads();
}


struct Sched { int xg, xi, ok; };
DI int tidx() { int t = (int)threadIdx.x; asm volatile("" : "+v"(t)); return t; }
DI unsigned pk2(float a, float b) { fv2 v = {a, b}; bfv2 r = __builtin_convertvector(v, bfv2); return __builtin_bit_cast(unsigned, r); }
DI u16 f2bf(float a) { return (u16)(pk2(a, 0.f) & 0xffffu); }
DI float bf2f(u16 v) { return __uint_as_float(((unsigned)v) << 16); }
DI float bflo(unsigned v) { return __uint_as_float(v << 16); }
DI float bfhi(unsigned v) { return __uint_as_float(v & 0xffff0000u); }
DI int crow(int i, int h) { return (i & 3) + 8 * (i >> 2) + 4 * h; }
DI float xhalf_max(float v) {
  unsigned u = __float_as_uint(v);
  auto rr = __builtin_amdgcn_permlane32_swap(u, u, false, false);
  return fmaxf(__uint_as_float(rr[0]), __uint_as_float(rr[1]));
}
DI float xhalf_sum(float v) {
  unsigned u = __float_as_uint(v);
  auto rr = __builtin_amdgcn_permlane32_swap(u, u, false, false);
  return __uint_as_float(rr[0]) + __uint_as_float(rr[1]);
}
DI float wave_sum(float v) {
#pragma unroll
  for (int o = 32; o >= 1; o >>= 1) v += __shfl_xor(v, o);
  return v;
}
DI float wave_max(float v) {
#pragma unroll
  for (int o = 32; o >= 1; o >>= 1) v = fmaxf(v, __shfl_xor(v, o));
  return v;
}
DI void unpack8(uint4 v, float (&x)[8]) {
  x[0] = bflo(v.x); x[1] = bfhi(v.x); x[2] = bflo(v.y); x[3] = bfhi(v.y);
  x[4] = bflo(v.z); x[5] = bfhi(v.z); x[6] = bflo(v.w); x[7] = bfhi(v.w);
}
DI uint4 pack8(const float (&x)[8]) {
  uint4 v; v.x = pk2(x[0], x[1]); v.y = pk2(x[2], x[3]); v.z = pk2(x[4], x[5]); v.w = pk2(x[6], x[7]); return v;
}
DI u16* wsb(const Params& p, size_t off) { return (u16*)(p.ws + off); }
DI float* wsf(const Params& p, size_t off) { return (float*)(p.ws + off); }
DI const float* xrow(const Params& p, int l, int tok) {
  if (l == 0) return tok < NP ? p.x_prompt + (size_t)tok * 1024 : p.x_sample + (size_t)(tok - NP) * 1024;
  return p.out + (size_t)tok * 1024;
}
DI int tok_pos(int tok) { return tok < NP ? (tok & 16383) : 1024 + ((tok - NP) & 63); }

template <int TM, int TN>
DI void gemm_mainloop(const u16* __restrict__ A, long lda, const u16* __restrict__ Bt, long ldb, int K, char* smem,
                      f32x16 (&acc)[TM][TN]) {
  constexpr int BM = 64 * TM, BN = 64 * TN, LD = 72;
  u16* sA = (u16*)smem;
  u16* sB = sA + 2 * BM * LD;
  const int tid = tidx(), lane = tid & 63, w = tid >> 6, r = lane & 31, h = lane >> 5;
  const int wm = w >> 1, wn = w & 1;
  constexpr int NA = BM / 32, NB = BN / 32;
  u32x4 ra[NA], rb[NB];
#pragma unroll
  for (int tm = 0; tm < TM; tm++)
#pragma unroll
    for (int tn = 0; tn < TN; tn++)
#pragma unroll
      for (int i = 0; i < 16; i++) acc[tm][tn][i] = 0.f;
  const int nk = K / 64;
  const int lrow = tid >> 3, lch = (tid & 7) * 8;
  const u16* gA = A + (long)lrow * lda + lch;
  const u16* gB = Bt + (long)lrow * ldb + lch;
  const int soff = lrow * LD + lch;
#define GEMM_GLOAD(k0)                                                                   \
  {                                                                                      \
    _Pragma("unroll") for (int i = 0; i < NA; i++) ra[i] = *(const u32x4*)(gA + (long)(32 * i) * lda + (k0)); \
    _Pragma("unroll") for (int i = 0; i < NB; i++) rb[i] = *(const u32x4*)(gB + (long)(32 * i) * ldb + (k0)); \
  }
#define GEMM_SSTORE(buf)                                                                 \
  {                                                                                      \
    _Pragma("unroll") for (int i = 0; i < NA; i++) *(u32x4*)(sA + (buf) * BM * LD + soff + 32 * i * LD) = ra[i]; \
    _Pragma("unroll") for (int i = 0; i < NB; i++) *(u32x4*)(sB + (buf) * BN * LD + soff + 32 * i * LD) = rb[i]; \
  }
  GEMM_GLOAD(0)
  __syncthreads();
  GEMM_SSTORE(0)
  if (nk > 1) GEMM_GLOAD(64)
  __syncthreads();
  for (int kt = 0; kt < nk; kt++) {
    const int buf = kt & 1;
    const u16* cA = sA + buf * BM * LD + (wm * 32 * TM + r) * LD + h * 8;
    const u16* cB = sB + buf * BN * LD + (wn * 32 * TN + r) * LD + h * 8;
    bf16x8 af[TM], bfr[TN];
#pragma unroll
    for (int tm = 0; tm < TM; tm++) af[tm] = *(const bf16x8*)(cA + tm * 32 * LD);
#pragma unroll
    for (int tn = 0; tn < TN; tn++) bfr[tn] = *(const bf16x8*)(cB + tn * 32 * LD);
    if (kt + 1 < nk) GEMM_SSTORE(buf ^ 1)
    __builtin_amdgcn_sched_barrier(0);
    __builtin_amdgcn_s_setprio(1);
#pragma unroll
    for (int tm = 0; tm < TM; tm++)
#pragma unroll
      for (int tn = 0; tn < TN; tn++) acc[tm][tn] = MFMA(af[tm], bfr[tn], acc[tm][tn]);
#pragma unroll
    for (int tm = 0; tm < TM; tm++) af[tm] = *(const bf16x8*)(cA + tm * 32 * LD + 16);
#pragma unroll
    for (int tn = 0; tn < TN; tn++) bfr[tn] = *(const bf16x8*)(cB + tn * 32 * LD + 16);
#pragma unroll
    for (int tm = 0; tm < TM; tm++)
#pragma unroll
      for (int tn = 0; tn < TN; tn++) acc[tm][tn] = MFMA(af[tm], bfr[tn], acc[tm][tn]);
    __builtin_amdgcn_sched_barrier(0);
    if (kt + 2 < nk) GEMM_GLOAD((kt + 2) * 64)
    __builtin_amdgcn_sched_barrier(0);
#pragma unroll
    for (int ks = 2; ks < 4; ks++) {
#pragma unroll
      for (int tm = 0; tm < TM; tm++) af[tm] = *(const bf16x8*)(cA + tm * 32 * LD + ks * 16);
#pragma unroll
      for (int tn = 0; tn < TN; tn++) bfr[tn] = *(const bf16x8*)(cB + tn * 32 * LD + ks * 16);
#pragma unroll
      for (int tm = 0; tm < TM; tm++)
#pragma unroll
        for (int tn = 0; tn < TN; tn++) acc[tm][tn] = MFMA(af[tm], bfr[tn], acc[tm][tn]);
    }
    __builtin_amdgcn_s_setprio(0);
    __syncthreads();
  }
#undef GEMM_GLOAD
#undef GEMM_SSTORE
}

template <int TM, int TN, class Epi>
DI void gemm_tile(const u16* A, long lda, const u16* Bt, long ldb, int K, int m0, int n0, char* smem, const Epi& epi) {
  constexpr int BM = 64 * TM, BN = 64 * TN, LDC = BN + Epi::PAD;
  f32x16 acc[TM][TN];
  gemm_mainloop<TM, TN>(A + (long)m0 * lda, lda, Bt + (long)n0 * ldb, ldb, K, smem, acc);
  const int tid = tidx(), lane = tid & 63, w = tid >> 6, r = lane & 31, h = lane >> 5;
  const int wm = w >> 1, wn = w & 1;
  float* Ct = (float*)smem;
#pragma unroll
  for (int tm = 0; tm < TM; tm++)
#pragma unroll
    for (int tn = 0; tn < TN; tn++)
#pragma unroll
      for (int i = 0; i < 16; i++)
        Ct[(wm * 32 * TM + tm * 32 + crow(i, h)) * LDC + wn * 32 * TN + tn * 32 + r] = acc[tm][tn][i];
  __syncthreads();
  epi(Ct, LDC, m0, n0, tid, BM);
  __syncthreads();
  (void)BM;
}

struct EpiStoreBf16 {
  static constexpr int PAD = 4;
  u16* out; long ldo; int nmax; float* gates;
  DI void operator()(const float* Ct, int ldc, int m0, int n0, int tid, int bm) const {
#pragma unroll 4
    for (int it = 0; it < bm / 16; it++) {
      int id = tid + 256 * it; int row = id >> 4, c8 = (id & 15) * 8;
      int n = n0 + c8;
      if (n < nmax) {
        const float* c = Ct + row * ldc + c8;
        float4 a = *(const float4*)c, b = *(const float4*)(c + 4);
        uint4 v; v.x = pk2(a.x, a.y); v.y = pk2(a.z, a.w); v.z = pk2(b.x, b.y); v.w = pk2(b.z, b.w);
        *(uint4*)(out + (long)(m0 + row) * ldo + n) = v;
        if (gates != nullptr && n == 1952) {
          float* g = gates + (long)(m0 + row) * 8;
          *(float4*)g = a; *(float4*)(g + 4) = b;
        }
      }
    }
  }
};
struct EpiRelu2 {
  static constexpr int PAD = 4;
  u16* out; long ldo;
  DI void operator()(const float* Ct, int ldc, int m0, int n0, int tid, int bm) const {
#pragma unroll 4
    for (int it = 0; it < bm / 16; it++) {
      int id = tid + 256 * it; int row = id >> 4, c8 = (id & 15) * 8;
      const float* c = Ct + row * ldc + c8;
      float x[8];
#pragma unroll
      for (int j = 0; j < 8; j++) { float v = fmaxf(c[j], 0.f); x[j] = v * v; }
      *(uint4*)(out + (long)(m0 + row) * ldo + n0 + c8) = pack8(x);
    }
  }
};
struct EpiF32 {
  static constexpr int PAD = 4;
  float* out; long ldo;
  DI void operator()(const float* Ct, int ldc, int m0, int n0, int tid, int bm) const {
#pragma unroll 4
    for (int it = 0; it < bm / 16; it++) {
      int id = tid + 256 * it; int row = id >> 4, c8 = (id & 15) * 8;
      const float* c = Ct + row * ldc + c8;
      float* o = out + (long)(m0 + row) * ldo + n0 + c8;
      *(float4*)o = *(const float4*)c; *(float4*)(o + 4) = *(const float4*)(c + 4);
    }
  }
};
struct EpiRes {
  static constexpr int PAD = 4;
  const float* src0; const float* src1; float* dst;
  DI void operator()(const float* Ct, int ldc, int m0, int n0, int tid, int bm) const {
#pragma unroll 4
    for (int it = 0; it < bm / 16; it++) {
      int id = tid + 256 * it; int row = id >> 4, c8 = (id & 15) * 8;
      int m = m0 + row;
      const float* s = (m < NP ? src0 + (size_t)m * 1024 : src1 + (size_t)(m - NP) * 1024) + n0 + c8;
      const float* c = Ct + row * ldc + c8;
      float4 a = *(const float4*)c, b = *(const float4*)(c + 4);
      float4 sa = *(const float4*)s, sb = *(const float4*)(s + 4);
      a.x += sa.x; a.y += sa.y; a.z += sa.z; a.w += sa.w; b.x += sb.x; b.y += sb.y; b.z += sb.z; b.w += sb.w;
      float* o = dst + (size_t)m * 1024 + n0 + c8;
      *(float4*)o = a; *(float4*)(o + 4) = b;
    }
  }
};
struct EpiQ {
  static constexpr int PAD = 1;
  u16* q; const float* rq; const float2* rope; const float* g;
  DI void operator()(const float* Ct, int ldc, int m0, int n0, int tid, int bm) const {
    float* r2s = (float*)((char*)Ct + 60000);
    {
      const int row = tid >> 2, hh = (tid >> 1) & 1, half = tid & 1; const int m = m0 + row;
      const float* c = Ct + row * ldc + hh * 96 + half * 48;
      float ss = 0.f;
#pragma unroll 8
      for (int d = 0; d < 48; d++) ss += c[d] * c[d];
      ss += __shfl_xor(ss, 1);
      const float rqv = rq[m];
      ss *= rqv * rqv;
      if (half == 0) r2s[row * 2 + hh] = rsqrtf(ss * (1.f / 96.f) + EPS) * rqv * (0.10206207261596575f * LOG2E);
    }
    __syncthreads();
#pragma unroll
    for (int it = 0; it < 6; it++) {
      const int id = tid + 256 * it; const int row = id / 24, cc = id % 24; const int hh = cc / 12, c8 = cc % 12;
      const int m = m0 + row;
      const float* c = Ct + row * ldc + hh * 96;
      const float r2 = r2s[row * 2 + hh];
      float x[8];
      if (c8 < 8) {
#pragma unroll
        for (int jj = 0; jj < 8; jj++) x[jj] = c[c8 * 8 + jj] * r2 * g[c8 * 8 + jj];
      } else {
        const int half = c8 & 1;
        const bool second = c8 >= 10;
        const float2* tab = rope + (size_t)tok_pos(m) * 16 + half * 8;
#pragma unroll
        for (int jj = 0; jj < 8; jj++) {
          const int i = half * 8 + jj;
          const float a = c[64 + i], b = c[80 + i]; const float2 cs = tab[jj];
          const float v = second ? (a * cs.y + b * cs.x) : (a * cs.x - b * cs.y);
          x[jj] = v * r2 * g[(second ? 80 : 64) + i];
        }
      }
      *(uint4*)(q + (size_t)m * 768 + n0 + cc * 8) = pack8(x);
    }
  }
};
struct EpiKV {
  static constexpr int PAD = 1;
  u16* Kb; u16* Vt; const float* krope; const float* g;
  DI void operator()(const float* Ct, int ldc, int m0, int n0, int tid, int bm) const {
    const int hd = n0 >> 7;
#pragma unroll
    for (int it = 0; it < 4; it++) {
      int id = tid + 256 * it; int oct = id & 15, e = id >> 4;
      float x[8];
#pragma unroll
      for (int j = 0; j < 8; j++) x[j] = Ct[(16 * (oct >> 1) + 4 * (oct & 1) + (j & 3) + 8 * (j >> 2)) * ldc + 64 + e];
      *(uint4*)(Vt + (size_t)(hd * 64 + e) * LDVT + m0 + oct * 8) = pack8(x);
    }
    float* rrs = (float*)((char*)Ct + 66560);
    {
      const int row = tid >> 1, half = tid & 1;
      const float* c = Ct + row * ldc + half * 32;
      const float* kr = krope + (size_t)(m0 + row) * 32 + half * 16;
      float ss = 0.f;
#pragma unroll 8
      for (int d = 0; d < 32; d++) ss += c[d] * c[d];
#pragma unroll 8
      for (int d = 0; d < 16; d++) ss += kr[d] * kr[d];
      ss += __shfl_xor(ss, 1);
      if (half == 0) rrs[row] = rsqrtf(ss * (1.f / 96.f) + EPS);
    }
    __syncthreads();
    u16* ob = Kb + ((size_t)hd * NROWS + m0) * 96;
#pragma unroll
    for (int it = 0; it < 6; it++) {
      const int id = tid + 256 * it; const int row = id / 12, cc = id % 12;
      const float rr = rrs[row];
      float x[8];
      if (cc < 8) {
        const float* c = Ct + row * ldc + cc * 8;
#pragma unroll
        for (int jj = 0; jj < 8; jj++) x[jj] = c[jj] * rr * g[cc * 8 + jj];
      } else {
        const float* kr = krope + (size_t)(m0 + row) * 32 + (cc - 8) * 8;
#pragma unroll
        for (int jj = 0; jj < 8; jj++) x[jj] = kr[jj] * rr * g[cc * 8 + jj];
      }
      *(uint4*)(ob + (size_t)id * 8) = pack8(x);
    }
  }
};

template <int DQK, int NE, int EV, bool DB, bool QNORM, bool QREG, bool VPERM = false>
DI void flash_item(const u16* Qrow, bool wave_active, int ntb, int ntw, const u16* Kbase, long ldk, const u16* Vtbase, long ldv,
                   int e0, u16* Orow, char* smem) {
  constexpr int LDK = DQK + 8, LDV = 72;
  constexpr int KS = DQK / 16;
  constexpr int KTILE = 64 * LDK, VTILE = EV * LDV;
  constexpr int NKC = 64 * (DQK / 8) / 256;
  constexpr int NVC = EV * 8 / 256;
  u16* sK = (u16*)smem;
  u16* sV = sK + (DB ? 2 : 1) * KTILE;
  const int tid = tidx(), lane = tid & 63, r = lane & 31, h = lane >> 5;
  bf16x8 qf[QREG ? KS : 1];
  float rqs = 1.f;
  if (wave_active) {
    if (QREG) {
#pragma unroll
      for (int ks = 0; ks < KS; ks++) qf[QREG ? ks : 0] = *(const bf16x8*)(Qrow + ks * 16 + h * 8);
    }
    if (QNORM) {
      float ss = 0.f;
#pragma unroll
      for (int ks = 0; ks < KS; ks++) {
        bf16x8 qq = QREG ? qf[QREG ? ks : 0] : *(const bf16x8*)(Qrow + ks * 16 + h * 8);
#pragma unroll
        for (int j = 0; j < 8; j++) { float v = bf2f((u16)qq[j]); ss += v * v; }
      }
      ss = xhalf_sum(ss);
      rqs = rsqrtf(ss * (1.f / DQK) + EPS);
    }
  } else if (QREG) {
#pragma unroll
    for (int ks = 0; ks < KS; ks++)
#pragma unroll
      for (int j = 0; j < 8; j++) qf[QREG ? ks : 0][j] = 0;
  }
  f32x16 o[NE];
#pragma unroll
  for (int et = 0; et < NE; et++)
#pragma unroll
    for (int i = 0; i < 16; i++) o[et][i] = 0.f;
  float mrun = 0.f, lrun = 0.f;
  const float rqinv = __builtin_amdgcn_rcpf(rqs);

  u32x4 rk[DB ? NKC : 1], rv[DB ? NVC : 1];
  auto gload = [&](int t) {
#pragma unroll
    for (int i = 0; i < NKC; i++) {
      int id = tid + 256 * i; int row = id / (DQK / 8), ch = id % (DQK / 8);
      u32x4 v = *(const u32x4*)(Kbase + (long)(t * 64 + row) * ldk + ch * 8);
      if (DB) rk[DB ? i : 0] = v; else *(u32x4*)(sK + row * LDK + ch * 8) = v;
    }
#pragma unroll
    for (int i = 0; i < NVC; i++) {
      int id = tid + 256 * i; int row = id >> 3, ch = id & 7;
      u32x4 v = *(const u32x4*)(Vtbase + (long)row * ldv + t * 64 + ch * 8);
      if (DB) rv[DB ? i : 0] = v; else *(u32x4*)(sV + row * LDV + ch * 8) = v;
    }
  };
  auto sstore = [&](int buf) {
#pragma unroll
    for (int i = 0; i < NKC; i++) { int id = tid + 256 * i; int row = id / (DQK / 8), ch = id % (DQK / 8); *(u32x4*)(sK + buf * KTILE + row * LDK + ch * 8) = rk[DB ? i : 0]; }
#pragma unroll
    for (int i = 0; i < NVC; i++) { int id = tid + 256 * i; int row = id >> 3, ch = id & 7; *(u32x4*)(sV + buf * VTILE + row * LDV + ch * 8) = rv[DB ? i : 0]; }
  };
  auto compute = [&](int buf) {
    const u16* cK = sK + buf * KTILE + r * LDK + h * 8;
    const u16* cV = sV + buf * VTILE + (e0 + r) * LDV + 4 * h;
    const float sinit = QNORM ? -mrun * rqinv : -mrun;
    f32x16 s[2];
#pragma unroll
    for (int sub = 0; sub < 2; sub++) {
#pragma unroll
      for (int i = 0; i < 16; i++) s[sub][i] = sinit;
#pragma unroll
      for (int ks = 0; ks < KS; ks++) {
        bf16x8 a = *(const bf16x8*)(cK + sub * 32 * LDK + ks * 16);
        bf16x8 qq = QREG ? qf[QREG ? ks : 0] : *(const bf16x8*)(Qrow + ks * 16 + h * 8);
        s[sub] = MFMA(a, qq, s[sub]);
      }
    }
    float mx = -1e30f;
#pragma unroll
    for (int sub = 0; sub < 2; sub++)
#pragma unroll
      for (int i = 0; i < 16; i++) { if (QNORM) s[sub][i] *= rqs; mx = fmaxf(mx, s[sub][i]); }
    mx = xhalf_max(mx);
    if (__any(mx > 8.f)) {
      const float d = fmaxf(mx, 0.f);
      const float alpha = __builtin_amdgcn_exp2f(-d);
      mrun += d;
      lrun *= alpha;
#pragma unroll
      for (int et = 0; et < NE; et++)
#pragma unroll
        for (int i = 0; i < 16; i++) o[et][i] *= alpha;
#pragma unroll
      for (int sub = 0; sub < 2; sub++)
#pragma unroll
        for (int i = 0; i < 16; i++) s[sub][i] -= d;
    }
    float psum = 0.f;
#pragma unroll
    for (int sub = 0; sub < 2; sub++)
#pragma unroll
      for (int i = 0; i < 16; i++) { float pv = __builtin_amdgcn_exp2f(s[sub][i]); s[sub][i] = pv; psum += pv; }
    lrun += psum;
#pragma unroll
    for (int sub = 0; sub < 2; sub++)
#pragma unroll
      for (int st = 0; st < 2; st++) {
        uint4 pp;
        pp.x = pk2(s[sub][8 * st + 0], s[sub][8 * st + 1]); pp.y = pk2(s[sub][8 * st + 2], s[sub][8 * st + 3]);
        pp.z = pk2(s[sub][8 * st + 4], s[sub][8 * st + 5]); pp.w = pk2(s[sub][8 * st + 6], s[sub][8 * st + 7]);
        bf16x8 pb = __builtin_bit_cast(bf16x8, pp);
#pragma unroll
        for (int et = 0; et < NE; et++) {
          bf16x8 a;
          if (VPERM) {
            a = *(const bf16x8*)(sV + buf * VTILE + (e0 + et * 32 + r) * LDV + sub * 32 + st * 16 + 8 * h);
          } else {
            const u16* vp = cV + et * 32 * LDV + sub * 32 + st * 16;
            s16x4 lo = *(const s16x4*)vp;
            s16x4 hi = *(const s16x4*)(vp + 8);
            a = __builtin_shufflevector(lo, hi, 0, 1, 2, 3, 4, 5, 6, 7);
          }
          o[et] = MFMA(a, pb, o[et]);
        }
      }
  };

  __syncthreads();
  if (DB) {
    gload(0);
    sstore(0);
    __syncthreads();
    for (int t = 0; t < ntb; t++) {
      const bool more = (t + 1 < ntb);
      if (more) gload(t + 1);
      __builtin_amdgcn_sched_barrier(0);
      if (wave_active && t < ntw) { __builtin_amdgcn_s_setprio(1); compute(t & 1); __builtin_amdgcn_s_setprio(0); }
      if (more) sstore((t + 1) & 1);
      __syncthreads();
    }
  } else {
    for (int t = 0; t < ntb; t++) {
      if (t > 0) __syncthreads();
      gload(t);
      __syncthreads();
      if (wave_active && t < ntw) compute(0);
    }
    __syncthreads();
  }
  if (wave_active) {
    float lt = xhalf_sum(lrun);
    float inv = __builtin_amdgcn_rcpf(lt);
#pragma unroll
    for (int et = 0; et < NE; et++)
#pragma unroll
      for (int g = 0; g < 4; g++) {
        uint2 v;
        v.x = pk2(o[et][4 * g + 0] * inv, o[et][4 * g + 1] * inv);
        v.y = pk2(o[et][4 * g + 2] * inv, o[et][4 * g + 3] * inv);
        *(uint2*)(Orow + et * 32 + 8 * g + 4 * h) = v;
      }
  }
}

DI void flash_item64(const u16* Qbase  , int ntb, int ntw, const u16* Kbase, const u16* Vtbase,
                     u16* Obase  , char* smem) {
  constexpr int LDK = 104, LDV = 72, KS = 6, KTILE = 64 * LDK, VTILE = 64 * LDV;
  u16* sK = (u16*)smem;
  u16* sV = sK + 2 * KTILE;
  const int tid = tidx(), lane = tid & 63, r = lane & 31, h = lane >> 5;
  bf16x8 qf[2][KS];
#pragma unroll
  for (int qh = 0; qh < 2; qh++)
#pragma unroll
    for (int ks = 0; ks < KS; ks++) qf[qh][ks] = *(const bf16x8*)(Qbase + (long)(qh * 32 + r) * 768 + ks * 16 + h * 8);
  f32x16 o[2][2];
#pragma unroll
  for (int qh = 0; qh < 2; qh++)
#pragma unroll
    for (int et = 0; et < 2; et++)
#pragma unroll
      for (int i = 0; i < 16; i++) o[qh][et][i] = 0.f;
  float mrun[2] = {0.f, 0.f}, lrun[2] = {0.f, 0.f};
  u32x4 rk[3], rv[2];
  auto gload = [&](int t) {
#pragma unroll
    for (int i = 0; i < 3; i++) { int id = tid + 256 * i; int row = id / 12, ch = id % 12; rk[i] = *(const u32x4*)(Kbase + (long)(t * 64 + row) * 96 + ch * 8); }
#pragma unroll
    for (int i = 0; i < 2; i++) { int id = tid + 256 * i; int row = id >> 3, ch = id & 7; rv[i] = *(const u32x4*)(Vtbase + (long)row * LDVT + t * 64 + ch * 8); }
  };
  auto sstore = [&](int buf) {
#pragma unroll
    for (int i = 0; i < 3; i++) { int id = tid + 256 * i; int row = id / 12, ch = id % 12; *(u32x4*)(sK + buf * KTILE + row * LDK + ch * 8) = rk[i]; }
#pragma unroll
    for (int i = 0; i < 2; i++) { int id = tid + 256 * i; int row = id >> 3, ch = id & 7; *(u32x4*)(sV + buf * VTILE + row * LDV + ch * 8) = rv[i]; }
  };
  auto compute = [&](int buf) {
    const u16* cK = sK + buf * KTILE + r * LDK + h * 8;
    const u16* cV = sV + buf * VTILE + r * LDV + 8 * h;
    f32x16 s[2][2];
#pragma unroll
    for (int sub = 0; sub < 2; sub++)
#pragma unroll
      for (int qh = 0; qh < 2; qh++)
#pragma unroll
        for (int i = 0; i < 16; i++) s[sub][qh][i] = -mrun[qh];
#pragma unroll
    for (int sub = 0; sub < 2; sub++)
#pragma unroll
      for (int ks = 0; ks < KS; ks++) {
        bf16x8 a = *(const bf16x8*)(cK + sub * 32 * LDK + ks * 16);
        s[sub][0] = MFMA(a, qf[0][ks], s[sub][0]);
        s[sub][1] = MFMA(a, qf[1][ks], s[sub][1]);
      }
#pragma unroll
    for (int qh = 0; qh < 2; qh++) {
      float mx = -1e30f;
#pragma unroll
      for (int sub = 0; sub < 2; sub++)
#pragma unroll
        for (int i = 0; i < 16; i++) mx = fmaxf(mx, s[sub][qh][i]);
      mx = xhalf_max(mx);
      if (__any(mx > 8.f)) {
        const float d = fmaxf(mx, 0.f);
        const float alpha = __builtin_amdgcn_exp2f(-d);
        mrun[qh] += d;
        lrun[qh] *= alpha;
#pragma unroll
        for (int et = 0; et < 2; et++)
#pragma unroll
          for (int i = 0; i < 16; i++) o[qh][et][i] *= alpha;
#pragma unroll
        for (int sub = 0; sub < 2; sub++)
#pragma unroll
          for (int i = 0; i < 16; i++) s[sub][qh][i] -= d;
      }
      float psum = 0.f;
#pragma unroll
      for (int sub = 0; sub < 2; sub++)
#pragma unroll
        for (int i = 0; i < 16; i++) { float pv = __builtin_amdgcn_exp2f(s[sub][qh][i]); s[sub][qh][i] = pv; psum += pv; }
      lrun[qh] += psum;
    }
#pragma unroll
    for (int sub = 0; sub < 2; sub++)
#pragma unroll
      for (int st = 0; st < 2; st++) {
        bf16x8 pb[2];
#pragma unroll
        for (int qh = 0; qh < 2; qh++) {
          uint4 pp;
          pp.x = pk2(s[sub][qh][8 * st + 0], s[sub][qh][8 * st + 1]); pp.y = pk2(s[sub][qh][8 * st + 2], s[sub][qh][8 * st + 3]);
          pp.z = pk2(s[sub][qh][8 * st + 4], s[sub][qh][8 * st + 5]); pp.w = pk2(s[sub][qh][8 * st + 6], s[sub][qh][8 * st + 7]);
          pb[qh] = __builtin_bit_cast(bf16x8, pp);
        }
#pragma unroll
        for (int et = 0; et < 2; et++) {
          bf16x8 a = *(const bf16x8*)(cV + et * 32 * LDV + sub * 32 + st * 16);
          o[0][et] = MFMA(a, pb[0], o[0][et]);
          o[1][et] = MFMA(a, pb[1], o[1][et]);
        }
      }
  };
  __syncthreads();
  gload(0);
  sstore(0);
  __syncthreads();
  for (int t = 0; t < ntb; t++) {
    const bool more = (t + 1 < ntb);
    if (more) gload(t + 1);
    __builtin_amdgcn_sched_barrier(0);
    if (t < ntw) { __builtin_amdgcn_s_setprio(1); compute(t & 1); __builtin_amdgcn_s_setprio(0); }
    if (more) sstore((t + 1) & 1);
    __syncthreads();
  }
#pragma unroll
  for (int qh = 0; qh < 2; qh++) {
    const float inv = __builtin_amdgcn_rcpf(xhalf_sum(lrun[qh]));
    u16* Orow = Obase + (long)(qh * 32 + r) * LDA;
#pragma unroll
    for (int et = 0; et < 2; et++)
#pragma unroll
      for (int g = 0; g < 4; g++) {
        uint2 v;
        v.x = pk2(o[qh][et][4 * g + 0] * inv, o[qh][et][4 * g + 1] * inv);
        v.y = pk2(o[qh][et][4 * g + 2] * inv, o[qh][et][4 * g + 3] * inv);
        *(uint2*)(Orow + et * 32 + 8 * g + 4 * h) = v;
      }
  }
}

DI void norm_row_wave(const float* src, u16* dst, int lane) {
  float4 v[4]; float ss = 0.f;
#pragma unroll
  for (int i = 0; i < 4; i++) { v[i] = *(const float4*)(src + i * 256 + lane * 4); ss += v[i].x * v[i].x + v[i].y * v[i].y + v[i].z * v[i].z + v[i].w * v[i].w; }
  ss = wave_sum(ss);
  float rr = rsqrtf(ss * (1.f / 1024.f) + EPS);
#pragma unroll
  for (int i = 0; i < 4; i++) {
    uint2 o; o.x = pk2(v[i].x * rr, v[i].y * rr); o.y = pk2(v[i].z * rr, v[i].w * rr);
    *(uint2*)(dst + i * 256 + lane * 4) = o;
  }
}

DI void phase_norm(const Params& p, int l) {
  const int lane = tidx() & 63, w = tidx() >> 6;
  u16* act = wsb(p, WS_ACT);
  for (int t = blockIdx.x * 4 + w; t < NTOK; t += gridDim.x * 4) norm_row_wave(xrow(p, l, t), act + (size_t)t * LDA, lane);
}

DI void wtile(const float* src, const float* gain, int K, int N, u16* dst, int ldd, int k0, int n0, char* smem) {
  u16* T = (u16*)smem;
  const int tid = tidx();
  __syncthreads();
  {
    const int nn = tid & 63, kk0 = tid >> 6;
    const int n = n0 + nn;
#pragma unroll 4
    for (int i = 0; i < 16; i++) {
      int kk = kk0 + 4 * i;
      float v = 0.f;
      if (n < N) { v = src[(size_t)(k0 + kk) * N + n]; if (gain) v *= gain[k0 + kk]; }
      T[nn * 72 + kk] = f2bf(v);
    }
  }
  __syncthreads();
  {
    const int nn = tid >> 2, kq = tid & 3;
    const uint4* s = (const uint4*)(T + nn * 72 + kq * 16);
    uint4* d = (uint4*)(dst + (size_t)(n0 + nn) * ldd + k0 + kq * 16);
    d[0] = s[0]; d[1] = s[1];
  }
}

DI void phase_prep(const Params& p, char* smem) {
  const int tid = tidx(), lane = tid & 63, w = tid >> 6;
  for (int t = blockIdx.x; t < 2 * 4048; t += gridDim.x) {
    int l = t / 4048, u = t % 4048;
    const float* src; const float* gain = nullptr; int K, N, Npad; size_t doff; int ldd = LDW;
    if (u < 640) { src = p.w_in + (size_t)l * 1024 * INC; gain = p.g_mix + l * 1024; K = 1024; N = INC; Npad = 2560; doff = W_IN; }
    else if (u < 688) { u -= 640; src = p.w_q_up + (size_t)l * 256 * 768; gain = p.g_qa + l * 256; K = 256; N = 768; Npad = 768; doff = W_Q; ldd = LDWQ; }
    else if (u < 720) { u -= 688; src = p.w_kv_up + (size_t)l * 128 * 1024; K = 128; N = 1024; Npad = 1024; doff = W_KV; ldd = LDWKV; }
    else if (u < 976) { u -= 720; src = p.w_out + (size_t)l * 1048576; K = 1024; N = 1024; Npad = 1024; doff = W_OUT; }
    else if (u < 1232) { u -= 976; src = p.w_xq + (size_t)l * 1048576; gain = p.g_xattn + l * 1024; K = 1024; N = 1024; Npad = 1024; doff = W_XQ; }
    else if (u < 1488) { u -= 1232; src = p.w_xk + (size_t)l * 1048576; gain = p.g_mem + l * 1024; K = 1024; N = 1024; Npad = 1024; doff = W_XK; }
    else if (u < 1744) { u -= 1488; src = p.w_xv + (size_t)l * 1048576; gain = p.g_mem + l * 1024; K = 1024; N = 1024; Npad = 1024; doff = W_XV; }
    else if (u < 2000) { u -= 1744; src = p.w_xo + (size_t)l * 1048576; K = 1024; N = 1024; Npad = 1024; doff = W_XO; }
    else if (u < 3024) { u -= 2000; src = p.w_ff1 + (size_t)l * 4194304; gain = p.g_mlp + l * 1024; K = 1024; N = 4096; Npad = 4096; doff = W_FF1; }
    else { u -= 3024; src = p.w_ff2 + (size_t)l * 4194304; K = 4096; N = 1024; Npad = 1024; doff = W_FF2; ldd = LDW2; }
    int nt = Npad / 64;
    int kt = u / nt, ntile = u % nt;
    wtile(src, gain, K, N, wsb(p, WS_W) + (size_t)l * W_LAYER + doff, ldd, kt * 64, ntile * 64, smem);
  }
  float2* tab = (float2*)(p.ws + WS_ROPE);
  for (int t = blockIdx.x; t < 1024; t += gridDim.x) {
    int idx = t * 256 + tid; int pos = idx >> 4, i = idx & 15;
    float inv_freq = __builtin_amdgcn_exp2f(-(float)i * 0.830482023721841f);
    float ang = (float)pos * inv_freq;
    double rev = (double)ang * 0.15915494309189535;
    rev -= rint(rev);
    float fr = (float)rev;
    tab[idx] = make_float2(__builtin_amdgcn_cosf(fr), __builtin_amdgcn_sinf(fr));
  }
  u16* hm = wsb(p, WS_HM);
  for (int t = blockIdx.x * 4 + w; t < 512; t += gridDim.x * 4) norm_row_wave(p.mem_prompt + (size_t)t * 1024, hm + (size_t)t * LDA, lane);
  phase_norm(p, 0);
}

template <class Epi>
DI void phase_gemm128(const Sched& sc, const u16* A, long lda, const u16* Bt, long ldb, int K, int MT, int NT, int SN, char* smem, const Epi& epi);
DI void phase_inproj(const Params& p, const Sched& sc, int l, char* smem) {
  const u16* W = wsb(p, WS_W) + (size_t)l * W_LAYER;
  {
    EpiStoreBf16 epi{wsb(p, WS_BIG + B_P), INC, INC, wsf(p, WS_GATES)};
    phase_gemm128(sc, wsb(p, WS_ACT), LDA, W + W_IN, LDW, 1024, 272, 20, 4, smem, epi);
  }
  if (l == 0) {
    for (int u = blockIdx.x; u < 128; u += gridDim.x) {
      int l2 = u >> 6, which = (u >> 5) & 1, mt = (u >> 3) & 3, nt = u & 7;
      const u16* W2 = wsb(p, WS_W) + (size_t)l2 * W_LAYER + (which ? W_XV : W_XK);
      EpiF32 epi{p.out + (which ? O_PMEMV : O_PMEMK) + (size_t)l2 * 524288, 1024};
      gemm_tile<2, 2>(wsb(p, WS_HM), LDA, W2, LDW, 1024, mt * 128, nt * 128, smem, epi);
    }
  }
}

DI void post_token(const Params& p, int l, int tok, int lane) {
  const u16* pr = wsb(p, WS_BIG + B_P) + (size_t)tok * INC;
  {
    uint2 q4 = *(const uint2*)(pr + lane * 4);
    float a = bflo(q4.x), b = bfhi(q4.x), c = bflo(q4.y), d = bfhi(q4.y);
    float ss = wave_sum(a * a + b * b + c * c + d * d);
    if (lane == 0) wsf(p, WS_RQ)[tok] = rsqrtf(ss * (1.f / 256.f) + EPS);
  }
  const bool prompt = tok < NP;
  int b, s, row, pos; float* ckv_out; float* kr_out;
  if (prompt) {
    b = tok >> 14; s = tok & 16383; row = tok; pos = s;
    ckv_out = p.out + O_PCKV + ((size_t)(l * 2 + b) * 16384 + s) * 128;
    kr_out = p.out + O_PKROPE + ((size_t)(l * 2 + b) * 16384 + s) * 32;
  } else {
    int t2 = tok - NP; b = t2 >> 6; s = t2 & 63; row = NP + b * 1088 + 1024 + s; pos = 1024 + s;
    ckv_out = p.out + O_SCKV + ((size_t)(l * 32 + b) * 64 + s) * 128;
    kr_out = p.out + O_SKROPE + ((size_t)(l * 32 + b) * 64 + s) * 32;
  }
  {
    unsigned c2 = *(const unsigned*)(pr + 256 + lane * 2);
    float c0 = bflo(c2), c1 = bfhi(c2);
    float ss = wave_sum(c0 * c0 + c1 * c1);
    float rr = rsqrtf(ss * (1.f / 128.f) + EPS);
    float o0 = c0 * rr * p.g_kva[l * 128 + lane * 2], o1 = c1 * rr * p.g_kva[l * 128 + lane * 2 + 1];
    *(float2*)(ckv_out + lane * 2) = make_float2(o0, o1);
    *(unsigned*)(wsb(p, WS_CKV) + (size_t)row * 128 + lane * 2) = pk2(o0, o1);
  }
  if (lane < 16) {
    float x1 = bf2f(pr[384 + lane]), x2 = bf2f(pr[400 + lane]);
    float2 cs = ((const float2*)(p.ws + WS_ROPE))[(size_t)pos * 16 + lane];
    float o1 = x1 * cs.x - x2 * cs.y, o2 = x1 * cs.y + x2 * cs.x;
    kr_out[lane] = o1; kr_out[16 + lane] = o2;
    float* ka = wsf(p, WS_KROPE) + (size_t)row * 32;
    ka[lane] = o1; ka[16 + lane] = o2;
  }
  const int S = prompt ? 16384 : 64;
  if (s >= S - 3) {
    int j = s - (S - 3);
    float* dst = prompt ? p.out + O_PCONV + ((size_t)(l * 2 + b) * 3 + j) * 1024 : p.out + O_SCONV + ((size_t)(l * 32 + b) * 3 + j) * 1024;
#pragma unroll 4
    for (int i = 0; i < 16; i++) dst[lane + 64 * i] = bf2f(pr[416 + lane + 64 * i]);
  }
}

DI void post_past(const Params& p, int l, int pi, int lane) {
  int b = pi >> 10, t = pi & 1023;
  size_t row = (size_t)NP + b * 1088 + t;
  const float* src = p.cache_ckv + ((size_t)(l * 32 + b) * 1024 + t) * 128;
  float2 v = *(const float2*)(src + lane * 2);
  *(unsigned*)(wsb(p, WS_CKV) + row * 128 + lane * 2) = pk2(v.x, v.y);
  if (lane < 32) wsf(p, WS_KROPE)[row * 32 + lane] = p.cache_krope[((size_t)(l * 32 + b) * 1024 + t) * 32 + lane];
}

struct ChunkInfo { int tok0, b, h, chain, has_prev, sample; };
DI ChunkInfo chunk_info(int item) {
  ChunkInfo ci;
  if (item < 2048) {
    ci.chain = item >> 8; ci.b = ci.chain >> 2; ci.h = ci.chain & 3; int c = item & 255;
    ci.tok0 = ci.b * 16384 + c * 64; ci.has_prev = (c > 0); ci.sample = 0;
  } else {
    int j = item - 2048; ci.chain = 8 + j; ci.b = j >> 2; ci.h = j & 3; ci.tok0 = NP + ci.b * 64; ci.has_prev = 0; ci.sample = 1;
  }
  return ci;
}
DI void load_x8(const Params& p, int l, const ChunkInfo& ci, int tp, int col, float (&x)[8]) {
  if (tp >= 0 || ci.has_prev) {
    uint4 v = *(const uint4*)(wsb(p, WS_BIG + B_P) + (size_t)(ci.tok0 + tp) * INC + col);
    unpack8(v, x);
  } else if (ci.sample) {
    const float* s = p.st_conv + (((size_t)l * 32 + ci.b) * 3 + (3 + tp)) * 1024 + (col - 416);
    float4 a = *(const float4*)s, b = *(const float4*)(s + 4);
    x[0] = a.x; x[1] = a.y; x[2] = a.z; x[3] = a.w; x[4] = b.x; x[5] = b.y; x[6] = b.z; x[7] = b.w;
  } else {
#pragma unroll
    for (int j = 0; j < 8; j++) x[j] = 0.f;
  }
}
template <class Emit>
DI void conv_run(const Params& p, int l, const ChunkInfo& ci, int mat, int chunk, int row0, int nrows, Emit emit) {
  const int ch0 = mat * 512 + ci.h * 128 + chunk * 8;
  const int col = 416 + ch0;
  float w0[8], w1[8], w2[8], w3[8], bias[8];
  {
    const float* wc = p.w_conv + (size_t)l * 4096 + ch0;
    float4 a, b;
    a = *(const float4*)(wc); b = *(const float4*)(wc + 4);
    w0[0] = a.x; w0[1] = a.y; w0[2] = a.z; w0[3] = a.w; w0[4] = b.x; w0[5] = b.y; w0[6] = b.z; w0[7] = b.w;
    a = *(const float4*)(wc + 1024); b = *(const float4*)(wc + 1028);
    w1[0] = a.x; w1[1] = a.y; w1[2] = a.z; w1[3] = a.w; w1[4] = b.x; w1[5] = b.y; w1[6] = b.z; w1[7] = b.w;
    a = *(const float4*)(wc + 2048); b = *(const float4*)(wc + 2052);
    w2[0] = a.x; w2[1] = a.y; w2[2] = a.z; w2[3] = a.w; w2[4] = b.x; w2[5] = b.y; w2[6] = b.z; w2[7] = b.w;
    a = *(const float4*)(wc + 3072); b = *(const float4*)(wc + 3076);
    w3[0] = a.x; w3[1] = a.y; w3[2] = a.z; w3[3] = a.w; w3[4] = b.x; w3[5] = b.y; w3[6] = b.z; w3[7] = b.w;
    const float* bc = p.b_conv + (size_t)l * 1024 + ch0;
    a = *(const float4*)(bc); b = *(const float4*)(bc + 4);
    bias[0] = a.x; bias[1] = a.y; bias[2] = a.z; bias[3] = a.w; bias[4] = b.x; bias[5] = b.y; bias[6] = b.z; bias[7] = b.w;
  }
  float xa[8], xb[8], xc[8], xd[8];
  load_x8(p, l, ci, row0 - 3, col, xa);
  load_x8(p, l, ci, row0 - 2, col, xb);
  load_x8(p, l, ci, row0 - 1, col, xc);
  for (int t = row0; t < row0 + nrows; t++) {
    load_x8(p, l, ci, t, col, xd);
    float y[8];
#pragma unroll
    for (int j = 0; j < 8; j++) {
      float v = bias[j] + xa[j] * w0[j] + xb[j] * w1[j] + xc[j] * w2[j] + xd[j] * w3[j];
      y[j] = v * __builtin_amdgcn_rcpf(1.f + __expf(-v));
      xa[j] = xb[j]; xb[j] = xc[j]; xc[j] = xd[j];
    }
    emit(t, y);
  }
}
DI float logsigmoid(float z) { return fminf(z, 0.f) - log1pf(__expf(-fabsf(z))); }

DI void mlstm_m1(const Params& p, int l, int item, char* smem) {
  const ChunkInfo ci = chunk_info(item);
  const int tid = tidx(), lane = tid & 63, w = tid >> 6, r = lane & 31, h = lane >> 5;
  u16* sVt = (u16*)smem;
  u16* sKt = sVt + 128 * 72;
  float* swk = (float*)(sKt + 128 * 72);
  __syncthreads();
  if (w == 0) {
    const float* g = wsf(p, WS_GATES) + (size_t)(ci.tok0 + lane) * 8;
    float ig = g[ci.h] + p.b_igate[l * 4 + ci.h];
    float lf = logsigmoid(g[4 + ci.h] + p.b_fgate[l * 4 + ci.h]);
    float bcs = lf;
#pragma unroll
    for (int o = 1; o < 64; o <<= 1) { float t = __shfl_up(bcs, o); if (lane >= o) bcs += t; }
    float u = ig - bcs;
    float umax = wave_max(u);
    swk[lane] = __expf(u - umax);
    float blast = __shfl(bcs, 63);
    if (lane == 0) { float* sc = wsf(p, WS_SCAL) + (size_t)item * 2; sc[0] = blast; sc[1] = blast + umax; }
  }
#pragma unroll
  for (int it = 0; it < 4; it++) {
    int id = tid + 256 * it; int s = id >> 4, ch = id & 15;
    uint4 v = *(const uint4*)(wsb(p, WS_BIG + B_P) + (size_t)(ci.tok0 + s) * INC + 1440 + ci.h * 128 + ch * 8);
    const u16* vv = (const u16*)&v;
    unsigned a[4] = {v.x, v.y, v.z, v.w};
#pragma unroll
    for (int j = 0; j < 4; j++) { sVt[(ch * 8 + 2 * j) * 72 + s] = (u16)(a[j] & 0xffffu); sVt[(ch * 8 + 2 * j + 1) * 72 + s] = (u16)(a[j] >> 16); }
    (void)vv;
  }
  __syncthreads();
  {
    const int chunk = tid & 15, rg = tid >> 4;
    conv_run(p, l, ci, 1, chunk, rg * 4, 4, [&](int t, const float (&y)[8]) {
      float sc = 0.08838834764831845f * swk[t];
#pragma unroll
      for (int j = 0; j < 8; j++) sKt[(chunk * 8 + j) * 72 + t] = f2bf(y[j] * sc);
    });
  }
  __syncthreads();
  const int wm = w >> 1, wn = w & 1;
  f32x16 acc[2][2];
#pragma unroll
  for (int a = 0; a < 2; a++)
#pragma unroll
    for (int b = 0; b < 2; b++)
#pragma unroll
      for (int i = 0; i < 16; i++) acc[a][b][i] = 0.f;
#pragma unroll
  for (int ks = 0; ks < 4; ks++) {
    bf16x8 af[2], bfr[2];
#pragma unroll
    for (int tm = 0; tm < 2; tm++) af[tm] = *(const bf16x8*)(sVt + (wm * 64 + tm * 32 + r) * 72 + ks * 16 + h * 8);
#pragma unroll
    for (int tn = 0; tn < 2; tn++) bfr[tn] = *(const bf16x8*)(sKt + (wn * 64 + tn * 32 + r) * 72 + ks * 16 + h * 8);
#pragma unroll
    for (int tm = 0; tm < 2; tm++)
#pragma unroll
      for (int tn = 0; tn < 2; tn++) acc[tm][tn] = MFMA(bfr[tn], af[tm], acc[tm][tn]);
  }
  u16* slot = wsb(p, WS_BIG + B_ST) + (size_t)item * 16384;
#pragma unroll
  for (int tm = 0; tm < 2; tm++)
#pragma unroll
    for (int tn = 0; tn < 2; tn++)
#pragma unroll
      for (int g = 0; g < 4; g++) {
        uint2 v;
        v.x = pk2(acc[tm][tn][4 * g + 0], acc[tm][tn][4 * g + 1]);
        v.y = pk2(acc[tm][tn][4 * g + 2], acc[tm][tn][4 * g + 3]);
        *(uint2*)(slot + (wm * 64 + tm * 32 + r) * 128 + wn * 64 + tn * 32 + 8 * g + 4 * h) = v;
      }
  if (tid < 128) {
    float sum = 0.f;
    const u16* kr = sKt + tid * 72;
#pragma unroll 8
    for (int s = 0; s < 64; s++) sum += bf2f(kr[s]);
    wsf(p, WS_NU)[(size_t)item * 128 + tid] = sum;
  }
}

DI void mlstm_m2(const Params& p, int l, int unit, char* smem) {
  const int tid = tidx();
  int chain, g, nc, item0, b, h; bool sample;
  if (unit < 256) { chain = unit >> 5; g = unit & 31; nc = 256; item0 = chain * 256; b = chain >> 2; h = chain & 3; sample = false; }
  else { int u = unit - 256; int j = u >> 5; g = u & 31; chain = 8 + j; nc = 1; item0 = 2048 + j; b = j >> 2; h = j & 3; sample = true; }
  const int el = g * 512 + tid * 2; const int e = el >> 7, d = el & 127;
  float c0 = 0.f, c1 = 0.f, nst = 0.f, m0 = 0.f;
  const bool do_n = (g == 0 && tid < 128);
  if (sample) {
    const float* C0 = p.st_C + ((size_t)(l * 32 + b) * 4 + h) * 16384;
    c0 = C0[d * 128 + e]; c1 = C0[(d + 1) * 128 + e];
    if (do_n) nst = p.st_n[((size_t)(l * 32 + b) * 4 + h) * 128 + tid];
    m0 = p.st_m[(l * 32 + b) * 4 + h];
  }
  u16* slots = wsb(p, WS_BIG + B_ST);
  const float* scal = wsf(p, WS_SCAL);
  float* nu = wsf(p, WS_NU);
  float* mst = wsf(p, WS_MST);
  float* sA = (float*)smem; float* sC = sA + 256; float* sdec = sC + 256; float* sus = sdec + 256; float* smst = sus + 256;
  __syncthreads();
  if (tid < nc) { sA[tid] = scal[(size_t)(item0 + tid) * 2]; sC[tid] = scal[(size_t)(item0 + tid) * 2 + 1]; }
  __syncthreads();
  if (tid == 0) {
    float m = m0;
    for (int c = 0; c < nc; c++) {
      const float A = sA[c], Cm = sC[c];
      const float mnew = fmaxf(A + m, Cm);
      sdec[c] = __expf(A + m - mnew); sus[c] = __expf(Cm - mnew); smst[c] = m;
      m = mnew;
    }
    smst[256] = m;
  }
  __syncthreads();
  unsigned uu[8], un[8]; float nn[8], nx[8];
#pragma unroll
  for (int j = 0; j < 8; j++) {
    uu[j] = 0; nn[j] = 0.f;
    if (j < nc) {
      uu[j] = *(const unsigned*)(slots + (size_t)(item0 + j) * 16384 + el);
      if (do_n) nn[j] = nu[(size_t)(item0 + j) * 128 + tid];
    }
  }
  for (int cb = 0; cb < nc; cb += 8) {
#pragma unroll
    for (int j = 0; j < 8; j++) {
      un[j] = 0; nx[j] = 0.f;
      if (cb + 8 + j < nc) {
        un[j] = *(const unsigned*)(slots + (size_t)(item0 + cb + 8 + j) * 16384 + el);
        if (do_n) nx[j] = nu[(size_t)(item0 + cb + 8 + j) * 128 + tid];
      }
    }
#pragma unroll
    for (int j = 0; j < 8; j++) {
      if (cb + j < nc) {
        const int item = item0 + cb + j;
        const float dec = sdec[cb + j], us = sus[cb + j];
        *(unsigned*)(slots + (size_t)item * 16384 + el) = pk2(c0, c1);
        c0 = dec * c0 + us * bflo(uu[j]);
        c1 = dec * c1 + us * bfhi(uu[j]);
        if (do_n) { nu[(size_t)item * 128 + tid] = nst; nst = dec * nst + us * nn[j]; }
        if (g == 0 && tid == 0) mst[item] = smst[cb + j];
      }
    }
#pragma unroll
    for (int j = 0; j < 8; j++) { uu[j] = un[j]; nn[j] = nx[j]; }
  }
  float* oC = sample ? p.out + O_SC + ((size_t)(l * 32 + b) * 4 + h) * 16384 : p.out + O_PC + ((size_t)(l * 2 + b) * 4 + h) * 16384;
  oC[d * 128 + e] = c0; oC[(d + 1) * 128 + e] = c1;
  if (do_n) { float* on = sample ? p.out + O_SN + ((size_t)(l * 32 + b) * 4 + h) * 128 : p.out + O_PN + ((size_t)(l * 2 + b) * 4 + h) * 128; on[tid] = nst; }
  if (g == 0 && tid == 0) { float* om = sample ? p.out + O_SM + (l * 32 + b) * 4 + h : p.out + O_PM + (l * 2 + b) * 4 + h; *om = smst[256]; }
}

DI void mlstm_m3(const Params& p, int l, int item, char* smem) {
  const ChunkInfo ci = chunk_info(item);
  const int tid = tidx(), lane = tid & 63, w = tid >> 6, r = lane & 31, h = lane >> 5;
  u16* sQ = (u16*)smem;
  u16* sK = sQ + 64 * 136;
  u16* sVt = sK + 64 * 136;
  u16* sP = sVt + 128 * 72;
  float* su = (float*)(sP + 64 * 72);
  float* sM = su + 64;
  float* sa = sM + 64;
  float* sden = sa + 64;
  float* sinv = sden + 64;
  float* sn = sinv + 64;
  float* sH = (float*)smem;
  __syncthreads();
  const float m_start = wsf(p, WS_MST)[item];
  if (w == 0) {
    const float* g = wsf(p, WS_GATES) + (size_t)(ci.tok0 + lane) * 8;
    float ig = g[ci.h] + p.b_igate[l * 4 + ci.h];
    float lf = logsigmoid(g[4 + ci.h] + p.b_fgate[l * 4 + ci.h]);
    float bcs = lf;
#pragma unroll
    for (int o = 1; o < 64; o <<= 1) { float t = __shfl_up(bcs, o); if (lane >= o) bcs += t; }
    float u = ig - bcs;
    float cm = u;
#pragma unroll
    for (int o = 1; o < 64; o <<= 1) { float t = __shfl_up(cm, o); if (lane >= o) cm = fmaxf(cm, t); }
    float Mt = fmaxf(m_start, cm);
    su[lane] = u; sM[lane] = Mt; sa[lane] = __expf(m_start - Mt); sden[lane] = __expf(-(bcs + Mt));
  } else if (w == 1) {
    sn[lane] = wsf(p, WS_NU)[(size_t)item * 128 + lane];
    sn[lane + 64] = wsf(p, WS_NU)[(size_t)item * 128 + lane + 64];
  }
#pragma unroll
  for (int it = 0; it < 4; it++) {
    int id = tid + 256 * it; int s = id >> 4, ch = id & 15;
    uint4 v = *(const uint4*)(wsb(p, WS_BIG + B_P) + (size_t)(ci.tok0 + s) * INC + 1440 + ci.h * 128 + ch * 8);
    unsigned a[4] = {v.x, v.y, v.z, v.w};
#pragma unroll
    for (int j = 0; j < 4; j++) { sVt[(ch * 8 + 2 * j) * 72 + s] = (u16)(a[j] & 0xffffu); sVt[(ch * 8 + 2 * j + 1) * 72 + s] = (u16)(a[j] >> 16); }
  }
  {
    const int mc = tid & 31, mat = mc >> 4, chunk = mc & 15, rg = tid >> 5;
    u16* dst = mat ? sK : sQ;
    const float sc = mat ? 0.08838834764831845f : 1.f;
    conv_run(p, l, ci, mat, chunk, rg * 8, 8, [&](int t, const float (&y)[8]) {
      float x[8];
#pragma unroll
      for (int j = 0; j < 8; j++) x[j] = y[j] * sc;
      *(uint4*)(dst + t * 136 + chunk * 8) = pack8(x);
    });
  }
  __syncthreads();
  {
    const int tq = w >> 1, ts = w & 1;
    f32x16 s;
#pragma unroll
    for (int i = 0; i < 16; i++) s[i] = 0.f;
#pragma unroll
    for (int ks = 0; ks < 8; ks++) {
      bf16x8 a = *(const bf16x8*)(sQ + (tq * 32 + r) * 136 + ks * 16 + h * 8);
      bf16x8 b = *(const bf16x8*)(sK + (ts * 32 + r) * 136 + ks * 16 + h * 8);
      s = MFMA(a, b, s);
    }
    const int sidx = ts * 32 + r;
    const float us = su[sidx];
#pragma unroll
    for (int i = 0; i < 16; i++) {
      int t = tq * 32 + crow(i, h);
      float v = (sidx <= t) ? s[i] * __expf(us - sM[t]) : 0.f;
      sP[t * 72 + sidx] = f2bf(v);
    }
  }
  __syncthreads();
  if (tid < 64) {
    float rs = 0.f, qd = 0.f;
    const u16* pr = sP + tid * 72;
#pragma unroll 8
    for (int s = 0; s < 64; s++) rs += bf2f(pr[s]);
    const u16* qr = sQ + tid * 136;
#pragma unroll 8
    for (int d = 0; d < 128; d++) qd += bf2f(qr[d]) * sn[d];
    float qn = sa[tid] * qd + rs;
    sinv[tid] = __builtin_amdgcn_rcpf(fmaxf(fabsf(qn), sden[tid]));
  }
  const int tq = w & 1, eb = (w >> 1) * 2;
  f32x16 a1[2], a2[2];
#pragma unroll
  for (int et = 0; et < 2; et++)
#pragma unroll
    for (int i = 0; i < 16; i++) { a1[et][i] = 0.f; a2[et][i] = 0.f; }
  const u16* slot = wsb(p, WS_BIG + B_ST) + (size_t)item * 16384;
#pragma unroll
  for (int ks = 0; ks < 8; ks++) {
    bf16x8 a = *(const bf16x8*)(sQ + (tq * 32 + r) * 136 + ks * 16 + h * 8);
#pragma unroll
    for (int et = 0; et < 2; et++) {
      bf16x8 b = *(const bf16x8*)(slot + ((eb + et) * 32 + r) * 128 + ks * 16 + h * 8);
      a1[et] = MFMA(a, b, a1[et]);
    }
  }
#pragma unroll
  for (int ks = 0; ks < 4; ks++) {
    bf16x8 a = *(const bf16x8*)(sP + (tq * 32 + r) * 72 + ks * 16 + h * 8);
#pragma unroll
    for (int et = 0; et < 2; et++) {
      bf16x8 b = *(const bf16x8*)(sVt + ((eb + et) * 32 + r) * 72 + ks * 16 + h * 8);
      a2[et] = MFMA(a, b, a2[et]);
    }
  }
  __syncthreads();
#pragma unroll
  for (int et = 0; et < 2; et++)
#pragma unroll
    for (int i = 0; i < 16; i++) {
      int t = tq * 32 + crow(i, h);
      sH[t * 132 + (eb + et) * 32 + r] = (sa[t] * a1[et][i] + a2[et][i]) * sinv[t];
    }
  __syncthreads();
  {
    const int t = tid >> 2, part = tid & 3;
    const float* hr = sH + t * 132 + part * 32;
    float ss = 0.f;
#pragma unroll 8
    for (int j = 0; j < 32; j++) ss += hr[j] * hr[j];
    ss += __shfl_xor(ss, 1); ss += __shfl_xor(ss, 2);
    const float rr = rsqrtf(ss * (1.f / 128.f) + EPS);
    const int tok = ci.tok0 + t;
    const u16* og = wsb(p, WS_BIG + B_P) + (size_t)tok * INC + 1960 + ci.h * 128 + part * 32;
    const float* gm = p.g_mhead + (size_t)l * 512 + ci.h * 128 + part * 32;
    u16* o = wsb(p, WS_ACT) + (size_t)tok * LDA + 512 + ci.h * 128 + part * 32;
#pragma unroll
    for (int c8 = 0; c8 < 4; c8++) {
      float gv[8], x[8];
      unpack8(*(const uint4*)(og + c8 * 8), gv);
#pragma unroll
      for (int j = 0; j < 8; j++) x[j] = hr[c8 * 8 + j] * rr * gm[c8 * 8 + j] * __builtin_amdgcn_rcpf(1.f + __expf(-gv[j]));
      *(uint4*)(o + c8 * 8) = pack8(x);
    }
  }
}

DI void xkv_item(const Params& p, int l, int item, char* smem) {
  const int tid = tidx();
  const int kg = item & 3, hh = (item >> 2) & 3, bidx = item >> 4;
  u16* T = (u16*)smem;
  __syncthreads();
  const int key = tid >> 2, qt = tid & 3;
  const int mem = kg * 64 + key;
  const bool prompt = bidx < 2;
  float* kp; const float* vp;
  if (prompt) {
    kp = p.out + O_PMEMK + (((size_t)(l * 2 + bidx) * 256 + mem) * 4 + hh) * 256 + qt * 64;
    vp = p.out + O_PMEMV + (((size_t)(l * 2 + bidx) * 256 + mem) * 4 + hh) * 256 + qt * 64;
  } else {
    kp = (float*)(p.cache_mem_k + (((size_t)(l * 32 + bidx - 2) * 256 + mem) * 4 + hh) * 256 + qt * 64);
    vp = p.cache_mem_v + (((size_t)(l * 32 + bidx - 2) * 256 + mem) * 4 + hh) * 256 + qt * 64;
  }
  float rr = 1.f;
  if (prompt) {
    float ss = 0.f;
#pragma unroll 4
    for (int j = 0; j < 16; j++) { float4 v = *(const float4*)(kp + j * 4); ss += v.x * v.x + v.y * v.y + v.z * v.z + v.w * v.w; }
    ss += __shfl_xor(ss, 1); ss += __shfl_xor(ss, 2);
    rr = rsqrtf(ss * (1.f / 256.f) + EPS);
  }
  const float* gk = p.g_xk + l * 256 + qt * 64;
  const float* gq = p.g_xq + l * 256 + qt * 64;
  u16* xk = wsb(p, WS_BIG + B_XK) + ((size_t)(bidx * 4 + hh) * 256 + mem) * 256 + qt * 64;
#pragma unroll 2
  for (int c8 = 0; c8 < 8; c8++) {
    float4 a = *(const float4*)(kp + c8 * 8), b = *(const float4*)(kp + c8 * 8 + 4);
    float x[8] = {a.x, a.y, a.z, a.w, b.x, b.y, b.z, b.w};
    if (prompt) {
#pragma unroll
      for (int j = 0; j < 8; j++) x[j] = x[j] * rr * gk[c8 * 8 + j];
      *(float4*)(kp + c8 * 8) = make_float4(x[0], x[1], x[2], x[3]);
      *(float4*)(kp + c8 * 8 + 4) = make_float4(x[4], x[5], x[6], x[7]);
    }
#pragma unroll
    for (int j = 0; j < 8; j++) x[j] = x[j] * gq[c8 * 8 + j] * (0.0625f * LOG2E);
    *(uint4*)(xk + c8 * 8) = pack8(x);
    float4 va = *(const float4*)(vp + c8 * 8), vb = *(const float4*)(vp + c8 * 8 + 4);
    float y[8] = {va.x, va.y, va.z, va.w, vb.x, vb.y, vb.z, vb.w};
    *(uint4*)(T + key * 264 + qt * 64 + c8 * 8) = pack8(y);
  }
  __syncthreads();
  {
    const int e = tid;
    u16* xv = wsb(p, WS_BIG + B_XVT) + ((size_t)(bidx * 4 + hh) * 256 + e) * LDXV + kg * 64;
#pragma unroll 2
    for (int oct = 0; oct < 8; oct++) {
      uint4 v;
      const int kb = 16 * (oct >> 1) + 4 * (oct & 1);
      v.x = (unsigned)T[(kb + 0) * 264 + e] | ((unsigned)T[(kb + 1) * 264 + e] << 16);
      v.y = (unsigned)T[(kb + 2) * 264 + e] | ((unsigned)T[(kb + 3) * 264 + e] << 16);
      v.z = (unsigned)T[(kb + 8) * 264 + e] | ((unsigned)T[(kb + 9) * 264 + e] << 16);
      v.w = (unsigned)T[(kb + 10) * 264 + e] | ((unsigned)T[(kb + 11) * 264 + e] << 16);
      *(uint4*)(xv + oct * 8) = v;
    }
  }
}

DI void phase_C2(const Params& p, int l, char* smem) {
  for (int t = blockIdx.x; t < 544; t += gridDim.x) xkv_item(p, l, t, smem);
}
DI void phase_C1(const Params& p, int l, char* smem) {
  const int lane = tidx() & 63, w = tidx() >> 6;
  for (int t = blockIdx.x; t < NITEM; t += gridDim.x) mlstm_m1(p, l, t, smem);
  for (int t = blockIdx.x * 4 + w; t < NTOK + 32768; t += gridDim.x * 4) {
    if (t < NTOK) post_token(p, l, t, lane); else post_past(p, l, t - NTOK, lane);
  }
}

DI void phase_D(const Params& p, int l, char* smem) {
  const int n_scan = 256 + 4096;
  const int n_q = 544 * 4;
  const u16* W = wsb(p, WS_W) + (size_t)l * W_LAYER;
  for (int t = blockIdx.x; t < n_scan + n_q; t += gridDim.x) {
    if (t < n_scan) mlstm_m2(p, l, t, smem);
    else {
      int u = t - n_scan; int mt = u >> 2, nt = u & 3;
      EpiQ epi{wsb(p, WS_BIG + B_Q), wsf(p, WS_RQ), (const float2*)(p.ws + WS_ROPE), p.g_qnorm + l * 96};
      gemm_tile<1, 3>(wsb(p, WS_BIG + B_P), INC, W + W_Q, LDWQ, 256, mt * 64, nt * 192, smem, epi);
    }
  }
}

DI void phase_E(const Params& p, int l, char* smem) {
  for (int t = blockIdx.x; t < NITEM; t += gridDim.x) mlstm_m3(p, l, t, smem);
}

DI void phase_F(const Params& p, int l, char* smem) {
  const u16* W = wsb(p, WS_W) + (size_t)l * W_LAYER;
  for (int t = blockIdx.x; t < 528 * 8; t += gridDim.x) {
    int mt = t >> 3, nt = t & 7;
    EpiKV epi{wsb(p, WS_BIG + B_K), wsb(p, WS_BIG + B_VT), wsf(p, WS_KROPE), p.g_knorm + l * 96};
    gemm_tile<2, 2>(wsb(p, WS_CKV), 128, W + W_KV, LDWKV, 128, mt * 128, nt * 128, smem, epi);
  }
}

DI void phase_G(const Params& p, const Sched& sc, char* smem) {
  const int G = gridDim.x, j = blockIdx.x;
  const int lane = tidx() & 63, w = tidx() >> 6, r = lane & 31;
  const int NIT = 2048 + 256;
  const u16* qb = wsb(p, WS_BIG + B_Q);
  const u16* Kb = wsb(p, WS_BIG + B_K);
  const u16* Vt = wsb(p, WS_BIG + B_VT);
  u16* act = wsb(p, WS_ACT);
  auto run_prompt = [&](int bh, int bi) {
    int b = bh >> 3, hd = bh & 7;
    int tok = b * 16384 + bi * 128 + w * 32 + r;
    flash_item<96, 2, 64, true, false, true, true>(qb + (size_t)tok * 768 + hd * 96, true, 2 * bi + 2, 2 * bi + 1 + (w >> 1),
                                             Kb + ((size_t)hd * NROWS + b * 16384) * 96, 96, Vt + (size_t)hd * 64 * LDVT + b * 16384, LDVT, 0,
                                             act + (size_t)tok * LDA + hd * 64, smem);
  };
  auto run_sample = [&](int u) {
    int b = u >> 3, hd = u & 7;
    int tok = NP + b * 64 + (w & 1) * 32 + r;
    size_t row0 = (size_t)NP + b * 1088;
    flash_item<96, 2, 64, true, false, true, true>(qb + (size_t)tok * 768 + hd * 96, w < 2, 17, 17, Kb + ((size_t)hd * NROWS + row0) * 96, 96,
                                             Vt + (size_t)hd * 64 * LDVT + row0, LDVT, 0, act + (size_t)tok * LDA + hd * 64, smem);
  };
  if (sc.ok) {
    const int xg = sc.xg, xi = sc.xi;
    for (int pass = 0; pass < 2; pass++) {
      const int bh = xg + 8 * pass, b = bh >> 3, hd = bh & 7;
      const int bi = pass ? 63 - xi : xi;
      const int tok0 = b * 16384 + bi * 256 + w * 64;
      flash_item64(qb + (size_t)tok0 * 768 + hd * 96, 4 * bi + 4, 4 * bi + w + 1, Kb + ((size_t)hd * NROWS + b * 16384) * 96,
                   Vt + (size_t)hd * 64 * LDVT + b * 16384, act + (size_t)tok0 * LDA + hd * 64, smem);
    }
    if ((j & 1) == 0) run_sample(j >> 1);
  } else {
    for (int k = 0; k * G < NIT; k++) {
      int it = (k & 1) ? (k * G + (G - 1 - j)) : (k * G + j);
      if (it >= NIT) continue;
      if (it < 2048) run_prompt(it & 15, 127 - (it >> 4)); else run_sample(it - 2048);
    }
  }
}

DI void xattn_item(const u16* Qtile  , const u16* Kbase, const u16* Vtbase, u16* Otile, char* smem) {
  constexpr int LDQ = 264, LDV = 40;
  u16* sQ = (u16*)smem;
  u16* sK = sQ + 64 * LDQ;
  u16* sV = sK + 32 * LDQ;
  const int tid = tidx(), lane = tid & 63, w = tid >> 6, r = lane & 31, h = lane >> 5;
  const int qrow = 32 * (w & 1) + r, e0 = 128 * (w >> 1);
  u32x4 rk[4], rv[4];
  auto gload = [&](int t) {
#pragma unroll
    for (int i = 0; i < 4; i++) {
      int id = tid + 256 * i;
      rk[i] = *(const u32x4*)(Kbase + (long)(t * 32 + (id >> 5)) * 256 + (id & 31) * 8);
      rv[i] = *(const u32x4*)(Vtbase + (long)(id >> 2) * LDXV + t * 32 + (id & 3) * 8);
    }
  };
  auto sstore = [&]() {
#pragma unroll
    for (int i = 0; i < 4; i++) {
      int id = tid + 256 * i;
      *(u32x4*)(sK + (id >> 5) * LDQ + (id & 31) * 8) = rk[i];
      *(u32x4*)(sV + (id >> 2) * LDV + (id & 3) * 8) = rv[i];
    }
  };
  __syncthreads();
  gload(0);
#pragma unroll
  for (int i = 0; i < 8; i++) {
    int id = tid + 256 * i;
    *(u32x4*)(sQ + (id >> 5) * LDQ + (id & 31) * 8) = *(const u32x4*)(Qtile + (long)(id >> 5) * LDA + (id & 31) * 8);
  }
  sstore();
  __syncthreads();
  float rqs;
  {
    float ss = 0.f;
#pragma unroll
    for (int ks = 0; ks < 16; ks++) {
      bf16x8 qq = *(const bf16x8*)(sQ + qrow * LDQ + ks * 16 + h * 8);
#pragma unroll
      for (int j = 0; j < 8; j++) { float v = bf2f((u16)qq[j]); ss += v * v; }
    }
    ss = xhalf_sum(ss);
    rqs = rsqrtf(ss * (1.f / 256.f) + EPS);
  }
  const float rqinv = __builtin_amdgcn_rcpf(rqs);
  f32x16 o[4];
#pragma unroll
  for (int et = 0; et < 4; et++)
#pragma unroll
    for (int i = 0; i < 16; i++) o[et][i] = 0.f;
  float mrun = 0.f, lrun = 0.f;
  for (int t = 0; t < 8; t++) {
    if (t + 1 < 8) gload(t + 1);
    __builtin_amdgcn_sched_barrier(0);
    __builtin_amdgcn_s_setprio(1);
    {
      f32x16 s;
      const float sinit = -mrun * rqinv;
#pragma unroll
      for (int i = 0; i < 16; i++) s[i] = sinit;
#pragma unroll
      for (int ks = 0; ks < 16; ks++) {
        bf16x8 a = *(const bf16x8*)(sK + r * LDQ + ks * 16 + h * 8);
        bf16x8 b = *(const bf16x8*)(sQ + qrow * LDQ + ks * 16 + h * 8);
        s = MFMA(a, b, s);
      }
      float mx = -1e30f;
#pragma unroll
      for (int i = 0; i < 16; i++) { s[i] *= rqs; mx = fmaxf(mx, s[i]); }
      mx = xhalf_max(mx);
      if (__any(mx > 8.f)) {
        const float d = fmaxf(mx, 0.f);
        const float alpha = __builtin_amdgcn_exp2f(-d);
        mrun += d;
        lrun *= alpha;
#pragma unroll
        for (int et = 0; et < 4; et++)
#pragma unroll
          for (int i = 0; i < 16; i++) o[et][i] *= alpha;
#pragma unroll
        for (int i = 0; i < 16; i++) s[i] -= d;
      }
      float psum = 0.f;
#pragma unroll
      for (int i = 0; i < 16; i++) { float pv = __builtin_amdgcn_exp2f(s[i]); s[i] = pv; psum += pv; }
      lrun += psum;
#pragma unroll
      for (int st = 0; st < 2; st++) {
        uint4 pp;
        pp.x = pk2(s[8 * st + 0], s[8 * st + 1]); pp.y = pk2(s[8 * st + 2], s[8 * st + 3]);
        pp.z = pk2(s[8 * st + 4], s[8 * st + 5]); pp.w = pk2(s[8 * st + 6], s[8 * st + 7]);
        bf16x8 pb = __builtin_bit_cast(bf16x8, pp);
#pragma unroll
        for (int et = 0; et < 4; et++) {
          bf16x8 a = *(const bf16x8*)(sV + (e0 + et * 32 + r) * LDV + st * 16 + 8 * h);
          o[et] = MFMA(a, pb, o[et]);
        }
      }
    }
    __builtin_amdgcn_s_setprio(0);
    __builtin_amdgcn_sched_barrier(0);
    __syncthreads();
    if (t + 1 < 8) { sstore(); __syncthreads(); }
  }
  {
    float lt = xhalf_sum(lrun);
    float inv = __builtin_amdgcn_rcpf(lt);
    u16* Orow = Otile + (long)qrow * LDA + e0;
#pragma unroll
    for (int et = 0; et < 4; et++)
#pragma unroll
      for (int g = 0; g < 4; g++) {
        uint2 v;
        v.x = pk2(o[et][4 * g + 0] * inv, o[et][4 * g + 1] * inv);
        v.y = pk2(o[et][4 * g + 2] * inv, o[et][4 * g + 3] * inv);
        *(uint2*)(Orow + et * 32 + 8 * g + 4 * h) = v;
      }
  }
}

DI void phase_K(const Params& p, char* smem) {
  const int lane = tidx() & 63, w = tidx() >> 6, r = lane & 31;
  const u16* qx = wsb(p, WS_BIG + B_QX);
  u16* act = wsb(p, WS_ACT);
  for (int t = blockIdx.x; t < 2176; t += gridDim.x) {
    int bidx, hh, tok0;
    if (t < 2048) { bidx = t >> 10; hh = (t >> 8) & 3; tok0 = bidx * 16384 + (t & 255) * 64; }
    else { int u = t - 2048; bidx = 2 + (u >> 2); hh = u & 3; tok0 = NP + (u >> 2) * 64; }
    const u16* Kb = wsb(p, WS_BIG + B_XK) + (size_t)(bidx * 4 + hh) * 65536;
    const u16* Vt = wsb(p, WS_BIG + B_XVT) + (size_t)(bidx * 4 + hh) * 256 * LDXV;
    xattn_item(qx + (size_t)tok0 * LDA + hh * 256, Kb, Vt, act + (size_t)tok0 * LDA + hh * 256, smem);
  }
  (void)lane; (void)w; (void)r;
}

template <class Epi>
DI void phase_gemm128(const Sched& sc, const u16* A, long lda, const u16* Bt, long ldb, int K, int MT, int NT, int SN, char* smem, const Epi& epi) {
  if (sc.ok) {
    const int xg = sc.xg, xi = sc.xi;
    const int SM = 64 / SN;
    const int sng = NT / SN, smg = MT / SM;
    const int nst = smg * sng;
    const int left = nst & 7;
    const int nfull = (left > 0 && left <= 4) ? nst - left : nst;
    for (int st = xg; st < nfull; st += 8) {
      int sm = st / sng, sn = st % sng;
      int mt = sm * SM + xi / SN, nt = sn * SN + xi % SN;
      gemm_tile<2, 2>(A, lda, Bt, ldb, K, mt * 128, nt * 128, smem, epi);
    }
    if (nfull < nst) {
      const int q = xg * 64 + xi;
      if (q < left * 128) {
        const int tile = q >> 1, half = q & 1;
        const int st = nfull + (tile >> 6), t64 = tile & 63;
        int sm = st / sng, sn = st % sng;
        int mt = sm * SM + t64 / SN, nt = sn * SN + t64 % SN;
        gemm_tile<1, 2>(A, lda, Bt, ldb, K, mt * 128 + half * 64, nt * 128, smem, epi);
      }
    }
  } else {
    for (int t = blockIdx.x; t < MT * NT; t += gridDim.x) {
      int mt = t / NT, nt = t % NT;
      gemm_tile<2, 2>(A, lda, Bt, ldb, K, mt * 128, nt * 128, smem, epi);
    }
  }
}

#if defined(__HIP_DEVICE_COMPILE__)
typedef const __attribute__((address_space(4))) Params* KargPtr;
#define KARG_LOAD KargPtr pp4 = (KargPtr)__builtin_amdgcn_kernarg_segment_ptr(); asm volatile("" : "+s"(pp4)); const Params p = *pp4;
#else
#define KARG_LOAD const Params p{};
#endif
template <int L>
DI void run_layer(const Sched& sc, int ph_begin, int ph_end, char* smem, const XcdBarrier& xb) {
  const int base = 1 + 15 * L;
#define RUN_PHASE(S, ...)  RUN_PHASE_R(S, 1, __VA_ARGS__)
#define RUN_PHASE_R(S, R, ...)                                    \
  {                                                          \
    const int ph = base + (S);                               \
    if (ph >= ph_begin && ph < ph_end) {                     \
      for (int rep_ = 0; rep_ < (R); rep_++) {               \
        KARG_LOAD                                            \
        const u16* W = wsb(p, WS_W) + (size_t)L * W_LAYER;   \
        const float* xs0 = (L == 0) ? p.x_prompt : p.out;    \
        const float* xs1 = (L == 0) ? p.x_sample : p.out + (size_t)NP * 1024; \
        (void)W; (void)xs0; (void)xs1;                       \
        __VA_ARGS__;                                         \
        if (ph + 1 < ph_end) xcd_barrier(xb);                \
      }                                                      \
    }                                                        \
  }
  if (L > 0) RUN_PHASE(0, phase_norm(p, L))
  RUN_PHASE_R(1, REP_INPROJ, phase_inproj(p, sc, L, smem))
  RUN_PHASE_R(2, REP_C, { phase_C1(p, L, smem); phase_C2(p, L, smem); })
  RUN_PHASE(3, phase_D(p, L, smem))
  RUN_PHASE_R(4, REP_E, phase_E(p, L, smem))
  RUN_PHASE_R(5, REP_F, phase_F(p, L, smem))
  RUN_PHASE_R(6, REP_G, phase_G(p, sc, smem))
  RUN_PHASE(7, { EpiRes epi{xs0, xs1, p.out}; phase_gemm128(sc, wsb(p, WS_ACT), LDA, W + W_OUT, LDW, 1024, 272, 8, 8, smem, epi); })
  RUN_PHASE_R(8, REP_NORM, phase_norm(p, 1))
  RUN_PHASE(9, { EpiStoreBf16 epi{wsb(p, WS_BIG + B_QX), LDA, 1024, nullptr}; phase_gemm128(sc, wsb(p, WS_ACT), LDA, W + W_XQ, LDW, 1024, 272, 8, 8, smem, epi); })
  RUN_PHASE_R(10, REP_K, phase_K(p, smem))
  RUN_PHASE(11, { EpiRes epi{p.out, p.out + (size_t)NP * 1024, p.out}; phase_gemm128(sc, wsb(p, WS_ACT), LDA, W + W_XO, LDW, 1024, 272, 8, 8, smem, epi); })
  RUN_PHASE(12, phase_norm(p, 1))
  RUN_PHASE_R(13, REP_FF1, { EpiRelu2 epi{wsb(p, WS_BIG + B_H1), LDH1}; phase_gemm128(sc, wsb(p, WS_ACT), LDA, W + W_FF1, LDW, 1024, 272, 32, 8, smem, epi); })
  RUN_PHASE(14, { EpiRes epi{p.out, p.out + (size_t)NP * 1024, p.out}; phase_gemm128(sc, wsb(p, WS_BIG + B_H1), LDH1, W + W_FF2, LDW2, 4096, 272, 8, 8, smem, epi); })
#undef RUN_PHASE
#undef RUN_PHASE_R
}

__global__ void __launch_bounds__(256, 2) fwd_megakernel(Params p, int ph_begin, int ph_end) {
  __shared__ __attribute__((aligned(16))) char smem[SMEM_BYTES];
  cg::grid_group grid = cg::this_grid();
  __shared__ int s_rank;
  __shared__ __attribute__((aligned(16))) unsigned xb_words[4];
  if (tidx() < 4) xb_words[tidx()] = 0u;
  __syncthreads();
  const XcdBarrier xb = xcd_barrier_post((unsigned*)(p.ws + WS_BAR), (volatile LAS unsigned*)&xb_words);
  Sched sc;
  sc.xg = (int)((unsigned)__builtin_amdgcn_s_getreg((3 << 11) | 20) & 7u);
  unsigned* cnt = (unsigned*)(p.ws + WS_CNT);
  if (tidx() == 0) s_rank = (int)atomicAdd(&cnt[sc.xg], 1u);
  __syncthreads();
  sc.xi = __builtin_amdgcn_readfirstlane(s_rank);
  sc.ok = 0;
  if (ph_begin <= 0 && 0 < ph_end) {
    phase_prep(p, smem);
    if (ph_end < 0) grid.sync();
    if (1 < ph_end) xcd_barrier(xb);
  }
  {
    int ok = (gridDim.x == 512);
#pragma unroll
    for (int i = 0; i < 8; i++) ok &= (__atomic_load_n(&cnt[i], __ATOMIC_RELAXED) == 64u);
    sc.ok = ok;
  }
  run_layer<0>(sc, ph_begin, ph_end, smem, xb);
  run_layer<1>(sc, ph_begin, ph_end, smem, xb);
}

extern "C" void kernel_launch(void* const* d_in, const int* in_sizes, int n_in, void* d_out, int out_size, void* d_ws, size_t ws_size,
                              hipStream_t stream) {
  static int grid_blocks = 0;
  if (!grid_blocks) {
    int dev = 0, cus = 0, per_cu = 0;
    (void)hipGetDevice(&dev);
    (void)hipDeviceGetAttribute(&cus, hipDeviceAttributeMultiprocessorCount, dev);
    (void)hipOccupancyMaxActiveBlocksPerMultiprocessor(&per_cu, fwd_megakernel, 256, 0);
    per_cu = 2;
    grid_blocks = cus * per_cu;
  }
  Params p{};
  const float** pp = (const float**)&p;
  for (int i = 0; i < 36; i++) pp[i] = (const float*)d_in[i];
  p.out = (float*)d_out;
  p.ws = (char*)d_ws;
  int ph_begin = 0, ph_end = 31;
  (void)hipMemsetAsync((char*)d_ws + WS_CNT, 0, 256 + 16384, stream);
  void* args[] = {&p, &ph_begin, &ph_end};
  hipError_t e = hipLaunchCooperativeKernel((void*)fwd_megakernel, dim3(grid_blocks), dim3(256), args, 0, stream);
  if (e != hipSuccess) fprintf(stderr, "cooperative launch failed: %s (grid %d)\n", hipGetErrorString(e), grid_blocks);
}
```

```cpp
#include <hip/hip_runtime.h>
#include <hip/hip_cooperative_groups.h>
#include <stdint.h>
#include <stdio.h>
namespace cg = cooperative_groups;

typedef unsigned short u16;
typedef short bf16x8 __attribute__((ext_vector_type(8)));
typedef short s16x4 __attribute__((ext_vector_type(4)));
typedef float f32x16 __attribute__((ext_vector_type(16)));
typedef __bf16 bfv2 __attribute__((ext_vector_type(2)));
typedef float fv2 __attribute__((ext_vector_type(2)));
typedef unsigned u32x4 __attribute__((ext_vector_type(4)));
#define DI __device__ __forceinline__
#define MFMA(a, b, c) __builtin_amdgcn_mfma_f32_32x32x16_bf16((a), (b), (c), 0, 0, 0)

constexpr int NP = 32768;
constexpr int NS = 2048;
constexpr int NTOK = NP + NS;
constexpr int NROWS = NP + 32 * 1088;
constexpr int INC = 2472;
constexpr float EPS = 1e-6f;
constexpr float LOG2E = 1.4426950408889634f;
constexpr int NITEM = 2048 + 128;
constexpr int LDA = 1088;
constexpr int LDW = 1088;
constexpr int LDW2 = 4160;
constexpr int LDWQ = 320;
constexpr int LDWKV = 192;
constexpr int LDH1 = 4160;
constexpr int LDVT = NROWS + 64;
constexpr int LDXV = 320;

constexpr size_t O_Y = 0;
constexpr size_t O_PCKV = 35651584;
constexpr size_t O_PKROPE = O_PCKV + 8388608;
constexpr size_t O_PC = O_PKROPE + 2097152;
constexpr size_t O_PN = O_PC + 262144;
constexpr size_t O_PM = O_PN + 2048;
constexpr size_t O_PCONV = O_PM + 16;
constexpr size_t O_PMEMK = O_PCONV + 12288;
constexpr size_t O_PMEMV = O_PMEMK + 1048576;
constexpr size_t O_SCKV = O_PMEMV + 1048576;
constexpr size_t O_SKROPE = O_SCKV + 524288;
constexpr size_t O_SC = O_SKROPE + 131072;
constexpr size_t O_SN = O_SC + 4194304;
constexpr size_t O_SM = O_SN + 32768;
constexpr size_t O_SCONV = O_SM + 256;

constexpr size_t W_IN = 0;
constexpr size_t W_Q = W_IN + 2560 * LDW;
constexpr size_t W_KV = W_Q + 768 * LDWQ;
constexpr size_t W_OUT = W_KV + 1024 * LDWKV;
constexpr size_t W_XQ = W_OUT + 1024 * LDW;
constexpr size_t W_XK = W_XQ + 1024 * LDW;
constexpr size_t W_XV = W_XK + 1024 * LDW;
constexpr size_t W_XO = W_XV + 1024 * LDW;
constexpr size_t W_FF1 = W_XO + 1024 * LDW;
constexpr size_t W_FF2 = W_FF1 + 4096 * LDW;
constexpr size_t W_LAYER = W_FF2 + 1024 * LDW2;

constexpr size_t WS_W = 0;
constexpr size_t WS_ACT = WS_W + 2 * W_LAYER * 2;
constexpr size_t WS_CKV = WS_ACT + (size_t)NTOK * LDA * 2;
constexpr size_t WS_KROPE = WS_CKV + (size_t)NROWS * 128 * 2;
constexpr size_t WS_RQ = WS_KROPE + (size_t)NROWS * 32 * 4;
constexpr size_t WS_GATES = WS_RQ + (size_t)NTOK * 4;
constexpr size_t WS_ROPE = WS_GATES + (size_t)NTOK * 8 * 4;
constexpr size_t WS_SCAL = WS_ROPE + (size_t)16384 * 16 * 8;
constexpr size_t WS_MST = WS_SCAL + (size_t)NITEM * 2 * 4;
constexpr size_t WS_NU = WS_MST + (size_t)NITEM * 4 + 256;
constexpr size_t WS_CNT = WS_NU + (size_t)NITEM * 128 * 4;
constexpr size_t WS_BAR = WS_CNT + 256;
constexpr size_t WS_HM = WS_BAR + 16384;
constexpr size_t WS_BIG = WS_HM + (size_t)512 * LDA * 2;
constexpr size_t B_P = 0;
constexpr size_t B_K = 0;
constexpr size_t B_VT = B_K + (size_t)8 * NROWS * 96 * 2;
constexpr size_t B_Q = B_VT + (size_t)8 * 64 * LDVT * 2;
constexpr size_t B_ST = B_Q + (size_t)NTOK * 768 * 2;
constexpr size_t B_XK = B_ST + (size_t)NITEM * 16384 * 2;
constexpr size_t B_XVT = B_XK + (size_t)34 * 4 * 256 * 256 * 2;
constexpr size_t B_END = B_XVT + (size_t)34 * 4 * 256 * LDXV * 2;
constexpr size_t B_QX = 0;
constexpr size_t B_H1 = 0;
static_assert((size_t)NTOK * INC * 2 <= B_Q, "p overlaps q");
static_assert((size_t)NTOK * LDH1 * 2 <= B_XK, "h1 overlaps xkv");
static_assert((size_t)NTOK * LDA * 2 <= B_Q, "qx overlaps q");
static_assert(WS_BIG + B_END <= (size_t)536870912, "workspace too large");
static_assert(WS_BIG % 256 == 0 && B_Q % 256 == 0 && B_ST % 256 == 0 && B_VT % 256 == 0, "align");

constexpr int SMEM_BYTES = 73728;
#ifndef REP_INPROJ
#define REP_INPROJ 1
#endif
#ifndef REP_C
#define REP_C 1
#endif
#ifndef REP_E
#define REP_E 1
#endif
#ifndef REP_F
#define REP_F 1
#endif
#ifndef REP_G
#define REP_G 1
#endif
#ifndef REP_K
#define REP_K 1
#endif
#ifndef REP_FF1
#define REP_FF1 1
#endif
#ifndef REP_NORM
#define REP_NORM 1
#endif

struct Params {
  const float* x_prompt; const float* x_sample; const float* cache_ckv; const float* cache_krope;
  const float* st_C; const float* st_n; const float* st_m; const float* st_conv;
  const float* cache_mem_k; const float* cache_mem_v; const float* mem_prompt;
  const float* g_mix; const float* w_in; const float* g_qa; const float* w_q_up; const float* g_qnorm; const float* g_kva;
  const float* w_kv_up; const float* g_knorm; const float* w_conv; const float* b_conv; const float* b_igate; const float* b_fgate;
  const float* g_mhead; const float* w_out; const float* g_xattn; const float* g_mem; const float* w_xq; const float* w_xk; const float* w_xv;
  const float* g_xq; const float* g_xk; const float* w_xo; const float* g_mlp; const float* w_ff1; const float* w_ff2;
  float* out; char* ws;
};

#define XB_TMO      128
#define XB_XCNT(j)  (256  + 64 * (j))
#define XB_XSUB(j)  (1280 + 64 * (j))
#define XB_XGEN(j)  (2304 + 64 * (j))
#define XB_TOP      3328
#define XB_TOPGEN   3392
#define XCD_BAR_WORDS 3456
#define XB_SPIN_CAP (1u << 18)
#define LAS __attribute__((address_space(3)))

__device__ __forceinline__ unsigned xb_ld(unsigned* p)              { return __hip_atomic_load(p, __ATOMIC_RELAXED, __HIP_MEMORY_SCOPE_AGENT); }
__device__ __forceinline__ unsigned xb_add(unsigned* p, unsigned v) { return __hip_atomic_fetch_add(p, v, __ATOMIC_RELAXED, __HIP_MEMORY_SCOPE_AGENT); }
__device__ __forceinline__ unsigned xb_xcc_id() { return (unsigned)__builtin_amdgcn_s_getreg((3 << 11) | 20) & 0xFu; }
#define XB_SPIN(cond, bar) do { unsigned _sp = 0; while (cond) { __builtin_amdgcn_s_sleep(1); \
    if ((++_sp & 255u) == 0u) { if (xb_ld(&(bar)[XB_TMO])) break; if (_sp > XB_SPIN_CAP) { atomicAdd(&(bar)[XB_TMO], 1u); break; } } } } while (0)

struct XcdBarrier {
    unsigned* bar; unsigned x;
    volatile LAS unsigned* st;
};

__device__ __forceinline__ XcdBarrier xcd_barrier_post(unsigned* bar, volatile LAS unsigned* st) {
    XcdBarrier b; b.bar = bar; b.x = xb_xcc_id(); b.st = st;
    if (threadIdx.x == 0) (void)xb_add(&bar[XB_XCNT(b.x)], 1u);
    return b;
}
__device__ __forceinline__ void xcd_barrier_complete(unsigned* bar, unsigned x, unsigned& nloc, unsigned& nx) {
    const unsigned G = gridDim.x * gridDim.y * gridDim.z;
    unsigned sum, cnt, mine, sp = 0u;
    for (;;) {
        sum = 0u; cnt = 0u; mine = 0u;
#pragma unroll
        for (unsigned j = 0; j < 16; ++j) { const unsigned c = xb_ld(&bar[XB_XCNT(j)]); sum += c; cnt += (c > 0u) ? 1u : 0u; mine = (j == x) ? c : mine; }
        if (sum == G) break;
        __builtin_amdgcn_s_sleep(1);
        if ((++sp & 255u) == 0u) { if (xb_ld(&bar[XB_TMO])) break; if (sp > XB_SPIN_CAP) { atomicAdd(&bar[XB_TMO], 1u); break; } }
    }
    nloc = mine > 0u ? mine : 1u; nx = cnt > 0u ? cnt : 1u;
}

__device__ __forceinline__ void xcd_barrier(const XcdBarrier& b) {
    asm volatile("s_waitcnt vmcnt(0)" ::: "memory");
    __syncthreads();
    if (threadIdx.x == 0) {
        unsigned* bar = b.bar;
        __builtin_amdgcn_s_waitcnt(0);
        unsigned nloc = b.st[0], nx = b.st[1];
        if (nloc == 0u) { xcd_barrier_complete(bar, b.x, nloc, nx); b.st[0] = nloc; b.st[1] = nx; }
        const unsigned old = xb_add(&bar[XB_XSUB(b.x)], 1u);
        const unsigned gen = old / nloc;
        if (old + 1u == (gen + 1u) * nloc) {
            __builtin_amdgcn_fence(__ATOMIC_RELEASE, "agent");
            asm volatile("s_waitcnt vmcnt(0)" ::: "memory");
            const unsigned og = xb_add(&bar[XB_TOP], 1u);
            const unsigned tg = og / nx;
            if (og + 1u == (tg + 1u) * nx) xb_add(&bar[XB_TOPGEN], 1u);
            else XB_SPIN(xb_ld(&bar[XB_TOPGEN]) == tg, bar);
            __builtin_amdgcn_fence(__ATOMIC_ACQUIRE, "agent");
            xb_add(&bar[XB_XGEN(b.x)], 1u);
            asm volatile("s_waitcnt vmcnt(0)" ::: "memory");
        } else {
            XB_SPIN(xb_ld(&bar[XB_XGEN(b.x)]) == gen, bar);
            __builtin_amdgcn_fence(__ATOMIC_ACQUIRE, "agent");
            asm volatile("s_waitcnt vmcnt(0)" ::: "memory");
        }
    }
    __syncthreads();
}


struct Sched { int xg, xi, ok; };
DI int tidx() { int t = (int)threadIdx.x; asm volatile("" : "+v"(t)); return t; }
DI unsigned pk2(float a, float b) { fv2 v = {a, b}; bfv2 r = __builtin_convertvector(v, bfv2); return __builtin_bit_cast(unsigned, r); }
DI u16 f2bf(float a) { return (u16)(pk2(a, 0.f) & 0xffffu); }
DI float bf2f(u16 v) { return __uint_as_float(((unsigned)v) << 16); }
DI float bflo(unsigned v) { return __uint_as_float(v << 16); }
DI float bfhi(unsigned v) { return __uint_as_float(v & 0xffff0000u); }
DI int crow(int i, int h) { return (i & 3) + 8 * (i >> 2) + 4 * h; }
DI float xhalf_max(float v) {
  unsigned u = __float_as_uint(v);
  auto rr = __builtin_amdgcn_permlane32_swap(u, u, false, false);
  return fmaxf(__uint_as_float(rr[0]), __uint_as_float(rr[1]));
}
DI float xhalf_sum(float v) {
  unsigned u = __float_as_uint(v);
  auto rr = __builtin_amdgcn_permlane32_swap(u, u, false, false);
  return __uint_as_float(rr[0]) + __uint_as_float(rr[1]);
}
DI float wave_sum(float v) {
#pragma unroll
  for (int o = 32; o >= 1; o >>= 1) v += __shfl_xor(v, o);
  return v;
}
DI float wave_max(float v) {
#pragma unroll
  for (int o = 32; o >= 1; o >>= 1) v = fmaxf(v, __shfl_xor(v, o));
  return v;
}
DI void unpack8(uint4 v, float (&x)[8]) {
  x[0] = bflo(v.x); x[1] = bfhi(v.x); x[2] = bflo(v.y); x[3] = bfhi(v.y);
  x[4] = bflo(v.z); x[5] = bfhi(v.z); x[6] = bflo(v.w); x[7] = bfhi(v.w);
}
DI uint4 pack8(const float (&x)[8]) {
  uint4 v; v.x = pk2(x[0], x[1]); v.y = pk2(x[2], x[3]); v.z = pk2(x[4], x[5]); v.w = pk2(x[6], x[7]); return v;
}
DI u16* wsb(const Params& p, size_t off) { return (u16*)(p.ws + off); }
DI float* wsf(const Params& p, size_t off) { return (float*)(p.ws + off); }
DI u16* actp(const Params& p) { return (u16*)p.out; }
DI u16* xres(const Params& p) { return (u16*)(p.ws + WS_ACT); }
DI const float* xrow(const Params& p, int l, int tok) {
  if (l == 0) return tok < NP ? p.x_prompt + (size_t)tok * 1024 : p.x_sample + (size_t)(tok - NP) * 1024;
  return p.out + (size_t)tok * 1024;
}
DI int tok_pos(int tok) { return tok < NP ? (tok & 16383) : 1024 + ((tok - NP) & 63); }

template <int TM, int TN>
DI void gemm_mainloop(const u16* __restrict__ A, long lda, const u16* __restrict__ Bt, long ldb, int K, char* smem,
                      f32x16 (&acc)[TM][TN]) {
  constexpr int BM = 64 * TM, BN = 64 * TN, LD = 72;
  u16* sA = (u16*)smem;
  u16* sB = sA + 2 * BM * LD;
  const int tid = tidx(), lane = tid & 63, w = tid >> 6, r = lane & 31, h = lane >> 5;
  const int wm = w >> 1, wn = w & 1;
  constexpr int NA = BM / 32, NB = BN / 32;
  u32x4 ra[NA], rb[NB];
#pragma unroll
  for (int tm = 0; tm < TM; tm++)
#pragma unroll
    for (int tn = 0; tn < TN; tn++)
#pragma unroll
      for (int i = 0; i < 16; i++) acc[tm][tn][i] = 0.f;
  const int nk = K / 64;
  const int lrow = tid >> 3, lch = (tid & 7) * 8;
  const u16* gA = A + (long)lrow * lda + lch;
  const u16* gB = Bt + (long)lrow * ldb + lch;
  const int soff = lrow * LD + lch;
#define GEMM_GLOAD(k0)                                                                   \
  {                                                                                      \
    _Pragma("unroll") for (int i = 0; i < NA; i++) ra[i] = *(const u32x4*)(gA + (long)(32 * i) * lda + (k0)); \
    _Pragma("unroll") for (int i = 0; i < NB; i++) rb[i] = *(const u32x4*)(gB + (long)(32 * i) * ldb + (k0)); \
  }
#define GEMM_SSTORE(buf)                                                                 \
  {                                                                                      \
    _Pragma("unroll") for (int i = 0; i < NA; i++) *(u32x4*)(sA + (buf) * BM * LD + soff + 32 * i * LD) = ra[i]; \
    _Pragma("unroll") for (int i = 0; i < NB; i++) *(u32x4*)(sB + (buf) * BN * LD + soff + 32 * i * LD) = rb[i]; \
  }
  GEMM_GLOAD(0)
  __syncthreads();
  GEMM_SSTORE(0)
  if (nk > 1) GEMM_GLOAD(64)
  __syncthreads();
  for (int kt = 0; kt < nk; kt++) {
    const int buf = kt & 1;
    const u16* cA = sA + buf * BM * LD + (wm * 32 * TM + r) * LD + h * 8;
    const u16* cB = sB + buf * BN * LD + (wn * 32 * TN + r) * LD + h * 8;
    bf16x8 af[TM], bfr[TN];
#pragma unroll
    for (int tm = 0; tm < TM; tm++) af[tm] = *(const bf16x8*)(cA + tm * 32 * LD);
#pragma unroll
    for (int tn = 0; tn < TN; tn++) bfr[tn] = *(const bf16x8*)(cB + tn * 32 * LD);
    if (kt + 1 < nk) GEMM_SSTORE(buf ^ 1)
    __builtin_amdgcn_sched_barrier(0);
    __builtin_amdgcn_s_setprio(1);
#pragma unroll
    for (int tm = 0; tm < TM; tm++)
#pragma unroll
      for (int tn = 0; tn < TN; tn++) acc[tm][tn] = MFMA(af[tm], bfr[tn], acc[tm][tn]);
#pragma unroll
    for (int tm = 0; tm < TM; tm++) af[tm] = *(const bf16x8*)(cA + tm * 32 * LD + 16);
#pragma unroll
    for (int tn = 0; tn < TN; tn++) bfr[tn] = *(const bf16x8*)(cB + tn * 32 * LD + 16);
#pragma unroll
    for (int tm = 0; tm < TM; tm++)
#pragma unroll
      for (int tn = 0; tn < TN; tn++) acc[tm][tn] = MFMA(af[tm], bfr[tn], acc[tm][tn]);
    __builtin_amdgcn_sched_barrier(0);
    if (kt + 2 < nk) GEMM_GLOAD((kt + 2) * 64)
    __builtin_amdgcn_sched_barrier(0);
#pragma unroll
    for (int ks = 2; ks < 4; ks++) {
#pragma unroll
      for (int tm = 0; tm < TM; tm++) af[tm] = *(const bf16x8*)(cA + tm * 32 * LD + ks * 16);
#pragma unroll
      for (int tn = 0; tn < TN; tn++) bfr[tn] = *(const bf16x8*)(cB + tn * 32 * LD + ks * 16);
#pragma unroll
      for (int tm = 0; tm < TM; tm++)
#pragma unroll
        for (int tn = 0; tn < TN; tn++) acc[tm][tn] = MFMA(af[tm], bfr[tn], acc[tm][tn]);
    }
    __builtin_amdgcn_s_setprio(0);
    __syncthreads();
  }
#undef GEMM_GLOAD
#undef GEMM_SSTORE
}

template <int TM, int TN, class Epi>
DI void gemm_tile(const u16* A, long lda, const u16* Bt, long ldb, int K, int m0, int n0, char* smem, const Epi& epi) {
  constexpr int BM = 64 * TM, BN = 64 * TN, LDC = BN + Epi::PAD;
  f32x16 acc[TM][TN];
  gemm_mainloop<TM, TN>(A + (long)m0 * lda, lda, Bt + (long)n0 * ldb, ldb, K, smem, acc);
  const int tid = tidx(), lane = tid & 63, w = tid >> 6, r = lane & 31, h = lane >> 5;
  const int wm = w >> 1, wn = w & 1;
  float* Ct = (float*)smem;
#pragma unroll
  for (int tm = 0; tm < TM; tm++)
#pragma unroll
    for (int tn = 0; tn < TN; tn++)
#pragma unroll
      for (int i = 0; i < 16; i++)
        Ct[(wm * 32 * TM + tm * 32 + crow(i, h)) * LDC + wn * 32 * TN + tn * 32 + r] = acc[tm][tn][i];
  __syncthreads();
  epi(Ct, LDC, m0, n0, tid, BM);
  __syncthreads();
  (void)BM;
}

struct EpiStoreBf16 {
  static constexpr int PAD = 4;
  u16* out; long ldo; int nmax; float* gates;
  DI void operator()(const float* Ct, int ldc, int m0, int n0, int tid, int bm) const {
#pragma unroll 4
    for (int it = 0; it < bm / 16; it++) {
      int id = tid + 256 * it; int row = id >> 4, c8 = (id & 15) * 8;
      int n = n0 + c8;
      if (n < nmax) {
        const float* c = Ct + row * ldc + c8;
        float4 a = *(const float4*)c, b = *(const float4*)(c + 4);
        uint4 v; v.x = pk2(a.x, a.y); v.y = pk2(a.z, a.w); v.z = pk2(b.x, b.y); v.w = pk2(b.z, b.w);
        *(uint4*)(out + (long)(m0 + row) * ldo + n) = v;
        if (gates != nullptr && n == 1952) {
          float* g = gates + (long)(m0 + row) * 8;
          *(float4*)g = a; *(float4*)(g + 4) = b;
        }
      }
    }
  }
};
struct EpiRelu2 {
  static constexpr int PAD = 4;
  u16* out; long ldo;
  DI void operator()(const float* Ct, int ldc, int m0, int n0, int tid, int bm) const {
#pragma unroll 4
    for (int it = 0; it < bm / 16; it++) {
      int id = tid + 256 * it; int row = id >> 4, c8 = (id & 15) * 8;
      const float* c = Ct + row * ldc + c8;
      float x[8];
#pragma unroll
      for (int j = 0; j < 8; j++) { float v = fmaxf(c[j], 0.f); x[j] = v * v; }
      *(uint4*)(out + (long)(m0 + row) * ldo + n0 + c8) = pack8(x);
    }
  }
};
struct EpiF32 {
  static constexpr int PAD = 4;
  float* out; long ldo;
  DI void operator()(const float* Ct, int ldc, int m0, int n0, int tid, int bm) const {
#pragma unroll 4
    for (int it = 0; it < bm / 16; it++) {
      int id = tid + 256 * it; int row = id >> 4, c8 = (id & 15) * 8;
      const float* c = Ct + row * ldc + c8;
      float* o = out + (long)(m0 + row) * ldo + n0 + c8;
      *(float4*)o = *(const float4*)c; *(float4*)(o + 4) = *(const float4*)(c + 4);
    }
  }
};
struct EpiRes {
  static constexpr int PAD = 4;
  const float* src0; const float* src1;
  const u16* srcb; u16* dstb; float* dstf;
  DI void operator()(const float* Ct, int ldc, int m0, int n0, int tid, int bm) const {
#pragma unroll 4
    for (int it = 0; it < bm / 16; it++) {
      int id = tid + 256 * it; int row = id >> 4, c8 = (id & 15) * 8;
      int m = m0 + row;
      const float* c = Ct + row * ldc + c8;
      float4 a = *(const float4*)c, b = *(const float4*)(c + 4);
      float x[8];
      if (srcb != nullptr) {
        unpack8(*(const uint4*)(srcb + (size_t)m * LDA + n0 + c8), x);
      } else {
        const float* sp = (m < NP ? src0 + (size_t)m * 1024 : src1 + (size_t)(m - NP) * 1024) + n0 + c8;
        float4 sa = *(const float4*)sp, sb = *(const float4*)(sp + 4);
        x[0] = sa.x; x[1] = sa.y; x[2] = sa.z; x[3] = sa.w; x[4] = sb.x; x[5] = sb.y; x[6] = sb.z; x[7] = sb.w;
      }
      x[0] += a.x; x[1] += a.y; x[2] += a.z; x[3] += a.w; x[4] += b.x; x[5] += b.y; x[6] += b.z; x[7] += b.w;
      if (dstf != nullptr) {
        float* o = dstf + (size_t)m * 1024 + n0 + c8;
        *(float4*)o = make_float4(x[0], x[1], x[2], x[3]); *(float4*)(o + 4) = make_float4(x[4], x[5], x[6], x[7]);
      } else {
        *(uint4*)(dstb + (size_t)m * LDA + n0 + c8) = pack8(x);
      }
    }
  }
};
struct EpiQ {
  static constexpr int PAD = 1;
  u16* q; const float* rq; const float2* rope; const float* g;
  DI void operator()(const float* Ct, int ldc, int m0, int n0, int tid, int bm) const {
    float* r2s = (float*)((char*)Ct + 60000);
    {
      const int row = tid >> 2, hh = (tid >> 1) & 1, half = tid & 1; const int m = m0 + row;
      const float* c = Ct + row * ldc + hh * 96 + half * 48;
      float ss = 0.f;
#pragma unroll 8
      for (int d = 0; d < 48; d++) ss += c[d] * c[d];
      ss += __shfl_xor(ss, 1);
      const float rqv = rq[m];
      ss *= rqv * rqv;
      if (half == 0) r2s[row * 2 + hh] = rsqrtf(ss * (1.f / 96.f) + EPS) * rqv * (0.10206207261596575f * LOG2E);
    }
    __syncthreads();
#pragma unroll
    for (int it = 0; it < 6; it++) {
      const int id = tid + 256 * it; const int row = id / 24, cc = id % 24; const int hh = cc / 12, c8 = cc % 12;
      const int m = m0 + row;
      const float* c = Ct + row * ldc + hh * 96;
      const float r2 = r2s[row * 2 + hh];
      float x[8];
      if (c8 < 8) {
#pragma unroll
        for (int jj = 0; jj < 8; jj++) x[jj] = c[c8 * 8 + jj] * r2 * g[c8 * 8 + jj];
      } else {
        const int half = c8 & 1;
        const bool second = c8 >= 10;
        const float2* tab = rope + (size_t)tok_pos(m) * 16 + half * 8;
#pragma unroll
        for (int jj = 0; jj < 8; jj++) {
          const int i = half * 8 + jj;
          const float a = c[64 + i], b = c[80 + i]; const float2 cs = tab[jj];
          const float v = second ? (a * cs.y + b * cs.x) : (a * cs.x - b * cs.y);
          x[jj] = v * r2 * g[(second ? 80 : 64) + i];
        }
      }
      *(uint4*)(q + (size_t)m * 768 + n0 + cc * 8) = pack8(x);
    }
  }
};
struct EpiKV {
  static constexpr int PAD = 1;
  u16* Kb; u16* Vt; const float* krope; const float* g;
  DI void operator()(const float* Ct, int ldc, int m0, int n0, int tid, int bm) const {
    const int hd = n0 >> 7;
#pragma unroll
    for (int it = 0; it < 4; it++) {
      int id = tid + 256 * it; int oct = id & 15, e = id >> 4;
      float x[8];
#pragma unroll
      for (int j = 0; j < 8; j++) x[j] = Ct[(16 * (oct >> 1) + 4 * (oct & 1) + (j & 3) + 8 * (j >> 2)) * ldc + 64 + e];
      *(uint4*)(Vt + (size_t)(hd * 64 + e) * LDVT + m0 + oct * 8) = pack8(x);
    }
    float* rrs = (float*)((char*)Ct + 66560);
    {
      const int row = tid >> 1, half = tid & 1;
      const float* c = Ct + row * ldc + half * 32;
      const float* kr = krope + (size_t)(m0 + row) * 32 + half * 16;
      float ss = 0.f;
#pragma unroll 8
      for (int d = 0; d < 32; d++) ss += c[d] * c[d];
#pragma unroll 8
      for (int d = 0; d < 16; d++) ss += kr[d] * kr[d];
      ss += __shfl_xor(ss, 1);
      if (half == 0) rrs[row] = rsqrtf(ss * (1.f / 96.f) + EPS);
    }
    __syncthreads();
    u16* ob = Kb + ((size_t)hd * NROWS + m0) * 96;
#pragma unroll
    for (int it = 0; it < 6; it++) {
      const int id = tid + 256 * it; const int row = id / 12, cc = id % 12;
      const float rr = rrs[row];
      float x[8];
      if (cc < 8) {
        const float* c = Ct + row * ldc + cc * 8;
#pragma unroll
        for (int jj = 0; jj < 8; jj++) x[jj] = c[jj] * rr * g[cc * 8 + jj];
      } else {
        const float* kr = krope + (size_t)(m0 + row) * 32 + (cc - 8) * 8;
#pragma unroll
        for (int jj = 0; jj < 8; jj++) x[jj] = kr[jj] * rr * g[cc * 8 + jj];
      }
      *(uint4*)(ob + (size_t)id * 8) = pack8(x);
    }
  }
};

template <int DQK, int NE, int EV, bool DB, bool QNORM, bool QREG, bool VPERM = false>
DI void flash_item(const u16* Qrow, bool wave_active, int ntb, int ntw, const u16* Kbase, long ldk, const u16* Vtbase, long ldv,
                   int e0, u16* Orow, char* smem) {
  constexpr int LDK = DQK + 8, LDV = 72;
  constexpr int KS = DQK / 16;
  constexpr int KTILE = 64 * LDK, VTILE = EV * LDV;
  constexpr int NKC = 64 * (DQK / 8) / 256;
  constexpr int NVC = EV * 8 / 256;
  u16* sK = (u16*)smem;
  u16* sV = sK + (DB ? 2 : 1) * KTILE;
  const int tid = tidx(), lane = tid & 63, r = lane & 31, h = lane >> 5;
  bf16x8 qf[QREG ? KS : 1];
  float rqs = 1.f;
  if (wave_active) {
    if (QREG) {
#pragma unroll
      for (int ks = 0; ks < KS; ks++) qf[QREG ? ks : 0] = *(const bf16x8*)(Qrow + ks * 16 + h * 8);
    }
    if (QNORM) {
      float ss = 0.f;
#pragma unroll
      for (int ks = 0; ks < KS; ks++) {
        bf16x8 qq = QREG ? qf[QREG ? ks : 0] : *(const bf16x8*)(Qrow + ks * 16 + h * 8);
#pragma unroll
        for (int j = 0; j < 8; j++) { float v = bf2f((u16)qq[j]); ss += v * v; }
      }
      ss = xhalf_sum(ss);
      rqs = rsqrtf(ss * (1.f / DQK) + EPS);
    }
  } else if (QREG) {
#pragma unroll
    for (int ks = 0; ks < KS; ks++)
#pragma unroll
      for (int j = 0; j < 8; j++) qf[QREG ? ks : 0][j] = 0;
  }
  f32x16 o[NE];
#pragma unroll
  for (int et = 0; et < NE; et++)
#pragma unroll
    for (int i = 0; i < 16; i++) o[et][i] = 0.f;
  float mrun = 0.f, lrun = 0.f;
  const float rqinv = __builtin_amdgcn_rcpf(rqs);

  u32x4 rk[DB ? NKC : 1], rv[DB ? NVC : 1];
  auto gload = [&](int t) {
#pragma unroll
    for (int i = 0; i < NKC; i++) {
      int id = tid + 256 * i; int row = id / (DQK / 8), ch = id % (DQK / 8);
      u32x4 v = *(const u32x4*)(Kbase + (long)(t * 64 + row) * ldk + ch * 8);
      if (DB) rk[DB ? i : 0] = v; else *(u32x4*)(sK + row * LDK + ch * 8) = v;
    }
#pragma unroll
    for (int i = 0; i < NVC; i++) {
      int id = tid + 256 * i; int row = id >> 3, ch = id & 7;
      u32x4 v = *(const u32x4*)(Vtbase + (long)row * ldv + t * 64 + ch * 8);
      if (DB) rv[DB ? i : 0] = v; else *(u32x4*)(sV + row * LDV + ch * 8) = v;
    }
  };
  auto sstore = [&](int buf) {
#pragma unroll
    for (int i = 0; i < NKC; i++) { int id = tid + 256 * i; int row = id / (DQK / 8), ch = id % (DQK / 8); *(u32x4*)(sK + buf * KTILE + row * LDK + ch * 8) = rk[DB ? i : 0]; }
#pragma unroll
    for (int i = 0; i < NVC; i++) { int id = tid + 256 * i; int row = id >> 3, ch = id & 7; *(u32x4*)(sV + buf * VTILE + row * LDV + ch * 8) = rv[DB ? i : 0]; }
  };
  auto compute = [&](int buf) {
    const u16* cK = sK + buf * KTILE + r * LDK + h * 8;
    const u16* cV = sV + buf * VTILE + (e0 + r) * LDV + 4 * h;
    const float sinit = QNORM ? -mrun * rqinv : -mrun;
    f32x16 s[2];
#pragma unroll
    for (int sub = 0; sub < 2; sub++) {
#pragma unroll
      for (int i = 0; i < 16; i++) s[sub][i] = sinit;
#pragma unroll
      for (int ks = 0; ks < KS; ks++) {
        bf16x8 a = *(const bf16x8*)(cK + sub * 32 * LDK + ks * 16);
        bf16x8 qq = QREG ? qf[QREG ? ks : 0] : *(const bf16x8*)(Qrow + ks * 16 + h * 8);
        s[sub] = MFMA(a, qq, s[sub]);
      }
    }
    float mx = -1e30f;
#pragma unroll
    for (int sub = 0; sub < 2; sub++)
#pragma unroll
      for (int i = 0; i < 16; i++) { if (QNORM) s[sub][i] *= rqs; mx = fmaxf(mx, s[sub][i]); }
    mx = xhalf_max(mx);
    if (__any(mx > 8.f)) {
      const float d = fmaxf(mx, 0.f);
      const float alpha = __builtin_amdgcn_exp2f(-d);
      mrun += d;
      lrun *= alpha;
#pragma unroll
      for (int et = 0; et < NE; et++)
#pragma unroll
        for (int i = 0; i < 16; i++) o[et][i] *= alpha;
#pragma unroll
      for (int sub = 0; sub < 2; sub++)
#pragma unroll
        for (int i = 0; i < 16; i++) s[sub][i] -= d;
    }
    float psum = 0.f;
#pragma unroll
    for (int sub = 0; sub < 2; sub++)
#pragma unroll
      for (int i = 0; i < 16; i++) { float pv = __builtin_amdgcn_exp2f(s[sub][i]); s[sub][i] = pv; psum += pv; }
    lrun += psum;
#pragma unroll
    for (int sub = 0; sub < 2; sub++)
#pragma unroll
      for (int st = 0; st < 2; st++) {
        uint4 pp;
        pp.x = pk2(s[sub][8 * st + 0], s[sub][8 * st + 1]); pp.y = pk2(s[sub][8 * st + 2], s[sub][8 * st + 3]);
        pp.z = pk2(s[sub][8 * st + 4], s[sub][8 * st + 5]); pp.w = pk2(s[sub][8 * st + 6], s[sub][8 * st + 7]);
        bf16x8 pb = __builtin_bit_cast(bf16x8, pp);
#pragma unroll
        for (int et = 0; et < NE; et++) {
          bf16x8 a;
          if (VPERM) {
            a = *(const bf16x8*)(sV + buf * VTILE + (e0 + et * 32 + r) * LDV + sub * 32 + st * 16 + 8 * h);
          } else {
            const u16* vp = cV + et * 32 * LDV + sub * 32 + st * 16;
            s16x4 lo = *(const s16x4*)vp;
            s16x4 hi = *(const s16x4*)(vp + 8);
            a = __builtin_shufflevector(lo, hi, 0, 1, 2, 3, 4, 5, 6, 7);
          }
          o[et] = MFMA(a, pb, o[et]);
        }
      }
  };

  __syncthreads();
  if (DB) {
    gload(0);
    sstore(0);
    __syncthreads();
    for (int t = 0; t < ntb; t++) {
      const bool more = (t + 1 < ntb);
      if (more) gload(t + 1);
      __builtin_amdgcn_sched_barrier(0);
      if (wave_active && t < ntw) { __builtin_amdgcn_s_setprio(1); compute(t & 1); __builtin_amdgcn_s_setprio(0); }
      if (more) sstore((t + 1) & 1);
      __syncthreads();
    }
  } else {
    for (int t = 0; t < ntb; t++) {
      if (t > 0) __syncthreads();
      gload(t);
      __syncthreads();
      if (wave_active && t < ntw) compute(0);
    }
    __syncthreads();
  }
  if (wave_active) {
    float lt = xhalf_sum(lrun);
    float inv = __builtin_amdgcn_rcpf(lt);
#pragma unroll
    for (int et = 0; et < NE; et++)
#pragma unroll
      for (int g = 0; g < 4; g++) {
        uint2 v;
        v.x = pk2(o[et][4 * g + 0] * inv, o[et][4 * g + 1] * inv);
        v.y = pk2(o[et][4 * g + 2] * inv, o[et][4 * g + 3] * inv);
        *(uint2*)(Orow + et * 32 + 8 * g + 4 * h) = v;
      }
  }
}

DI void flash_item64(const u16* Qbase  , int ntb, int ntw, const u16* Kbase, const u16* Vtbase,
                     u16* Obase  , char* smem) {
  constexpr int LDK = 104, LDV = 72, KS = 6, KTILE = 64 * LDK, VTILE = 64 * LDV;
  u16* sK = (u16*)smem;
  u16* sV = sK + 2 * KTILE;
  const int tid = tidx(), lane = tid & 63, r = lane & 31, h = lane >> 5;
  bf16x8 qf[2][KS];
#pragma unroll
  for (int qh = 0; qh < 2; qh++)
#pragma unroll
    for (int ks = 0; ks < KS; ks++) qf[qh][ks] = *(const bf16x8*)(Qbase + (long)(qh * 32 + r) * 768 + ks * 16 + h * 8);
  f32x16 o[2][2];
#pragma unroll
  for (int qh = 0; qh < 2; qh++)
#pragma unroll
    for (int et = 0; et < 2; et++)
#pragma unroll
      for (int i = 0; i < 16; i++) o[qh][et][i] = 0.f;
  float mrun[2] = {0.f, 0.f}, lrun[2] = {0.f, 0.f};
  u32x4 rk[3], rv[2];
  auto gload = [&](int t) {
#pragma unroll
    for (int i = 0; i < 3; i++) { int id = tid + 256 * i; int row = id / 12, ch = id % 12; rk[i] = *(const u32x4*)(Kbase + (long)(t * 64 + row) * 96 + ch * 8); }
#pragma unroll
    for (int i = 0; i < 2; i++) { int id = tid + 256 * i; int row = id >> 3, ch = id & 7; rv[i] = *(const u32x4*)(Vtbase + (long)row * LDVT + t * 64 + ch * 8); }
  };
  auto sstore = [&](int buf) {
#pragma unroll
    for (int i = 0; i < 3; i++) { int id = tid + 256 * i; int row = id / 12, ch = id % 12; *(u32x4*)(sK + buf * KTILE + row * LDK + ch * 8) = rk[i]; }
#pragma unroll
    for (int i = 0; i < 2; i++) { int id = tid + 256 * i; int row = id >> 3, ch = id & 7; *(u32x4*)(sV + buf * VTILE + row * LDV + ch * 8) = rv[i]; }
  };
  auto compute = [&](int buf) {
    const u16* cK = sK + buf * KTILE + r * LDK + h * 8;
    const u16* cV = sV + buf * VTILE + r * LDV + 8 * h;
    f32x16 s[2][2];
#pragma unroll
    for (int sub = 0; sub < 2; sub++)
#pragma unroll
      for (int qh = 0; qh < 2; qh++)
#pragma unroll
        for (int i = 0; i < 16; i++) s[sub][qh][i] = -mrun[qh];
#pragma unroll
    for (int sub = 0; sub < 2; sub++)
#pragma unroll
      for (int ks = 0; ks < KS; ks++) {
        bf16x8 a = *(const bf16x8*)(cK + sub * 32 * LDK + ks * 16);
        s[sub][0] = MFMA(a, qf[0][ks], s[sub][0]);
        s[sub][1] = MFMA(a, qf[1][ks], s[sub][1]);
      }
#pragma unroll
    for (int qh = 0; qh < 2; qh++) {
      float mx = -1e30f;
#pragma unroll
      for (int sub = 0; sub < 2; sub++)
#pragma unroll
        for (int i = 0; i < 16; i++) mx = fmaxf(mx, s[sub][qh][i]);
      mx = xhalf_max(mx);
      if (__any(mx > 8.f)) {
        const float d = fmaxf(mx, 0.f);
        const float alpha = __builtin_amdgcn_exp2f(-d);
        mrun[qh] += d;
        lrun[qh] *= alpha;
#pragma unroll
        for (int et = 0; et < 2; et++)
#pragma unroll
          for (int i = 0; i < 16; i++) o[qh][et][i] *= alpha;
#pragma unroll
        for (int sub = 0; sub < 2; sub++)
#pragma unroll
          for (int i = 0; i < 16; i++) s[sub][qh][i] -= d;
      }
      float psum = 0.f;
#pragma unroll
      for (int sub = 0; sub < 2; sub++)
#pragma unroll
        for (int i = 0; i < 16; i++) { float pv = __builtin_amdgcn_exp2f(s[sub][qh][i]); s[sub][qh][i] = pv; psum += pv; }
      lrun[qh] += psum;
    }
#pragma unroll
    for (int sub = 0; sub < 2; sub++)
#pragma unroll
      for (int st = 0; st < 2; st++) {
        bf16x8 pb[2];
#pragma unroll
        for (int qh = 0; qh < 2; qh++) {
          uint4 pp;
          pp.x = pk2(s[sub][qh][8 * st + 0], s[sub][qh][8 * st + 1]); pp.y = pk2(s[sub][qh][8 * st + 2], s[sub][qh][8 * st + 3]);
          pp.z = pk2(s[sub][qh][8 * st + 4], s[sub][qh][8 * st + 5]); pp.w = pk2(s[sub][qh][8 * st + 6], s[sub][qh][8 * st + 7]);
          pb[qh] = __builtin_bit_cast(bf16x8, pp);
        }
#pragma unroll
        for (int et = 0; et < 2; et++) {
          bf16x8 a = *(const bf16x8*)(cV + et * 32 * LDV + sub * 32 + st * 16);
          o[0][et] = MFMA(a, pb[0], o[0][et]);
          o[1][et] = MFMA(a, pb[1], o[1][et]);
        }
      }
  };
  __syncthreads();
  gload(0);
  sstore(0);
  __syncthreads();
  for (int t = 0; t < ntb; t++) {
    const bool more = (t + 1 < ntb);
    if (more) gload(t + 1);
    __builtin_amdgcn_sched_barrier(0);
    if (t < ntw) { __builtin_amdgcn_s_setprio(1); compute(t & 1); __builtin_amdgcn_s_setprio(0); }
    if (more) sstore((t + 1) & 1);
    __syncthreads();
  }
#pragma unroll
  for (int qh = 0; qh < 2; qh++) {
    const float inv = __builtin_amdgcn_rcpf(xhalf_sum(lrun[qh]));
    u16* Orow = Obase + (long)(qh * 32 + r) * LDA;
#pragma unroll
    for (int et = 0; et < 2; et++)
#pragma unroll
      for (int g = 0; g < 4; g++) {
        uint2 v;
        v.x = pk2(o[qh][et][4 * g + 0] * inv, o[qh][et][4 * g + 1] * inv);
        v.y = pk2(o[qh][et][4 * g + 2] * inv, o[qh][et][4 * g + 3] * inv);
        *(uint2*)(Orow + et * 32 + 8 * g + 4 * h) = v;
      }
  }
}

DI void norm_row_wave(const float* src, u16* dst, int lane) {
  float4 v[4]; float ss = 0.f;
#pragma unroll
  for (int i = 0; i < 4; i++) { v[i] = *(const float4*)(src + i * 256 + lane * 4); ss += v[i].x * v[i].x + v[i].y * v[i].y + v[i].z * v[i].z + v[i].w * v[i].w; }
  ss = wave_sum(ss);
  float rr = rsqrtf(ss * (1.f / 1024.f) + EPS);
#pragma unroll
  for (int i = 0; i < 4; i++) {
    uint2 o; o.x = pk2(v[i].x * rr, v[i].y * rr); o.y = pk2(v[i].z * rr, v[i].w * rr);
    *(uint2*)(dst + i * 256 + lane * 4) = o;
  }
}

DI void phase_norm(const Params& p, int l) {
  const int lane = tidx() & 63, w = tidx() >> 6;
  u16* act = actp(p);
  if (l == 0) {
    for (int t = blockIdx.x * 4 + w; t < NTOK; t += gridDim.x * 4) norm_row_wave(xrow(p, 0, t), act + (size_t)t * LDA, lane);
  } else {
    const u16* xr = xres(p);
    for (int t = blockIdx.x * 4 + w; t < NTOK; t += gridDim.x * 4) {
      const u16* src = xr + (size_t)t * LDA + lane * 16;
      float x[16];
      { float a[8], b[8]; unpack8(*(const uint4*)src, a); unpack8(*(const uint4*)(src + 8), b);
#pragma unroll
        for (int j = 0; j < 8; j++) { x[j] = a[j]; x[8 + j] = b[j]; } }
      float ss = 0.f;
#pragma unroll
      for (int j = 0; j < 16; j++) ss += x[j] * x[j];
      ss = wave_sum(ss);
      const float rr = rsqrtf(ss * (1.f / 1024.f) + EPS);
      float y0[8], y1[8];
#pragma unroll
      for (int j = 0; j < 8; j++) { y0[j] = x[j] * rr; y1[j] = x[8 + j] * rr; }
      u16* dst = act + (size_t)t * LDA + lane * 16;
      *(uint4*)dst = pack8(y0); *(uint4*)(dst + 8) = pack8(y1);
    }
  }
}

DI void wtile(const float* src, const float* gain, int K, int N, u16* dst, int ldd, int k0, int n0, char* smem) {
  u16* T = (u16*)smem;
  const int tid = tidx();
  __syncthreads();
  {
    const int nn = tid & 63, kk0 = tid >> 6;
    const int n = n0 + nn;
#pragma unroll 4
    for (int i = 0; i < 16; i++) {
      int kk = kk0 + 4 * i;
      float v = 0.f;
      if (n < N) { v = src[(size_t)(k0 + kk) * N + n]; if (gain) v *= gain[k0 + kk]; }
      T[nn * 72 + kk] = f2bf(v);
    }
  }
  __syncthreads();
  {
    const int nn = tid >> 2, kq = tid & 3;
    const uint4* s = (const uint4*)(T + nn * 72 + kq * 16);
    uint4* d = (uint4*)(dst + (size_t)(n0 + nn) * ldd + k0 + kq * 16);
    d[0] = s[0]; d[1] = s[1];
  }
}

DI void phase_prep(const Params& p, char* smem) {
  const int tid = tidx(), lane = tid & 63, w = tid >> 6;
  for (int t = blockIdx.x; t < 2 * 4048; t += gridDim.x) {
    int l = t / 4048, u = t % 4048;
    const float* src; const float* gain = nullptr; int K, N, Npad; size_t doff; int ldd = LDW;
    if (u < 640) { src = p.w_in + (size_t)l * 1024 * INC; gain = p.g_mix + l * 1024; K = 1024; N = INC; Npad = 2560; doff = W_IN; }
    else if (u < 688) { u -= 640; src = p.w_q_up + (size_t)l * 256 * 768; gain = p.g_qa + l * 256; K = 256; N = 768; Npad = 768; doff = W_Q; ldd = LDWQ; }
    else if (u < 720) { u -= 688; src = p.w_kv_up + (size_t)l * 128 * 1024; K = 128; N = 1024; Npad = 1024; doff = W_KV; ldd = LDWKV; }
    else if (u < 976) { u -= 720; src = p.w_out + (size_t)l * 1048576; K = 1024; N = 1024; Npad = 1024; doff = W_OUT; }
    else if (u < 1232) { u -= 976; src = p.w_xq + (size_t)l * 1048576; gain = p.g_xattn + l * 1024; K = 1024; N = 1024; Npad = 1024; doff = W_XQ; }
    else if (u < 1488) { u -= 1232; src = p.w_xk + (size_t)l * 1048576; gain = p.g_mem + l * 1024; K = 1024; N = 1024; Npad = 1024; doff = W_XK; }
    else if (u < 1744) { u -= 1488; src = p.w_xv + (size_t)l * 1048576; gain = p.g_mem + l * 1024; K = 1024; N = 1024; Npad = 1024; doff = W_XV; }
    else if (u < 2000) { u -= 1744; src = p.w_xo + (size_t)l * 1048576; K = 1024; N = 1024; Npad = 1024; doff = W_XO; }
    else if (u < 3024) { u -= 2000; src = p.w_ff1 + (size_t)l * 4194304; gain = p.g_mlp + l * 1024; K = 1024; N = 4096; Npad = 4096; doff = W_FF1; }
    else { u -= 3024; src = p.w_ff2 + (size_t)l * 4194304; K = 4096; N = 1024; Npad = 1024; doff = W_FF2; ldd = LDW2; }
    int nt = Npad / 64;
    int kt = u / nt, ntile = u % nt;
    wtile(src, gain, K, N, wsb(p, WS_W) + (size_t)l * W_LAYER + doff, ldd, kt * 64, ntile * 64, smem);
  }
  float2* tab = (float2*)(p.ws + WS_ROPE);
  for (int t = blockIdx.x; t < 1024; t += gridDim.x) {
    int idx = t * 256 + tid; int pos = idx >> 4, i = idx & 15;
    float inv_freq = __builtin_amdgcn_exp2f(-(float)i * 0.830482023721841f);
    float ang = (float)pos * inv_freq;
    double rev = (double)ang * 0.15915494309189535;
    rev -= rint(rev);
    float fr = (float)rev;
    tab[idx] = make_float2(__builtin_amdgcn_cosf(fr), __builtin_amdgcn_sinf(fr));
  }
  u16* hm = wsb(p, WS_HM);
  for (int t = blockIdx.x * 4 + w; t < 512; t += gridDim.x * 4) norm_row_wave(p.mem_prompt + (size_t)t * 1024, hm + (size_t)t * LDA, lane);
  phase_norm(p, 0);
}

template <class Epi>
DI void phase_gemm128(const Sched& sc, const u16* A, long lda, const u16* Bt, long ldb, int K, int MT, int NT, int SN, char* smem, const Epi& epi);
DI void phase_inproj(const Params& p, const Sched& sc, int l, char* smem) {
  const u16* W = wsb(p, WS_W) + (size_t)l * W_LAYER;
  {
    EpiStoreBf16 epi{wsb(p, WS_BIG + B_P), INC, INC, wsf(p, WS_GATES)};
    phase_gemm128(sc, actp(p), LDA, W + W_IN, LDW, 1024, 272, 20, 4, smem, epi);
  }
  if (l == 0) {
    for (int u = blockIdx.x; u < 128; u += gridDim.x) {
      int l2 = u >> 6, which = (u >> 5) & 1, mt = (u >> 3) & 3, nt = u & 7;
      const u16* W2 = wsb(p, WS_W) + (size_t)l2 * W_LAYER + (which ? W_XV : W_XK);
      EpiF32 epi{p.out + (which ? O_PMEMV : O_PMEMK) + (size_t)l2 * 524288, 1024};
      gemm_tile<2, 2>(wsb(p, WS_HM), LDA, W2, LDW, 1024, mt * 128, nt * 128, smem, epi);
    }
  }
}

DI void post_token(const Params& p, int l, int tok, int lane) {
  const u16* pr = wsb(p, WS_BIG + B_P) + (size_t)tok * INC;
  {
    uint2 q4 = *(const uint2*)(pr + lane * 4);
    float a = bflo(q4.x), b = bfhi(q4.x), c = bflo(q4.y), d = bfhi(q4.y);
    float ss = wave_sum(a * a + b * b + c * c + d * d);
    if (lane == 0) wsf(p, WS_RQ)[tok] = rsqrtf(ss * (1.f / 256.f) + EPS);
  }
  const bool prompt = tok < NP;
  int b, s, row, pos; float* ckv_out; float* kr_out;
  if (prompt) {
    b = tok >> 14; s = tok & 16383; row = tok; pos = s;
    ckv_out = p.out + O_PCKV + ((size_t)(l * 2 + b) * 16384 + s) * 128;
    kr_out = p.out + O_PKROPE + ((size_t)(l * 2 + b) * 16384 + s) * 32;
  } else {
    int t2 = tok - NP; b = t2 >> 6; s = t2 & 63; row = NP + b * 1088 + 1024 + s; pos = 1024 + s;
    ckv_out = p.out + O_SCKV + ((size_t)(l * 32 + b) * 64 + s) * 128;
    kr_out = p.out + O_SKROPE + ((size_t)(l * 32 + b) * 64 + s) * 32;
  }
  {
    unsigned c2 = *(const unsigned*)(pr + 256 + lane * 2);
    float c0 = bflo(c2), c1 = bfhi(c2);
    float ss = wave_sum(c0 * c0 + c1 * c1);
    float rr = rsqrtf(ss * (1.f / 128.f) + EPS);
    float o0 = c0 * rr * p.g_kva[l * 128 + lane * 2], o1 = c1 * rr * p.g_kva[l * 128 + lane * 2 + 1];
    *(float2*)(ckv_out + lane * 2) = make_float2(o0, o1);
    *(unsigned*)(wsb(p, WS_CKV) + (size_t)row * 128 + lane * 2) = pk2(o0, o1);
  }
  if (lane < 16) {
    float x1 = bf2f(pr[384 + lane]), x2 = bf2f(pr[400 + lane]);
    float2 cs = ((const float2*)(p.ws + WS_ROPE))[(size_t)pos * 16 + lane];
    float o1 = x1 * cs.x - x2 * cs.y, o2 = x1 * cs.y + x2 * cs.x;
    kr_out[lane] = o1; kr_out[16 + lane] = o2;
    float* ka = wsf(p, WS_KROPE) + (size_t)row * 32;
    ka[lane] = o1; ka[16 + lane] = o2;
  }
  const int S = prompt ? 16384 : 64;
  if (s >= S - 3) {
    int j = s - (S - 3);
    float* dst = prompt ? p.out + O_PCONV + ((size_t)(l * 2 + b) * 3 + j) * 1024 : p.out + O_SCONV + ((size_t)(l * 32 + b) * 3 + j) * 1024;
#pragma unroll 4
    for (int i = 0; i < 16; i++) dst[lane + 64 * i] = bf2f(pr[416 + lane + 64 * i]);
  }
}

DI void post_past(const Params& p, int l, int pi, int lane) {
  int b = pi >> 10, t = pi & 1023;
  size_t row = (size_t)NP + b * 1088 + t;
  const float* src = p.cache_ckv + ((size_t)(l * 32 + b) * 1024 + t) * 128;
  float2 v = *(const float2*)(src + lane * 2);
  *(unsigned*)(wsb(p, WS_CKV) + row * 128 + lane * 2) = pk2(v.x, v.y);
  if (lane < 32) wsf(p, WS_KROPE)[row * 32 + lane] = p.cache_krope[((size_t)(l * 32 + b) * 1024 + t) * 32 + lane];
}

struct ChunkInfo { int tok0, b, h, chain, has_prev, sample; };
DI ChunkInfo chunk_info(int item) {
  ChunkInfo ci;
  if (item < 2048) {
    ci.chain = item >> 8; ci.b = ci.chain >> 2; ci.h = ci.chain & 3; int c = item & 255;
    ci.tok0 = ci.b * 16384 + c * 64; ci.has_prev = (c > 0); ci.sample = 0;
  } else {
    int j = item - 2048; ci.chain = 8 + j; ci.b = j >> 2; ci.h = j & 3; ci.tok0 = NP + ci.b * 64; ci.has_prev = 0; ci.sample = 1;
  }
  return ci;
}
DI void load_x8(const Params& p, int l, const ChunkInfo& ci, int tp, int col, float (&x)[8]) {
  if (tp >= 0 || ci.has_prev) {
    uint4 v = *(const uint4*)(wsb(p, WS_BIG + B_P) + (size_t)(ci.tok0 + tp) * INC + col);
    unpack8(v, x);
  } else if (ci.sample) {
    const float* s = p.st_conv + (((size_t)l * 32 + ci.b) * 3 + (3 + tp)) * 1024 + (col - 416);
    float4 a = *(const float4*)s, b = *(const float4*)(s + 4);
    x[0] = a.x; x[1] = a.y; x[2] = a.z; x[3] = a.w; x[4] = b.x; x[5] = b.y; x[6] = b.z; x[7] = b.w;
  } else {
#pragma unroll
    for (int j = 0; j < 8; j++) x[j] = 0.f;
  }
}
template <class Emit>
DI void conv_run(const Params& p, int l, const ChunkInfo& ci, int mat, int chunk, int row0, int nrows, Emit emit) {
  const int ch0 = mat * 512 + ci.h * 128 + chunk * 8;
  const int col = 416 + ch0;
  float w0[8], w1[8], w2[8], w3[8], bias[8];
  {
    const float* wc = p.w_conv + (size_t)l * 4096 + ch0;
    float4 a, b;
    a = *(const float4*)(wc); b = *(const float4*)(wc + 4);
    w0[0] = a.x; w0[1] = a.y; w0[2] = a.z; w0[3] = a.w; w0[4] = b.x; w0[5] = b.y; w0[6] = b.z; w0[7] = b.w;
    a = *(const float4*)(wc + 1024); b = *(const float4*)(wc + 1028);
    w1[0] = a.x; w1[1] = a.y; w1[2] = a.z; w1[3] = a.w; w1[4] = b.x; w1[5] = b.y; w1[6] = b.z; w1[7] = b.w;
    a = *(const float4*)(wc + 2048); b = *(const float4*)(wc + 2052);
    w2[0] = a.x; w2[1] = a.y; w2[2] = a.z; w2[3] = a.w; w2[4] = b.x; w2[5] = b.y; w2[6] = b.z; w2[7] = b.w;
    a = *(const float4*)(wc + 3072); b = *(const float4*)(wc + 3076);
    w3[0] = a.x; w3[1] = a.y; w3[2] = a.z; w3[3] = a.w; w3[4] = b.x; w3[5] = b.y; w3[6] = b.z; w3[7] = b.w;
    const float* bc = p.b_conv + (size_t)l * 1024 + ch0;
    a = *(const float4*)(bc); b = *(const float4*)(bc + 4);
    bias[0] = a.x; bias[1] = a.y; bias[2] = a.z; bias[3] = a.w; bias[4] = b.x; bias[5] = b.y; bias[6] = b.z; bias[7] = b.w;
  }
  float xa[8], xb[8], xc[8], xd[8];
  load_x8(p, l, ci, row0 - 3, col, xa);
  load_x8(p, l, ci, row0 - 2, col, xb);
  load_x8(p, l, ci, row0 - 1, col, xc);
  for (int t = row0; t < row0 + nrows; t++) {
    load_x8(p, l, ci, t, col, xd);
    float y[8];
#pragma unroll
    for (int j = 0; j < 8; j++) {
      float v = bias[j] + xa[j] * w0[j] + xb[j] * w1[j] + xc[j] * w2[j] + xd[j] * w3[j];
      y[j] = v * __builtin_amdgcn_rcpf(1.f + __expf(-v));
      xa[j] = xb[j]; xb[j] = xc[j]; xc[j] = xd[j];
    }
    emit(t, y);
  }
}
DI float logsigmoid(float z) { return fminf(z, 0.f) - log1pf(__expf(-fabsf(z))); }

DI void mlstm_m1(const Params& p, int l, int item, char* smem) {
  const ChunkInfo ci = chunk_info(item);
  const int tid = tidx(), lane = tid & 63, w = tid >> 6, r = lane & 31, h = lane >> 5;
  u16* sVt = (u16*)smem;
  u16* sKt = sVt + 128 * 72;
  float* swk = (float*)(sKt + 128 * 72);
  __syncthreads();
  if (w == 0) {
    const float* g = wsf(p, WS_GATES) + (size_t)(ci.tok0 + lane) * 8;
    float ig = g[ci.h] + p.b_igate[l * 4 + ci.h];
    float lf = logsigmoid(g[4 + ci.h] + p.b_fgate[l * 4 + ci.h]);
    float bcs = lf;
#pragma unroll
    for (int o = 1; o < 64; o <<= 1) { float t = __shfl_up(bcs, o); if (lane >= o) bcs += t; }
    float u = ig - bcs;
    float umax = wave_max(u);
    swk[lane] = __expf(u - umax);
    float blast = __shfl(bcs, 63);
    if (lane == 0) { float* sc = wsf(p, WS_SCAL) + (size_t)item * 2; sc[0] = blast; sc[1] = blast + umax; }
  }
#pragma unroll
  for (int it = 0; it < 4; it++) {
    int id = tid + 256 * it; int s = id >> 4, ch = id & 15;
    uint4 v = *(const uint4*)(wsb(p, WS_BIG + B_P) + (size_t)(ci.tok0 + s) * INC + 1440 + ci.h * 128 + ch * 8);
    const u16* vv = (const u16*)&v;
    unsigned a[4] = {v.x, v.y, v.z, v.w};
#pragma unroll
    for (int j = 0; j < 4; j++) { sVt[(ch * 8 + 2 * j) * 72 + s] = (u16)(a[j] & 0xffffu); sVt[(ch * 8 + 2 * j + 1) * 72 + s] = (u16)(a[j] >> 16); }
    (void)vv;
  }
  __syncthreads();
  {
    const int chunk = tid & 15, rg = tid >> 4;
    conv_run(p, l, ci, 1, chunk, rg * 4, 4, [&](int t, const float (&y)[8]) {
      float sc = 0.08838834764831845f * swk[t];
#pragma unroll
      for (int j = 0; j < 8; j++) sKt[(chunk * 8 + j) * 72 + t] = f2bf(y[j] * sc);
    });
  }
  __syncthreads();
  const int wm = w >> 1, wn = w & 1;
  f32x16 acc[2][2];
#pragma unroll
  for (int a = 0; a < 2; a++)
#pragma unroll
    for (int b = 0; b < 2; b++)
#pragma unroll
      for (int i = 0; i < 16; i++) acc[a][b][i] = 0.f;
#pragma unroll
  for (int ks = 0; ks < 4; ks++) {
    bf16x8 af[2], bfr[2];
#pragma unroll
    for (int tm = 0; tm < 2; tm++) af[tm] = *(const bf16x8*)(sVt + (wm * 64 + tm * 32 + r) * 72 + ks * 16 + h * 8);
#pragma unroll
    for (int tn = 0; tn < 2; tn++) bfr[tn] = *(const bf16x8*)(sKt + (wn * 64 + tn * 32 + r) * 72 + ks * 16 + h * 8);
#pragma unroll
    for (int tm = 0; tm < 2; tm++)
#pragma unroll
      for (int tn = 0; tn < 2; tn++) acc[tm][tn] = MFMA(bfr[tn], af[tm], acc[tm][tn]);
  }
  u16* slot = wsb(p, WS_BIG + B_ST) + (size_t)item * 16384;
#pragma unroll
  for (int tm = 0; tm < 2; tm++)
#pragma unroll
    for (int tn = 0; tn < 2; tn++)
#pragma unroll
      for (int g = 0; g < 4; g++) {
        uint2 v;
        v.x = pk2(acc[tm][tn][4 * g + 0], acc[tm][tn][4 * g + 1]);
        v.y = pk2(acc[tm][tn][4 * g + 2], acc[tm][tn][4 * g + 3]);
        *(uint2*)(slot + (wm * 64 + tm * 32 + r) * 128 + wn * 64 + tn * 32 + 8 * g + 4 * h) = v;
      }
  if (tid < 128) {
    float sum = 0.f;
    const u16* kr = sKt + tid * 72;
#pragma unroll 8
    for (int s = 0; s < 64; s++) sum += bf2f(kr[s]);
    wsf(p, WS_NU)[(size_t)item * 128 + tid] = sum;
  }
}

DI void mlstm_m2(const Params& p, int l, int unit, char* smem) {
  const int tid = tidx();
  int chain, g, nc, item0, b, h; bool sample;
  if (unit < 256) { chain = unit >> 5; g = unit & 31; nc = 256; item0 = chain * 256; b = chain >> 2; h = chain & 3; sample = false; }
  else { int u = unit - 256; int j = u >> 5; g = u & 31; chain = 8 + j; nc = 1; item0 = 2048 + j; b = j >> 2; h = j & 3; sample = true; }
  const int el = g * 512 + tid * 2; const int e = el >> 7, d = el & 127;
  float c0 = 0.f, c1 = 0.f, nst = 0.f, m0 = 0.f;
  const bool do_n = (g == 0 && tid < 128);
  if (sample) {
    const float* C0 = p.st_C + ((size_t)(l * 32 + b) * 4 + h) * 16384;
    c0 = C0[d * 128 + e]; c1 = C0[(d + 1) * 128 + e];
    if (do_n) nst = p.st_n[((size_t)(l * 32 + b) * 4 + h) * 128 + tid];
    m0 = p.st_m[(l * 32 + b) * 4 + h];
  }
  u16* slots = wsb(p, WS_BIG + B_ST);
  const float* scal = wsf(p, WS_SCAL);
  float* nu = wsf(p, WS_NU);
  float* mst = wsf(p, WS_MST);
  float* sA = (float*)smem; float* sC = sA + 256; float* sdec = sC + 256; float* sus = sdec + 256; float* smst = sus + 256;
  __syncthreads();
  if (tid < nc) { sA[tid] = scal[(size_t)(item0 + tid) * 2]; sC[tid] = scal[(size_t)(item0 + tid) * 2 + 1]; }
  __syncthreads();
  if (tid == 0) {
    float m = m0;
    for (int c = 0; c < nc; c++) {
      const float A = sA[c], Cm = sC[c];
      const float mnew = fmaxf(A + m, Cm);
      sdec[c] = __expf(A + m - mnew); sus[c] = __expf(Cm - mnew); smst[c] = m;
      m = mnew;
    }
    smst[256] = m;
  }
  __syncthreads();
  unsigned uu[8], un[8]; float nn[8], nx[8];
#pragma unroll
  for (int j = 0; j < 8; j++) {
    uu[j] = 0; nn[j] = 0.f;
    if (j < nc) {
      uu[j] = *(const unsigned*)(slots + (size_t)(item0 + j) * 16384 + el);
      if (do_n) nn[j] = nu[(size_t)(item0 + j) * 128 + tid];
    }
  }
  for (int cb = 0; cb < nc; cb += 8) {
#pragma unroll
    for (int j = 0; j < 8; j++) {
      un[j] = 0; nx[j] = 0.f;
      if (cb + 8 + j < nc) {
        un[j] = *(const unsigned*)(slots + (size_t)(item0 + cb + 8 + j) * 16384 + el);
        if (do_n) nx[j] = nu[(size_t)(item0 + cb + 8 + j) * 128 + tid];
      }
    }
#pragma unroll
    for (int j = 0; j < 8; j++) {
      if (cb + j < nc) {
        const int item = item0 + cb + j;
        const float dec = sdec[cb + j], us = sus[cb + j];
        *(unsigned*)(slots + (size_t)item * 16384 + el) = pk2(c0, c1);
        c0 = dec * c0 + us * bflo(uu[j]);
        c1 = dec * c1 + us * bfhi(uu[j]);
        if (do_n) { nu[(size_t)item * 128 + tid] = nst; nst = dec * nst + us * nn[j]; }
        if (g == 0 && tid == 0) mst[item] = smst[cb + j];
      }
    }
#pragma unroll
    for (int j = 0; j < 8; j++) { uu[j] = un[j]; nn[j] = nx[j]; }
  }
  float* oC = sample ? p.out + O_SC + ((size_t)(l * 32 + b) * 4 + h) * 16384 : p.out + O_PC + ((size_t)(l * 2 + b) * 4 + h) * 16384;
  oC[d * 128 + e] = c0; oC[(d + 1) * 128 + e] = c1;
  if (do_n) { float* on = sample ? p.out + O_SN + ((size_t)(l * 32 + b) * 4 + h) * 128 : p.out + O_PN + ((size_t)(l * 2 + b) * 4 + h) * 128; on[tid] = nst; }
  if (g == 0 && tid == 0) { float* om = sample ? p.out + O_SM + (l * 32 + b) * 4 + h : p.out + O_PM + (l * 2 + b) * 4 + h; *om = smst[256]; }
}

DI void mlstm_m3(const Params& p, int l, int item, char* smem) {
  const ChunkInfo ci = chunk_info(item);
  const int tid = tidx(), lane = tid & 63, w = tid >> 6, r = lane & 31, h = lane >> 5;
  u16* sQ = (u16*)smem;
  u16* sK = sQ + 64 * 136;
  u16* sVt = sK + 64 * 136;
  u16* sP = sVt + 128 * 72;
  float* su = (float*)(sP + 64 * 72);
  float* sM = su + 64;
  float* sa = sM + 64;
  float* sden = sa + 64;
  float* sinv = sden + 64;
  float* sn = sinv + 64;
  float* sH = (float*)smem;
  __syncthreads();
  const float m_start = wsf(p, WS_MST)[item];
  if (w == 0) {
    const float* g = wsf(p, WS_GATES) + (size_t)(ci.tok0 + lane) * 8;
    float ig = g[ci.h] + p.b_igate[l * 4 + ci.h];
    float lf = logsigmoid(g[4 + ci.h] + p.b_fgate[l * 4 + ci.h]);
    float bcs = lf;
#pragma unroll
    for (int o = 1; o < 64; o <<= 1) { float t = __shfl_up(bcs, o); if (lane >= o) bcs += t; }
    float u = ig - bcs;
    float cm = u;
#pragma unroll
    for (int o = 1; o < 64; o <<= 1) { float t = __shfl_up(cm, o); if (lane >= o) cm = fmaxf(cm, t); }
    float Mt = fmaxf(m_start, cm);
    su[lane] = u; sM[lane] = Mt; sa[lane] = __expf(m_start - Mt); sden[lane] = __expf(-(bcs + Mt));
  } else if (w == 1) {
    sn[lane] = wsf(p, WS_NU)[(size_t)item * 128 + lane];
    sn[lane + 64] = wsf(p, WS_NU)[(size_t)item * 128 + lane + 64];
  }
#pragma unroll
  for (int it = 0; it < 4; it++) {
    int id = tid + 256 * it; int s = id >> 4, ch = id & 15;
    uint4 v = *(const uint4*)(wsb(p, WS_BIG + B_P) + (size_t)(ci.tok0 + s) * INC + 1440 + ci.h * 128 + ch * 8);
    unsigned a[4] = {v.x, v.y, v.z, v.w};
#pragma unroll
    for (int j = 0; j < 4; j++) { sVt[(ch * 8 + 2 * j) * 72 + s] = (u16)(a[j] & 0xffffu); sVt[(ch * 8 + 2 * j + 1) * 72 + s] = (u16)(a[j] >> 16); }
  }
  {
    const int mc = tid & 31, mat = mc >> 4, chunk = mc & 15, rg = tid >> 5;
    u16* dst = mat ? sK : sQ;
    const float sc = mat ? 0.08838834764831845f : 1.f;
    conv_run(p, l, ci, mat, chunk, rg * 8, 8, [&](int t, const float (&y)[8]) {
      float x[8];
#pragma unroll
      for (int j = 0; j < 8; j++) x[j] = y[j] * sc;
      *(uint4*)(dst + t * 136 + chunk * 8) = pack8(x);
    });
  }
  __syncthreads();
  {
    const int tq = w >> 1, ts = w & 1;
    f32x16 s;
#pragma unroll
    for (int i = 0; i < 16; i++) s[i] = 0.f;
#pragma unroll
    for (int ks = 0; ks < 8; ks++) {
      bf16x8 a = *(const bf16x8*)(sQ + (tq * 32 + r) * 136 + ks * 16 + h * 8);
      bf16x8 b = *(const bf16x8*)(sK + (ts * 32 + r) * 136 + ks * 16 + h * 8);
      s = MFMA(a, b, s);
    }
    const int sidx = ts * 32 + r;
    const float us = su[sidx];
#pragma unroll
    for (int i = 0; i < 16; i++) {
      int t = tq * 32 + crow(i, h);
      float v = (sidx <= t) ? s[i] * __expf(us - sM[t]) : 0.f;
      sP[t * 72 + sidx] = f2bf(v);
    }
  }
  __syncthreads();
  if (tid < 64) {
    float rs = 0.f, qd = 0.f;
    const u16* pr = sP + tid * 72;
#pragma unroll 8
    for (int s = 0; s < 64; s++) rs += bf2f(pr[s]);
    const u16* qr = sQ + tid * 136;
#pragma unroll 8
    for (int d = 0; d < 128; d++) qd += bf2f(qr[d]) * sn[d];
    float qn = sa[tid] * qd + rs;
    sinv[tid] = __builtin_amdgcn_rcpf(fmaxf(fabsf(qn), sden[tid]));
  }
  const int tq = w & 1, eb = (w >> 1) * 2;
  f32x16 a1[2], a2[2];
#pragma unroll
  for (int et = 0; et < 2; et++)
#pragma unroll
    for (int i = 0; i < 16; i++) { a1[et][i] = 0.f; a2[et][i] = 0.f; }
  const u16* slot = wsb(p, WS_BIG + B_ST) + (size_t)item * 16384;
#pragma unroll
  for (int ks = 0; ks < 8; ks++) {
    bf16x8 a = *(const bf16x8*)(sQ + (tq * 32 + r) * 136 + ks * 16 + h * 8);
#pragma unroll
    for (int et = 0; et < 2; et++) {
      bf16x8 b = *(const bf16x8*)(slot + ((eb + et) * 32 + r) * 128 + ks * 16 + h * 8);
      a1[et] = MFMA(a, b, a1[et]);
    }
  }
#pragma unroll
  for (int ks = 0; ks < 4; ks++) {
    bf16x8 a = *(const bf16x8*)(sP + (tq * 32 + r) * 72 + ks * 16 + h * 8);
#pragma unroll
    for (int et = 0; et < 2; et++) {
      bf16x8 b = *(const bf16x8*)(sVt + ((eb + et) * 32 + r) * 72 + ks * 16 + h * 8);
      a2[et] = MFMA(a, b, a2[et]);
    }
  }
  __syncthreads();
#pragma unroll
  for (int et = 0; et < 2; et++)
#pragma unroll
    for (int i = 0; i < 16; i++) {
      int t = tq * 32 + crow(i, h);
      sH[t * 132 + (eb + et) * 32 + r] = (sa[t] * a1[et][i] + a2[et][i]) * sinv[t];
    }
  __syncthreads();
  {
    const int t = tid >> 2, part = tid & 3;
    const float* hr = sH + t * 132 + part * 32;
    float ss = 0.f;
#pragma unroll 8
    for (int j = 0; j < 32; j++) ss += hr[j] * hr[j];
    ss += __shfl_xor(ss, 1); ss += __shfl_xor(ss, 2);
    const float rr = rsqrtf(ss * (1.f / 128.f) + EPS);
    const int tok = ci.tok0 + t;
    const u16* og = wsb(p, WS_BIG + B_P) + (size_t)tok * INC + 1960 + ci.h * 128 + part * 32;
    const float* gm = p.g_mhead + (size_t)l * 512 + ci.h * 128 + part * 32;
    u16* o = actp(p) + (size_t)tok * LDA + 512 + ci.h * 128 + part * 32;
#pragma unroll
    for (int c8 = 0; c8 < 4; c8++) {
      float gv[8], x[8];
      unpack8(*(const uint4*)(og + c8 * 8), gv);
#pragma unroll
      for (int j = 0; j < 8; j++) x[j] = hr[c8 * 8 + j] * rr * gm[c8 * 8 + j] * __builtin_amdgcn_rcpf(1.f + __expf(-gv[j]));
      *(uint4*)(o + c8 * 8) = pack8(x);
    }
  }
}

DI void xkv_item(const Params& p, int l, int item, char* smem) {
  const int tid = tidx();
  const int kg = item & 3, hh = (item >> 2) & 3, bidx = item >> 4;
  u16* T = (u16*)smem;
  __syncthreads();
  const int key = tid >> 2, qt = tid & 3;
  const int mem = kg * 64 + key;
  const bool prompt = bidx < 2;
  float* kp; const float* vp;
  if (prompt) {
    kp = p.out + O_PMEMK + (((size_t)(l * 2 + bidx) * 256 + mem) * 4 + hh) * 256 + qt * 64;
    vp = p.out + O_PMEMV + (((size_t)(l * 2 + bidx) * 256 + mem) * 4 + hh) * 256 + qt * 64;
  } else {
    kp = (float*)(p.cache_mem_k + (((size_t)(l * 32 + bidx - 2) * 256 + mem) * 4 + hh) * 256 + qt * 64);
    vp = p.cache_mem_v + (((size_t)(l * 32 + bidx - 2) * 256 + mem) * 4 + hh) * 256 + qt * 64;
  }
  float rr = 1.f;
  if (prompt) {
    float ss = 0.f;
#pragma unroll 4
    for (int j = 0; j < 16; j++) { float4 v = *(const float4*)(kp + j * 4); ss += v.x * v.x + v.y * v.y + v.z * v.z + v.w * v.w; }
    ss += __shfl_xor(ss, 1); ss += __shfl_xor(ss, 2);
    rr = rsqrtf(ss * (1.f / 256.f) + EPS);
  }
  const float* gk = p.g_xk + l * 256 + qt * 64;
  const float* gq = p.g_xq + l * 256 + qt * 64;
  u16* xk = wsb(p, WS_BIG + B_XK) + ((size_t)(bidx * 4 + hh) * 256 + mem) * 256 + qt * 64;
#pragma unroll 2
  for (int c8 = 0; c8 < 8; c8++) {
    float4 a = *(const float4*)(kp + c8 * 8), b = *(const float4*)(kp + c8 * 8 + 4);
    float x[8] = {a.x, a.y, a.z, a.w, b.x, b.y, b.z, b.w};
    if (prompt) {
#pragma unroll
      for (int j = 0; j < 8; j++) x[j] = x[j] * rr * gk[c8 * 8 + j];
      *(float4*)(kp + c8 * 8) = make_float4(x[0], x[1], x[2], x[3]);
      *(float4*)(kp + c8 * 8 + 4) = make_float4(x[4], x[5], x[6], x[7]);
    }
#pragma unroll
    for (int j = 0; j < 8; j++) x[j] = x[j] * gq[c8 * 8 + j] * (0.0625f * LOG2E);
    *(uint4*)(xk + c8 * 8) = pack8(x);
    float4 va = *(const float4*)(vp + c8 * 8), vb = *(const float4*)(vp + c8 * 8 + 4);
    float y[8] = {va.x, va.y, va.z, va.w, vb.x, vb.y, vb.z, vb.w};
    *(uint4*)(T + key * 264 + qt * 64 + c8 * 8) = pack8(y);
  }
  __syncthreads();
  {
    const int e = tid;
    u16* xv = wsb(p, WS_BIG + B_XVT) + ((size_t)(bidx * 4 + hh) * 256 + e) * LDXV + kg * 64;
#pragma unroll 2
    for (int oct = 0; oct < 8; oct++) {
      uint4 v;
      const int kb = 16 * (oct >> 1) + 4 * (oct & 1);
      v.x = (unsigned)T[(kb + 0) * 264 + e] | ((unsigned)T[(kb + 1) * 264 + e] << 16);
      v.y = (unsigned)T[(kb + 2) * 264 + e] | ((unsigned)T[(kb + 3) * 264 + e] << 16);
      v.z = (unsigned)T[(kb + 8) * 264 + e] | ((unsigned)T[(kb + 9) * 264 + e] << 16);
      v.w = (unsigned)T[(kb + 10) * 264 + e] | ((unsigned)T[(kb + 11) * 264 + e] << 16);
      *(uint4*)(xv + oct * 8) = v;
    }
  }
}

DI void phase_C2(const Params& p, int l, char* smem) {
  for (int t = blockIdx.x; t < 544; t += gridDim.x) xkv_item(p, l, t, smem);
}
DI void phase_C1(const Params& p, int l, char* smem) {
  const int lane = tidx() & 63, w = tidx() >> 6;
  for (int t = blockIdx.x; t < NITEM; t += gridDim.x) mlstm_m1(p, l, t, smem);
  for (int t = blockIdx.x * 4 + w; t < NTOK + 32768; t += gridDim.x * 4) {
    if (t < NTOK) post_token(p, l, t, lane); else post_past(p, l, t - NTOK, lane);
  }
}

DI void phase_D(const Params& p, int l, char* smem) {
  const int n_scan = 256 + 4096;
  const int n_q = 544 * 4;
  const u16* W = wsb(p, WS_W) + (size_t)l * W_LAYER;
  for (int t = blockIdx.x; t < n_scan + n_q; t += gridDim.x) {
    if (t < n_scan) mlstm_m2(p, l, t, smem);
    else {
      int u = t - n_scan; int mt = u >> 2, nt = u & 3;
      EpiQ epi{wsb(p, WS_BIG + B_Q), wsf(p, WS_RQ), (const float2*)(p.ws + WS_ROPE), p.g_qnorm + l * 96};
      gemm_tile<1, 3>(wsb(p, WS_BIG + B_P), INC, W + W_Q, LDWQ, 256, mt * 64, nt * 192, smem, epi);
    }
  }
}

DI void phase_E(const Params& p, int l, char* smem) {
  for (int t = blockIdx.x; t < NITEM; t += gridDim.x) mlstm_m3(p, l, t, smem);
}

DI void phase_F(const Params& p, int l, char* smem) {
  const u16* W = wsb(p, WS_W) + (size_t)l * W_LAYER;
  for (int t = blockIdx.x; t < 528 * 8; t += gridDim.x) {
    int mt = t >> 3, nt = t & 7;
    EpiKV epi{wsb(p, WS_BIG + B_K), wsb(p, WS_BIG + B_VT), wsf(p, WS_KROPE), p.g_knorm + l * 96};
    gemm_tile<2, 2>(wsb(p, WS_CKV), 128, W + W_KV, LDWKV, 128, mt * 128, nt * 128, smem, epi);
  }
}

DI void phase_G(const Params& p, const Sched& sc, char* smem) {
  const int G = gridDim.x, j = blockIdx.x;
  const int lane = tidx() & 63, w = tidx() >> 6, r = lane & 31;
  const int NIT = 2048 + 256;
  const u16* qb = wsb(p, WS_BIG + B_Q);
  const u16* Kb = wsb(p, WS_BIG + B_K);
  const u16* Vt = wsb(p, WS_BIG + B_VT);
  u16* act = actp(p);
  auto run_prompt = [&](int bh, int bi) {
    int b = bh >> 3, hd = bh & 7;
    int tok = b * 16384 + bi * 128 + w * 32 + r;
    flash_item<96, 2, 64, true, false, true, true>(qb + (size_t)tok * 768 + hd * 96, true, 2 * bi + 2, 2 * bi + 1 + (w >> 1),
                                             Kb + ((size_t)hd * NROWS + b * 16384) * 96, 96, Vt + (size_t)hd * 64 * LDVT + b * 16384, LDVT, 0,
                                             act + (size_t)tok * LDA + hd * 64, smem);
  };
  auto run_sample = [&](int u) {
    int b = u >> 3, hd = u & 7;
    int tok = NP + b * 64 + (w & 1) * 32 + r;
    size_t row0 = (size_t)NP + b * 1088;
    flash_item<96, 2, 64, true, false, true, true>(qb + (size_t)tok * 768 + hd * 96, w < 2, 17, 17, Kb + ((size_t)hd * NROWS + row0) * 96, 96,
                                             Vt + (size_t)hd * 64 * LDVT + row0, LDVT, 0, act + (size_t)tok * LDA + hd * 64, smem);
  };
  if (sc.ok) {
    const int xg = sc.xg, xi = sc.xi;
    for (int pass = 0; pass < 2; pass++) {
      const int bh = xg + 8 * pass, b = bh >> 3, hd = bh & 7;
      const int bi = pass ? 63 - xi : xi;
      const int tok0 = b * 16384 + bi * 256 + w * 64;
      flash_item64(qb + (size_t)tok0 * 768 + hd * 96, 4 * bi + 4, 4 * bi + w + 1, Kb + ((size_t)hd * NROWS + b * 16384) * 96,
                   Vt + (size_t)hd * 64 * LDVT + b * 16384, act + (size_t)tok0 * LDA + hd * 64, smem);
    }
    if ((j & 1) == 0) run_sample(j >> 1);
  } else {
    for (int k = 0; k * G < NIT; k++) {
      int it = (k & 1) ? (k * G + (G - 1 - j)) : (k * G + j);
      if (it >= NIT) continue;
      if (it < 2048) run_prompt(it & 15, 127 - (it >> 4)); else run_sample(it - 2048);
    }
  }
}

DI void xattn_item(const u16* Qtile  , const u16* Kbase, const u16* Vtbase, u16* Otile, char* smem) {
  constexpr int LDQ = 264, LDV = 40;
  u16* sQ = (u16*)smem;
  u16* sK = sQ + 64 * LDQ;
  u16* sV = sK + 32 * LDQ;
  const int tid = tidx(), lane = tid & 63, w = tid >> 6, r = lane & 31, h = lane >> 5;
  const int qrow = 32 * (w & 1) + r, e0 = 128 * (w >> 1);
  u32x4 rk[4], rv[4];
  auto gload = [&](int t) {
#pragma unroll
    for (int i = 0; i < 4; i++) {
      int id = tid + 256 * i;
      rk[i] = *(const u32x4*)(Kbase + (long)(t * 32 + (id >> 5)) * 256 + (id & 31) * 8);
      rv[i] = *(const u32x4*)(Vtbase + (long)(id >> 2) * LDXV + t * 32 + (id & 3) * 8);
    }
  };
  auto sstore = [&]() {
#pragma unroll
    for (int i = 0; i < 4; i++) {
      int id = tid + 256 * i;
      *(u32x4*)(sK + (id >> 5) * LDQ + (id & 31) * 8) = rk[i];
      *(u32x4*)(sV + (id >> 2) * LDV + (id & 3) * 8) = rv[i];
    }
  };
  __syncthreads();
  gload(0);
#pragma unroll
  for (int i = 0; i < 8; i++) {
    int id = tid + 256 * i;
    *(u32x4*)(sQ + (id >> 5) * LDQ + (id & 31) * 8) = *(const u32x4*)(Qtile + (long)(id >> 5) * LDA + (id & 31) * 8);
  }
  sstore();
  __syncthreads();
  float rqs;
  {
    float ss = 0.f;
#pragma unroll
    for (int ks = 0; ks < 16; ks++) {
      bf16x8 qq = *(const bf16x8*)(sQ + qrow * LDQ + ks * 16 + h * 8);
#pragma unroll
      for (int j = 0; j < 8; j++) { float v = bf2f((u16)qq[j]); ss += v * v; }
    }
    ss = xhalf_sum(ss);
    rqs = rsqrtf(ss * (1.f / 256.f) + EPS);
  }
  const float rqinv = __builtin_amdgcn_rcpf(rqs);
  f32x16 o[4];
#pragma unroll
  for (int et = 0; et < 4; et++)
#pragma unroll
    for (int i = 0; i < 16; i++) o[et][i] = 0.f;
  float mrun = 0.f, lrun = 0.f;
  for (int t = 0; t < 8; t++) {
    if (t + 1 < 8) gload(t + 1);
    __builtin_amdgcn_sched_barrier(0);
    __builtin_amdgcn_s_setprio(1);
    {
      f32x16 s;
      const float sinit = -mrun * rqinv;
#pragma unroll
      for (int i = 0; i < 16; i++) s[i] = sinit;
#pragma unroll
      for (int ks = 0; ks < 16; ks++) {
        bf16x8 a = *(const bf16x8*)(sK + r * LDQ + ks * 16 + h * 8);
        bf16x8 b = *(const bf16x8*)(sQ + qrow * LDQ + ks * 16 + h * 8);
        s = MFMA(a, b, s);
      }
      float mx = -1e30f;
#pragma unroll
      for (int i = 0; i < 16; i++) { s[i] *= rqs; mx = fmaxf(mx, s[i]); }
      mx = xhalf_max(mx);
      if (__any(mx > 8.f)) {
        const float d = fmaxf(mx, 0.f);
        const float alpha = __builtin_amdgcn_exp2f(-d);
        mrun += d;
        lrun *= alpha;
#pragma unroll
        for (int et = 0; et < 4; et++)
#pragma unroll
          for (int i = 0; i < 16; i++) o[et][i] *= alpha;
#pragma unroll
        for (int i = 0; i < 16; i++) s[i] -= d;
      }
      float psum = 0.f;
#pragma unroll
      for (int i = 0; i < 16; i++) { float pv = __builtin_amdgcn_exp2f(s[i]); s[i] = pv; psum += pv; }
      lrun += psum;
#pragma unroll
      for (int st = 0; st < 2; st++) {
        uint4 pp;
        pp.x = pk2(s[8 * st + 0], s[8 * st + 1]); pp.y = pk2(s[8 * st + 2], s[8 * st + 3]);
        pp.z = pk2(s[8 * st + 4], s[8 * st + 5]); pp.w = pk2(s[8 * st + 6], s[8 * st + 7]);
        bf16x8 pb = __builtin_bit_cast(bf16x8, pp);
#pragma unroll
        for (int et = 0; et < 4; et++) {
          bf16x8 a = *(const bf16x8*)(sV + (e0 + et * 32 + r) * LDV + st * 16 + 8 * h);
          o[et] = MFMA(a, pb, o[et]);
        }
      }
    }
    __builtin_amdgcn_s_setprio(0);
    __builtin_amdgcn_sched_barrier(0);
    __syncthreads();
    if (t + 1 < 8) { sstore(); __syncthreads(); }
  }
  {
    float lt = xhalf_sum(lrun);
    float inv = __builtin_amdgcn_rcpf(lt);
    u16* Orow = Otile + (long)qrow * LDA + e0;
#pragma unroll
    for (int et = 0; et < 4; et++)
#pragma unroll
      for (int g = 0; g < 4; g++) {
        uint2 v;
        v.x = pk2(o[et][4 * g + 0] * inv, o[et][4 * g + 1] * inv);
        v.y = pk2(o[et][4 * g + 2] * inv, o[et][4 * g + 3] * inv);
        *(uint2*)(Orow + et * 32 + 8 * g + 4 * h) = v;
      }
  }
}

DI void phase_K(const Params& p, char* smem) {
  const int lane = tidx() & 63, w = tidx() >> 6, r = lane & 31;
  const u16* qx = wsb(p, WS_BIG + B_QX);
  u16* act = actp(p);
  for (int t = blockIdx.x; t < 2176; t += gridDim.x) {
    int bidx, hh, tok0;
    if (t < 2048) { bidx = t >> 10; hh = (t >> 8) & 3; tok0 = bidx * 16384 + (t & 255) * 64; }
    else { int u = t - 2048; bidx = 2 + (u >> 2); hh = u & 3; tok0 = NP + (u >> 2) * 64; }
    const u16* Kb = wsb(p, WS_BIG + B_XK) + (size_t)(bidx * 4 + hh) * 65536;
    const u16* Vt = wsb(p, WS_BIG + B_XVT) + (size_t)(bidx * 4 + hh) * 256 * LDXV;
    xattn_item(qx + (size_t)tok0 * LDA + hh * 256, Kb, Vt, act + (size_t)tok0 * LDA + hh * 256, smem);
  }
  (void)lane; (void)w; (void)r;
}

template <class Epi>
DI void phase_gemm128(const Sched& sc, const u16* A, long lda, const u16* Bt, long ldb, int K, int MT, int NT, int SN, char* smem, const Epi& epi) {
  if (sc.ok) {
    const int xg = sc.xg, xi = sc.xi;
    const int SM = 64 / SN;
    const int sng = NT / SN, smg = MT / SM;
    const int nst = smg * sng;
    const int left = nst & 7;
    const int nfull = (left > 0 && left <= 4) ? nst - left : nst;
    for (int st = xg; st < nfull; st += 8) {
      int sm = st / sng, sn = st % sng;
      int mt = sm * SM + xi / SN, nt = sn * SN + xi % SN;
      gemm_tile<2, 2>(A, lda, Bt, ldb, K, mt * 128, nt * 128, smem, epi);
    }
    if (nfull < nst) {
      const int q = xg * 64 + xi;
      if (q < left * 128) {
        const int tile = q >> 1, half = q & 1;
        const int st = nfull + (tile >> 6), t64 = tile & 63;
        int sm = st / sng, sn = st % sng;
        int mt = sm * SM + t64 / SN, nt = sn * SN + t64 % SN;
        gemm_tile<1, 2>(A, lda, Bt, ldb, K, mt * 128 + half * 64, nt * 128, smem, epi);
      }
    }
  } else {
    for (int t = blockIdx.x; t < MT * NT; t += gridDim.x) {
      int mt = t / NT, nt = t % NT;
      gemm_tile<2, 2>(A, lda, Bt, ldb, K, mt * 128, nt * 128, smem, epi);
    }
  }
}

#if defined(__HIP_DEVICE_COMPILE__)
typedef const __attribute__((address_space(4))) Params* KargPtr;
#define KARG_LOAD KargPtr pp4 = (KargPtr)__builtin_amdgcn_kernarg_segment_ptr(); asm volatile("" : "+s"(pp4)); const Params p = *pp4;
#else
#define KARG_LOAD const Params p{};
#endif
template <int L>
DI void run_layer(const Sched& sc, int ph_begin, int ph_end, char* smem, const XcdBarrier& xb) {
  const int base = 1 + 15 * L;
#define RUN_PHASE(S, ...)  RUN_PHASE_R(S, 1, __VA_ARGS__)
#define RUN_PHASE_R(S, R, ...)                                    \
  {                                                          \
    const int ph = base + (S);                               \
    if (ph >= ph_begin && ph < ph_end) {                     \
      for (int rep_ = 0; rep_ < (R); rep_++) {               \
        KARG_LOAD                                            \
        const u16* W = wsb(p, WS_W) + (size_t)L * W_LAYER;   \
        const float* xs0 = (L == 0) ? p.x_prompt : p.out;    \
        const float* xs1 = (L == 0) ? p.x_sample : p.out + (size_t)NP * 1024; \
        (void)W; (void)xs0; (void)xs1;                       \
        __VA_ARGS__;                                         \
        if (ph + 1 < ph_end) xcd_barrier(xb);                \
      }                                                      \
    }                                                        \
  }
  if (L > 0) RUN_PHASE(0, phase_norm(p, L))
  RUN_PHASE_R(1, REP_INPROJ, phase_inproj(p, sc, L, smem))
  RUN_PHASE_R(2, REP_C, { phase_C1(p, L, smem); phase_C2(p, L, smem); })
  RUN_PHASE(3, phase_D(p, L, smem))
  RUN_PHASE_R(4, REP_E, phase_E(p, L, smem))
  RUN_PHASE_R(5, REP_F, phase_F(p, L, smem))
  RUN_PHASE_R(6, REP_G, phase_G(p, sc, smem))
  RUN_PHASE(7, { EpiRes epi{xs0, xs1, (L == 0) ? (const u16*)nullptr : (const u16*)xres(p), xres(p), nullptr}; phase_gemm128(sc, actp(p), LDA, W + W_OUT, LDW, 1024, 272, 8, 8, smem, epi); })
  RUN_PHASE_R(8, REP_NORM, phase_norm(p, 1))
  RUN_PHASE(9, { EpiStoreBf16 epi{wsb(p, WS_BIG + B_QX), LDA, 1024, nullptr}; phase_gemm128(sc, actp(p), LDA, W + W_XQ, LDW, 1024, 272, 8, 8, smem, epi); })
  RUN_PHASE_R(10, REP_K, phase_K(p, smem))
  RUN_PHASE(11, { EpiRes epi{nullptr, nullptr, xres(p), xres(p), nullptr}; phase_gemm128(sc, actp(p), LDA, W + W_XO, LDW, 1024, 272, 8, 8, smem, epi); })
  RUN_PHASE(12, phase_norm(p, 1))
  RUN_PHASE_R(13, REP_FF1, { EpiRelu2 epi{wsb(p, WS_BIG + B_H1), LDH1}; phase_gemm128(sc, actp(p), LDA, W + W_FF1, LDW, 1024, 272, 32, 8, smem, epi); })
  RUN_PHASE(14, { EpiRes epi{nullptr, nullptr, xres(p), xres(p), (L == 1) ? p.out : (float*)nullptr}; phase_gemm128(sc, wsb(p, WS_BIG + B_H1), LDH1, W + W_FF2, LDW2, 4096, 272, 8, 8, smem, epi); })
#undef RUN_PHASE
#undef RUN_PHASE_R
}

__global__ void __launch_bounds__(256, 2) fwd_megakernel(Params p, int ph_begin, int ph_end) {
  __shared__ __attribute__((aligned(16))) char smem[SMEM_BYTES];
  cg::grid_group grid = cg::this_grid();
  __shared__ int s_rank;
  __shared__ __attribute__((aligned(16))) unsigned xb_words[4];
  if (tidx() < 4) xb_words[tidx()] = 0u;
  __syncthreads();
  const XcdBarrier xb = xcd_barrier_post((unsigned*)(p.ws + WS_BAR), (volatile LAS unsigned*)&xb_words);
  Sched sc;
  sc.xg = (int)((unsigned)__builtin_amdgcn_s_getreg((3 << 11) | 20) & 7u);
  unsigned* cnt = (unsigned*)(p.ws + WS_CNT);
  if (tidx() == 0) s_rank = (int)atomicAdd(&cnt[sc.xg], 1u);
  __syncthreads();
  sc.xi = __builtin_amdgcn_readfirstlane(s_rank);
  sc.ok = 0;
  if (ph_begin <= 0 && 0 < ph_end) {
    phase_prep(p, smem);
    if (ph_end < 0) grid.sync();
    if (1 < ph_end) xcd_barrier(xb);
  }
  {
    int ok = (gridDim.x == 512);
#pragma unroll
    for (int i = 0; i < 8; i++) ok &= (__atomic_load_n(&cnt[i], __ATOMIC_RELAXED) == 64u);
    sc.ok = ok;
  }
  run_layer<0>(sc, ph_begin, ph_end, smem, xb);
  run_layer<1>(sc, ph_begin, ph_end, smem, xb);
}

extern "C" void kernel_launch(void* const* d_in, const int* in_sizes, int n_in, void* d_out, int out_size, void* d_ws, size_t ws_size,
                              hipStream_t stream) {
  static int grid_blocks = 0;
  if (!grid_blocks) {
    int dev = 0, cus = 0, per_cu = 0;
    (void)hipGetDevice(&dev);
    (void)hipDeviceGetAttribute(&cus, hipDeviceAttributeMultiprocessorCount, dev);
    (void)hipOccupancyMaxActiveBlocksPerMultiprocessor(&per_cu, fwd_megakernel, 256, 0);
    per_cu = 2;
    grid_blocks = cus * per_cu;
  }
  Params p{};
  const float** pp = (const float**)&p;
  for (int i = 0; i < 36; i++) pp[i] = (const float*)d_in[i];
  p.out = (float*)d_out;
  p.ws = (char*)d_ws;
  int ph_begin = 0, ph_end = 31;
  (void)hipMemsetAsync((char*)d_ws + WS_CNT, 0, 256 + 16384, stream);
  void* args[] = {&p, &ph_begin, &ph_end};
  hipError_t e = hipLaunchCooperativeKernel((void*)fwd_megakernel, dim3(grid_blocks), dim3(256), args, 0, stream);
  if (e != hipSuccess) fprintf(stderr, "cooperative launch failed: %s (grid %d)\n", hipGetErrorString(e), grid_blocks);
}
```

```cpp
#include <hip/hip_runtime.h>
#include <hip/hip_cooperative_groups.h>
#include <stdint.h>
#include <stdio.h>
namespace cg = cooperative_groups;

typedef unsigned short u16;
typedef short bf16x8 __attribute__((ext_vector_type(8)));
typedef short s16x4 __attribute__((ext_vector_type(4)));
typedef float f32x16 __attribute__((ext_vector_type(16)));
typedef __bf16 bfv2 __attribute__((ext_vector_type(2)));
typedef float fv2 __attribute__((ext_vector_type(2)));
typedef unsigned u32x4 __attribute__((ext_vector_type(4)));
#define DI __device__ __forceinline__
#define MFMA(a, b, c) __builtin_amdgcn_mfma_f32_32x32x16_bf16((a), (b), (c), 0, 0, 0)

constexpr int NP = 32768;
constexpr int NS = 2048;
constexpr int NTOK = NP + NS;
constexpr int NROWS = NP + 32 * 1088;
constexpr int INC = 2472;
constexpr float EPS = 1e-6f;
constexpr float LOG2E = 1.4426950408889634f;
constexpr int NITEM = 2048 + 128;
constexpr int LDA = 1088;
constexpr int LDW = 1088;
constexpr int LDW2 = 4160;
constexpr int LDWQ = 320;
constexpr int LDWKV = 192;
constexpr int LDH1 = 4160;
constexpr int LDVT = NROWS + 64;
constexpr int LDXV = 320;

constexpr size_t O_Y = 0;
constexpr size_t O_PCKV = 35651584;
constexpr size_t O_PKROPE = O_PCKV + 8388608;
constexpr size_t O_PC = O_PKROPE + 2097152;
constexpr size_t O_PN = O_PC + 262144;
constexpr size_t O_PM = O_PN + 2048;
constexpr size_t O_PCONV = O_PM + 16;
constexpr size_t O_PMEMK = O_PCONV + 12288;
constexpr size_t O_PMEMV = O_PMEMK + 1048576;
constexpr size_t O_SCKV = O_PMEMV + 1048576;
constexpr size_t O_SKROPE = O_SCKV + 524288;
constexpr size_t O_SC = O_SKROPE + 131072;
constexpr size_t O_SN = O_SC + 4194304;
constexpr size_t O_SM = O_SN + 32768;
constexpr size_t O_SCONV = O_SM + 256;

constexpr size_t W_IN = 0;
constexpr size_t W_Q = W_IN + 2560 * LDW;
constexpr size_t W_KV = W_Q + 768 * LDWQ;
constexpr size_t W_OUT = W_KV + 1024 * LDWKV;
constexpr size_t W_XQ = W_OUT + 1024 * LDW;
constexpr size_t W_XK = W_XQ + 1024 * LDW;
constexpr size_t W_XV = W_XK + 1024 * LDW;
constexpr size_t W_XO = W_XV + 1024 * LDW;
constexpr size_t W_FF1 = W_XO + 1024 * LDW;
constexpr size_t W_FF2 = W_FF1 + 4096 * LDW;
constexpr size_t W_LAYER = W_FF2 + 1024 * LDW2;

constexpr size_t WS_W = 0;
constexpr size_t WS_ACT = WS_W + 2 * W_LAYER * 2;
constexpr size_t WS_CKV = WS_ACT + (size_t)NTOK * LDA * 2;
constexpr size_t WS_KROPE = WS_CKV + (size_t)NROWS * 128 * 2;
constexpr size_t WS_RQ = WS_KROPE + (size_t)NROWS * 32 * 4;
constexpr size_t WS_GATES = WS_RQ + (size_t)NTOK * 4;
constexpr size_t WS_ROPE = WS_GATES + (size_t)NTOK * 8 * 4;
constexpr size_t WS_SCAL = WS_ROPE + (size_t)16384 * 16 * 8;
constexpr size_t WS_MST = WS_SCAL + (size_t)NITEM * 2 * 4;
constexpr size_t WS_NU = WS_MST + (size_t)NITEM * 4 + 256;
constexpr size_t WS_CNT = WS_NU + (size_t)NITEM * 128 * 4;
constexpr size_t WS_BAR = WS_CNT + 256;
constexpr size_t WS_HM = WS_BAR + 16384;
constexpr size_t WS_BIG = WS_HM + (size_t)512 * LDA * 2;
constexpr size_t B_P = 0;
constexpr size_t B_K = 0;
constexpr size_t B_VT = B_K + (size_t)8 * NROWS * 96 * 2;
constexpr size_t B_Q = B_VT + (size_t)8 * 64 * LDVT * 2;
constexpr size_t B_ST = B_Q + (size_t)NTOK * 768 * 2;
constexpr size_t B_XK = B_ST + (size_t)NITEM * 16384 * 2;
constexpr size_t B_XVT = B_XK + (size_t)34 * 4 * 256 * 256 * 2;
constexpr size_t B_END = B_XVT + (size_t)34 * 4 * 256 * LDXV * 2;
constexpr size_t B_QX = 0;
constexpr size_t B_H1 = 0;
static_assert((size_t)NTOK * INC * 2 <= B_Q, "p overlaps q");
static_assert((size_t)NTOK * LDH1 * 2 <= B_XK, "h1 overlaps xkv");
static_assert((size_t)NTOK * LDA * 2 <= B_Q, "qx overlaps q");
static_assert(WS_BIG + B_END <= (size_t)536870912, "workspace too large");
static_assert(WS_BIG % 256 == 0 && B_Q % 256 == 0 && B_ST % 256 == 0 && B_VT % 256 == 0, "align");

constexpr int SMEM_BYTES = 73728;
#ifndef REP_INPROJ
#define REP_INPROJ 1
#endif
#ifndef REP_C
#define REP_C 1
#endif
#ifndef REP_E
#define REP_E 1
#endif
#ifndef REP_F
#define REP_F 1
#endif
#ifndef REP_G
#define REP_G 1
#endif
#ifndef REP_K
#define REP_K 1
#endif
#ifndef REP_FF1
#define REP_FF1 1
#endif
#ifndef REP_NORM
#define REP_NORM 1
#endif

struct Params {
  const float* x_prompt; const float* x_sample; const float* cache_ckv; const float* cache_krope;
  const float* st_C; const float* st_n; const float* st_m; const float* st_conv;
  const float* cache_mem_k; const float* cache_mem_v; const float* mem_prompt;
  const float* g_mix; const float* w_in; const float* g_qa; const float* w_q_up; const float* g_qnorm; const float* g_kva;
  const float* w_kv_up; const float* g_knorm; const float* w_conv; const float* b_conv; const float* b_igate; const float* b_fgate;
  const float* g_mhead; const float* w_out; const float* g_xattn; const float* g_mem; const float* w_xq; const float* w_xk; const float* w_xv;
  const float* g_xq; const float* g_xk; const float* w_xo; const float* g_mlp; const float* w_ff1; const float* w_ff2;
  float* out; char* ws;
};

#define XB_TMO      128
#define XB_XCNT(j)  (256  + 64 * (j))
#define XB_XSUB(j)  (1280 + 64 * (j))
#define XB_XGEN(j)  (2304 + 64 * (j))
#define XB_TOP      3328
#define XB_TOPGEN   3392
#define XCD_BAR_WORDS 3456
#define XB_SPIN_CAP (1u << 18)
#define LAS __attribute__((address_space(3)))

__device__ __forceinline__ unsigned xb_ld(unsigned* p)              { return __hip_atomic_load(p, __ATOMIC_RELAXED, __HIP_MEMORY_SCOPE_AGENT); }
__device__ __forceinline__ unsigned xb_add(unsigned* p, unsigned v) { return __hip_atomic_fetch_add(p, v, __ATOMIC_RELAXED, __HIP_MEMORY_SCOPE_AGENT); }
__device__ __forceinline__ unsigned xb_xcc_id() { return (unsigned)__builtin_amdgcn_s_getreg((3 << 11) | 20) & 0xFu; }
#define XB_SPIN(cond, bar) do { unsigned _sp = 0; while (cond) { __builtin_amdgcn_s_sleep(1); \
    if ((++_sp & 255u) == 0u) { if (xb_ld(&(bar)[XB_TMO])) break; if (_sp > XB_SPIN_CAP) { atomicAdd(&(bar)[XB_TMO], 1u); break; } } } } while (0)

struct XcdBarrier {
    unsigned* bar; unsigned x;
    volatile LAS unsigned* st;
};

__device__ __forceinline__ XcdBarrier xcd_barrier_post(unsigned* bar, volatile LAS unsigned* st) {
    XcdBarrier b; b.bar = bar; b.x = xb_xcc_id(); b.st = st;
    if (threadIdx.x == 0) (void)xb_add(&bar[XB_XCNT(b.x)], 1u);
    return b;
}
__device__ __forceinline__ void xcd_barrier_complete(unsigned* bar, unsigned x, unsigned& nloc, unsigned& nx) {
    const unsigned G = gridDim.x * gridDim.y * gridDim.z;
    unsigned sum, cnt, mine, sp = 0u;
    for (;;) {
        sum = 0u; cnt = 0u; mine = 0u;
#pragma unroll
        for (unsigned j = 0; j < 16; ++j) { const unsigned c = xb_ld(&bar[XB_XCNT(j)]); sum += c; cnt += (c > 0u) ? 1u : 0u; mine = (j == x) ? c : mine; }
        if (sum == G) break;
        __builtin_amdgcn_s_sleep(1);
        if ((++sp & 255u) == 0u) { if (xb_ld(&bar[XB_TMO])) break; if (sp > XB_SPIN_CAP) { atomicAdd(&bar[XB_TMO], 1u); break; } }
    }
    nloc = mine > 0u ? mine : 1u; nx = cnt > 0u ? cnt : 1u;
}

__device__ __forceinline__ void xcd_barrier(const XcdBarrier& b) {
    asm volatile("s_waitcnt vmcnt(0)" ::: "memory");
    __syncthreads();
    if (threadIdx.x == 0) {
        unsigned* bar = b.bar;
        __builtin_amdgcn_s_waitcnt(0);
        unsigned nloc = b.st[0], nx = b.st[1];
        if (nloc == 0u) { xcd_barrier_complete(bar, b.x, nloc, nx); b.st[0] = nloc; b.st[1] = nx; }
        const unsigned old = xb_add(&bar[XB_XSUB(b.x)], 1u);
        const unsigned gen = old / nloc;
        if (old + 1u == (gen + 1u) * nloc) {
            __builtin_amdgcn_fence(__ATOMIC_RELEASE, "agent");
            asm volatile("s_waitcnt vmcnt(0)" ::: "memory");
            const unsigned og = xb_add(&bar[XB_TOP], 1u);
            const unsigned tg = og / nx;
            if (og + 1u == (tg + 1u) * nx) xb_add(&bar[XB_TOPGEN], 1u);
            else XB_SPIN(xb_ld(&bar[XB_TOPGEN]) == tg, bar);
            __builtin_amdgcn_fence(__ATOMIC_ACQUIRE, "agent");
            xb_add(&bar[XB_XGEN(b.x)], 1u);
            asm volatile("s_waitcnt vmcnt(0)" ::: "memory");
        } else {
            XB_SPIN(xb_ld(&bar[XB_XGEN(b.x)]) == gen, bar);
            __builtin_amdgcn_fence(__ATOMIC_ACQUIRE, "agent");
            asm volatile("s_waitcnt vmcnt(0)" ::: "memory");
        }
    }
    __syncthreads();
}


struct Sched { int xg, xi, ok; };
DI int tidx() { int t = (int)threadIdx.x; asm volatile("" : "+v"(t)); return t; }
DI unsigned pk2(float a, float b) { fv2 v = {a, b}; bfv2 r = __builtin_convertvector(v, bfv2); return __builtin_bit_cast(unsigned, r); }
DI u16 f2bf(float a) { return (u16)(pk2(a, 0.f) & 0xffffu); }
DI float bf2f(u16 v) { return __uint_as_float(((unsigned)v) << 16); }
DI float bflo(unsigned v) { return __uint_as_float(v << 16); }
DI float bfhi(unsigned v) { return __uint_as_float(v & 0xffff0000u); }
DI int crow(int i, int h) { return (i & 3) + 8 * (i >> 2) + 4 * h; }
DI float xhalf_max(float v) {
  unsigned u = __float_as_uint(v);
  auto rr = __builtin_amdgcn_permlane32_swap(u, u, false, false);
  return fmaxf(__uint_as_float(rr[0]), __uint_as_float(rr[1]));
}
DI float xhalf_sum(float v) {
  unsigned u = __float_as_uint(v);
  auto rr = __builtin_amdgcn_permlane32_swap(u, u, false, false);
  return __uint_as_float(rr[0]) + __uint_as_float(rr[1]);
}
DI float wave_sum(float v) {
#pragma unroll
  for (int o = 32; o >= 1; o >>= 1) v += __shfl_xor(v, o);
  return v;
}
DI float wave_max(float v) {
#pragma unroll
  for (int o = 32; o >= 1; o >>= 1) v = fmaxf(v, __shfl_xor(v, o));
  return v;
}
DI void unpack8(uint4 v, float (&x)[8]) {
  x[0] = bflo(v.x); x[1] = bfhi(v.x); x[2] = bflo(v.y); x[3] = bfhi(v.y);
  x[4] = bflo(v.z); x[5] = bfhi(v.z); x[6] = bflo(v.w); x[7] = bfhi(v.w);
}
DI uint4 pack8(const float (&x)[8]) {
  uint4 v; v.x = pk2(x[0], x[1]); v.y = pk2(x[2], x[3]); v.z = pk2(x[4], x[5]); v.w = pk2(x[6], x[7]); return v;
}
DI u16* wsb(const Params& p, size_t off) { return (u16*)(p.ws + off); }
DI float* wsf(const Params& p, size_t off) { return (float*)(p.ws + off); }
DI u16* actp(const Params& p) { return (u16*)p.out; }
DI u16* xres(const Params& p) { return (u16*)(p.ws + WS_ACT); }
DI const float* xrow(const Params& p, int l, int tok) {
  if (l == 0) return tok < NP ? p.x_prompt + (size_t)tok * 1024 : p.x_sample + (size_t)(tok - NP) * 1024;
  return p.out + (size_t)tok * 1024;
}
DI int tok_pos(int tok) { return tok < NP ? (tok & 16383) : 1024 + ((tok - NP) & 63); }

template <int TM, int TN>
DI void gemm_mainloop(const u16* __restrict__ A, long lda, const u16* __restrict__ Bt, long ldb, int K, char* smem,
                      f32x16 (&acc)[TM][TN]) {
  constexpr int BM = 64 * TM, BN = 64 * TN, LD = 72;
  u16* sA = (u16*)smem;
  u16* sB = sA + 2 * BM * LD;
  const int tid = tidx(), lane = tid & 63, w = tid >> 6, r = lane & 31, h = lane >> 5;
  const int wm = w >> 1, wn = w & 1;
  constexpr int NA = BM / 32, NB = BN / 32;
  u32x4 ra[NA], rb[NB];
#pragma unroll
  for (int tm = 0; tm < TM; tm++)
#pragma unroll
    for (int tn = 0; tn < TN; tn++)
#pragma unroll
      for (int i = 0; i < 16; i++) acc[tm][tn][i] = 0.f;
  const int nk = K / 64;
  const int lrow = tid >> 3, lch = (tid & 7) * 8;
  const u16* gA = A + (long)lrow * lda + lch;
  const u16* gB = Bt + (long)lrow * ldb + lch;
  const int soff = lrow * LD + lch;
#define GEMM_GLOAD(k0)                                                                   \
  {                                                                                      \
    _Pragma("unroll") for (int i = 0; i < NA; i++) ra[i] = *(const u32x4*)(gA + (long)(32 * i) * lda + (k0)); \
    _Pragma("unroll") for (int i = 0; i < NB; i++) rb[i] = *(const u32x4*)(gB + (long)(32 * i) * ldb + (k0)); \
  }
#define GEMM_SSTORE(buf)                                                                 \
  {                                                                                      \
    _Pragma("unroll") for (int i = 0; i < NA; i++) *(u32x4*)(sA + (buf) * BM * LD + soff + 32 * i * LD) = ra[i]; \
    _Pragma("unroll") for (int i = 0; i < NB; i++) *(u32x4*)(sB + (buf) * BN * LD + soff + 32 * i * LD) = rb[i]; \
  }
  GEMM_GLOAD(0)
  __syncthreads();
  GEMM_SSTORE(0)
  if (nk > 1) GEMM_GLOAD(64)
  __syncthreads();
  for (int kt = 0; kt < nk; kt++) {
    const int buf = kt & 1;
    const u16* cA = sA + buf * BM * LD + (wm * 32 * TM + r) * LD + h * 8;
    const u16* cB = sB + buf * BN * LD + (wn * 32 * TN + r) * LD + h * 8;
    bf16x8 af[TM], bfr[TN];
#pragma unroll
    for (int tm = 0; tm < TM; tm++) af[tm] = *(const bf16x8*)(cA + tm * 32 * LD);
#pragma unroll
    for (int tn = 0; tn < TN; tn++) bfr[tn] = *(const bf16x8*)(cB + tn * 32 * LD);
    if (kt + 1 < nk) GEMM_SSTORE(buf ^ 1)
    __builtin_amdgcn_sched_barrier(0);
    __builtin_amdgcn_s_setprio(1);
#pragma unroll
    for (int tm = 0; tm < TM; tm++)
#pragma unroll
      for (int tn = 0; tn < TN; tn++) acc[tm][tn] = MFMA(af[tm], bfr[tn], acc[tm][tn]);
#pragma unroll
    for (int tm = 0; tm < TM; tm++) af[tm] = *(const bf16x8*)(cA + tm * 32 * LD + 16);
#pragma unroll
    for (int tn = 0; tn < TN; tn++) bfr[tn] = *(const bf16x8*)(cB + tn * 32 * LD + 16);
#pragma unroll
    for (int tm = 0; tm < TM; tm++)
#pragma unroll
      for (int tn = 0; tn < TN; tn++) acc[tm][tn] = MFMA(af[tm], bfr[tn], acc[tm][tn]);
    __builtin_amdgcn_sched_group_barrier(0x8, 4, 0);
    if (kt + 2 < nk) GEMM_GLOAD((kt + 2) * 64)
#pragma unroll
    for (int ks = 2; ks < 4; ks++) {
#pragma unroll
      for (int tm = 0; tm < TM; tm++) af[tm] = *(const bf16x8*)(cA + tm * 32 * LD + ks * 16);
#pragma unroll
      for (int tn = 0; tn < TN; tn++) bfr[tn] = *(const bf16x8*)(cB + tn * 32 * LD + ks * 16);
#pragma unroll
      for (int tm = 0; tm < TM; tm++)
#pragma unroll
        for (int tn = 0; tn < TN; tn++) acc[tm][tn] = MFMA(af[tm], bfr[tn], acc[tm][tn]);
    }
    __builtin_amdgcn_s_setprio(0);
    __syncthreads();
  }
#undef GEMM_GLOAD
#undef GEMM_SSTORE
}

template <int TM, int TN, class Epi>
DI void gemm_tile(const u16* A, long lda, const u16* Bt, long ldb, int K, int m0, int n0, char* smem, const Epi& epi) {
  constexpr int BM = 64 * TM, BN = 64 * TN, LDC = BN + Epi::PAD;
  f32x16 acc[TM][TN];
  gemm_mainloop<TM, TN>(A + (long)m0 * lda, lda, Bt + (long)n0 * ldb, ldb, K, smem, acc);
  const int tid = tidx(), lane = tid & 63, w = tid >> 6, r = lane & 31, h = lane >> 5;
  const int wm = w >> 1, wn = w & 1;
  float* Ct = (float*)smem;
#pragma unroll
  for (int tm = 0; tm < TM; tm++)
#pragma unroll
    for (int tn = 0; tn < TN; tn++)
#pragma unroll
      for (int i = 0; i < 16; i++)
        Ct[(wm * 32 * TM + tm * 32 + crow(i, h)) * LDC + wn * 32 * TN + tn * 32 + r] = acc[tm][tn][i];
  __syncthreads();
  epi(Ct, LDC, m0, n0, tid, BM);
  __syncthreads();
  (void)BM;
}

struct EpiStoreBf16 {
  static constexpr int PAD = 4;
  u16* out; long ldo; int nmax; float* gates;
  DI void operator()(const float* Ct, int ldc, int m0, int n0, int tid, int bm) const {
#pragma unroll 4
    for (int it = 0; it < bm / 16; it++) {
      int id = tid + 256 * it; int row = id >> 4, c8 = (id & 15) * 8;
      int n = n0 + c8;
      if (n < nmax) {
        const float* c = Ct + row * ldc + c8;
        float4 a = *(const float4*)c, b = *(const float4*)(c + 4);
        uint4 v; v.x = pk2(a.x, a.y); v.y = pk2(a.z, a.w); v.z = pk2(b.x, b.y); v.w = pk2(b.z, b.w);
        *(uint4*)(out + (long)(m0 + row) * ldo + n) = v;
        if (gates != nullptr && n == 1952) {
          float* g = gates + (long)(m0 + row) * 8;
          *(float4*)g = a; *(float4*)(g + 4) = b;
        }
      }
    }
  }
};
struct EpiRelu2 {
  static constexpr int PAD = 4;
  u16* out; long ldo;
  DI void operator()(const float* Ct, int ldc, int m0, int n0, int tid, int bm) const {
#pragma unroll 4
    for (int it = 0; it < bm / 16; it++) {
      int id = tid + 256 * it; int row = id >> 4, c8 = (id & 15) * 8;
      const float* c = Ct + row * ldc + c8;
      float x[8];
#pragma unroll
      for (int j = 0; j < 8; j++) { float v = fmaxf(c[j], 0.f); x[j] = v * v; }
      *(uint4*)(out + (long)(m0 + row) * ldo + n0 + c8) = pack8(x);
    }
  }
};
struct EpiF32 {
  static constexpr int PAD = 4;
  float* out; long ldo;
  DI void operator()(const float* Ct, int ldc, int m0, int n0, int tid, int bm) const {
#pragma unroll 4
    for (int it = 0; it < bm / 16; it++) {
      int id = tid + 256 * it; int row = id >> 4, c8 = (id & 15) * 8;
      const float* c = Ct + row * ldc + c8;
      float* o = out + (long)(m0 + row) * ldo + n0 + c8;
      *(float4*)o = *(const float4*)c; *(float4*)(o + 4) = *(const float4*)(c + 4);
    }
  }
};
struct EpiRes {
  static constexpr int PAD = 4;
  const float* src0; const float* src1;
  const u16* srcb; u16* dstb; float* dstf;
  DI void operator()(const float* Ct, int ldc, int m0, int n0, int tid, int bm) const {
#pragma unroll 4
    for (int it = 0; it < bm / 16; it++) {
      int id = tid + 256 * it; int row = id >> 4, c8 = (id & 15) * 8;
      int m = m0 + row;
      const float* c = Ct + row * ldc + c8;
      float4 a = *(const float4*)c, b = *(const float4*)(c + 4);
      float x[8];
      if (srcb != nullptr) {
        unpack8(*(const uint4*)(srcb + (size_t)m * LDA + n0 + c8), x);
      } else {
        const float* sp = (m < NP ? src0 + (size_t)m * 1024 : src1 + (size_t)(m - NP) * 1024) + n0 + c8;
        float4 sa = *(const float4*)sp, sb = *(const float4*)(sp + 4);
        x[0] = sa.x; x[1] = sa.y; x[2] = sa.z; x[3] = sa.w; x[4] = sb.x; x[5] = sb.y; x[6] = sb.z; x[7] = sb.w;
      }
      x[0] += a.x; x[1] += a.y; x[2] += a.z; x[3] += a.w; x[4] += b.x; x[5] += b.y; x[6] += b.z; x[7] += b.w;
      if (dstf != nullptr) {
        float* o = dstf + (size_t)m * 1024 + n0 + c8;
        *(float4*)o = make_float4(x[0], x[1], x[2], x[3]); *(float4*)(o + 4) = make_float4(x[4], x[5], x[6], x[7]);
      } else {
        *(uint4*)(dstb + (size_t)m * LDA + n0 + c8) = pack8(x);
      }
    }
  }
};
struct EpiQ {
  static constexpr int PAD = 1;
  u16* q; const float* rq; const float2* rope; const float* g;
  DI void operator()(const float* Ct, int ldc, int m0, int n0, int tid, int bm) const {
    float* r2s = (float*)((char*)Ct + 60000);
    {
      const int row = tid >> 2, hh = (tid >> 1) & 1, half = tid & 1; const int m = m0 + row;
      const float* c = Ct + row * ldc + hh * 96 + half * 48;
      float ss = 0.f;
#pragma unroll 8
      for (int d = 0; d < 48; d++) ss += c[d] * c[d];
      ss += __shfl_xor(ss, 1);
      const float rqv = rq[m];
      ss *= rqv * rqv;
      if (half == 0) r2s[row * 2 + hh] = rsqrtf(ss * (1.f / 96.f) + EPS) * rqv * (0.10206207261596575f * LOG2E);
    }
    __syncthreads();
#pragma unroll
    for (int it = 0; it < 6; it++) {
      const int id = tid + 256 * it; const int row = id / 24, cc = id % 24; const int hh = cc / 12, c8 = cc % 12;
      const int m = m0 + row;
      const float* c = Ct + row * ldc + hh * 96;
      const float r2 = r2s[row * 2 + hh];
      float x[8];
      if (c8 < 8) {
#pragma unroll
        for (int jj = 0; jj < 8; jj++) x[jj] = c[c8 * 8 + jj] * r2 * g[c8 * 8 + jj];
      } else {
        const int half = c8 & 1;
        const bool second = c8 >= 10;
        const float2* tab = rope + (size_t)tok_pos(m) * 16 + half * 8;
#pragma unroll
        for (int jj = 0; jj < 8; jj++) {
          const int i = half * 8 + jj;
          const float a = c[64 + i], b = c[80 + i]; const float2 cs = tab[jj];
          const float v = second ? (a * cs.y + b * cs.x) : (a * cs.x - b * cs.y);
          x[jj] = v * r2 * g[(second ? 80 : 64) + i];
        }
      }
      *(uint4*)(q + (size_t)m * 768 + n0 + cc * 8) = pack8(x);
    }
  }
};
struct EpiKV {
  static constexpr int PAD = 1;
  u16* Kb; u16* Vt; const float* krope; const float* g;
  DI void operator()(const float* Ct, int ldc, int m0, int n0, int tid, int bm) const {
    const int hd = n0 >> 7;
#pragma unroll
    for (int it = 0; it < 4; it++) {
      int id = tid + 256 * it; int oct = id & 15, e = id >> 4;
      float x[8];
#pragma unroll
      for (int j = 0; j < 8; j++) x[j] = Ct[(16 * (oct >> 1) + 4 * (oct & 1) + (j & 3) + 8 * (j >> 2)) * ldc + 64 + e];
      *(uint4*)(Vt + (size_t)(hd * 64 + e) * LDVT + m0 + oct * 8) = pack8(x);
    }
    float* rrs = (float*)((char*)Ct + 66560);
    {
      const int row = tid >> 1, half = tid & 1;
      const float* c = Ct + row * ldc + half * 32;
      const float* kr = krope + (size_t)(m0 + row) * 32 + half * 16;
      float ss = 0.f;
#pragma unroll 8
      for (int d = 0; d < 32; d++) ss += c[d] * c[d];
#pragma unroll 8
      for (int d = 0; d < 16; d++) ss += kr[d] * kr[d];
      ss += __shfl_xor(ss, 1);
      if (half == 0) rrs[row] = rsqrtf(ss * (1.f / 96.f) + EPS);
    }
    __syncthreads();
    u16* ob = Kb + ((size_t)hd * NROWS + m0) * 96;
#pragma unroll
    for (int it = 0; it < 6; it++) {
      const int id = tid + 256 * it; const int row = id / 12, cc = id % 12;
      const float rr = rrs[row];
      float x[8];
      if (cc < 8) {
        const float* c = Ct + row * ldc + cc * 8;
#pragma unroll
        for (int jj = 0; jj < 8; jj++) x[jj] = c[jj] * rr * g[cc * 8 + jj];
      } else {
        const float* kr = krope + (size_t)(m0 + row) * 32 + (cc - 8) * 8;
#pragma unroll
        for (int jj = 0; jj < 8; jj++) x[jj] = kr[jj] * rr * g[cc * 8 + jj];
      }
      *(uint4*)(ob + (size_t)id * 8) = pack8(x);
    }
  }
};

template <int DQK, int NE, int EV, bool DB, bool QNORM, bool QREG, bool VPERM = false>
DI void flash_item(const u16* Qrow, bool wave_active, int ntb, int ntw, const u16* Kbase, long ldk, const u16* Vtbase, long ldv,
                   int e0, u16* Orow, char* smem) {
  constexpr int LDK = DQK + 8, LDV = 72;
  constexpr int KS = DQK / 16;
  constexpr int KTILE = 64 * LDK, VTILE = EV * LDV;
  constexpr int NKC = 64 * (DQK / 8) / 256;
  constexpr int NVC = EV * 8 / 256;
  u16* sK = (u16*)smem;
  u16* sV = sK + (DB ? 2 : 1) * KTILE;
  const int tid = tidx(), lane = tid & 63, r = lane & 31, h = lane >> 5;
  bf16x8 qf[QREG ? KS : 1];
  float rqs = 1.f;
  if (wave_active) {
    if (QREG) {
#pragma unroll
      for (int ks = 0; ks < KS; ks++) qf[QREG ? ks : 0] = *(const bf16x8*)(Qrow + ks * 16 + h * 8);
    }
    if (QNORM) {
      float ss = 0.f;
#pragma unroll
      for (int ks = 0; ks < KS; ks++) {
        bf16x8 qq = QREG ? qf[QREG ? ks : 0] : *(const bf16x8*)(Qrow + ks * 16 + h * 8);
#pragma unroll
        for (int j = 0; j < 8; j++) { float v = bf2f((u16)qq[j]); ss += v * v; }
      }
      ss = xhalf_sum(ss);
      rqs = rsqrtf(ss * (1.f / DQK) + EPS);
    }
  } else if (QREG) {
#pragma unroll
    for (int ks = 0; ks < KS; ks++)
#pragma unroll
      for (int j = 0; j < 8; j++) qf[QREG ? ks : 0][j] = 0;
  }
  f32x16 o[NE];
#pragma unroll
  for (int et = 0; et < NE; et++)
#pragma unroll
    for (int i = 0; i < 16; i++) o[et][i] = 0.f;
  float mrun = 0.f, lrun = 0.f;
  const float rqinv = __builtin_amdgcn_rcpf(rqs);

  u32x4 rk[DB ? NKC : 1], rv[DB ? NVC : 1];
  auto gload = [&](int t) {
#pragma unroll
    for (int i = 0; i < NKC; i++) {
      int id = tid + 256 * i; int row = id / (DQK / 8), ch = id % (DQK / 8);
      u32x4 v = *(const u32x4*)(Kbase + (long)(t * 64 + row) * ldk + ch * 8);
      if (DB) rk[DB ? i : 0] = v; else *(u32x4*)(sK + row * LDK + ch * 8) = v;
    }
#pragma unroll
    for (int i = 0; i < NVC; i++) {
      int id = tid + 256 * i; int row = id >> 3, ch = id & 7;
      u32x4 v = *(const u32x4*)(Vtbase + (long)row * ldv + t * 64 + ch * 8);
      if (DB) rv[DB ? i : 0] = v; else *(u32x4*)(sV + row * LDV + ch * 8) = v;
    }
  };
  auto sstore = [&](int buf) {
#pragma unroll
    for (int i = 0; i < NKC; i++) { int id = tid + 256 * i; int row = id / (DQK / 8), ch = id % (DQK / 8); *(u32x4*)(sK + buf * KTILE + row * LDK + ch * 8) = rk[DB ? i : 0]; }
#pragma unroll
    for (int i = 0; i < NVC; i++) { int id = tid + 256 * i; int row = id >> 3, ch = id & 7; *(u32x4*)(sV + buf * VTILE + row * LDV + ch * 8) = rv[DB ? i : 0]; }
  };
  auto compute = [&](int buf) {
    const u16* cK = sK + buf * KTILE + r * LDK + h * 8;
    const u16* cV = sV + buf * VTILE + (e0 + r) * LDV + 4 * h;
    const float sinit = QNORM ? -mrun * rqinv : -mrun;
    f32x16 s[2];
#pragma unroll
    for (int sub = 0; sub < 2; sub++) {
#pragma unroll
      for (int i = 0; i < 16; i++) s[sub][i] = sinit;
#pragma unroll
      for (int ks = 0; ks < KS; ks++) {
        bf16x8 a = *(const bf16x8*)(cK + sub * 32 * LDK + ks * 16);
        bf16x8 qq = QREG ? qf[QREG ? ks : 0] : *(const bf16x8*)(Qrow + ks * 16 + h * 8);
        s[sub] = MFMA(a, qq, s[sub]);
      }
    }
    float mx = -1e30f;
#pragma unroll
    for (int sub = 0; sub < 2; sub++)
#pragma unroll
      for (int i = 0; i < 16; i++) { if (QNORM) s[sub][i] *= rqs; mx = fmaxf(mx, s[sub][i]); }
    mx = xhalf_max(mx);
    if (__any(mx > 8.f)) {
      const float d = fmaxf(mx, 0.f);
      const float alpha = __builtin_amdgcn_exp2f(-d);
      mrun += d;
      lrun *= alpha;
#pragma unroll
      for (int et = 0; et < NE; et++)
#pragma unroll
        for (int i = 0; i < 16; i++) o[et][i] *= alpha;
#pragma unroll
      for (int sub = 0; sub < 2; sub++)
#pragma unroll
        for (int i = 0; i < 16; i++) s[sub][i] -= d;
    }
    float psum = 0.f;
#pragma unroll
    for (int sub = 0; sub < 2; sub++)
#pragma unroll
      for (int i = 0; i < 16; i++) { float pv = __builtin_amdgcn_exp2f(s[sub][i]); s[sub][i] = pv; psum += pv; }
    lrun += psum;
#pragma unroll
    for (int sub = 0; sub < 2; sub++)
#pragma unroll
      for (int st = 0; st < 2; st++) {
        uint4 pp;
        pp.x = pk2(s[sub][8 * st + 0], s[sub][8 * st + 1]); pp.y = pk2(s[sub][8 * st + 2], s[sub][8 * st + 3]);
        pp.z = pk2(s[sub][8 * st + 4], s[sub][8 * st + 5]); pp.w = pk2(s[sub][8 * st + 6], s[sub][8 * st + 7]);
        bf16x8 pb = __builtin_bit_cast(bf16x8, pp);
#pragma unroll
        for (int et = 0; et < NE; et++) {
          bf16x8 a;
          if (VPERM) {
            a = *(const bf16x8*)(sV + buf * VTILE + (e0 + et * 32 + r) * LDV + sub * 32 + st * 16 + 8 * h);
          } else {
            const u16* vp = cV + et * 32 * LDV + sub * 32 + st * 16;
            s16x4 lo = *(const s16x4*)vp;
            s16x4 hi = *(const s16x4*)(vp + 8);
            a = __builtin_shufflevector(lo, hi, 0, 1, 2, 3, 4, 5, 6, 7);
          }
          o[et] = MFMA(a, pb, o[et]);
        }
      }
  };

  __syncthreads();
  if (DB) {
    gload(0);
    sstore(0);
    __syncthreads();
    for (int t = 0; t < ntb; t++) {
      const bool more = (t + 1 < ntb);
      if (more) gload(t + 1);
      __builtin_amdgcn_sched_barrier(0);
      if (wave_active && t < ntw) { __builtin_amdgcn_s_setprio(1); compute(t & 1); __builtin_amdgcn_s_setprio(0); }
      if (more) sstore((t + 1) & 1);
      __syncthreads();
    }
  } else {
    for (int t = 0; t < ntb; t++) {
      if (t > 0) __syncthreads();
      gload(t);
      __syncthreads();
      if (wave_active && t < ntw) compute(0);
    }
    __syncthreads();
  }
  if (wave_active) {
    float lt = xhalf_sum(lrun);
    float inv = __builtin_amdgcn_rcpf(lt);
#pragma unroll
    for (int et = 0; et < NE; et++)
#pragma unroll
      for (int g = 0; g < 4; g++) {
        uint2 v;
        v.x = pk2(o[et][4 * g + 0] * inv, o[et][4 * g + 1] * inv);
        v.y = pk2(o[et][4 * g + 2] * inv, o[et][4 * g + 3] * inv);
        *(uint2*)(Orow + et * 32 + 8 * g + 4 * h) = v;
      }
  }
}

DI void flash_item64(const u16* Qbase  , int ntb, int ntw, const u16* Kbase, const u16* Vtbase,
                     u16* Obase  , char* smem) {
  constexpr int LDK = 104, LDV = 72, KS = 6, KTILE = 64 * LDK, VTILE = 64 * LDV;
  u16* sK = (u16*)smem;
  u16* sV = sK + 2 * KTILE;
  const int tid = tidx(), lane = tid & 63, r = lane & 31, h = lane >> 5;
  bf16x8 qf[2][KS];
#pragma unroll
  for (int qh = 0; qh < 2; qh++)
#pragma unroll
    for (int ks = 0; ks < KS; ks++) qf[qh][ks] = *(const bf16x8*)(Qbase + (long)(qh * 32 + r) * 768 + ks * 16 + h * 8);
  f32x16 o[2][2];
#pragma unroll
  for (int qh = 0; qh < 2; qh++)
#pragma unroll
    for (int et = 0; et < 2; et++)
#pragma unroll
      for (int i = 0; i < 16; i++) o[qh][et][i] = 0.f;
  float mrun[2] = {0.f, 0.f}, lrun[2] = {0.f, 0.f};
  u32x4 rk[3], rv[2];
  auto gload = [&](int t) {
#pragma unroll
    for (int i = 0; i < 3; i++) { int id = tid + 256 * i; int row = id / 12, ch = id % 12; rk[i] = *(const u32x4*)(Kbase + (long)(t * 64 + row) * 96 + ch * 8); }
#pragma unroll
    for (int i = 0; i < 2; i++) { int id = tid + 256 * i; int row = id >> 3, ch = id & 7; rv[i] = *(const u32x4*)(Vtbase + (long)row * LDVT + t * 64 + ch * 8); }
  };
  auto sstore = [&](int buf) {
#pragma unroll
    for (int i = 0; i < 3; i++) { int id = tid + 256 * i; int row = id / 12, ch = id % 12; *(u32x4*)(sK + buf * KTILE + row * LDK + ch * 8) = rk[i]; }
#pragma unroll
    for (int i = 0; i < 2; i++) { int id = tid + 256 * i; int row = id >> 3, ch = id & 7; *(u32x4*)(sV + buf * VTILE + row * LDV + ch * 8) = rv[i]; }
  };
  auto compute = [&](int buf) {
    const u16* cK = sK + buf * KTILE + r * LDK + h * 8;
    const u16* cV = sV + buf * VTILE + r * LDV + 8 * h;
    f32x16 s[2][2];
#pragma unroll
    for (int sub = 0; sub < 2; sub++)
#pragma unroll
      for (int qh = 0; qh < 2; qh++)
#pragma unroll
        for (int i = 0; i < 16; i++) s[sub][qh][i] = -mrun[qh];
#pragma unroll
    for (int sub = 0; sub < 2; sub++)
#pragma unroll
      for (int ks = 0; ks < KS; ks++) {
        bf16x8 a = *(const bf16x8*)(cK + sub * 32 * LDK + ks * 16);
        s[sub][0] = MFMA(a, qf[0][ks], s[sub][0]);
        s[sub][1] = MFMA(a, qf[1][ks], s[sub][1]);
      }
#pragma unroll
    for (int qh = 0; qh < 2; qh++) {
      float mx = -1e30f;
#pragma unroll
      for (int sub = 0; sub < 2; sub++)
#pragma unroll
        for (int i = 0; i < 16; i++) mx = fmaxf(mx, s[sub][qh][i]);
      mx = xhalf_max(mx);
      if (__any(mx > 8.f)) {
        const float d = fmaxf(mx, 0.f);
        const float alpha = __builtin_amdgcn_exp2f(-d);
        mrun[qh] += d;
        lrun[qh] *= alpha;
#pragma unroll
        for (int et = 0; et < 2; et++)
#pragma unroll
          for (int i = 0; i < 16; i++) o[qh][et][i] *= alpha;
#pragma unroll
        for (int sub = 0; sub < 2; sub++)
#pragma unroll
          for (int i = 0; i < 16; i++) s[sub][qh][i] -= d;
      }
      float psum = 0.f;
#pragma unroll
      for (int sub = 0; sub < 2; sub++)
#pragma unroll
        for (int i = 0; i < 16; i++) { float pv = __builtin_amdgcn_exp2f(s[sub][qh][i]); s[sub][qh][i] = pv; psum += pv; }
      lrun[qh] += psum;
    }
#pragma unroll
    for (int sub = 0; sub < 2; sub++)
#pragma unroll
      for (int st = 0; st < 2; st++) {
        bf16x8 pb[2];
#pragma unroll
        for (int qh = 0; qh < 2; qh++) {
          uint4 pp;
          pp.x = pk2(s[sub][qh][8 * st + 0], s[sub][qh][8 * st + 1]); pp.y = pk2(s[sub][qh][8 * st + 2], s[sub][qh][8 * st + 3]);
          pp.z = pk2(s[sub][qh][8 * st + 4], s[sub][qh][8 * st + 5]); pp.w = pk2(s[sub][qh][8 * st + 6], s[sub][qh][8 * st + 7]);
          pb[qh] = __builtin_bit_cast(bf16x8, pp);
        }
#pragma unroll
        for (int et = 0; et < 2; et++) {
          bf16x8 a = *(const bf16x8*)(cV + et * 32 * LDV + sub * 32 + st * 16);
          o[0][et] = MFMA(a, pb[0], o[0][et]);
          o[1][et] = MFMA(a, pb[1], o[1][et]);
        }
      }
  };
  __syncthreads();
  gload(0);
  sstore(0);
  __syncthreads();
  for (int t = 0; t < ntb; t++) {
    const bool more = (t + 1 < ntb);
    if (more) gload(t + 1);
    __builtin_amdgcn_sched_barrier(0);
    if (t < ntw) { __builtin_amdgcn_s_setprio(1); compute(t & 1); __builtin_amdgcn_s_setprio(0); }
    if (more) sstore((t + 1) & 1);
    __syncthreads();
  }
#pragma unroll
  for (int qh = 0; qh < 2; qh++) {
    const float inv = __builtin_amdgcn_rcpf(xhalf_sum(lrun[qh]));
    u16* Orow = Obase + (long)(qh * 32 + r) * LDA;
#pragma unroll
    for (int et = 0; et < 2; et++)
#pragma unroll
      for (int g = 0; g < 4; g++) {
        uint2 v;
        v.x = pk2(o[qh][et][4 * g + 0] * inv, o[qh][et][4 * g + 1] * inv);
        v.y = pk2(o[qh][et][4 * g + 2] * inv, o[qh][et][4 * g + 3] * inv);
        *(uint2*)(Orow + et * 32 + 8 * g + 4 * h) = v;
      }
  }
}

DI void norm_row_wave(const float* src, u16* dst, int lane) {
  float4 v[4]; float ss = 0.f;
#pragma unroll
  for (int i = 0; i < 4; i++) { v[i] = *(const float4*)(src + i * 256 + lane * 4); ss += v[i].x * v[i].x + v[i].y * v[i].y + v[i].z * v[i].z + v[i].w * v[i].w; }
  ss = wave_sum(ss);
  float rr = rsqrtf(ss * (1.f / 1024.f) + EPS);
#pragma unroll
  for (int i = 0; i < 4; i++) {
    uint2 o; o.x = pk2(v[i].x * rr, v[i].y * rr); o.y = pk2(v[i].z * rr, v[i].w * rr);
    *(uint2*)(dst + i * 256 + lane * 4) = o;
  }
}

DI void phase_norm(const Params& p, int l) {
  const int lane = tidx() & 63, w = tidx() >> 6;
  u16* act = actp(p);
  if (l == 0) {
    for (int t = blockIdx.x * 4 + w; t < NTOK; t += gridDim.x * 4) norm_row_wave(xrow(p, 0, t), act + (size_t)t * LDA, lane);
  } else {
    const u16* xr = xres(p);
    for (int t = blockIdx.x * 4 + w; t < NTOK; t += gridDim.x * 4) {
      const u16* src = xr + (size_t)t * LDA + lane * 16;
      float x[16];
      { float a[8], b[8]; unpack8(*(const uint4*)src, a); unpack8(*(const uint4*)(src + 8), b);
#pragma unroll
        for (int j = 0; j < 8; j++) { x[j] = a[j]; x[8 + j] = b[j]; } }
      float ss = 0.f;
#pragma unroll
      for (int j = 0; j < 16; j++) ss += x[j] * x[j];
      ss = wave_sum(ss);
      const float rr = rsqrtf(ss * (1.f / 1024.f) + EPS);
      float y0[8], y1[8];
#pragma unroll
      for (int j = 0; j < 8; j++) { y0[j] = x[j] * rr; y1[j] = x[8 + j] * rr; }
      u16* dst = act + (size_t)t * LDA + lane * 16;
      *(uint4*)dst = pack8(y0); *(uint4*)(dst + 8) = pack8(y1);
    }
  }
}

DI void wtile(const float* src, const float* gain, int K, int N, u16* dst, int ldd, int k0, int n0, char* smem) {
  u16* T = (u16*)smem;
  const int tid = tidx();
  __syncthreads();
  {
    const int nn = tid & 63, kk0 = tid >> 6;
    const int n = n0 + nn;
#pragma unroll 4
    for (int i = 0; i < 16; i++) {
      int kk = kk0 + 4 * i;
      float v = 0.f;
      if (n < N) { v = src[(size_t)(k0 + kk) * N + n]; if (gain) v *= gain[k0 + kk]; }
      T[nn * 72 + kk] = f2bf(v);
    }
  }
  __syncthreads();
  {
    const int nn = tid >> 2, kq = tid & 3;
    const uint4* s = (const uint4*)(T + nn * 72 + kq * 16);
    uint4* d = (uint4*)(dst + (size_t)(n0 + nn) * ldd + k0 + kq * 16);
    d[0] = s[0]; d[1] = s[1];
  }
}

DI void phase_prep(const Params& p, char* smem) {
  const int tid = tidx(), lane = tid & 63, w = tid >> 6;
  for (int t = blockIdx.x; t < 2 * 4048; t += gridDim.x) {
    int l = t / 4048, u = t % 4048;
    const float* src; const float* gain = nullptr; int K, N, Npad; size_t doff; int ldd = LDW;
    if (u < 640) { src = p.w_in + (size_t)l * 1024 * INC; gain = p.g_mix + l * 1024; K = 1024; N = INC; Npad = 2560; doff = W_IN; }
    else if (u < 688) { u -= 640; src = p.w_q_up + (size_t)l * 256 * 768; gain = p.g_qa + l * 256; K = 256; N = 768; Npad = 768; doff = W_Q; ldd = LDWQ; }
    else if (u < 720) { u -= 688; src = p.w_kv_up + (size_t)l * 128 * 1024; K = 128; N = 1024; Npad = 1024; doff = W_KV; ldd = LDWKV; }
    else if (u < 976) { u -= 720; src = p.w_out + (size_t)l * 1048576; K = 1024; N = 1024; Npad = 1024; doff = W_OUT; }
    else if (u < 1232) { u -= 976; src = p.w_xq + (size_t)l * 1048576; gain = p.g_xattn + l * 1024; K = 1024; N = 1024; Npad = 1024; doff = W_XQ; }
    else if (u < 1488) { u -= 1232; src = p.w_xk + (size_t)l * 1048576; gain = p.g_mem + l * 1024; K = 1024; N = 1024; Npad = 1024; doff = W_XK; }
    else if (u < 1744) { u -= 1488; src = p.w_xv + (size_t)l * 1048576; gain = p.g_mem + l * 1024; K = 1024; N = 1024; Npad = 1024; doff = W_XV; }
    else if (u < 2000) { u -= 1744; src = p.w_xo + (size_t)l * 1048576; K = 1024; N = 1024; Npad = 1024; doff = W_XO; }
    else if (u < 3024) { u -= 2000; src = p.w_ff1 + (size_t)l * 4194304; gain = p.g_mlp + l * 1024; K = 1024; N = 4096; Npad = 4096; doff = W_FF1; }
    else { u -= 3024; src = p.w_ff2 + (size_t)l * 4194304; K = 4096; N = 1024; Npad = 1024; doff = W_FF2; ldd = LDW2; }
    int nt = Npad / 64;
    int kt = u / nt, ntile = u % nt;
    wtile(src, gain, K, N, wsb(p, WS_W) + (size_t)l * W_LAYER + doff, ldd, kt * 64, ntile * 64, smem);
  }
  float2* tab = (float2*)(p.ws + WS_ROPE);
  for (int t = blockIdx.x; t < 1024; t += gridDim.x) {
    int idx = t * 256 + tid; int pos = idx >> 4, i = idx & 15;
    float inv_freq = __builtin_amdgcn_exp2f(-(float)i * 0.830482023721841f);
    float ang = (float)pos * inv_freq;
    double rev = (double)ang * 0.15915494309189535;
    rev -= rint(rev);
    float fr = (float)rev;
    tab[idx] = make_float2(__builtin_amdgcn_cosf(fr), __builtin_amdgcn_sinf(fr));
  }
  u16* hm = wsb(p, WS_HM);
  for (int t = blockIdx.x * 4 + w; t < 512; t += gridDim.x * 4) norm_row_wave(p.mem_prompt + (size_t)t * 1024, hm + (size_t)t * LDA, lane);
  phase_norm(p, 0);
}

template <class Epi>
DI void phase_gemm128(const Sched& sc, const u16* A, long lda, const u16* Bt, long ldb, int K, int MT, int NT, int SN, char* smem, const Epi& epi);
DI void phase_inproj(const Params& p, const Sched& sc, int l, char* smem) {
  const u16* W = wsb(p, WS_W) + (size_t)l * W_LAYER;
  {
    EpiStoreBf16 epi{wsb(p, WS_BIG + B_P), INC, INC, wsf(p, WS_GATES)};
    phase_gemm128(sc, actp(p), LDA, W + W_IN, LDW, 1024, 272, 20, 4, smem, epi);
  }
  if (l == 0) {
    for (int u = blockIdx.x; u < 128; u += gridDim.x) {
      int l2 = u >> 6, which = (u >> 5) & 1, mt = (u >> 3) & 3, nt = u & 7;
      const u16* W2 = wsb(p, WS_W) + (size_t)l2 * W_LAYER + (which ? W_XV : W_XK);
      EpiF32 epi{p.out + (which ? O_PMEMV : O_PMEMK) + (size_t)l2 * 524288, 1024};
      gemm_tile<2, 2>(wsb(p, WS_HM), LDA, W2, LDW, 1024, mt * 128, nt * 128, smem, epi);
    }
  }
}

DI void post_token(const Params& p, int l, int tok, int lane) {
  const u16* pr = wsb(p, WS_BIG + B_P) + (size_t)tok * INC;
  {
    uint2 q4 = *(const uint2*)(pr + lane * 4);
    float a = bflo(q4.x), b = bfhi(q4.x), c = bflo(q4.y), d = bfhi(q4.y);
    float ss = wave_sum(a * a + b * b + c * c + d * d);
    if (lane == 0) wsf(p, WS_RQ)[tok] = rsqrtf(ss * (1.f / 256.f) + EPS);
  }
  const bool prompt = tok < NP;
  int b, s, row, pos; float* ckv_out; float* kr_out;
  if (prompt) {
    b = tok >> 14; s = tok & 16383; row = tok; pos = s;
    ckv_out = p.out + O_PCKV + ((size_t)(l * 2 + b) * 16384 + s) * 128;
    kr_out = p.out + O_PKROPE + ((size_t)(l * 2 + b) * 16384 + s) * 32;
  } else {
    int t2 = tok - NP; b = t2 >> 6; s = t2 & 63; row = NP + b * 1088 + 1024 + s; pos = 1024 + s;
    ckv_out = p.out + O_SCKV + ((size_t)(l * 32 + b) * 64 + s) * 128;
    kr_out = p.out + O_SKROPE + ((size_t)(l * 32 + b) * 64 + s) * 32;
  }
  {
    unsigned c2 = *(const unsigned*)(pr + 256 + lane * 2);
    float c0 = bflo(c2), c1 = bfhi(c2);
    float ss = wave_sum(c0 * c0 + c1 * c1);
    float rr = rsqrtf(ss * (1.f / 128.f) + EPS);
    float o0 = c0 * rr * p.g_kva[l * 128 + lane * 2], o1 = c1 * rr * p.g_kva[l * 128 + lane * 2 + 1];
    *(float2*)(ckv_out + lane * 2) = make_float2(o0, o1);
    *(unsigned*)(wsb(p, WS_CKV) + (size_t)row * 128 + lane * 2) = pk2(o0, o1);
  }
  if (lane < 16) {
    float x1 = bf2f(pr[384 + lane]), x2 = bf2f(pr[400 + lane]);
    float2 cs = ((const float2*)(p.ws + WS_ROPE))[(size_t)pos * 16 + lane];
    float o1 = x1 * cs.x - x2 * cs.y, o2 = x1 * cs.y + x2 * cs.x;
    kr_out[lane] = o1; kr_out[16 + lane] = o2;
    float* ka = wsf(p, WS_KROPE) + (size_t)row * 32;
    ka[lane] = o1; ka[16 + lane] = o2;
  }
  const int S = prompt ? 16384 : 64;
  if (s >= S - 3) {
    int j = s - (S - 3);
    float* dst = prompt ? p.out + O_PCONV + ((size_t)(l * 2 + b) * 3 + j) * 1024 : p.out + O_SCONV + ((size_t)(l * 32 + b) * 3 + j) * 1024;
#pragma unroll 4
    for (int i = 0; i < 16; i++) dst[lane + 64 * i] = bf2f(pr[416 + lane + 64 * i]);
  }
}

DI void post_past(const Params& p, int l, int pi, int lane) {
  int b = pi >> 10, t = pi & 1023;
  size_t row = (size_t)NP + b * 1088 + t;
  const float* src = p.cache_ckv + ((size_t)(l * 32 + b) * 1024 + t) * 128;
  float2 v = *(const float2*)(src + lane * 2);
  *(unsigned*)(wsb(p, WS_CKV) + row * 128 + lane * 2) = pk2(v.x, v.y);
  if (lane < 32) wsf(p, WS_KROPE)[row * 32 + lane] = p.cache_krope[((size_t)(l * 32 + b) * 1024 + t) * 32 + lane];
}

struct ChunkInfo { int tok0, b, h, chain, has_prev, sample; };
DI ChunkInfo chunk_info(int item) {
  ChunkInfo ci;
  if (item < 2048) {
    ci.chain = item >> 8; ci.b = ci.chain >> 2; ci.h = ci.chain & 3; int c = item & 255;
    ci.tok0 = ci.b * 16384 + c * 64; ci.has_prev = (c > 0); ci.sample = 0;
  } else {
    int j = item - 2048; ci.chain = 8 + j; ci.b = j >> 2; ci.h = j & 3; ci.tok0 = NP + ci.b * 64; ci.has_prev = 0; ci.sample = 1;
  }
  return ci;
}
DI void load_x8(const Params& p, int l, const ChunkInfo& ci, int tp, int col, float (&x)[8]) {
  if (tp >= 0 || ci.has_prev) {
    uint4 v = *(const uint4*)(wsb(p, WS_BIG + B_P) + (size_t)(ci.tok0 + tp) * INC + col);
    unpack8(v, x);
  } else if (ci.sample) {
    const float* s = p.st_conv + (((size_t)l * 32 + ci.b) * 3 + (3 + tp)) * 1024 + (col - 416);
    float4 a = *(const float4*)s, b = *(const float4*)(s + 4);
    x[0] = a.x; x[1] = a.y; x[2] = a.z; x[3] = a.w; x[4] = b.x; x[5] = b.y; x[6] = b.z; x[7] = b.w;
  } else {
#pragma unroll
    for (int j = 0; j < 8; j++) x[j] = 0.f;
  }
}
template <class Emit>
DI void conv_run(const Params& p, int l, const ChunkInfo& ci, int mat, int chunk, int row0, int nrows, Emit emit) {
  const int ch0 = mat * 512 + ci.h * 128 + chunk * 8;
  const int col = 416 + ch0;
  float w0[8], w1[8], w2[8], w3[8], bias[8];
  {
    const float* wc = p.w_conv + (size_t)l * 4096 + ch0;
    float4 a, b;
    a = *(const float4*)(wc); b = *(const float4*)(wc + 4);
    w0[0] = a.x; w0[1] = a.y; w0[2] = a.z; w0[3] = a.w; w0[4] = b.x; w0[5] = b.y; w0[6] = b.z; w0[7] = b.w;
    a = *(const float4*)(wc + 1024); b = *(const float4*)(wc + 1028);
    w1[0] = a.x; w1[1] = a.y; w1[2] = a.z; w1[3] = a.w; w1[4] = b.x; w1[5] = b.y; w1[6] = b.z; w1[7] = b.w;
    a = *(const float4*)(wc + 2048); b = *(const float4*)(wc + 2052);
    w2[0] = a.x; w2[1] = a.y; w2[2] = a.z; w2[3] = a.w; w2[4] = b.x; w2[5] = b.y; w2[6] = b.z; w2[7] = b.w;
    a = *(const float4*)(wc + 3072); b = *(const float4*)(wc + 3076);
    w3[0] = a.x; w3[1] = a.y; w3[2] = a.z; w3[3] = a.w; w3[4] = b.x; w3[5] = b.y; w3[6] = b.z; w3[7] = b.w;
    const float* bc = p.b_conv + (size_t)l * 1024 + ch0;
    a = *(const float4*)(bc); b = *(const float4*)(bc + 4);
    bias[0] = a.x; bias[1] = a.y; bias[2] = a.z; bias[3] = a.w; bias[4] = b.x; bias[5] = b.y; bias[6] = b.z; bias[7] = b.w;
  }
  float xa[8], xb[8], xc[8], xd[8];
  load_x8(p, l, ci, row0 - 3, col, xa);
  load_x8(p, l, ci, row0 - 2, col, xb);
  load_x8(p, l, ci, row0 - 1, col, xc);
  for (int t = row0; t < row0 + nrows; t++) {
    load_x8(p, l, ci, t, col, xd);
    float y[8];
#pragma unroll
    for (int j = 0; j < 8; j++) {
      float v = bias[j] + xa[j] * w0[j] + xb[j] * w1[j] + xc[j] * w2[j] + xd[j] * w3[j];
      y[j] = v * __builtin_amdgcn_rcpf(1.f + __expf(-v));
      xa[j] = xb[j]; xb[j] = xc[j]; xc[j] = xd[j];
    }
    emit(t, y);
  }
}
DI float logsigmoid(float z) { return fminf(z, 0.f) - log1pf(__expf(-fabsf(z))); }

DI void mlstm_m1(const Params& p, int l, int item, char* smem) {
  const ChunkInfo ci = chunk_info(item);
  const int tid = tidx(), lane = tid & 63, w = tid >> 6, r = lane & 31, h = lane >> 5;
  u16* sVt = (u16*)smem;
  u16* sKt = sVt + 128 * 72;
  float* swk = (float*)(sKt + 128 * 72);
  __syncthreads();
  if (w == 0) {
    const float* g = wsf(p, WS_GATES) + (size_t)(ci.tok0 + lane) * 8;
    float ig = g[ci.h] + p.b_igate[l * 4 + ci.h];
    float lf = logsigmoid(g[4 + ci.h] + p.b_fgate[l * 4 + ci.h]);
    float bcs = lf;
#pragma unroll
    for (int o = 1; o < 64; o <<= 1) { float t = __shfl_up(bcs, o); if (lane >= o) bcs += t; }
    float u = ig - bcs;
    float umax = wave_max(u);
    swk[lane] = __expf(u - umax);
    float blast = __shfl(bcs, 63);
    if (lane == 0) { float* sc = wsf(p, WS_SCAL) + (size_t)item * 2; sc[0] = blast; sc[1] = blast + umax; }
  }
#pragma unroll
  for (int it = 0; it < 4; it++) {
    int id = tid + 256 * it; int s = id >> 4, ch = id & 15;
    uint4 v = *(const uint4*)(wsb(p, WS_BIG + B_P) + (size_t)(ci.tok0 + s) * INC + 1440 + ci.h * 128 + ch * 8);
    const u16* vv = (const u16*)&v;
    unsigned a[4] = {v.x, v.y, v.z, v.w};
#pragma unroll
    for (int j = 0; j < 4; j++) { sVt[(ch * 8 + 2 * j) * 72 + s] = (u16)(a[j] & 0xffffu); sVt[(ch * 8 + 2 * j + 1) * 72 + s] = (u16)(a[j] >> 16); }
    (void)vv;
  }
  __syncthreads();
  {
    const int chunk = tid & 15, rg = tid >> 4;
    conv_run(p, l, ci, 1, chunk, rg * 4, 4, [&](int t, const float (&y)[8]) {
      float sc = 0.08838834764831845f * swk[t];
#pragma unroll
      for (int j = 0; j < 8; j++) sKt[(chunk * 8 + j) * 72 + t] = f2bf(y[j] * sc);
    });
  }
  __syncthreads();
  const int wm = w >> 1, wn = w & 1;
  f32x16 acc[2][2];
#pragma unroll
  for (int a = 0; a < 2; a++)
#pragma unroll
    for (int b = 0; b < 2; b++)
#pragma unroll
      for (int i = 0; i < 16; i++) acc[a][b][i] = 0.f;
#pragma unroll
  for (int ks = 0; ks < 4; ks++) {
    bf16x8 af[2], bfr[2];
#pragma unroll
    for (int tm = 0; tm < 2; tm++) af[tm] = *(const bf16x8*)(sVt + (wm * 64 + tm * 32 + r) * 72 + ks * 16 + h * 8);
#pragma unroll
    for (int tn = 0; tn < 2; tn++) bfr[tn] = *(const bf16x8*)(sKt + (wn * 64 + tn * 32 + r) * 72 + ks * 16 + h * 8);
#pragma unroll
    for (int tm = 0; tm < 2; tm++)
#pragma unroll
      for (int tn = 0; tn < 2; tn++) acc[tm][tn] = MFMA(bfr[tn], af[tm], acc[tm][tn]);
  }
  u16* slot = wsb(p, WS_BIG + B_ST) + (size_t)item * 16384;
#pragma unroll
  for (int tm = 0; tm < 2; tm++)
#pragma unroll
    for (int tn = 0; tn < 2; tn++)
#pragma unroll
      for (int g = 0; g < 4; g++) {
        uint2 v;
        v.x = pk2(acc[tm][tn][4 * g + 0], acc[tm][tn][4 * g + 1]);
        v.y = pk2(acc[tm][tn][4 * g + 2], acc[tm][tn][4 * g + 3]);
        *(uint2*)(slot + (wm * 64 + tm * 32 + r) * 128 + wn * 64 + tn * 32 + 8 * g + 4 * h) = v;
      }
  if (tid < 128) {
    float sum = 0.f;
    const u16* kr = sKt + tid * 72;
#pragma unroll 8
    for (int s = 0; s < 64; s++) sum += bf2f(kr[s]);
    wsf(p, WS_NU)[(size_t)item * 128 + tid] = sum;
  }
}

DI void mlstm_m2(const Params& p, int l, int unit, char* smem) {
  const int tid = tidx();
  int chain, g, nc, item0, b, h; bool sample;
  if (unit < 256) { chain = unit >> 5; g = unit & 31; nc = 256; item0 = chain * 256; b = chain >> 2; h = chain & 3; sample = false; }
  else { int u = unit - 256; int j = u >> 5; g = u & 31; chain = 8 + j; nc = 1; item0 = 2048 + j; b = j >> 2; h = j & 3; sample = true; }
  const int el = g * 512 + tid * 2; const int e = el >> 7, d = el & 127;
  float c0 = 0.f, c1 = 0.f, nst = 0.f, m0 = 0.f;
  const bool do_n = (g == 0 && tid < 128);
  if (sample) {
    const float* C0 = p.st_C + ((size_t)(l * 32 + b) * 4 + h) * 16384;
    c0 = C0[d * 128 + e]; c1 = C0[(d + 1) * 128 + e];
    if (do_n) nst = p.st_n[((size_t)(l * 32 + b) * 4 + h) * 128 + tid];
    m0 = p.st_m[(l * 32 + b) * 4 + h];
  }
  u16* slots = wsb(p, WS_BIG + B_ST);
  const float* scal = wsf(p, WS_SCAL);
  float* nu = wsf(p, WS_NU);
  float* mst = wsf(p, WS_MST);
  float* sA = (float*)smem; float* sC = sA + 256; float* sdec = sC + 256; float* sus = sdec + 256; float* smst = sus + 256;
  __syncthreads();
  if (tid < nc) { sA[tid] = scal[(size_t)(item0 + tid) * 2]; sC[tid] = scal[(size_t)(item0 + tid) * 2 + 1]; }
  __syncthreads();
  if (tid == 0) {
    float m = m0;
    for (int c = 0; c < nc; c++) {
      const float A = sA[c], Cm = sC[c];
      const float mnew = fmaxf(A + m, Cm);
      sdec[c] = __expf(A + m - mnew); sus[c] = __expf(Cm - mnew); smst[c] = m;
      m = mnew;
    }
    smst[256] = m;
  }
  __syncthreads();
  unsigned uu[8], un[8]; float nn[8], nx[8];
#pragma unroll
  for (int j = 0; j < 8; j++) {
    uu[j] = 0; nn[j] = 0.f;
    if (j < nc) {
      uu[j] = *(const unsigned*)(slots + (size_t)(item0 + j) * 16384 + el);
      if (do_n) nn[j] = nu[(size_t)(item0 + j) * 128 + tid];
    }
  }
  for (int cb = 0; cb < nc; cb += 8) {
#pragma unroll
    for (int j = 0; j < 8; j++) {
      un[j] = 0; nx[j] = 0.f;
      if (cb + 8 + j < nc) {
        un[j] = *(const unsigned*)(slots + (size_t)(item0 + cb + 8 + j) * 16384 + el);
        if (do_n) nx[j] = nu[(size_t)(item0 + cb + 8 + j) * 128 + tid];
      }
    }
#pragma unroll
    for (int j = 0; j < 8; j++) {
      if (cb + j < nc) {
        const int item = item0 + cb + j;
        const float dec = sdec[cb + j], us = sus[cb + j];
        *(unsigned*)(slots + (size_t)item * 16384 + el) = pk2(c0, c1);
        c0 = dec * c0 + us * bflo(uu[j]);
        c1 = dec * c1 + us * bfhi(uu[j]);
        if (do_n) { nu[(size_t)item * 128 + tid] = nst; nst = dec * nst + us * nn[j]; }
        if (g == 0 && tid == 0) mst[item] = smst[cb + j];
      }
    }
#pragma unroll
    for (int j = 0; j < 8; j++) { uu[j] = un[j]; nn[j] = nx[j]; }
  }
  float* oC = sample ? p.out + O_SC + ((size_t)(l * 32 + b) * 4 + h) * 16384 : p.out + O_PC + ((size_t)(l * 2 + b) * 4 + h) * 16384;
  oC[d * 128 + e] = c0; oC[(d + 1) * 128 + e] = c1;
  if (do_n) { float* on = sample ? p.out + O_SN + ((size_t)(l * 32 + b) * 4 + h) * 128 : p.out + O_PN + ((size_t)(l * 2 + b) * 4 + h) * 128; on[tid] = nst; }
  if (g == 0 && tid == 0) { float* om = sample ? p.out + O_SM + (l * 32 + b) * 4 + h : p.out + O_PM + (l * 2 + b) * 4 + h; *om = smst[256]; }
}

DI void mlstm_m3(const Params& p, int l, int item, char* smem) {
  const ChunkInfo ci = chunk_info(item);
  const int tid = tidx(), lane = tid & 63, w = tid >> 6, r = lane & 31, h = lane >> 5;
  u16* sQ = (u16*)smem;
  u16* sK = sQ + 64 * 136;
  u16* sVt = sK + 64 * 136;
  u16* sP = sVt + 128 * 72;
  float* su = (float*)(sP + 64 * 72);
  float* sM = su + 64;
  float* sa = sM + 64;
  float* sden = sa + 64;
  float* sinv = sden + 64;
  float* sn = sinv + 64;
  float* sH = (float*)smem;
  __syncthreads();
  const float m_start = wsf(p, WS_MST)[item];
  if (w == 0) {
    const float* g = wsf(p, WS_GATES) + (size_t)(ci.tok0 + lane) * 8;
    float ig = g[ci.h] + p.b_igate[l * 4 + ci.h];
    float lf = logsigmoid(g[4 + ci.h] + p.b_fgate[l * 4 + ci.h]);
    float bcs = lf;
#pragma unroll
    for (int o = 1; o < 64; o <<= 1) { float t = __shfl_up(bcs, o); if (lane >= o) bcs += t; }
    float u = ig - bcs;
    float cm = u;
#pragma unroll
    for (int o = 1; o < 64; o <<= 1) { float t = __shfl_up(cm, o); if (lane >= o) cm = fmaxf(cm, t); }
    float Mt = fmaxf(m_start, cm);
    su[lane] = u; sM[lane] = Mt; sa[lane] = __expf(m_start - Mt); sden[lane] = __expf(-(bcs + Mt));
  } else if (w == 1) {
    sn[lane] = wsf(p, WS_NU)[(size_t)item * 128 + lane];
    sn[lane + 64] = wsf(p, WS_NU)[(size_t)item * 128 + lane + 64];
  }
#pragma unroll
  for (int it = 0; it < 4; it++) {
    int id = tid + 256 * it; int s = id >> 4, ch = id & 15;
    uint4 v = *(const uint4*)(wsb(p, WS_BIG + B_P) + (size_t)(ci.tok0 + s) * INC + 1440 + ci.h * 128 + ch * 8);
    unsigned a[4] = {v.x, v.y, v.z, v.w};
#pragma unroll
    for (int j = 0; j < 4; j++) { sVt[(ch * 8 + 2 * j) * 72 + s] = (u16)(a[j] & 0xffffu); sVt[(ch * 8 + 2 * j + 1) * 72 + s] = (u16)(a[j] >> 16); }
  }
  {
    const int mc = tid & 31, mat = mc >> 4, chunk = mc & 15, rg = tid >> 5;
    u16* dst = mat ? sK : sQ;
    const float sc = mat ? 0.08838834764831845f : 1.f;
    conv_run(p, l, ci, mat, chunk, rg * 8, 8, [&](int t, const float (&y)[8]) {
      float x[8];
#pragma unroll
      for (int j = 0; j < 8; j++) x[j] = y[j] * sc;
      *(uint4*)(dst + t * 136 + chunk * 8) = pack8(x);
    });
  }
  __syncthreads();
  {
    const int tq = w >> 1, ts = w & 1;
    f32x16 s;
#pragma unroll
    for (int i = 0; i < 16; i++) s[i] = 0.f;
#pragma unroll
    for (int ks = 0; ks < 8; ks++) {
      bf16x8 a = *(const bf16x8*)(sQ + (tq * 32 + r) * 136 + ks * 16 + h * 8);
      bf16x8 b = *(const bf16x8*)(sK + (ts * 32 + r) * 136 + ks * 16 + h * 8);
      s = MFMA(a, b, s);
    }
    const int sidx = ts * 32 + r;
    const float us = su[sidx];
#pragma unroll
    for (int i = 0; i < 16; i++) {
      int t = tq * 32 + crow(i, h);
      float v = (sidx <= t) ? s[i] * __expf(us - sM[t]) : 0.f;
      sP[t * 72 + sidx] = f2bf(v);
    }
  }
  __syncthreads();
  if (tid < 64) {
    float rs = 0.f, qd = 0.f;
    const u16* pr = sP + tid * 72;
#pragma unroll 8
    for (int s = 0; s < 64; s++) rs += bf2f(pr[s]);
    const u16* qr = sQ + tid * 136;
#pragma unroll 8
    for (int d = 0; d < 128; d++) qd += bf2f(qr[d]) * sn[d];
    float qn = sa[tid] * qd + rs;
    sinv[tid] = __builtin_amdgcn_rcpf(fmaxf(fabsf(qn), sden[tid]));
  }
  const int tq = w & 1, eb = (w >> 1) * 2;
  f32x16 a1[2], a2[2];
#pragma unroll
  for (int et = 0; et < 2; et++)
#pragma unroll
    for (int i = 0; i < 16; i++) { a1[et][i] = 0.f; a2[et][i] = 0.f; }
  const u16* slot = wsb(p, WS_BIG + B_ST) + (size_t)item * 16384;
#pragma unroll
  for (int ks = 0; ks < 8; ks++) {
    bf16x8 a = *(const bf16x8*)(sQ + (tq * 32 + r) * 136 + ks * 16 + h * 8);
#pragma unroll
    for (int et = 0; et < 2; et++) {
      bf16x8 b = *(const bf16x8*)(slot + ((eb + et) * 32 + r) * 128 + ks * 16 + h * 8);
      a1[et] = MFMA(a, b, a1[et]);
    }
  }
#pragma unroll
  for (int ks = 0; ks < 4; ks++) {
    bf16x8 a = *(const bf16x8*)(sP + (tq * 32 + r) * 72 + ks * 16 + h * 8);
#pragma unroll
    for (int et = 0; et < 2; et++) {
      bf16x8 b = *(const bf16x8*)(sVt + ((eb + et) * 32 + r) * 72 + ks * 16 + h * 8);
      a2[et] = MFMA(a, b, a2[et]);
    }
  }
  __syncthreads();
#pragma unroll
  for (int et = 0; et < 2; et++)
#pragma unroll
    for (int i = 0; i < 16; i++) {
      int t = tq * 32 + crow(i, h);
      sH[t * 132 + (eb + et) * 32 + r] = (sa[t] * a1[et][i] + a2[et][i]) * sinv[t];
    }
  __syncthreads();
  {
    const int t = tid >> 2, part = tid & 3;
    const float* hr = sH + t * 132 + part * 32;
    float ss = 0.f;
#pragma unroll 8
    for (int j = 0; j < 32; j++) ss += hr[j] * hr[j];
    ss += __shfl_xor(ss, 1); ss += __shfl_xor(ss, 2);
    const float rr = rsqrtf(ss * (1.f / 128.f) + EPS);
    const int tok = ci.tok0 + t;
    const u16* og = wsb(p, WS_BIG + B_P) + (size_t)tok * INC + 1960 + ci.h * 128 + part * 32;
    const float* gm = p.g_mhead + (size_t)l * 512 + ci.h * 128 + part * 32;
    u16* o = actp(p) + (size_t)tok * LDA + 512 + ci.h * 128 + part * 32;
#pragma unroll
    for (int c8 = 0; c8 < 4; c8++) {
      float gv[8], x[8];
      unpack8(*(const uint4*)(og + c8 * 8), gv);
#pragma unroll
      for (int j = 0; j < 8; j++) x[j] = hr[c8 * 8 + j] * rr * gm[c8 * 8 + j] * __builtin_amdgcn_rcpf(1.f + __expf(-gv[j]));
      *(uint4*)(o + c8 * 8) = pack8(x);
    }
  }
}

DI void xkv_item(const Params& p, int l, int item, char* smem) {
  const int tid = tidx();
  const int kg = item & 3, hh = (item >> 2) & 3, bidx = item >> 4;
  u16* T = (u16*)smem;
  __syncthreads();
  const int key = tid >> 2, qt = tid & 3;
  const int mem = kg * 64 + key;
  const bool prompt = bidx < 2;
  float* kp; const float* vp;
  if (prompt) {
    kp = p.out + O_PMEMK + (((size_t)(l * 2 + bidx) * 256 + mem) * 4 + hh) * 256 + qt * 64;
    vp = p.out + O_PMEMV + (((size_t)(l * 2 + bidx) * 256 + mem) * 4 + hh) * 256 + qt * 64;
  } else {
    kp = (float*)(p.cache_mem_k + (((size_t)(l * 32 + bidx - 2) * 256 + mem) * 4 + hh) * 256 + qt * 64);
    vp = p.cache_mem_v + (((size_t)(l * 32 + bidx - 2) * 256 + mem) * 4 + hh) * 256 + qt * 64;
  }
  float rr = 1.f;
  if (prompt) {
    float ss = 0.f;
#pragma unroll 4
    for (int j = 0; j < 16; j++) { float4 v = *(const float4*)(kp + j * 4); ss += v.x * v.x + v.y * v.y + v.z * v.z + v.w * v.w; }
    ss += __shfl_xor(ss, 1); ss += __shfl_xor(ss, 2);
    rr = rsqrtf(ss * (1.f / 256.f) + EPS);
  }
  const float* gk = p.g_xk + l * 256 + qt * 64;
  const float* gq = p.g_xq + l * 256 + qt * 64;
  u16* xk = wsb(p, WS_BIG + B_XK) + ((size_t)(bidx * 4 + hh) * 256 + mem) * 256 + qt * 64;
#pragma unroll 2
  for (int c8 = 0; c8 < 8; c8++) {
    float4 a = *(const float4*)(kp + c8 * 8), b = *(const float4*)(kp + c8 * 8 + 4);
    float x[8] = {a.x, a.y, a.z, a.w, b.x, b.y, b.z, b.w};
    if (prompt) {
#pragma unroll
      for (int j = 0; j < 8; j++) x[j] = x[j] * rr * gk[c8 * 8 + j];
      *(float4*)(kp + c8 * 8) = make_float4(x[0], x[1], x[2], x[3]);
      *(float4*)(kp + c8 * 8 + 4) = make_float4(x[4], x[5], x[6], x[7]);
    }
#pragma unroll
    for (int j = 0; j < 8; j++) x[j] = x[j] * gq[c8 * 8 + j] * (0.0625f * LOG2E);
    *(uint4*)(xk + c8 * 8) = pack8(x);
    float4 va = *(const float4*)(vp + c8 * 8), vb = *(const float4*)(vp + c8 * 8 + 4);
    float y[8] = {va.x, va.y, va.z, va.w, vb.x, vb.y, vb.z, vb.w};
    *(uint4*)(T + key * 264 + qt * 64 + c8 * 8) = pack8(y);
  }
  __syncthreads();
  {
    const int e = tid;
    u16* xv = wsb(p, WS_BIG + B_XVT) + ((size_t)(bidx * 4 + hh) * 256 + e) * LDXV + kg * 64;
#pragma unroll 2
    for (int oct = 0; oct < 8; oct++) {
      uint4 v;
      const int kb = 16 * (oct >> 1) + 4 * (oct & 1);
      v.x = (unsigned)T[(kb + 0) * 264 + e] | ((unsigned)T[(kb + 1) * 264 + e] << 16);
      v.y = (unsigned)T[(kb + 2) * 264 + e] | ((unsigned)T[(kb + 3) * 264 + e] << 16);
      v.z = (unsigned)T[(kb + 8) * 264 + e] | ((unsigned)T[(kb + 9) * 264 + e] << 16);
      v.w = (unsigned)T[(kb + 10) * 264 + e] | ((unsigned)T[(kb + 11) * 264 + e] << 16);
      *(uint4*)(xv + oct * 8) = v;
    }
  }
}

DI void phase_C2(const Params& p, int l, char* smem) {
  for (int t = blockIdx.x; t < 544; t += gridDim.x) xkv_item(p, l, t, smem);
}
DI void phase_C1(const Params& p, int l, char* smem) {
  const int lane = tidx() & 63, w = tidx() >> 6;
  for (int t = blockIdx.x; t < NITEM; t += gridDim.x) mlstm_m1(p, l, t, smem);
  for (int t = blockIdx.x * 4 + w; t < NTOK + 32768; t += gridDim.x * 4) {
    if (t < NTOK) post_token(p, l, t, lane); else post_past(p, l, t - NTOK, lane);
  }
}

DI void phase_D(const Params& p, int l, char* smem) {
  const int n_scan = 256 + 4096;
  const int n_q = 544 * 4;
  const u16* W = wsb(p, WS_W) + (size_t)l * W_LAYER;
  for (int t = blockIdx.x; t < n_scan + n_q; t += gridDim.x) {
    if (t < n_scan) mlstm_m2(p, l, t, smem);
    else {
      int u = t - n_scan; int mt = u >> 2, nt = u & 3;
      EpiQ epi{wsb(p, WS_BIG + B_Q), wsf(p, WS_RQ), (const float2*)(p.ws + WS_ROPE), p.g_qnorm + l * 96};
      gemm_tile<1, 3>(wsb(p, WS_BIG + B_P), INC, W + W_Q, LDWQ, 256, mt * 64, nt * 192, smem, epi);
    }
  }
}

DI void phase_E(const Params& p, int l, char* smem) {
  for (int t = blockIdx.x; t < NITEM; t += gridDim.x) mlstm_m3(p, l, t, smem);
}

DI void phase_F(const Params& p, int l, char* smem) {
  const u16* W = wsb(p, WS_W) + (size_t)l * W_LAYER;
  for (int t = blockIdx.x; t < 528 * 8; t += gridDim.x) {
    int mt = t >> 3, nt = t & 7;
    EpiKV epi{wsb(p, WS_BIG + B_K), wsb(p, WS_BIG + B_VT), wsf(p, WS_KROPE), p.g_knorm + l * 96};
    gemm_tile<2, 2>(wsb(p, WS_CKV), 128, W + W_KV, LDWKV, 128, mt * 128, nt * 128, smem, epi);
  }
}

DI void phase_G(const Params& p, const Sched& sc, char* smem) {
  const int G = gridDim.x, j = blockIdx.x;
  const int lane = tidx() & 63, w = tidx() >> 6, r = lane & 31;
  const int NIT = 2048 + 256;
  const u16* qb = wsb(p, WS_BIG + B_Q);
  const u16* Kb = wsb(p, WS_BIG + B_K);
  const u16* Vt = wsb(p, WS_BIG + B_VT);
  u16* act = actp(p);
  auto run_prompt = [&](int bh, int bi) {
    int b = bh >> 3, hd = bh & 7;
    int tok = b * 16384 + bi * 128 + w * 32 + r;
    flash_item<96, 2, 64, true, false, true, true>(qb + (size_t)tok * 768 + hd * 96, true, 2 * bi + 2, 2 * bi + 1 + (w >> 1),
                                             Kb + ((size_t)hd * NROWS + b * 16384) * 96, 96, Vt + (size_t)hd * 64 * LDVT + b * 16384, LDVT, 0,
                                             act + (size_t)tok * LDA + hd * 64, smem);
  };
  auto run_sample = [&](int u) {
    int b = u >> 3, hd = u & 7;
    int tok = NP + b * 64 + (w & 1) * 32 + r;
    size_t row0 = (size_t)NP + b * 1088;
    flash_item<96, 2, 64, true, false, true, true>(qb + (size_t)tok * 768 + hd * 96, w < 2, 17, 17, Kb + ((size_t)hd * NROWS + row0) * 96, 96,
                                             Vt + (size_t)hd * 64 * LDVT + row0, LDVT, 0, act + (size_t)tok * LDA + hd * 64, smem);
  };
  if (sc.ok) {
    const int xg = sc.xg, xi = sc.xi;
    for (int pass = 0; pass < 2; pass++) {
      const int bh = xg + 8 * pass, b = bh >> 3, hd = bh & 7;
      const int bi = pass ? 63 - xi : xi;
      const int tok0 = b * 16384 + bi * 256 + w * 64;
      flash_item64(qb + (size_t)tok0 * 768 + hd * 96, 4 * bi + 4, 4 * bi + w + 1, Kb + ((size_t)hd * NROWS + b * 16384) * 96,
                   Vt + (size_t)hd * 64 * LDVT + b * 16384, act + (size_t)tok0 * LDA + hd * 64, smem);
    }
    if ((j & 1) == 0) run_sample(j >> 1);
  } else {
    for (int k = 0; k * G < NIT; k++) {
      int it = (k & 1) ? (k * G + (G - 1 - j)) : (k * G + j);
      if (it >= NIT) continue;
      if (it < 2048) run_prompt(it & 15, 127 - (it >> 4)); else run_sample(it - 2048);
    }
  }
}

DI void xattn_item(const u16* Qtile  , const u16* Kbase, const u16* Vtbase, u16* Otile, char* smem) {
  constexpr int LDQ = 264, LDV = 40;
  u16* sQ = (u16*)smem;
  u16* sK = sQ + 64 * LDQ;
  u16* sV = sK + 32 * LDQ;
  const int tid = tidx(), lane = tid & 63, w = tid >> 6, r = lane & 31, h = lane >> 5;
  const int qrow = 32 * (w & 1) + r, e0 = 128 * (w >> 1);
  u32x4 rk[4], rv[4];
  auto gload = [&](int t) {
#pragma unroll
    for (int i = 0; i < 4; i++) {
      int id = tid + 256 * i;
      rk[i] = *(const u32x4*)(Kbase + (long)(t * 32 + (id >> 5)) * 256 + (id & 31) * 8);
      rv[i] = *(const u32x4*)(Vtbase + (long)(id >> 2) * LDXV + t * 32 + (id & 3) * 8);
    }
  };
  auto sstore = [&]() {
#pragma unroll
    for (int i = 0; i < 4; i++) {
      int id = tid + 256 * i;
      *(u32x4*)(sK + (id >> 5) * LDQ + (id & 31) * 8) = rk[i];
      *(u32x4*)(sV + (id >> 2) * LDV + (id & 3) * 8) = rv[i];
    }
  };
  __syncthreads();
  gload(0);
#pragma unroll
  for (int i = 0; i < 8; i++) {
    int id = tid + 256 * i;
    *(u32x4*)(sQ + (id >> 5) * LDQ + (id & 31) * 8) = *(const u32x4*)(Qtile + (long)(id >> 5) * LDA + (id & 31) * 8);
  }
  sstore();
  __syncthreads();
  float rqs;
  {
    float ss = 0.f;
#pragma unroll
    for (int ks = 0; ks < 16; ks++) {
      bf16x8 qq = *(const bf16x8*)(sQ + qrow * LDQ + ks * 16 + h * 8);
#pragma unroll
      for (int j = 0; j < 8; j++) { float v = bf2f((u16)qq[j]); ss += v * v; }
    }
    ss = xhalf_sum(ss);
    rqs = rsqrtf(ss * (1.f / 256.f) + EPS);
  }
  const float rqinv = __builtin_amdgcn_rcpf(rqs);
  f32x16 o[4];
#pragma unroll
  for (int et = 0; et < 4; et++)
#pragma unroll
    for (int i = 0; i < 16; i++) o[et][i] = 0.f;
  float mrun = 0.f, lrun = 0.f;
  for (int t = 0; t < 8; t++) {
    if (t + 1 < 8) gload(t + 1);
    __builtin_amdgcn_sched_barrier(0);
    __builtin_amdgcn_s_setprio(1);
    {
      f32x16 s;
      const float sinit = -mrun * rqinv;
#pragma unroll
      for (int i = 0; i < 16; i++) s[i] = sinit;
#pragma unroll
      for (int ks = 0; ks < 16; ks++) {
        bf16x8 a = *(const bf16x8*)(sK + r * LDQ + ks * 16 + h * 8);
        bf16x8 b = *(const bf16x8*)(sQ + qrow * LDQ + ks * 16 + h * 8);
        s = MFMA(a, b, s);
      }
      float mx = -1e30f;
#pragma unroll
      for (int i = 0; i < 16; i++) { s[i] *= rqs; mx = fmaxf(mx, s[i]); }
      mx = xhalf_max(mx);
      if (__any(mx > 8.f)) {
        const float d = fmaxf(mx, 0.f);
        const float alpha = __builtin_amdgcn_exp2f(-d);
        mrun += d;
        lrun *= alpha;
#pragma unroll
        for (int et = 0; et < 4; et++)
#pragma unroll
          for (int i = 0; i < 16; i++) o[et][i] *= alpha;
#pragma unroll
        for (int i = 0; i < 16; i++) s[i] -= d;
      }
      float psum = 0.f;
#pragma unroll
      for (int i = 0; i < 16; i++) { float pv = __builtin_amdgcn_exp2f(s[i]); s[i] = pv; psum += pv; }
      lrun += psum;
#pragma unroll
      for (int st = 0; st < 2; st++) {
        uint4 pp;
        pp.x = pk2(s[8 * st + 0], s[8 * st + 1]); pp.y = pk2(s[8 * st + 2], s[8 * st + 3]);
        pp.z = pk2(s[8 * st + 4], s[8 * st + 5]); pp.w = pk2(s[8 * st + 6], s[8 * st + 7]);
        bf16x8 pb = __builtin_bit_cast(bf16x8, pp);
#pragma unroll
        for (int et = 0; et < 4; et++) {
          bf16x8 a = *(const bf16x8*)(sV + (e0 + et * 32 + r) * LDV + st * 16 + 8 * h);
          o[et] = MFMA(a, pb, o[et]);
        }
      }
    }
    __builtin_amdgcn_s_setprio(0);
    __builtin_amdgcn_sched_barrier(0);
    __syncthreads();
    if (t + 1 < 8) { sstore(); __syncthreads(); }
  }
  {
    float lt = xhalf_sum(lrun);
    float inv = __builtin_amdgcn_rcpf(lt);
    u16* Orow = Otile + (long)qrow * LDA + e0;
#pragma unroll
    for (int et = 0; et < 4; et++)
#pragma unroll
      for (int g = 0; g < 4; g++) {
        uint2 v;
        v.x = pk2(o[et][4 * g + 0] * inv, o[et][4 * g + 1] * inv);
        v.y = pk2(o[et][4 * g + 2] * inv, o[et][4 * g + 3] * inv);
        *(uint2*)(Orow + et * 32 + 8 * g + 4 * h) = v;
      }
  }
}

DI void phase_K(const Params& p, char* smem) {
  const int lane = tidx() & 63, w = tidx() >> 6, r = lane & 31;
  const u16* qx = wsb(p, WS_BIG + B_QX);
  u16* act = actp(p);
  for (int t = blockIdx.x; t < 2176; t += gridDim.x) {
    int bidx, hh, tok0;
    if (t < 2048) { bidx = t >> 10; hh = (t >> 8) & 3; tok0 = bidx * 16384 + (t & 255) * 64; }
    else { int u = t - 2048; bidx = 2 + (u >> 2); hh = u & 3; tok0 = NP + (u >> 2) * 64; }
    const u16* Kb = wsb(p, WS_BIG + B_XK) + (size_t)(bidx * 4 + hh) * 65536;
    const u16* Vt = wsb(p, WS_BIG + B_XVT) + (size_t)(bidx * 4 + hh) * 256 * LDXV;
    xattn_item(qx + (size_t)tok0 * LDA + hh * 256, Kb, Vt, act + (size_t)tok0 * LDA + hh * 256, smem);
  }
  (void)lane; (void)w; (void)r;
}

template <class Epi>
DI void phase_gemm128(const Sched& sc, const u16* A, long lda, const u16* Bt, long ldb, int K, int MT, int NT, int SN, char* smem, const Epi& epi) {
  if (sc.ok) {
    const int xg = sc.xg, xi = sc.xi;
    const int SM = 64 / SN;
    const int sng = NT / SN, smg = MT / SM;
    const int nst = smg * sng;
    const int left = nst & 7;
    const int nfull = (left > 0 && left <= 4) ? nst - left : nst;
    for (int st = xg; st < nfull; st += 8) {
      int sm = st / sng, sn = st % sng;
      int mt = sm * SM + xi / SN, nt = sn * SN + xi % SN;
      gemm_tile<2, 2>(A, lda, Bt, ldb, K, mt * 128, nt * 128, smem, epi);
    }
    if (nfull < nst) {
      const int q = xg * 64 + xi;
      if (q < left * 128) {
        const int tile = q >> 1, half = q & 1;
        const int st = nfull + (tile >> 6), t64 = tile & 63;
        int sm = st / sng, sn = st % sng;
        int mt = sm * SM + t64 / SN, nt = sn * SN + t64 % SN;
        gemm_tile<1, 2>(A, lda, Bt, ldb, K, mt * 128 + half * 64, nt * 128, smem, epi);
      }
    }
  } else {
    for (int t = blockIdx.x; t < MT * NT; t += gridDim.x) {
      int mt = t / NT, nt = t % NT;
      gemm_tile<2, 2>(A, lda, Bt, ldb, K, mt * 128, nt * 128, smem, epi);
    }
  }
}

#if defined(__HIP_DEVICE_COMPILE__)
typedef const __attribute__((address_space(4))) Params* KargPtr;
#define KARG_LOAD KargPtr pp4 = (KargPtr)__builtin_amdgcn_kernarg_segment_ptr(); asm volatile("" : "+s"(pp4)); const Params p = *pp4;
#else
#define KARG_LOAD const Params p{};
#endif
template <int L>
DI void run_layer(const Sched& sc, int ph_begin, int ph_end, char* smem, const XcdBarrier& xb) {
  const int base = 1 + 15 * L;
#define RUN_PHASE(S, ...)  RUN_PHASE_R(S, 1, __VA_ARGS__)
#define RUN_PHASE_R(S, R, ...)                                    \
  {                                                          \
    const int ph = base + (S);                               \
    if (ph >= ph_begin && ph < ph_end) {                     \
      for (int rep_ = 0; rep_ < (R); rep_++) {               \
        KARG_LOAD                                            \
        const u16* W = wsb(p, WS_W) + (size_t)L * W_LAYER;   \
        const float* xs0 = (L == 0) ? p.x_prompt : p.out;    \
        const float* xs1 = (L == 0) ? p.x_sample : p.out + (size_t)NP * 1024; \
        (void)W; (void)xs0; (void)xs1;                       \
        __VA_ARGS__;                                         \
        if (ph + 1 < ph_end) xcd_barrier(xb);                \
      }                                                      \
    }                                                        \
  }
  if (L > 0) RUN_PHASE(0, phase_norm(p, L))
  RUN_PHASE_R(1, REP_INPROJ, phase_inproj(p, sc, L, smem))
  RUN_PHASE_R(2, REP_C, { phase_C1(p, L, smem); phase_C2(p, L, smem); })
  RUN_PHASE(3, phase_D(p, L, smem))
  RUN_PHASE_R(4, REP_E, phase_E(p, L, smem))
  RUN_PHASE_R(5, REP_F, phase_F(p, L, smem))
  RUN_PHASE_R(6, REP_G, phase_G(p, sc, smem))
  RUN_PHASE(7, { EpiRes epi{xs0, xs1, (L == 0) ? (const u16*)nullptr : (const u16*)xres(p), xres(p), nullptr}; phase_gemm128(sc, actp(p), LDA, W + W_OUT, LDW, 1024, 272, 8, 8, smem, epi); })
  RUN_PHASE_R(8, REP_NORM, phase_norm(p, 1))
  RUN_PHASE(9, { EpiStoreBf16 epi{wsb(p, WS_BIG + B_QX), LDA, 1024, nullptr}; phase_gemm128(sc, actp(p), LDA, W + W_XQ, LDW, 1024, 272, 8, 8, smem, epi); })
  RUN_PHASE_R(10, REP_K, phase_K(p, smem))
  RUN_PHASE(11, { EpiRes epi{nullptr, nullptr, xres(p), xres(p), nullptr}; phase_gemm128(sc, actp(p), LDA, W + W_XO, LDW, 1024, 272, 8, 8, smem, epi); })
  RUN_PHASE(12, phase_norm(p, 1))
  RUN_PHASE_R(13, REP_FF1, { EpiRelu2 epi{wsb(p, WS_BIG + B_H1), LDH1}; phase_gemm128(sc, actp(p), LDA, W + W_FF1, LDW, 1024, 272, 32, 8, smem, epi); })
  RUN_PHASE(14, { EpiRes epi{nullptr, nullptr, xres(p), xres(p), (L == 1) ? p.out : (float*)nullptr}; phase_gemm128(sc, wsb(p, WS_BIG + B_H1), LDH1, W + W_FF2, LDW2, 4096, 272, 8, 8, smem, epi); })
#undef RUN_PHASE
#undef RUN_PHASE_R
}

__global__ void __launch_bounds__(256, 2) fwd_megakernel(Params p, int ph_begin, int ph_end) {
  __shared__ __attribute__((aligned(16))) char smem[SMEM_BYTES];
  cg::grid_group grid = cg::this_grid();
  __shared__ int s_rank;
  __shared__ __attribute__((aligned(16))) unsigned xb_words[4];
  if (tidx() < 4) xb_words[tidx()] = 0u;
  __syncthreads();
  const XcdBarrier xb = xcd_barrier_post((unsigned*)(p.ws + WS_BAR), (volatile LAS unsigned*)&xb_words);
  Sched sc;
  sc.xg = (int)((unsigned)__builtin_amdgcn_s_getreg((3 << 11) | 20) & 7u);
  unsigned* cnt = (unsigned*)(p.ws + WS_CNT);
  if (tidx() == 0) s_rank = (int)atomicAdd(&cnt[sc.xg], 1u);
  __syncthreads();
  sc.xi = __builtin_amdgcn_readfirstlane(s_rank);
  sc.ok = 0;
  if (ph_begin <= 0 && 0 < ph_end) {
    phase_prep(p, smem);
    if (ph_end < 0) grid.sync();
    if (1 < ph_end) xcd_barrier(xb);
  }
  {
    int ok = (gridDim.x == 512);
#pragma unroll
    for (int i = 0; i < 8; i++) ok &= (__atomic_load_n(&cnt[i], __ATOMIC_RELAXED) == 64u);
    sc.ok = ok;
  }
  run_layer<0>(sc, ph_begin, ph_end, smem, xb);
  run_layer<1>(sc, ph_begin, ph_end, smem, xb);
}

extern "C" void kernel_launch(void* const* d_in, const int* in_sizes, int n_in, void* d_out, int out_size, void* d_ws, size_t ws_size,
                              hipStream_t stream) {
  static int grid_blocks = 0;
  if (!grid_blocks) {
    int dev = 0, cus = 0, per_cu = 0;
    (void)hipGetDevice(&dev);
    (void)hipDeviceGetAttribute(&cus, hipDeviceAttributeMultiprocessorCount, dev);
    (void)hipOccupancyMaxActiveBlocksPerMultiprocessor(&per_cu, fwd_megakernel, 256, 0);
    per_cu = 2;
    grid_blocks = cus * per_cu;
  }
  Params p{};
  const float** pp = (const float**)&p;
  for (int i = 0; i < 36; i++) pp[i] = (const float*)d_in[i];
  p.out = (float*)d_out;
  p.ws = (char*)d_ws;
  int ph_begin = 0, ph_end = 31;
  (void)hipMemsetAsync((char*)d_ws + WS_CNT, 0, 256 + 16384, stream);
  void* args[] = {&p, &ph_begin, &ph_end};
  hipError_t e = hipLaunchCooperativeKernel((void*)fwd_megakernel, dim3(grid_blocks), dim3(256), args, 0, stream);
  if (e != hipSuccess) fprintf(stderr, "cooperative launch failed: %s (grid %d)\n", hipGetErrorString(e), grid_blocks);
}
```

```cpp
#include <hip/hip_runtime.h>
#include <hip/hip_cooperative_groups.h>
#include <stdint.h>
#include <stdio.h>
namespace cg = cooperative_groups;

typedef unsigned short u16;
typedef short bf16x8 __attribute__((ext_vector_type(8)));
typedef short s16x4 __attribute__((ext_vector_type(4)));
typedef float f32x16 __attribute__((ext_vector_type(16)));
typedef __bf16 bfv2 __attribute__((ext_vector_type(2)));
typedef float fv2 __attribute__((ext_vector_type(2)));
typedef unsigned u32x4 __attribute__((ext_vector_type(4)));
#define DI __device__ __forceinline__
#define MFMA(a, b, c) __builtin_amdgcn_mfma_f32_32x32x16_bf16((a), (b), (c), 0, 0, 0)

constexpr int NP = 32768;
constexpr int NS = 2048;
constexpr int NTOK = NP + NS;
constexpr int NROWS = NP + 32 * 1088;
constexpr int INC = 2472;
constexpr float EPS = 1e-6f;
constexpr float LOG2E = 1.4426950408889634f;
constexpr int NITEM = 2048 + 128;
constexpr int LDA = 1088;
constexpr int LDW = 1088;
constexpr int LDW2 = 4160;
constexpr int LDWQ = 320;
constexpr int LDWKV = 192;
constexpr int LDH1 = 4160;
constexpr int LDVT = NROWS + 64;
constexpr int LDXV = 320;

constexpr size_t O_Y = 0;
constexpr size_t O_PCKV = 35651584;
constexpr size_t O_PKROPE = O_PCKV + 8388608;
constexpr size_t O_PC = O_PKROPE + 2097152;
constexpr size_t O_PN = O_PC + 262144;
constexpr size_t O_PM = O_PN + 2048;
constexpr size_t O_PCONV = O_PM + 16;
constexpr size_t O_PMEMK = O_PCONV + 12288;
constexpr size_t O_PMEMV = O_PMEMK + 1048576;
constexpr size_t O_SCKV = O_PMEMV + 1048576;
constexpr size_t O_SKROPE = O_SCKV + 524288;
constexpr size_t O_SC = O_SKROPE + 131072;
constexpr size_t O_SN = O_SC + 4194304;
constexpr size_t O_SM = O_SN + 32768;
constexpr size_t O_SCONV = O_SM + 256;

constexpr size_t W_IN = 0;
constexpr size_t W_Q = W_IN + 2560 * LDW;
constexpr size_t W_KV = W_Q + 768 * LDWQ;
constexpr size_t W_OUT = W_KV + 1024 * LDWKV;
constexpr size_t W_XQ = W_OUT + 1024 * LDW;
constexpr size_t W_XK = W_XQ + 1024 * LDW;
constexpr size_t W_XV = W_XK + 1024 * LDW;
constexpr size_t W_XO = W_XV + 1024 * LDW;
constexpr size_t W_FF1 = W_XO + 1024 * LDW;
constexpr size_t W_FF2 = W_FF1 + 4096 * LDW;
constexpr size_t W_LAYER = W_FF2 + 1024 * LDW2;

constexpr size_t WS_W = 0;
constexpr size_t WS_ACT = WS_W + 2 * W_LAYER * 2;
constexpr size_t WS_CKV = WS_ACT + (size_t)NTOK * LDA * 2;
constexpr size_t WS_KROPE = WS_CKV + (size_t)NROWS * 128 * 2;
constexpr size_t WS_RQ = WS_KROPE + (size_t)NROWS * 32 * 4;
constexpr size_t WS_GATES = WS_RQ + (size_t)NTOK * 4;
constexpr size_t WS_ROPE = WS_GATES + (size_t)NTOK * 8 * 4;
constexpr size_t WS_SCAL = WS_ROPE + (size_t)16384 * 16 * 8;
constexpr size_t WS_MST = WS_SCAL + (size_t)NITEM * 2 * 4;
constexpr size_t WS_NU = WS_MST + (size_t)NITEM * 4 + 256;
constexpr size_t WS_CNT = WS_NU + (size_t)NITEM * 128 * 4;
constexpr size_t WS_BAR = WS_CNT + 256;
constexpr size_t WS_HM = WS_BAR + 16384;
constexpr size_t WS_BIG = WS_HM + (size_t)512 * LDA * 2;
constexpr size_t B_P = 0;
constexpr size_t B_K = 0;
constexpr size_t B_VT = B_K + (size_t)8 * NROWS * 96 * 2;
constexpr size_t B_Q = B_VT + (size_t)8 * 64 * LDVT * 2;
constexpr size_t B_ST = B_Q + (size_t)NTOK * 768 * 2;
constexpr size_t B_XK = B_ST + (size_t)NITEM * 16384 * 2;
constexpr size_t B_XVT = B_XK + (size_t)34 * 4 * 256 * 256 * 2;
constexpr size_t B_END = B_XVT + (size_t)34 * 4 * 256 * LDXV * 2;
constexpr size_t B_QX = 0;
constexpr size_t B_H1 = 0;
static_assert((size_t)NTOK * INC * 2 <= B_Q, "p overlaps q");
static_assert((size_t)NTOK * LDH1 * 2 <= B_XK, "h1 overlaps xkv");
static_assert((size_t)NTOK * LDA * 2 <= B_Q, "qx overlaps q");
static_assert(WS_BIG + B_END <= (size_t)536870912, "workspace too large");
static_assert(WS_BIG % 256 == 0 && B_Q % 256 == 0 && B_ST % 256 == 0 && B_VT % 256 == 0, "align");

constexpr int SMEM_BYTES = 73728;
#ifndef REP_INPROJ
#define REP_INPROJ 1
#endif
#ifndef REP_C
#define REP_C 1
#endif
#ifndef REP_E
#define REP_E 1
#endif
#ifndef REP_F
#define REP_F 1
#endif
#ifndef REP_G
#define REP_G 1
#endif
#ifndef REP_K
#define REP_K 1
#endif
#ifndef REP_FF1
#define REP_FF1 1
#endif
#ifndef REP_NORM
#define REP_NORM 1
#endif

struct Params {
  const float* x_prompt; const float* x_sample; const float* cache_ckv; const float* cache_krope;
  const float* st_C; const float* st_n; const float* st_m; const float* st_conv;
  const float* cache_mem_k; const float* cache_mem_v; const float* mem_prompt;
  const float* g_mix; const float* w_in; const float* g_qa; const float* w_q_up; const float* g_qnorm; const float* g_kva;
  const float* w_kv_up; const float* g_knorm; const float* w_conv; const float* b_conv; const float* b_igate; const float* b_fgate;
  const float* g_mhead; const float* w_out; const float* g_xattn; const float* g_mem; const float* w_xq; const float* w_xk; const float* w_xv;
  const float* g_xq; const float* g_xk; const float* w_xo; const float* g_mlp; const float* w_ff1; const float* w_ff2;
  float* out; char* ws;
};

#define XB_TMO      128
#define XB_XCNT(j)  (256  + 64 * (j))
#define XB_XSUB(j)  (1280 + 64 * (j))
#define XB_XGEN(j)  (2304 + 64 * (j))
#define XB_TOP      3328
#define XB_TOPGEN   3392
#define XCD_BAR_WORDS 3456
#define XB_SPIN_CAP (1u << 18)
#define LAS __attribute__((address_space(3)))

__device__ __forceinline__ unsigned xb_ld(unsigned* p)              { return __hip_atomic_load(p, __ATOMIC_RELAXED, __HIP_MEMORY_SCOPE_AGENT); }
__device__ __forceinline__ unsigned xb_add(unsigned* p, unsigned v) { return __hip_atomic_fetch_add(p, v, __ATOMIC_RELAXED, __HIP_MEMORY_SCOPE_AGENT); }
__device__ __forceinline__ unsigned xb_xcc_id() { return (unsigned)__builtin_amdgcn_s_getreg((3 << 11) | 20) & 0xFu; }
#define XB_SPIN(cond, bar) do { unsigned _sp = 0; while (cond) { __builtin_amdgcn_s_sleep(1); \
    if ((++_sp & 255u) == 0u) { if (xb_ld(&(bar)[XB_TMO])) break; if (_sp > XB_SPIN_CAP) { atomicAdd(&(bar)[XB_TMO], 1u); break; } } } } while (0)

struct XcdBarrier {
    unsigned* bar; unsigned x;
    volatile LAS unsigned* st;
};

__device__ __forceinline__ XcdBarrier xcd_barrier_post(unsigned* bar, volatile LAS unsigned* st) {
    XcdBarrier b; b.bar = bar; b.x = xb_xcc_id(); b.st = st;
    if (threadIdx.x == 0) (void)xb_add(&bar[XB_XCNT(b.x)], 1u);
    return b;
}
__device__ __forceinline__ void xcd_barrier_complete(unsigned* bar, unsigned x, unsigned& nloc, unsigned& nx) {
    const unsigned G = gridDim.x * gridDim.y * gridDim.z;
    unsigned sum, cnt, mine, sp = 0u;
    for (;;) {
        sum = 0u; cnt = 0u; mine = 0u;
#pragma unroll
        for (unsigned j = 0; j < 16; ++j) { const unsigned c = xb_ld(&bar[XB_XCNT(j)]); sum += c; cnt += (c > 0u) ? 1u : 0u; mine = (j == x) ? c : mine; }
        if (sum == G) break;
        __builtin_amdgcn_s_sleep(1);
        if ((++sp & 255u) == 0u) { if (xb_ld(&bar[XB_TMO])) break; if (sp > XB_SPIN_CAP) { atomicAdd(&bar[XB_TMO], 1u); break; } }
    }
    nloc = mine > 0u ? mine : 1u; nx = cnt > 0u ? cnt : 1u;
}

__device__ __forceinline__ void xcd_barrier(const XcdBarrier& b) {
    asm volatile("s_waitcnt vmcnt(0)" ::: "memory");
    __syncthreads();
    if (threadIdx.x == 0) {
        unsigned* bar = b.bar;
        __builtin_amdgcn_s_waitcnt(0);
        unsigned nloc = b.st[0], nx = b.st[1];
        if (nloc == 0u) { xcd_barrier_complete(bar, b.x, nloc, nx); b.st[0] = nloc; b.st[1] = nx; }
        const unsigned old = xb_add(&bar[XB_XSUB(b.x)], 1u);
        const unsigned gen = old / nloc;
        if (old + 1u == (gen + 1u) * nloc) {
            __builtin_amdgcn_fence(__ATOMIC_RELEASE, "agent");
            asm volatile("s_waitcnt vmcnt(0)" ::: "memory");
            const unsigned og = xb_add(&bar[XB_TOP], 1u);
            const unsigned tg = og / nx;
            if (og + 1u == (tg + 1u) * nx) xb_add(&bar[XB_TOPGEN], 1u);
            else XB_SPIN(xb_ld(&bar[XB_TOPGEN]) == tg, bar);
            __builtin_amdgcn_fence(__ATOMIC_ACQUIRE, "agent");
            xb_add(&bar[XB_XGEN(b.x)], 1u);
            asm volatile("s_waitcnt vmcnt(0)" ::: "memory");
        } else {
            XB_SPIN(xb_ld(&bar[XB_XGEN(b.x)]) == gen, bar);
            __builtin_amdgcn_fence(__ATOMIC_ACQUIRE, "agent");
            asm volatile("s_waitcnt vmcnt(0)" ::: "memory");
        }
    }
    __syncthreads();
}


struct Sched { int xg, xi, ok; };
DI int tidx() { int t = (int)threadIdx.x; asm volatile("" : "+v"(t)); return t; }
DI unsigned pk2(float a, float b) { fv2 v = {a, b}; bfv2 r = __builtin_convertvector(v, bfv2); return __builtin_bit_cast(unsigned, r); }
DI u16 f2bf(float a) { return (u16)(pk2(a, 0.f) & 0xffffu); }
DI float bf2f(u16 v) { return __uint_as_float(((unsigned)v) << 16); }
DI float bflo(unsigned v) { return __uint_as_float(v << 16); }
DI float bfhi(unsigned v) { return __uint_as_float(v & 0xffff0000u); }
DI int crow(int i, int h) { return (i & 3) + 8 * (i >> 2) + 4 * h; }
DI float xhalf_max(float v) {
  unsigned u = __float_as_uint(v);
  auto rr = __builtin_amdgcn_permlane32_swap(u, u, false, false);
  return fmaxf(__uint_as_float(rr[0]), __uint_as_float(rr[1]));
}
DI float xhalf_sum(float v) {
  unsigned u = __float_as_uint(v);
  auto rr = __builtin_amdgcn_permlane32_swap(u, u, false, false);
  return __uint_as_float(rr[0]) + __uint_as_float(rr[1]);
}
DI float wave_sum(float v) {
#pragma unroll
  for (int o = 32; o >= 1; o >>= 1) v += __shfl_xor(v, o);
  return v;
}
DI float wave_max(float v) {
#pragma unroll
  for (int o = 32; o >= 1; o >>= 1) v = fmaxf(v, __shfl_xor(v, o));
  return v;
}
DI void unpack8(uint4 v, float (&x)[8]) {
  x[0] = bflo(v.x); x[1] = bfhi(v.x); x[2] = bflo(v.y); x[3] = bfhi(v.y);
  x[4] = bflo(v.z); x[5] = bfhi(v.z); x[6] = bflo(v.w); x[7] = bfhi(v.w);
}
DI uint4 pack8(const float (&x)[8]) {
  uint4 v; v.x = pk2(x[0], x[1]); v.y = pk2(x[2], x[3]); v.z = pk2(x[4], x[5]); v.w = pk2(x[6], x[7]); return v;
}
DI u16* wsb(const Params& p, size_t off) { return (u16*)(p.ws + off); }
DI float* wsf(const Params& p, size_t off) { return (float*)(p.ws + off); }
DI u16* actp(const Params& p) { return (u16*)p.out; }
DI u16* xres(const Params& p) { return (u16*)(p.ws + WS_ACT); }
DI const float* xrow(const Params& p, int l, int tok) {
  if (l == 0) return tok < NP ? p.x_prompt + (size_t)tok * 1024 : p.x_sample + (size_t)(tok - NP) * 1024;
  return p.out + (size_t)tok * 1024;
}
DI int tok_pos(int tok) { return tok < NP ? (tok & 16383) : 1024 + ((tok - NP) & 63); }

template <int TM, int TN>
DI void gemm_mainloop(const u16* __restrict__ A, long lda, const u16* __restrict__ Bt, long ldb, int K, char* smem,
                      f32x16 (&acc)[TM][TN]) {
  constexpr int BM = 64 * TM, BN = 64 * TN, LD = 72;
  u16* sA = (u16*)smem;
  u16* sB = sA + 2 * BM * LD;
  const int tid = tidx(), lane = tid & 63, w = tid >> 6, r = lane & 31, h = lane >> 5;
  const int wm = w >> 1, wn = w & 1;
  constexpr int NA = BM / 32, NB = BN / 32;
  u32x4 ra[NA], rb[NB];
#pragma unroll
  for (int tm = 0; tm < TM; tm++)
#pragma unroll
    for (int tn = 0; tn < TN; tn++)
#pragma unroll
      for (int i = 0; i < 16; i++) acc[tm][tn][i] = 0.f;
  const int nk = K / 64;
  const int lrow = tid >> 3, lch = (tid & 7) * 8;
  const u16* gA = A + (long)lrow * lda + lch;
  const u16* gB = Bt + (long)lrow * ldb + lch;
  const int soff = lrow * LD + lch;
#define GEMM_GLOAD(k0)                                                                   \
  {                                                                                      \
    _Pragma("unroll") for (int i = 0; i < NA; i++) ra[i] = *(const u32x4*)(gA + (long)(32 * i) * lda + (k0)); \
    _Pragma("unroll") for (int i = 0; i < NB; i++) rb[i] = *(const u32x4*)(gB + (long)(32 * i) * ldb + (k0)); \
  }
#define GEMM_SSTORE(buf)                                                                 \
  {                                                                                      \
    _Pragma("unroll") for (int i = 0; i < NA; i++) *(u32x4*)(sA + (buf) * BM * LD + soff + 32 * i * LD) = ra[i]; \
    _Pragma("unroll") for (int i = 0; i < NB; i++) *(u32x4*)(sB + (buf) * BN * LD + soff + 32 * i * LD) = rb[i]; \
  }
  GEMM_GLOAD(0)
  __syncthreads();
  GEMM_SSTORE(0)
  if (nk > 1) GEMM_GLOAD(64)
  __syncthreads();
  for (int kt = 0; kt < nk; kt++) {
    const int buf = kt & 1;
    const u16* cA = sA + buf * BM * LD + (wm * 32 * TM + r) * LD + h * 8;
    const u16* cB = sB + buf * BN * LD + (wn * 32 * TN + r) * LD + h * 8;
    bf16x8 af[TM], bfr[TN];
#pragma unroll
    for (int tm = 0; tm < TM; tm++) af[tm] = *(const bf16x8*)(cA + tm * 32 * LD);
#pragma unroll
    for (int tn = 0; tn < TN; tn++) bfr[tn] = *(const bf16x8*)(cB + tn * 32 * LD);
    if (kt + 1 < nk) GEMM_SSTORE(buf ^ 1)
    __builtin_amdgcn_sched_barrier(0);
    __builtin_amdgcn_s_setprio(1);
#pragma unroll
    for (int tm = 0; tm < TM; tm++)
#pragma unroll
      for (int tn = 0; tn < TN; tn++) acc[tm][tn] = MFMA(af[tm], bfr[tn], acc[tm][tn]);
#pragma unroll
    for (int tm = 0; tm < TM; tm++) af[tm] = *(const bf16x8*)(cA + tm * 32 * LD + 16);
#pragma unroll
    for (int tn = 0; tn < TN; tn++) bfr[tn] = *(const bf16x8*)(cB + tn * 32 * LD + 16);
#pragma unroll
    for (int tm = 0; tm < TM; tm++)
#pragma unroll
      for (int tn = 0; tn < TN; tn++) acc[tm][tn] = MFMA(af[tm], bfr[tn], acc[tm][tn]);
    __builtin_amdgcn_sched_group_barrier(0x8, 4, 0);
    if (kt + 2 < nk) GEMM_GLOAD((kt + 2) * 64)
#pragma unroll
    for (int ks = 2; ks < 4; ks++) {
#pragma unroll
      for (int tm = 0; tm < TM; tm++) af[tm] = *(const bf16x8*)(cA + tm * 32 * LD + ks * 16);
#pragma unroll
      for (int tn = 0; tn < TN; tn++) bfr[tn] = *(const bf16x8*)(cB + tn * 32 * LD + ks * 16);
#pragma unroll
      for (int tm = 0; tm < TM; tm++)
#pragma unroll
        for (int tn = 0; tn < TN; tn++) acc[tm][tn] = MFMA(af[tm], bfr[tn], acc[tm][tn]);
    }
    __builtin_amdgcn_s_setprio(0);
    __syncthreads();
  }
#undef GEMM_GLOAD
#undef GEMM_SSTORE
}

template <int TM, int TN, class Epi>
DI void gemm_tile(const u16* A, long lda, const u16* Bt, long ldb, int K, int m0, int n0, char* smem, const Epi& epi) {
  constexpr int BM = 64 * TM, BN = 64 * TN, LDC = BN + Epi::PAD;
  f32x16 acc[TM][TN];
  gemm_mainloop<TM, TN>(A + (long)m0 * lda, lda, Bt + (long)n0 * ldb, ldb, K, smem, acc);
  const int tid = tidx(), lane = tid & 63, w = tid >> 6, r = lane & 31, h = lane >> 5;
  const int wm = w >> 1, wn = w & 1;
  float* Ct = (float*)smem;
#pragma unroll
  for (int tm = 0; tm < TM; tm++)
#pragma unroll
    for (int tn = 0; tn < TN; tn++)
#pragma unroll
      for (int i = 0; i < 16; i++)
        Ct[(wm * 32 * TM + tm * 32 + crow(i, h)) * LDC + wn * 32 * TN + tn * 32 + r] = acc[tm][tn][i];
  __syncthreads();
  epi(Ct, LDC, m0, n0, tid, BM);
  __syncthreads();
  (void)BM;
}

struct EpiStoreBf16 {
  static constexpr int PAD = 4;
  u16* out; long ldo; int nmax; float* gates;
  DI void operator()(const float* Ct, int ldc, int m0, int n0, int tid, int bm) const {
#pragma unroll 4
    for (int it = 0; it < bm / 16; it++) {
      int id = tid + 256 * it; int row = id >> 4, c8 = (id & 15) * 8;
      int n = n0 + c8;
      if (n < nmax) {
        const float* c = Ct + row * ldc + c8;
        float4 a = *(const float4*)c, b = *(const float4*)(c + 4);
        uint4 v; v.x = pk2(a.x, a.y); v.y = pk2(a.z, a.w); v.z = pk2(b.x, b.y); v.w = pk2(b.z, b.w);
        *(uint4*)(out + (long)(m0 + row) * ldo + n) = v;
        if (gates != nullptr && n == 1952) {
          float* g = gates + (long)(m0 + row) * 8;
          *(float4*)g = a; *(float4*)(g + 4) = b;
        }
      }
    }
  }
};
struct EpiRelu2 {
  static constexpr int PAD = 4;
  u16* out; long ldo;
  DI void operator()(const float* Ct, int ldc, int m0, int n0, int tid, int bm) const {
#pragma unroll 4
    for (int it = 0; it < bm / 16; it++) {
      int id = tid + 256 * it; int row = id >> 4, c8 = (id & 15) * 8;
      const float* c = Ct + row * ldc + c8;
      float x[8];
#pragma unroll
      for (int j = 0; j < 8; j++) { float v = fmaxf(c[j], 0.f); x[j] = v * v; }
      *(uint4*)(out + (long)(m0 + row) * ldo + n0 + c8) = pack8(x);
    }
  }
};
struct EpiF32 {
  static constexpr int PAD = 4;
  float* out; long ldo;
  DI void operator()(const float* Ct, int ldc, int m0, int n0, int tid, int bm) const {
#pragma unroll 4
    for (int it = 0; it < bm / 16; it++) {
      int id = tid + 256 * it; int row = id >> 4, c8 = (id & 15) * 8;
      const float* c = Ct + row * ldc + c8;
      float* o = out + (long)(m0 + row) * ldo + n0 + c8;
      *(float4*)o = *(const float4*)c; *(float4*)(o + 4) = *(const float4*)(c + 4);
    }
  }
};
struct EpiRes {
  static constexpr int PAD = 4;
  const float* src0; const float* src1;
  const u16* srcb; u16* dstb; float* dstf;
  DI void operator()(const float* Ct, int ldc, int m0, int n0, int tid, int bm) const {
#pragma unroll 4
    for (int it = 0; it < bm / 16; it++) {
      int id = tid + 256 * it; int row = id >> 4, c8 = (id & 15) * 8;
      int m = m0 + row;
      const float* c = Ct + row * ldc + c8;
      float4 a = *(const float4*)c, b = *(const float4*)(c + 4);
      float x[8];
      if (srcb != nullptr) {
        unpack8(*(const uint4*)(srcb + (size_t)m * LDA + n0 + c8), x);
      } else {
        const float* sp = (m < NP ? src0 + (size_t)m * 1024 : src1 + (size_t)(m - NP) * 1024) + n0 + c8;
        float4 sa = *(const float4*)sp, sb = *(const float4*)(sp + 4);
        x[0] = sa.x; x[1] = sa.y; x[2] = sa.z; x[3] = sa.w; x[4] = sb.x; x[5] = sb.y; x[6] = sb.z; x[7] = sb.w;
      }
      x[0] += a.x; x[1] += a.y; x[2] += a.z; x[3] += a.w; x[4] += b.x; x[5] += b.y; x[6] += b.z; x[7] += b.w;
      if (dstf != nullptr) {
        float* o = dstf + (size_t)m * 1024 + n0 + c8;
        *(float4*)o = make_float4(x[0], x[1], x[2], x[3]); *(float4*)(o + 4) = make_float4(x[4], x[5], x[6], x[7]);
      } else {
        *(uint4*)(dstb + (size_t)m * LDA + n0 + c8) = pack8(x);
      }
    }
  }
};
struct EpiQ {
  static constexpr int PAD = 1;
  u16* q; const float* rq; const float2* rope; const float* g;
  DI void operator()(const float* Ct, int ldc, int m0, int n0, int tid, int bm) const {
    float* r2s = (float*)((char*)Ct + 60000);
    {
      const int row = tid >> 2, hh = (tid >> 1) & 1, half = tid & 1; const int m = m0 + row;
      const float* c = Ct + row * ldc + hh * 96 + half * 48;
      float ss = 0.f;
#pragma unroll 8
      for (int d = 0; d < 48; d++) ss += c[d] * c[d];
      ss += __shfl_xor(ss, 1);
      const float rqv = rq[m];
      ss *= rqv * rqv;
      if (half == 0) r2s[row * 2 + hh] = rsqrtf(ss * (1.f / 96.f) + EPS) * rqv * (0.10206207261596575f * LOG2E);
    }
    __syncthreads();
#pragma unroll
    for (int it = 0; it < 6; it++) {
      const int id = tid + 256 * it; const int row = id / 24, cc = id % 24; const int hh = cc / 12, c8 = cc % 12;
      const int m = m0 + row;
      const float* c = Ct + row * ldc + hh * 96;
      const float r2 = r2s[row * 2 + hh];
      float x[8];
      if (c8 < 8) {
#pragma unroll
        for (int jj = 0; jj < 8; jj++) x[jj] = c[c8 * 8 + jj] * r2 * g[c8 * 8 + jj];
      } else {
        const int half = c8 & 1;
        const bool second = c8 >= 10;
        const float2* tab = rope + (size_t)tok_pos(m) * 16 + half * 8;
#pragma unroll
        for (int jj = 0; jj < 8; jj++) {
          const int i = half * 8 + jj;
          const float a = c[64 + i], b = c[80 + i]; const float2 cs = tab[jj];
          const float v = second ? (a * cs.y + b * cs.x) : (a * cs.x - b * cs.y);
          x[jj] = v * r2 * g[(second ? 80 : 64) + i];
        }
      }
      *(uint4*)(q + (size_t)m * 768 + n0 + cc * 8) = pack8(x);
    }
  }
};
struct EpiKV {
  static constexpr int PAD = 1;
  u16* Kb; u16* Vt; const float* krope; const float* g;
  DI void operator()(const float* Ct, int ldc, int m0, int n0, int tid, int bm) const {
    const int hd = n0 >> 7;
#pragma unroll
    for (int it = 0; it < 4; it++) {
      int id = tid + 256 * it; int oct = id & 15, e = id >> 4;
      float x[8];
#pragma unroll
      for (int j = 0; j < 8; j++) x[j] = Ct[(16 * (oct >> 1) + 4 * (oct & 1) + (j & 3) + 8 * (j >> 2)) * ldc + 64 + e];
      *(uint4*)(Vt + (size_t)(hd * 64 + e) * LDVT + m0 + oct * 8) = pack8(x);
    }
    float* rrs = (float*)((char*)Ct + 66560);
    {
      const int row = tid >> 1, half = tid & 1;
      const float* c = Ct + row * ldc + half * 32;
      const float* kr = krope + (size_t)(m0 + row) * 32 + half * 16;
      float ss = 0.f;
#pragma unroll 8
      for (int d = 0; d < 32; d++) ss += c[d] * c[d];
#pragma unroll 8
      for (int d = 0; d < 16; d++) ss += kr[d] * kr[d];
      ss += __shfl_xor(ss, 1);
      if (half == 0) rrs[row] = rsqrtf(ss * (1.f / 96.f) + EPS);
    }
    __syncthreads();
    u16* ob = Kb + ((size_t)hd * NROWS + m0) * 96;
#pragma unroll
    for (int it = 0; it < 6; it++) {
      const int id = tid + 256 * it; const int row = id / 12, cc = id % 12;
      const float rr = rrs[row];
      float x[8];
      if (cc < 8) {
        const float* c = Ct + row * ldc + cc * 8;
#pragma unroll
        for (int jj = 0; jj < 8; jj++) x[jj] = c[jj] * rr * g[cc * 8 + jj];
      } else {
        const float* kr = krope + (size_t)(m0 + row) * 32 + (cc - 8) * 8;
#pragma unroll
        for (int jj = 0; jj < 8; jj++) x[jj] = kr[jj] * rr * g[cc * 8 + jj];
      }
      *(uint4*)(ob + (size_t)id * 8) = pack8(x);
    }
  }
};

template <int DQK, int NE, int EV, bool DB, bool QNORM, bool QREG, bool VPERM = false>
DI void flash_item(const u16* Qrow, bool wave_active, int ntb, int ntw, const u16* Kbase, long ldk, const u16* Vtbase, long ldv,
                   int e0, u16* Orow, char* smem) {
  constexpr int LDK = DQK + 8, LDV = 72;
  constexpr int KS = DQK / 16;
  constexpr int KTILE = 64 * LDK, VTILE = EV * LDV;
  constexpr int NKC = 64 * (DQK / 8) / 256;
  constexpr int NVC = EV * 8 / 256;
  u16* sK = (u16*)smem;
  u16* sV = sK + (DB ? 2 : 1) * KTILE;
  const int tid = tidx(), lane = tid & 63, r = lane & 31, h = lane >> 5;
  bf16x8 qf[QREG ? KS : 1];
  float rqs = 1.f;
  if (wave_active) {
    if (QREG) {
#pragma unroll
      for (int ks = 0; ks < KS; ks++) qf[QREG ? ks : 0] = *(const bf16x8*)(Qrow + ks * 16 + h * 8);
    }
    if (QNORM) {
      float ss = 0.f;
#pragma unroll
      for (int ks = 0; ks < KS; ks++) {
        bf16x8 qq = QREG ? qf[QREG ? ks : 0] : *(const bf16x8*)(Qrow + ks * 16 + h * 8);
#pragma unroll
        for (int j = 0; j < 8; j++) { float v = bf2f((u16)qq[j]); ss += v * v; }
      }
      ss = xhalf_sum(ss);
      rqs = rsqrtf(ss * (1.f / DQK) + EPS);
    }
  } else if (QREG) {
#pragma unroll
    for (int ks = 0; ks < KS; ks++)
#pragma unroll
      for (int j = 0; j < 8; j++) qf[QREG ? ks : 0][j] = 0;
  }
  f32x16 o[NE];
#pragma unroll
  for (int et = 0; et < NE; et++)
#pragma unroll
    for (int i = 0; i < 16; i++) o[et][i] = 0.f;
  float mrun = 0.f, lrun = 0.f;
  const float rqinv = __builtin_amdgcn_rcpf(rqs);

  u32x4 rk[DB ? NKC : 1], rv[DB ? NVC : 1];
  auto gload = [&](int t) {
#pragma unroll
    for (int i = 0; i < NKC; i++) {
      int id = tid + 256 * i; int row = id / (DQK / 8), ch = id % (DQK / 8);
      u32x4 v = *(const u32x4*)(Kbase + (long)(t * 64 + row) * ldk + ch * 8);
      if (DB) rk[DB ? i : 0] = v; else *(u32x4*)(sK + row * LDK + ch * 8) = v;
    }
#pragma unroll
    for (int i = 0; i < NVC; i++) {
      int id = tid + 256 * i; int row = id >> 3, ch = id & 7;
      u32x4 v = *(const u32x4*)(Vtbase + (long)row * ldv + t * 64 + ch * 8);
      if (DB) rv[DB ? i : 0] = v; else *(u32x4*)(sV + row * LDV + ch * 8) = v;
    }
  };
  auto sstore = [&](int buf) {
#pragma unroll
    for (int i = 0; i < NKC; i++) { int id = tid + 256 * i; int row = id / (DQK / 8), ch = id % (DQK / 8); *(u32x4*)(sK + buf * KTILE + row * LDK + ch * 8) = rk[DB ? i : 0]; }
#pragma unroll
    for (int i = 0; i < NVC; i++) { int id = tid + 256 * i; int row = id >> 3, ch = id & 7; *(u32x4*)(sV + buf * VTILE + row * LDV + ch * 8) = rv[DB ? i : 0]; }
  };
  auto compute = [&](int buf) {
    const u16* cK = sK + buf * KTILE + r * LDK + h * 8;
    const u16* cV = sV + buf * VTILE + (e0 + r) * LDV + 4 * h;
    const float sinit = QNORM ? -mrun * rqinv : -mrun;
    f32x16 s[2];
#pragma unroll
    for (int sub = 0; sub < 2; sub++) {
#pragma unroll
      for (int i = 0; i < 16; i++) s[sub][i] = sinit;
#pragma unroll
      for (int ks = 0; ks < KS; ks++) {
        bf16x8 a = *(const bf16x8*)(cK + sub * 32 * LDK + ks * 16);
        bf16x8 qq = QREG ? qf[QREG ? ks : 0] : *(const bf16x8*)(Qrow + ks * 16 + h * 8);
        s[sub] = MFMA(a, qq, s[sub]);
      }
    }
    float mx = -1e30f;
#pragma unroll
    for (int sub = 0; sub < 2; sub++)
#pragma unroll
      for (int i = 0; i < 16; i++) { if (QNORM) s[sub][i] *= rqs; mx = fmaxf(mx, s[sub][i]); }
    mx = xhalf_max(mx);
    if (__any(mx > 8.f)) {
      const float d = fmaxf(mx, 0.f);
      const float alpha = __builtin_amdgcn_exp2f(-d);
      mrun += d;
      lrun *= alpha;
#pragma unroll
      for (int et = 0; et < NE; et++)
#pragma unroll
        for (int i = 0; i < 16; i++) o[et][i] *= alpha;
#pragma unroll
      for (int sub = 0; sub < 2; sub++)
#pragma unroll
        for (int i = 0; i < 16; i++) s[sub][i] -= d;
    }
    float psum = 0.f;
#pragma unroll
    for (int sub = 0; sub < 2; sub++)
#pragma unroll
      for (int i = 0; i < 16; i++) { float pv = __builtin_amdgcn_exp2f(s[sub][i]); s[sub][i] = pv; psum += pv; }
    lrun += psum;
#pragma unroll
    for (int sub = 0; sub < 2; sub++)
#pragma unroll
      for (int st = 0; st < 2; st++) {
        uint4 pp;
        pp.x = pk2(s[sub][8 * st + 0], s[sub][8 * st + 1]); pp.y = pk2(s[sub][8 * st + 2], s[sub][8 * st + 3]);
        pp.z = pk2(s[sub][8 * st + 4], s[sub][8 * st + 5]); pp.w = pk2(s[sub][8 * st + 6], s[sub][8 * st + 7]);
        bf16x8 pb = __builtin_bit_cast(bf16x8, pp);
#pragma unroll
        for (int et = 0; et < NE; et++) {
          bf16x8 a;
          if (VPERM) {
            a = *(const bf16x8*)(sV + buf * VTILE + (e0 + et * 32 + r) * LDV + sub * 32 + st * 16 + 8 * h);
          } else {
            const u16* vp = cV + et * 32 * LDV + sub * 32 + st * 16;
            s16x4 lo = *(const s16x4*)vp;
            s16x4 hi = *(const s16x4*)(vp + 8);
            a = __builtin_shufflevector(lo, hi, 0, 1, 2, 3, 4, 5, 6, 7);
          }
          o[et] = MFMA(a, pb, o[et]);
        }
      }
  };

  __syncthreads();
  if (DB) {
    gload(0);
    sstore(0);
    __syncthreads();
    for (int t = 0; t < ntb; t++) {
      const bool more = (t + 1 < ntb);
      if (more) gload(t + 1);
      __builtin_amdgcn_sched_barrier(0);
      if (wave_active && t < ntw) { __builtin_amdgcn_s_setprio(1); compute(t & 1); __builtin_amdgcn_s_setprio(0); }
      if (more) sstore((t + 1) & 1);
      __syncthreads();
    }
  } else {
    for (int t = 0; t < ntb; t++) {
      if (t > 0) __syncthreads();
      gload(t);
      __syncthreads();
      if (wave_active && t < ntw) compute(0);
    }
    __syncthreads();
  }
  if (wave_active) {
    float lt = xhalf_sum(lrun);
    float inv = __builtin_amdgcn_rcpf(lt);
#pragma unroll
    for (int et = 0; et < NE; et++)
#pragma unroll
      for (int g = 0; g < 4; g++) {
        uint2 v;
        v.x = pk2(o[et][4 * g + 0] * inv, o[et][4 * g + 1] * inv);
        v.y = pk2(o[et][4 * g + 2] * inv, o[et][4 * g + 3] * inv);
        *(uint2*)(Orow + et * 32 + 8 * g + 4 * h) = v;
      }
  }
}

DI void flash_item64(const u16* Qbase  , int ntb, int ntw, const u16* Kbase, const u16* Vtbase,
                     u16* Obase  , char* smem) {
  constexpr int LDK = 104, LDV = 72, KS = 6, KTILE = 64 * LDK, VTILE = 64 * LDV;
  u16* sK = (u16*)smem;
  u16* sV = sK + 2 * KTILE;
  const int tid = tidx(), lane = tid & 63, r = lane & 31, h = lane >> 5;
  bf16x8 qf[2][KS];
#pragma unroll
  for (int qh = 0; qh < 2; qh++)
#pragma unroll
    for (int ks = 0; ks < KS; ks++) qf[qh][ks] = *(const bf16x8*)(Qbase + (long)(qh * 32 + r) * 768 + ks * 16 + h * 8);
  f32x16 o[2][2];
#pragma unroll
  for (int qh = 0; qh < 2; qh++)
#pragma unroll
    for (int et = 0; et < 2; et++)
#pragma unroll
      for (int i = 0; i < 16; i++) o[qh][et][i] = 0.f;
  float mrun[2] = {0.f, 0.f}, lrun[2] = {0.f, 0.f};
  u32x4 rk[3], rv[2];
  auto gload = [&](int t) {
#pragma unroll
    for (int i = 0; i < 3; i++) { int id = tid + 256 * i; int row = id / 12, ch = id % 12; rk[i] = *(const u32x4*)(Kbase + (long)(t * 64 + row) * 96 + ch * 8); }
#pragma unroll
    for (int i = 0; i < 2; i++) { int id = tid + 256 * i; int row = id >> 3, ch = id & 7; rv[i] = *(const u32x4*)(Vtbase + (long)row * LDVT + t * 64 + ch * 8); }
  };
  auto sstore = [&](int buf) {
#pragma unroll
    for (int i = 0; i < 3; i++) { int id = tid + 256 * i; int row = id / 12, ch = id % 12; *(u32x4*)(sK + buf * KTILE + row * LDK + ch * 8) = rk[i]; }
#pragma unroll
    for (int i = 0; i < 2; i++) { int id = tid + 256 * i; int row = id >> 3, ch = id & 7; *(u32x4*)(sV + buf * VTILE + row * LDV + ch * 8) = rv[i]; }
  };
  auto compute = [&](int buf) {
    const u16* cK = sK + buf * KTILE + r * LDK + h * 8;
    const u16* cV = sV + buf * VTILE + r * LDV + 8 * h;
    f32x16 s[2][2];
#pragma unroll
    for (int sub = 0; sub < 2; sub++)
#pragma unroll
      for (int qh = 0; qh < 2; qh++)
#pragma unroll
        for (int i = 0; i < 16; i++) s[sub][qh][i] = -mrun[qh];
#pragma unroll
    for (int sub = 0; sub < 2; sub++)
#pragma unroll
      for (int ks = 0; ks < KS; ks++) {
        bf16x8 a = *(const bf16x8*)(cK + sub * 32 * LDK + ks * 16);
        s[sub][0] = MFMA(a, qf[0][ks], s[sub][0]);
        s[sub][1] = MFMA(a, qf[1][ks], s[sub][1]);
      }
#pragma unroll
    for (int qh = 0; qh < 2; qh++) {
      float mx = -1e30f;
#pragma unroll
      for (int sub = 0; sub < 2; sub++)
#pragma unroll
        for (int i = 0; i < 16; i++) mx = fmaxf(mx, s[sub][qh][i]);
      mx = xhalf_max(mx);
      if (__any(mx > 8.f)) {
        const float d = fmaxf(mx, 0.f);
        const float alpha = __builtin_amdgcn_exp2f(-d);
        mrun[qh] += d;
        lrun[qh] *= alpha;
#pragma unroll
        for (int et = 0; et < 2; et++)
#pragma unroll
          for (int i = 0; i < 16; i++) o[qh][et][i] *= alpha;
#pragma unroll
        for (int sub = 0; sub < 2; sub++)
#pragma unroll
          for (int i = 0; i < 16; i++) s[sub][qh][i] -= d;
      }
      float psum = 0.f;
#pragma unroll
      for (int sub = 0; sub < 2; sub++)
#pragma unroll
        for (int i = 0; i < 16; i++) { float pv = __builtin_amdgcn_exp2f(s[sub][qh][i]); s[sub][qh][i] = pv; psum += pv; }
      lrun[qh] += psum;
    }
#pragma unroll
    for (int sub = 0; sub < 2; sub++)
#pragma unroll
      for (int st = 0; st < 2; st++) {
        bf16x8 pb[2];
#pragma unroll
        for (int qh = 0; qh < 2; qh++) {
          uint4 pp;
          pp.x = pk2(s[sub][qh][8 * st + 0], s[sub][qh][8 * st + 1]); pp.y = pk2(s[sub][qh][8 * st + 2], s[sub][qh][8 * st + 3]);
          pp.z = pk2(s[sub][qh][8 * st + 4], s[sub][qh][8 * st + 5]); pp.w = pk2(s[sub][qh][8 * st + 6], s[sub][qh][8 * st + 7]);
          pb[qh] = __builtin_bit_cast(bf16x8, pp);
        }
#pragma unroll
        for (int et = 0; et < 2; et++) {
          bf16x8 a = *(const bf16x8*)(cV + et * 32 * LDV + sub * 32 + st * 16);
          o[0][et] = MFMA(a, pb[0], o[0][et]);
          o[1][et] = MFMA(a, pb[1], o[1][et]);
        }
      }
  };
  __syncthreads();
  gload(0);
  sstore(0);
  __syncthreads();
  for (int t = 0; t < ntb; t++) {
    const bool more = (t + 1 < ntb);
    if (more) gload(t + 1);
    __builtin_amdgcn_sched_barrier(0);
    if (t < ntw) { __builtin_amdgcn_s_setprio(1); compute(t & 1); __builtin_amdgcn_s_setprio(0); }
    if (more) sstore((t + 1) & 1);
    __syncthreads();
  }
#pragma unroll
  for (int qh = 0; qh < 2; qh++) {
    const float inv = __builtin_amdgcn_rcpf(xhalf_sum(lrun[qh]));
    u16* Orow = Obase + (long)(qh * 32 + r) * LDA;
#pragma unroll
    for (int et = 0; et < 2; et++)
#pragma unroll
      for (int g = 0; g < 4; g++) {
        uint2 v;
        v.x = pk2(o[qh][et][4 * g + 0] * inv, o[qh][et][4 * g + 1] * inv);
        v.y = pk2(o[qh][et][4 * g + 2] * inv, o[qh][et][4 * g + 3] * inv);
        *(uint2*)(Orow + et * 32 + 8 * g + 4 * h) = v;
      }
  }
}

DI void norm_row_wave(const float* src, u16* dst, int lane) {
  float4 v[4]; float ss = 0.f;
#pragma unroll
  for (int i = 0; i < 4; i++) { v[i] = *(const float4*)(src + i * 256 + lane * 4); ss += v[i].x * v[i].x + v[i].y * v[i].y + v[i].z * v[i].z + v[i].w * v[i].w; }
  ss = wave_sum(ss);
  float rr = rsqrtf(ss * (1.f / 1024.f) + EPS);
#pragma unroll
  for (int i = 0; i < 4; i++) {
    uint2 o; o.x = pk2(v[i].x * rr, v[i].y * rr); o.y = pk2(v[i].z * rr, v[i].w * rr);
    *(uint2*)(dst + i * 256 + lane * 4) = o;
  }
}

DI void phase_norm(const Params& p, int l) {
  const int lane = tidx() & 63, w = tidx() >> 6;
  u16* act = actp(p);
  if (l == 0) {
    for (int t = blockIdx.x * 4 + w; t < NTOK; t += gridDim.x * 4) norm_row_wave(xrow(p, 0, t), act + (size_t)t * LDA, lane);
  } else {
    const u16* xr = xres(p);
    for (int t = blockIdx.x * 4 + w; t < NTOK; t += gridDim.x * 4) {
      const u16* src = xr + (size_t)t * LDA + lane * 16;
      float x[16];
      { float a[8], b[8]; unpack8(*(const uint4*)src, a); unpack8(*(const uint4*)(src + 8), b);
#pragma unroll
        for (int j = 0; j < 8; j++) { x[j] = a[j]; x[8 + j] = b[j]; } }
      float ss = 0.f;
#pragma unroll
      for (int j = 0; j < 16; j++) ss += x[j] * x[j];
      ss = wave_sum(ss);
      const float rr = rsqrtf(ss * (1.f / 1024.f) + EPS);
      float y0[8], y1[8];
#pragma unroll
      for (int j = 0; j < 8; j++) { y0[j] = x[j] * rr; y1[j] = x[8 + j] * rr; }
      u16* dst = act + (size_t)t * LDA + lane * 16;
      *(uint4*)dst = pack8(y0); *(uint4*)(dst + 8) = pack8(y1);
    }
  }
}

DI void wtile(const float* src, const float* gain, int K, int N, u16* dst, int ldd, int k0, int n0, char* smem) {
  u16* T = (u16*)smem;
  const int tid = tidx();
  __syncthreads();
  {
    const int nn = tid & 63, kk0 = tid >> 6;
    const int n = n0 + nn;
#pragma unroll 4
    for (int i = 0; i < 16; i++) {
      int kk = kk0 + 4 * i;
      float v = 0.f;
      if (n < N) { v = src[(size_t)(k0 + kk) * N + n]; if (gain) v *= gain[k0 + kk]; }
      T[nn * 72 + kk] = f2bf(v);
    }
  }
  __syncthreads();
  {
    const int nn = tid >> 2, kq = tid & 3;
    const uint4* s = (const uint4*)(T + nn * 72 + kq * 16);
    uint4* d = (uint4*)(dst + (size_t)(n0 + nn) * ldd + k0 + kq * 16);
    d[0] = s[0]; d[1] = s[1];
  }
}

DI void phase_prep(const Params& p, char* smem) {
  const int tid = tidx(), lane = tid & 63, w = tid >> 6;
  for (int t = blockIdx.x; t < 2 * 4048; t += gridDim.x) {
    int l = t / 4048, u = t % 4048;
    const float* src; const float* gain = nullptr; int K, N, Npad; size_t doff; int ldd = LDW;
    if (u < 640) { src = p.w_in + (size_t)l * 1024 * INC; gain = p.g_mix + l * 1024; K = 1024; N = INC; Npad = 2560; doff = W_IN; }
    else if (u < 688) { u -= 640; src = p.w_q_up + (size_t)l * 256 * 768; gain = p.g_qa + l * 256; K = 256; N = 768; Npad = 768; doff = W_Q; ldd = LDWQ; }
    else if (u < 720) { u -= 688; src = p.w_kv_up + (size_t)l * 128 * 1024; K = 128; N = 1024; Npad = 1024; doff = W_KV; ldd = LDWKV; }
    else if (u < 976) { u -= 720; src = p.w_out + (size_t)l * 1048576; K = 1024; N = 1024; Npad = 1024; doff = W_OUT; }
    else if (u < 1232) { u -= 976; src = p.w_xq + (size_t)l * 1048576; gain = p.g_xattn + l * 1024; K = 1024; N = 1024; Npad = 1024; doff = W_XQ; }
    else if (u < 1488) { u -= 1232; src = p.w_xk + (size_t)l * 1048576; gain = p.g_mem + l * 1024; K = 1024; N = 1024; Npad = 1024; doff = W_XK; }
    else if (u < 1744) { u -= 1488; src = p.w_xv + (size_t)l * 1048576; gain = p.g_mem + l * 1024; K = 1024; N = 1024; Npad = 1024; doff = W_XV; }
    else if (u < 2000) { u -= 1744; src = p.w_xo + (size_t)l * 1048576; K = 1024; N = 1024; Npad = 1024; doff = W_XO; }
    else if (u < 3024) { u -= 2000; src = p.w_ff1 + (size_t)l * 4194304; gain = p.g_mlp + l * 1024; K = 1024; N = 4096; Npad = 4096; doff = W_FF1; }
    else { u -= 3024; src = p.w_ff2 + (size_t)l * 4194304; K = 4096; N = 1024; Npad = 1024; doff = W_FF2; ldd = LDW2; }
    int nt = Npad / 64;
    int kt = u / nt, ntile = u % nt;
    wtile(src, gain, K, N, wsb(p, WS_W) + (size_t)l * W_LAYER + doff, ldd, kt * 64, ntile * 64, smem);
  }
  float2* tab = (float2*)(p.ws + WS_ROPE);
  for (int t = blockIdx.x; t < 1024; t += gridDim.x) {
    int idx = t * 256 + tid; int pos = idx >> 4, i = idx & 15;
    float inv_freq = __builtin_amdgcn_exp2f(-(float)i * 0.830482023721841f);
    float ang = (float)pos * inv_freq;
    double rev = (double)ang * 0.15915494309189535;
    rev -= rint(rev);
    float fr = (float)rev;
    tab[idx] = make_float2(__builtin_amdgcn_cosf(fr), __builtin_amdgcn_sinf(fr));
  }
  u16* hm = wsb(p, WS_HM);
  for (int t = blockIdx.x * 4 + w; t < 512; t += gridDim.x * 4) norm_row_wave(p.mem_prompt + (size_t)t * 1024, hm + (size_t)t * LDA, lane);
  phase_norm(p, 0);
}

template <class Epi>
DI void phase_gemm128(const Sched& sc, const u16* A, long lda, const u16* Bt, long ldb, int K, int MT, int NT, int SN, char* smem, const Epi& epi);
DI void phase_inproj(const Params& p, const Sched& sc, int l, char* smem) {
  const u16* W = wsb(p, WS_W) + (size_t)l * W_LAYER;
  {
    EpiStoreBf16 epi{wsb(p, WS_BIG + B_P), INC, INC, wsf(p, WS_GATES)};
    phase_gemm128(sc, actp(p), LDA, W + W_IN, LDW, 1024, 272, 20, 4, smem, epi);
  }
  if (l == 0) {
    for (int u = blockIdx.x; u < 128; u += gridDim.x) {
      int l2 = u >> 6, which = (u >> 5) & 1, mt = (u >> 3) & 3, nt = u & 7;
      const u16* W2 = wsb(p, WS_W) + (size_t)l2 * W_LAYER + (which ? W_XV : W_XK);
      EpiF32 epi{p.out + (which ? O_PMEMV : O_PMEMK) + (size_t)l2 * 524288, 1024};
      gemm_tile<2, 2>(wsb(p, WS_HM), LDA, W2, LDW, 1024, mt * 128, nt * 128, smem, epi);
    }
  }
}

DI void post_token(const Params& p, int l, int tok, int lane) {
  const u16* pr = wsb(p, WS_BIG + B_P) + (size_t)tok * INC;
  {
    uint2 q4 = *(const uint2*)(pr + lane * 4);
    float a = bflo(q4.x), b = bfhi(q4.x), c = bflo(q4.y), d = bfhi(q4.y);
    float ss = wave_sum(a * a + b * b + c * c + d * d);
    if (lane == 0) wsf(p, WS_RQ)[tok] = rsqrtf(ss * (1.f / 256.f) + EPS);
  }
  const bool prompt = tok < NP;
  int b, s, row, pos; float* ckv_out; float* kr_out;
  if (prompt) {
    b = tok >> 14; s = tok & 16383; row = tok; pos = s;
    ckv_out = p.out + O_PCKV + ((size_t)(l * 2 + b) * 16384 + s) * 128;
    kr_out = p.out + O_PKROPE + ((size_t)(l * 2 + b) * 16384 + s) * 32;
  } else {
    int t2 = tok - NP; b = t2 >> 6; s = t2 & 63; row = NP + b * 1088 + 1024 + s; pos = 1024 + s;
    ckv_out = p.out + O_SCKV + ((size_t)(l * 32 + b) * 64 + s) * 128;
    kr_out = p.out + O_SKROPE + ((size_t)(l * 32 + b) * 64 + s) * 32;
  }
  {
    unsigned c2 = *(const unsigned*)(pr + 256 + lane * 2);
    float c0 = bflo(c2), c1 = bfhi(c2);
    float ss = wave_sum(c0 * c0 + c1 * c1);
    float rr = rsqrtf(ss * (1.f / 128.f) + EPS);
    float o0 = c0 * rr * p.g_kva[l * 128 + lane * 2], o1 = c1 * rr * p.g_kva[l * 128 + lane * 2 + 1];
    *(float2*)(ckv_out + lane * 2) = make_float2(o0, o1);
    *(unsigned*)(wsb(p, WS_CKV) + (size_t)row * 128 + lane * 2) = pk2(o0, o1);
  }
  if (lane < 16) {
    float x1 = bf2f(pr[384 + lane]), x2 = bf2f(pr[400 + lane]);
    float2 cs = ((const float2*)(p.ws + WS_ROPE))[(size_t)pos * 16 + lane];
    float o1 = x1 * cs.x - x2 * cs.y, o2 = x1 * cs.y + x2 * cs.x;
    kr_out[lane] = o1; kr_out[16 + lane] = o2;
    float* ka = wsf(p, WS_KROPE) + (size_t)row * 32;
    ka[lane] = o1; ka[16 + lane] = o2;
  }
  const int S = prompt ? 16384 : 64;
  if (s >= S - 3) {
    int j = s - (S - 3);
    float* dst = prompt ? p.out + O_PCONV + ((size_t)(l * 2 + b) * 3 + j) * 1024 : p.out + O_SCONV + ((size_t)(l * 32 + b) * 3 + j) * 1024;
#pragma unroll 4
    for (int i = 0; i < 16; i++) dst[lane + 64 * i] = bf2f(pr[416 + lane + 64 * i]);
  }
}

DI void post_past(const Params& p, int l, int pi, int lane) {
  int b = pi >> 10, t = pi & 1023;
  size_t row = (size_t)NP + b * 1088 + t;
  const float* src = p.cache_ckv + ((size_t)(l * 32 + b) * 1024 + t) * 128;
  float2 v = *(const float2*)(src + lane * 2);
  *(unsigned*)(wsb(p, WS_CKV) + row * 128 + lane * 2) = pk2(v.x, v.y);
  if (lane < 32) wsf(p, WS_KROPE)[row * 32 + lane] = p.cache_krope[((size_t)(l * 32 + b) * 1024 + t) * 32 + lane];
}

struct ChunkInfo { int tok0, b, h, chain, has_prev, sample; };
DI ChunkInfo chunk_info(int item) {
  ChunkInfo ci;
  if (item < 2048) {
    ci.chain = item >> 8; ci.b = ci.chain >> 2; ci.h = ci.chain & 3; int c = item & 255;
    ci.tok0 = ci.b * 16384 + c * 64; ci.has_prev = (c > 0); ci.sample = 0;
  } else {
    int j = item - 2048; ci.chain = 8 + j; ci.b = j >> 2; ci.h = j & 3; ci.tok0 = NP + ci.b * 64; ci.has_prev = 0; ci.sample = 1;
  }
  return ci;
}
DI void load_x8(const Params& p, int l, const ChunkInfo& ci, int tp, int col, float (&x)[8]) {
  if (tp >= 0 || ci.has_prev) {
    uint4 v = *(const uint4*)(wsb(p, WS_BIG + B_P) + (size_t)(ci.tok0 + tp) * INC + col);
    unpack8(v, x);
  } else if (ci.sample) {
    const float* s = p.st_conv + (((size_t)l * 32 + ci.b) * 3 + (3 + tp)) * 1024 + (col - 416);
    float4 a = *(const float4*)s, b = *(const float4*)(s + 4);
    x[0] = a.x; x[1] = a.y; x[2] = a.z; x[3] = a.w; x[4] = b.x; x[5] = b.y; x[6] = b.z; x[7] = b.w;
  } else {
#pragma unroll
    for (int j = 0; j < 8; j++) x[j] = 0.f;
  }
}
template <class Emit>
DI void conv_run(const Params& p, int l, const ChunkInfo& ci, int mat, int chunk, int row0, int nrows, Emit emit) {
  const int ch0 = mat * 512 + ci.h * 128 + chunk * 8;
  const int col = 416 + ch0;
  float w0[8], w1[8], w2[8], w3[8], bias[8];
  {
    const float* wc = p.w_conv + (size_t)l * 4096 + ch0;
    float4 a, b;
    a = *(const float4*)(wc); b = *(const float4*)(wc + 4);
    w0[0] = a.x; w0[1] = a.y; w0[2] = a.z; w0[3] = a.w; w0[4] = b.x; w0[5] = b.y; w0[6] = b.z; w0[7] = b.w;
    a = *(const float4*)(wc + 1024); b = *(const float4*)(wc + 1028);
    w1[0] = a.x; w1[1] = a.y; w1[2] = a.z; w1[3] = a.w; w1[4] = b.x; w1[5] = b.y; w1[6] = b.z; w1[7] = b.w;
    a = *(const float4*)(wc + 2048); b = *(const float4*)(wc + 2052);
    w2[0] = a.x; w2[1] = a.y; w2[2] = a.z; w2[3] = a.w; w2[4] = b.x; w2[5] = b.y; w2[6] = b.z; w2[7] = b.w;
    a = *(const float4*)(wc + 3072); b = *(const float4*)(wc + 3076);
    w3[0] = a.x; w3[1] = a.y; w3[2] = a.z; w3[3] = a.w; w3[4] = b.x; w3[5] = b.y; w3[6] = b.z; w3[7] = b.w;
    const float* bc = p.b_conv + (size_t)l * 1024 + ch0;
    a = *(const float4*)(bc); b = *(const float4*)(bc + 4);
    bias[0] = a.x; bias[1] = a.y; bias[2] = a.z; bias[3] = a.w; bias[4] = b.x; bias[5] = b.y; bias[6] = b.z; bias[7] = b.w;
  }
  float xa[8], xb[8], xc[8], xd[8];
  load_x8(p, l, ci, row0 - 3, col, xa);
  load_x8(p, l, ci, row0 - 2, col, xb);
  load_x8(p, l, ci, row0 - 1, col, xc);
  for (int t = row0; t < row0 + nrows; t++) {
    load_x8(p, l, ci, t, col, xd);
    float y[8];
#pragma unroll
    for (int j = 0; j < 8; j++) {
      float v = bias[j] + xa[j] * w0[j] + xb[j] * w1[j] + xc[j] * w2[j] + xd[j] * w3[j];
      y[j] = v * __builtin_amdgcn_rcpf(1.f + __expf(-v));
      xa[j] = xb[j]; xb[j] = xc[j]; xc[j] = xd[j];
    }
    emit(t, y);
  }
}
DI float logsigmoid(float z) { return fminf(z, 0.f) - log1pf(__expf(-fabsf(z))); }

DI void mlstm_m1(const Params& p, int l, int item, char* smem) {
  const ChunkInfo ci = chunk_info(item);
  const int tid = tidx(), lane = tid & 63, w = tid >> 6, r = lane & 31, h = lane >> 5;
  u16* sVt = (u16*)smem;
  u16* sKt = sVt + 128 * 72;
  float* swk = (float*)(sKt + 128 * 72);
  __syncthreads();
  if (w == 0) {
    const float* g = wsf(p, WS_GATES) + (size_t)(ci.tok0 + lane) * 8;
    float ig = g[ci.h] + p.b_igate[l * 4 + ci.h];
    float lf = logsigmoid(g[4 + ci.h] + p.b_fgate[l * 4 + ci.h]);
    float bcs = lf;
#pragma unroll
    for (int o = 1; o < 64; o <<= 1) { float t = __shfl_up(bcs, o); if (lane >= o) bcs += t; }
    float u = ig - bcs;
    float umax = wave_max(u);
    swk[lane] = __expf(u - umax);
    float blast = __shfl(bcs, 63);
    if (lane == 0) { float* sc = wsf(p, WS_SCAL) + (size_t)item * 2; sc[0] = blast; sc[1] = blast + umax; }
  }
#pragma unroll
  for (int it = 0; it < 4; it++) {
    int id = tid + 256 * it; int s = id >> 4, ch = id & 15;
    uint4 v = *(const uint4*)(wsb(p, WS_BIG + B_P) + (size_t)(ci.tok0 + s) * INC + 1440 + ci.h * 128 + ch * 8);
    const u16* vv = (const u16*)&v;
    unsigned a[4] = {v.x, v.y, v.z, v.w};
#pragma unroll
    for (int j = 0; j < 4; j++) { sVt[(ch * 8 + 2 * j) * 72 + s] = (u16)(a[j] & 0xffffu); sVt[(ch * 8 + 2 * j + 1) * 72 + s] = (u16)(a[j] >> 16); }
    (void)vv;
  }
  __syncthreads();
  {
    const int chunk = tid & 15, rg = tid >> 4;
    conv_run(p, l, ci, 1, chunk, rg * 4, 4, [&](int t, const float (&y)[8]) {
      float sc = 0.08838834764831845f * swk[t];
#pragma unroll
      for (int j = 0; j < 8; j++) sKt[(chunk * 8 + j) * 72 + t] = f2bf(y[j] * sc);
    });
  }
  __syncthreads();
  const int wm = w >> 1, wn = w & 1;
  f32x16 acc[2][2];
#pragma unroll
  for (int a = 0; a < 2; a++)
#pragma unroll
    for (int b = 0; b < 2; b++)
#pragma unroll
      for (int i = 0; i < 16; i++) acc[a][b][i] = 0.f;
#pragma unroll
  for (int ks = 0; ks < 4; ks++) {
    bf16x8 af[2], bfr[2];
#pragma unroll
    for (int tm = 0; tm < 2; tm++) af[tm] = *(const bf16x8*)(sVt + (wm * 64 + tm * 32 + r) * 72 + ks * 16 + h * 8);
#pragma unroll
    for (int tn = 0; tn < 2; tn++) bfr[tn] = *(const bf16x8*)(sKt + (wn * 64 + tn * 32 + r) * 72 + ks * 16 + h * 8);
#pragma unroll
    for (int tm = 0; tm < 2; tm++)
#pragma unroll
      for (int tn = 0; tn < 2; tn++) acc[tm][tn] = MFMA(bfr[tn], af[tm], acc[tm][tn]);
  }
  u16* slot = wsb(p, WS_BIG + B_ST) + (size_t)item * 16384;
#pragma unroll
  for (int tm = 0; tm < 2; tm++)
#pragma unroll
    for (int tn = 0; tn < 2; tn++)
#pragma unroll
      for (int g = 0; g < 4; g++) {
        uint2 v;
        v.x = pk2(acc[tm][tn][4 * g + 0], acc[tm][tn][4 * g + 1]);
        v.y = pk2(acc[tm][tn][4 * g + 2], acc[tm][tn][4 * g + 3]);
        *(uint2*)(slot + (wm * 64 + tm * 32 + r) * 128 + wn * 64 + tn * 32 + 8 * g + 4 * h) = v;
      }
  if (tid < 128) {
    float sum = 0.f;
    const u16* kr = sKt + tid * 72;
#pragma unroll 8
    for (int s = 0; s < 64; s++) sum += bf2f(kr[s]);
    wsf(p, WS_NU)[(size_t)item * 128 + tid] = sum;
  }
}

DI void mlstm_m2(const Params& p, int l, int unit, char* smem) {
  const int tid = tidx();
  int chain, g, nc, item0, b, h; bool sample;
  if (unit < 256) { chain = unit >> 5; g = unit & 31; nc = 256; item0 = chain * 256; b = chain >> 2; h = chain & 3; sample = false; }
  else { int u = unit - 256; int j = u >> 5; g = u & 31; chain = 8 + j; nc = 1; item0 = 2048 + j; b = j >> 2; h = j & 3; sample = true; }
  const int el = g * 512 + tid * 2; const int e = el >> 7, d = el & 127;
  float c0 = 0.f, c1 = 0.f, nst = 0.f, m0 = 0.f;
  const bool do_n = (g == 0 && tid < 128);
  if (sample) {
    const float* C0 = p.st_C + ((size_t)(l * 32 + b) * 4 + h) * 16384;
    c0 = C0[d * 128 + e]; c1 = C0[(d + 1) * 128 + e];
    if (do_n) nst = p.st_n[((size_t)(l * 32 + b) * 4 + h) * 128 + tid];
    m0 = p.st_m[(l * 32 + b) * 4 + h];
  }
  u16* slots = wsb(p, WS_BIG + B_ST);
  const float* scal = wsf(p, WS_SCAL);
  float* nu = wsf(p, WS_NU);
  float* mst = wsf(p, WS_MST);
  float* sA = (float*)smem; float* sC = sA + 256; float* sdec = sC + 256; float* sus = sdec + 256; float* smst = sus + 256;
  __syncthreads();
  if (tid < nc) { sA[tid] = scal[(size_t)(item0 + tid) * 2]; sC[tid] = scal[(size_t)(item0 + tid) * 2 + 1]; }
  __syncthreads();
  if (tid == 0) {
    float m = m0;
    for (int c = 0; c < nc; c++) {
      const float A = sA[c], Cm = sC[c];
      const float mnew = fmaxf(A + m, Cm);
      sdec[c] = __expf(A + m - mnew); sus[c] = __expf(Cm - mnew); smst[c] = m;
      m = mnew;
    }
    smst[256] = m;
  }
  __syncthreads();
  unsigned uu[8], un[8]; float nn[8], nx[8];
#pragma unroll
  for (int j = 0; j < 8; j++) {
    uu[j] = 0; nn[j] = 0.f;
    if (j < nc) {
      uu[j] = *(const unsigned*)(slots + (size_t)(item0 + j) * 16384 + el);
      if (do_n) nn[j] = nu[(size_t)(item0 + j) * 128 + tid];
    }
  }
  for (int cb = 0; cb < nc; cb += 8) {
#pragma unroll
    for (int j = 0; j < 8; j++) {
      un[j] = 0; nx[j] = 0.f;
      if (cb + 8 + j < nc) {
        un[j] = *(const unsigned*)(slots + (size_t)(item0 + cb + 8 + j) * 16384 + el);
        if (do_n) nx[j] = nu[(size_t)(item0 + cb + 8 + j) * 128 + tid];
      }
    }
#pragma unroll
    for (int j = 0; j < 8; j++) {
      if (cb + j < nc) {
        const int item = item0 + cb + j;
        const float dec = sdec[cb + j], us = sus[cb + j];
        *(unsigned*)(slots + (size_t)item * 16384 + el) = pk2(c0, c1);
        c0 = dec * c0 + us * bflo(uu[j]);
        c1 = dec * c1 + us * bfhi(uu[j]);
        if (do_n) { nu[(size_t)item * 128 + tid] = nst; nst = dec * nst + us * nn[j]; }
        if (g == 0 && tid == 0) mst[item] = smst[cb + j];
      }
    }
#pragma unroll
    for (int j = 0; j < 8; j++) { uu[j] = un[j]; nn[j] = nx[j]; }
  }
  float* oC = sample ? p.out + O_SC + ((size_t)(l * 32 + b) * 4 + h) * 16384 : p.out + O_PC + ((size_t)(l * 2 + b) * 4 + h) * 16384;
  oC[d * 128 + e] = c0; oC[(d + 1) * 128 + e] = c1;
  if (do_n) { float* on = sample ? p.out + O_SN + ((size_t)(l * 32 + b) * 4 + h) * 128 : p.out + O_PN + ((size_t)(l * 2 + b) * 4 + h) * 128; on[tid] = nst; }
  if (g == 0 && tid == 0) { float* om = sample ? p.out + O_SM + (l * 32 + b) * 4 + h : p.out + O_PM + (l * 2 + b) * 4 + h; *om = smst[256]; }
}

DI void mlstm_m3(const Params& p, int l, int item, char* smem) {
  const ChunkInfo ci = chunk_info(item);
  const int tid = tidx(), lane = tid & 63, w = tid >> 6, r = lane & 31, h = lane >> 5;
  u16* sQ = (u16*)smem;
  u16* sK = sQ + 64 * 136;
  u16* sVt = sK + 64 * 136;
  u16* sP = sVt + 128 * 72;
  float* su = (float*)(sP + 64 * 72);
  float* sM = su + 64;
  float* sa = sM + 64;
  float* sden = sa + 64;
  float* sinv = sden + 64;
  float* sn = sinv + 64;
  float* sH = (float*)smem;
  __syncthreads();
  const float m_start = wsf(p, WS_MST)[item];
  if (w == 0) {
    const float* g = wsf(p, WS_GATES) + (size_t)(ci.tok0 + lane) * 8;
    float ig = g[ci.h] + p.b_igate[l * 4 + ci.h];
    float lf = logsigmoid(g[4 + ci.h] + p.b_fgate[l * 4 + ci.h]);
    float bcs = lf;
#pragma unroll
    for (int o = 1; o < 64; o <<= 1) { float t = __shfl_up(bcs, o); if (lane >= o) bcs += t; }
    float u = ig - bcs;
    float cm = u;
#pragma unroll
    for (int o = 1; o < 64; o <<= 1) { float t = __shfl_up(cm, o); if (lane >= o) cm = fmaxf(cm, t); }
    float Mt = fmaxf(m_start, cm);
    su[lane] = u; sM[lane] = Mt; sa[lane] = __expf(m_start - Mt); sden[lane] = __expf(-(bcs + Mt));
  } else if (w == 1) {
    sn[lane] = wsf(p, WS_NU)[(size_t)item * 128 + lane];
    sn[lane + 64] = wsf(p, WS_NU)[(size_t)item * 128 + lane + 64];
  }
#pragma unroll
  for (int it = 0; it < 4; it++) {
    int id = tid + 256 * it; int s = id >> 4, ch = id & 15;
    uint4 v = *(const uint4*)(wsb(p, WS_BIG + B_P) + (size_t)(ci.tok0 + s) * INC + 1440 + ci.h * 128 + ch * 8);
    unsigned a[4] = {v.x, v.y, v.z, v.w};
#pragma unroll
    for (int j = 0; j < 4; j++) { sVt[(ch * 8 + 2 * j) * 72 + s] = (u16)(a[j] & 0xffffu); sVt[(ch * 8 + 2 * j + 1) * 72 + s] = (u16)(a[j] >> 16); }
  }
  {
    const int mc = tid & 31, mat = mc >> 4, chunk = mc & 15, rg = tid >> 5;
    u16* dst = mat ? sK : sQ;
    const float sc = mat ? 0.08838834764831845f : 1.f;
    conv_run(p, l, ci, mat, chunk, rg * 8, 8, [&](int t, const float (&y)[8]) {
      float x[8];
#pragma unroll
      for (int j = 0; j < 8; j++) x[j] = y[j] * sc;
      *(uint4*)(dst + t * 136 + chunk * 8) = pack8(x);
    });
  }
  __syncthreads();
  {
    const int tq = w >> 1, ts = w & 1;
    f32x16 s;
#pragma unroll
    for (int i = 0; i < 16; i++) s[i] = 0.f;
#pragma unroll
    for (int ks = 0; ks < 8; ks++) {
      bf16x8 a = *(const bf16x8*)(sQ + (tq * 32 + r) * 136 + ks * 16 + h * 8);
      bf16x8 b = *(const bf16x8*)(sK + (ts * 32 + r) * 136 + ks * 16 + h * 8);
      s = MFMA(a, b, s);
    }
    const int sidx = ts * 32 + r;
    const float us = su[sidx];
#pragma unroll
    for (int i = 0; i < 16; i++) {
      int t = tq * 32 + crow(i, h);
      float v = (sidx <= t) ? s[i] * __expf(us - sM[t]) : 0.f;
      sP[t * 72 + sidx] = f2bf(v);
    }
  }
  __syncthreads();
  if (tid < 64) {
    float rs = 0.f, qd = 0.f;
    const u16* pr = sP + tid * 72;
#pragma unroll 8
    for (int s = 0; s < 64; s++) rs += bf2f(pr[s]);
    const u16* qr = sQ + tid * 136;
#pragma unroll 8
    for (int d = 0; d < 128; d++) qd += bf2f(qr[d]) * sn[d];
    float qn = sa[tid] * qd + rs;
    sinv[tid] = __builtin_amdgcn_rcpf(fmaxf(fabsf(qn), sden[tid]));
  }
  const int tq = w & 1, eb = (w >> 1) * 2;
  f32x16 a1[2], a2[2];
#pragma unroll
  for (int et = 0; et < 2; et++)
#pragma unroll
    for (int i = 0; i < 16; i++) { a1[et][i] = 0.f; a2[et][i] = 0.f; }
  const u16* slot = wsb(p, WS_BIG + B_ST) + (size_t)item * 16384;
#pragma unroll
  for (int ks = 0; ks < 8; ks++) {
    bf16x8 a = *(const bf16x8*)(sQ + (tq * 32 + r) * 136 + ks * 16 + h * 8);
#pragma unroll
    for (int et = 0; et < 2; et++) {
      bf16x8 b = *(const bf16x8*)(slot + ((eb + et) * 32 + r) * 128 + ks * 16 + h * 8);
      a1[et] = MFMA(a, b, a1[et]);
    }
  }
#pragma unroll
  for (int ks = 0; ks < 4; ks++) {
    bf16x8 a = *(const bf16x8*)(sP + (tq * 32 + r) * 72 + ks * 16 + h * 8);
#pragma unroll
    for (int et = 0; et < 2; et++) {
      bf16x8 b = *(const bf16x8*)(sVt + ((eb + et) * 32 + r) * 72 + ks * 16 + h * 8);
      a2[et] = MFMA(a, b, a2[et]);
    }
  }
  __syncthreads();
#pragma unroll
  for (int et = 0; et < 2; et++)
#pragma unroll
    for (int i = 0; i < 16; i++) {
      int t = tq * 32 + crow(i, h);
      sH[t * 132 + (eb + et) * 32 + r] = (sa[t] * a1[et][i] + a2[et][i]) * sinv[t];
    }
  __syncthreads();
  {
    const int t = tid >> 2, part = tid & 3;
    const float* hr = sH + t * 132 + part * 32;
    float ss = 0.f;
#pragma unroll 8
    for (int j = 0; j < 32; j++) ss += hr[j] * hr[j];
    ss += __shfl_xor(ss, 1); ss += __shfl_xor(ss, 2);
    const float rr = rsqrtf(ss * (1.f / 128.f) + EPS);
    const int tok = ci.tok0 + t;
    const u16* og = wsb(p, WS_BIG + B_P) + (size_t)tok * INC + 1960 + ci.h * 128 + part * 32;
    const float* gm = p.g_mhead + (size_t)l * 512 + ci.h * 128 + part * 32;
    u16* o = actp(p) + (size_t)tok * LDA + 512 + ci.h * 128 + part * 32;
#pragma unroll
    for (int c8 = 0; c8 < 4; c8++) {
      float gv[8], x[8];
      unpack8(*(const uint4*)(og + c8 * 8), gv);
#pragma unroll
      for (int j = 0; j < 8; j++) x[j] = hr[c8 * 8 + j] * rr * gm[c8 * 8 + j] * __builtin_amdgcn_rcpf(1.f + __expf(-gv[j]));
      *(uint4*)(o + c8 * 8) = pack8(x);
    }
  }
}

DI void xkv_item(const Params& p, int l, int item, char* smem) {
  const int tid = tidx();
  const int kg = item & 3, hh = (item >> 2) & 3, bidx = item >> 4;
  u16* T = (u16*)smem;
  __syncthreads();
  const int key = tid >> 2, qt = tid & 3;
  const int mem = kg * 64 + key;
  const bool prompt = bidx < 2;
  float* kp; const float* vp;
  if (prompt) {
    kp = p.out + O_PMEMK + (((size_t)(l * 2 + bidx) * 256 + mem) * 4 + hh) * 256 + qt * 64;
    vp = p.out + O_PMEMV + (((size_t)(l * 2 + bidx) * 256 + mem) * 4 + hh) * 256 + qt * 64;
  } else {
    kp = (float*)(p.cache_mem_k + (((size_t)(l * 32 + bidx - 2) * 256 + mem) * 4 + hh) * 256 + qt * 64);
    vp = p.cache_mem_v + (((size_t)(l * 32 + bidx - 2) * 256 + mem) * 4 + hh) * 256 + qt * 64;
  }
  float rr = 1.f;
  if (prompt) {
    float ss = 0.f;
#pragma unroll 4
    for (int j = 0; j < 16; j++) { float4 v = *(const float4*)(kp + j * 4); ss += v.x * v.x + v.y * v.y + v.z * v.z + v.w * v.w; }
    ss += __shfl_xor(ss, 1); ss += __shfl_xor(ss, 2);
    rr = rsqrtf(ss * (1.f / 256.f) + EPS);
  }
  const float* gk = p.g_xk + l * 256 + qt * 64;
  const float* gq = p.g_xq + l * 256 + qt * 64;
  u16* xk = wsb(p, WS_BIG + B_XK) + ((size_t)(bidx * 4 + hh) * 256 + mem) * 256 + qt * 64;
#pragma unroll 2
  for (int c8 = 0; c8 < 8; c8++) {
    float4 a = *(const float4*)(kp + c8 * 8), b = *(const float4*)(kp + c8 * 8 + 4);
    float x[8] = {a.x, a.y, a.z, a.w, b.x, b.y, b.z, b.w};
    if (prompt) {
#pragma unroll
      for (int j = 0; j < 8; j++) x[j] = x[j] * rr * gk[c8 * 8 + j];
      *(float4*)(kp + c8 * 8) = make_float4(x[0], x[1], x[2], x[3]);
      *(float4*)(kp + c8 * 8 + 4) = make_float4(x[4], x[5], x[6], x[7]);
    }
#pragma unroll
    for (int j = 0; j < 8; j++) x[j] = x[j] * gq[c8 * 8 + j] * (0.0625f * LOG2E);
    *(uint4*)(xk + c8 * 8) = pack8(x);
    float4 va = *(const float4*)(vp + c8 * 8), vb = *(const float4*)(vp + c8 * 8 + 4);
    float y[8] = {va.x, va.y, va.z, va.w, vb.x, vb.y, vb.z, vb.w};
    *(uint4*)(T + key * 264 + qt * 64 + c8 * 8) = pack8(y);
  }
  __syncthreads();
  {
    const int e = tid;
    u16* xv = wsb(p, WS_BIG + B_XVT) + ((size_t)(bidx * 4 + hh) * 256 + e) * LDXV + kg * 64;
#pragma unroll 2
    for (int oct = 0; oct < 8; oct++) {
      uint4 v;
      const int kb = 16 * (oct >> 1) + 4 * (oct & 1);
      v.x = (unsigned)T[(kb + 0) * 264 + e] | ((unsigned)T[(kb + 1) * 264 + e] << 16);
      v.y = (unsigned)T[(kb + 2) * 264 + e] | ((unsigned)T[(kb + 3) * 264 + e] << 16);
      v.z = (unsigned)T[(kb + 8) * 264 + e] | ((unsigned)T[(kb + 9) * 264 + e] << 16);
      v.w = (unsigned)T[(kb + 10) * 264 + e] | ((unsigned)T[(kb + 11) * 264 + e] << 16);
      *(uint4*)(xv + oct * 8) = v;
    }
  }
}

DI void phase_C2(const Params& p, int l, char* smem) {
  for (int t = blockIdx.x; t < 544; t += gridDim.x) xkv_item(p, l, t, smem);
}
DI void phase_C1(const Params& p, int l, char* smem) {
  const int lane = tidx() & 63, w = tidx() >> 6;
  for (int t = blockIdx.x; t < NITEM; t += gridDim.x) mlstm_m1(p, l, t, smem);
  for (int t = blockIdx.x * 4 + w; t < NTOK + 32768; t += gridDim.x * 4) {
    if (t < NTOK) post_token(p, l, t, lane); else post_past(p, l, t - NTOK, lane);
  }
}

DI void phase_D(const Params& p, int l, char* smem) {
  const int n_scan = 256 + 4096;
  const int n_q = 544 * 4;
  const u16* W = wsb(p, WS_W) + (size_t)l * W_LAYER;
  for (int t = blockIdx.x; t < n_scan + n_q; t += gridDim.x) {
    if (t < n_scan) mlstm_m2(p, l, t, smem);
    else {
      int u = t - n_scan; int mt = u >> 2, nt = u & 3;
      EpiQ epi{wsb(p, WS_BIG + B_Q), wsf(p, WS_RQ), (const float2*)(p.ws + WS_ROPE), p.g_qnorm + l * 96};
      gemm_tile<1, 3>(wsb(p, WS_BIG + B_P), INC, W + W_Q, LDWQ, 256, mt * 64, nt * 192, smem, epi);
    }
  }
}

DI void phase_E(const Params& p, int l, char* smem) {
  for (int t = blockIdx.x; t < NITEM; t += gridDim.x) mlstm_m3(p, l, t, smem);
}

DI void phase_F(const Params& p, int l, char* smem) {
  const u16* W = wsb(p, WS_W) + (size_t)l * W_LAYER;
  for (int t = blockIdx.x; t < 528 * 8; t += gridDim.x) {
    int mt = t >> 3, nt = t & 7;
    EpiKV epi{wsb(p, WS_BIG + B_K), wsb(p, WS_BIG + B_VT), wsf(p, WS_KROPE), p.g_knorm + l * 96};
    gemm_tile<2, 2>(wsb(p, WS_CKV), 128, W + W_KV, LDWKV, 128, mt * 128, nt * 128, smem, epi);
  }
}

DI void phase_G(const Params& p, const Sched& sc, char* smem) {
  const int G = gridDim.x, j = blockIdx.x;
  const int lane = tidx() & 63, w = tidx() >> 6, r = lane & 31;
  const int NIT = 2048 + 256;
  const u16* qb = wsb(p, WS_BIG + B_Q);
  const u16* Kb = wsb(p, WS_BIG + B_K);
  const u16* Vt = wsb(p, WS_BIG + B_VT);
  u16* act = actp(p);
  auto run_prompt = [&](int bh, int bi) {
    int b = bh >> 3, hd = bh & 7;
    int tok = b * 16384 + bi * 128 + w * 32 + r;
    flash_item<96, 2, 64, true, false, true, true>(qb + (size_t)tok * 768 + hd * 96, true, 2 * bi + 2, 2 * bi + 1 + (w >> 1),
                                             Kb + ((size_t)hd * NROWS + b * 16384) * 96, 96, Vt + (size_t)hd * 64 * LDVT + b * 16384, LDVT, 0,
                                             act + (size_t)tok * LDA + hd * 64, smem);
  };
  auto run_sample = [&](int u) {
    int b = u >> 3, hd = u & 7;
    int tok = NP + b * 64 + (w & 1) * 32 + r;
    size_t row0 = (size_t)NP + b * 1088;
    flash_item<96, 2, 64, true, false, true, true>(qb + (size_t)tok * 768 + hd * 96, w < 2, 17, 17, Kb + ((size_t)hd * NROWS + row0) * 96, 96,
                                             Vt + (size_t)hd * 64 * LDVT + row0, LDVT, 0, act + (size_t)tok * LDA + hd * 64, smem);
  };
  if (sc.ok) {
    const int xg = sc.xg, xi = sc.xi;
    for (int pass = 0; pass < 2; pass++) {
      const int bh = xg + 8 * pass, b = bh >> 3, hd = bh & 7;
      const int bi = pass ? 63 - xi : xi;
      const int tok0 = b * 16384 + bi * 256 + w * 64;
      flash_item64(qb + (size_t)tok0 * 768 + hd * 96, 4 * bi + 4, 4 * bi + w + 1, Kb + ((size_t)hd * NROWS + b * 16384) * 96,
                   Vt + (size_t)hd * 64 * LDVT + b * 16384, act + (size_t)tok0 * LDA + hd * 64, smem);
    }
    if ((j & 1) == 0) run_sample(j >> 1);
  } else {
    for (int k = 0; k * G < NIT; k++) {
      int it = (k & 1) ? (k * G + (G - 1 - j)) : (k * G + j);
      if (it >= NIT) continue;
      if (it < 2048) run_prompt(it & 15, 127 - (it >> 4)); else run_sample(it - 2048);
    }
  }
}

DI void xattn_item(const u16* Qtile  , const u16* Kbase, const u16* Vtbase, u16* Otile, char* smem) {
  constexpr int LDQ = 264, LDV = 40;
  u16* sQ = (u16*)smem;
  u16* sK = sQ + 64 * LDQ;
  u16* sV = sK + 32 * LDQ;
  const int tid = tidx(), lane = tid & 63, w = tid >> 6, r = lane & 31, h = lane >> 5;
  const int qrow = 32 * (w & 1) + r, e0 = 128 * (w >> 1);
  u32x4 rk[4], rv[4];
  auto gload = [&](int t) {
#pragma unroll
    for (int i = 0; i < 4; i++) {
      int id = tid + 256 * i;
      rk[i] = *(const u32x4*)(Kbase + (long)(t * 32 + (id >> 5)) * 256 + (id & 31) * 8);
      rv[i] = *(const u32x4*)(Vtbase + (long)(id >> 2) * LDXV + t * 32 + (id & 3) * 8);
    }
  };
  auto sstore = [&]() {
#pragma unroll
    for (int i = 0; i < 4; i++) {
      int id = tid + 256 * i;
      *(u32x4*)(sK + (id >> 5) * LDQ + (id & 31) * 8) = rk[i];
      *(u32x4*)(sV + (id >> 2) * LDV + (id & 3) * 8) = rv[i];
    }
  };
  __syncthreads();
  gload(0);
#pragma unroll
  for (int i = 0; i < 8; i++) {
    int id = tid + 256 * i;
    *(u32x4*)(sQ + (id >> 5) * LDQ + (id & 31) * 8) = *(const u32x4*)(Qtile + (long)(id >> 5) * LDA + (id & 31) * 8);
  }
  sstore();
  __syncthreads();
  float rqs;
  {
    float ss = 0.f;
#pragma unroll
    for (int ks = 0; ks < 16; ks++) {
      bf16x8 qq = *(const bf16x8*)(sQ + qrow * LDQ + ks * 16 + h * 8);
#pragma unroll
      for (int j = 0; j < 8; j++) { float v = bf2f((u16)qq[j]); ss += v * v; }
    }
    ss = xhalf_sum(ss);
    rqs = rsqrtf(ss * (1.f / 256.f) + EPS);
  }
  const float rqinv = __builtin_amdgcn_rcpf(rqs);
  f32x16 o[4];
#pragma unroll
  for (int et = 0; et < 4; et++)
#pragma unroll
    for (int i = 0; i < 16; i++) o[et][i] = 0.f;
  float mrun = 0.f, lrun = 0.f;
  for (int t = 0; t < 8; t++) {
    if (t + 1 < 8) gload(t + 1);
    __builtin_amdgcn_sched_barrier(0);
    __builtin_amdgcn_s_setprio(1);
    {
      f32x16 s;
      const float sinit = -mrun * rqinv;
#pragma unroll
      for (int i = 0; i < 16; i++) s[i] = sinit;
#pragma unroll
      for (int ks = 0; ks < 16; ks++) {
        bf16x8 a = *(const bf16x8*)(sK + r * LDQ + ks * 16 + h * 8);
        bf16x8 b = *(const bf16x8*)(sQ + qrow * LDQ + ks * 16 + h * 8);
        s = MFMA(a, b, s);
      }
      float mx = -1e30f;
#pragma unroll
      for (int i = 0; i < 16; i++) { s[i] *= rqs; mx = fmaxf(mx, s[i]); }
      mx = xhalf_max(mx);
      if (__any(mx > 8.f)) {
        const float d = fmaxf(mx, 0.f);
        const float alpha = __builtin_amdgcn_exp2f(-d);
        mrun += d;
        lrun *= alpha;
#pragma unroll
        for (int et = 0; et < 4; et++)
#pragma unroll
          for (int i = 0; i < 16; i++) o[et][i] *= alpha;
#pragma unroll
        for (int i = 0; i < 16; i++) s[i] -= d;
      }
      float psum = 0.f;
#pragma unroll
      for (int i = 0; i < 16; i++) { float pv = __builtin_amdgcn_exp2f(s[i]); s[i] = pv; psum += pv; }
      lrun += psum;
#pragma unroll
      for (int st = 0; st < 2; st++) {
        uint4 pp;
        pp.x = pk2(s[8 * st + 0], s[8 * st + 1]); pp.y = pk2(s[8 * st + 2], s[8 * st + 3]);
        pp.z = pk2(s[8 * st + 4], s[8 * st + 5]); pp.w = pk2(s[8 * st + 6], s[8 * st + 7]);
        bf16x8 pb = __builtin_bit_cast(bf16x8, pp);
#pragma unroll
        for (int et = 0; et < 4; et++) {
          bf16x8 a = *(const bf16x8*)(sV + (e0 + et * 32 + r) * LDV + st * 16 + 8 * h);
          o[et] = MFMA(a, pb, o[et]);
        }
      }
    }
    __builtin_amdgcn_s_setprio(0);
    __builtin_amdgcn_sched_barrier(0);
    __syncthreads();
    if (t + 1 < 8) { sstore(); __syncthreads(); }
  }
  {
    float lt = xhalf_sum(lrun);
    float inv = __builtin_amdgcn_rcpf(lt);
    u16* Orow = Otile + (long)qrow * LDA + e0;
#pragma unroll
    for (int et = 0; et < 4; et++)
#pragma unroll
      for (int g = 0; g < 4; g++) {
        uint2 v;
        v.x = pk2(o[et][4 * g + 0] * inv, o[et][4 * g + 1] * inv);
        v.y = pk2(o[et][4 * g + 2] * inv, o[et][4 * g + 3] * inv);
        *(uint2*)(Orow + et * 32 + 8 * g + 4 * h) = v;
      }
  }
}

DI void phase_K(const Params& p, char* smem) {
  const int lane = tidx() & 63, w = tidx() >> 6, r = lane & 31;
  const u16* qx = wsb(p, WS_BIG + B_QX);
  u16* act = actp(p);
  for (int t = blockIdx.x; t < 2176; t += gridDim.x) {
    int bidx, hh, tok0;
    if (t < 2048) { bidx = t >> 10; hh = (t >> 8) & 3; tok0 = bidx * 16384 + (t & 255) * 64; }
    else { int u = t - 2048; bidx = 2 + (u >> 2); hh = u & 3; tok0 = NP + (u >> 2) * 64; }
    const u16* Kb = wsb(p, WS_BIG + B_XK) + (size_t)(bidx * 4 + hh) * 65536;
    const u16* Vt = wsb(p, WS_BIG + B_XVT) + (size_t)(bidx * 4 + hh) * 256 * LDXV;
    xattn_item(qx + (size_t)tok0 * LDA + hh * 256, Kb, Vt, act + (size_t)tok0 * LDA + hh * 256, smem);
  }
  (void)lane; (void)w; (void)r;
}

template <class Epi>
DI void phase_gemm128(const Sched& sc, const u16* A, long lda, const u16* Bt, long ldb, int K, int MT, int NT, int SN, char* smem, const Epi& epi) {
  if (sc.ok) {
    const int xg = sc.xg, xi = sc.xi;
    const int SM = 64 / SN;
    const int sng = NT / SN, smg = MT / SM;
    const int nst = smg * sng;
    const int left = nst & 7;
    const int nfull = (left > 0 && left <= 4) ? nst - left : nst;
    for (int st = xg; st < nfull; st += 8) {
      int sm = st / sng, sn = st % sng;
      int mt = sm * SM + xi / SN, nt = sn * SN + xi % SN;
      gemm_tile<2, 2>(A, lda, Bt, ldb, K, mt * 128, nt * 128, smem, epi);
    }
    if (nfull < nst) {
      const int q = xg * 64 + xi;
      if (q < left * 128) {
        const int tile = q >> 1, half = q & 1;
        const int st = nfull + (tile >> 6), t64 = tile & 63;
        int sm = st / sng, sn = st % sng;
        int mt = sm * SM + t64 / SN, nt = sn * SN + t64 % SN;
        gemm_tile<1, 2>(A, lda, Bt, ldb, K, mt * 128 + half * 64, nt * 128, smem, epi);
      }
    }
  } else {
    for (int t = blockIdx.x; t < MT * NT; t += gridDim.x) {
      int mt = t / NT, nt = t % NT;
      gemm_tile<2, 2>(A, lda, Bt, ldb, K, mt * 128, nt * 128, smem, epi);
    }
  }
}

#if defined(__HIP_DEVICE_COMPILE__)
typedef const __attribute__((address_space(4))) Params* KargPtr;
#define KARG_LOAD KargPtr pp4 = (KargPtr)__builtin_amdgcn_kernarg_segment_ptr(); asm volatile("" : "+s"(pp4)); const Params p = *pp4;
#else
#define KARG_LOAD const Params p{};
#endif
template <int L>
DI void run_layer(const Sched& sc, int ph_begin, int ph_end, char* smem, const XcdBarrier& xb) {
  const int base = 1 + 15 * L;
#define RUN_PHASE(S, ...)  RUN_PHASE_R(S, 1, __VA_ARGS__)
#define RUN_PHASE_R(S, R, ...)                                    \
  {                                                          \
    const int ph = base + (S);                               \
    if (ph >= ph_begin && ph < ph_end) {                     \
      for (int rep_ = 0; rep_ < (R); rep_++) {               \
        KARG_LOAD                                            \
        const u16* W = wsb(p, WS_W) + (size_t)L * W_LAYER;   \
        const float* xs0 = (L == 0) ? p.x_prompt : p.out;    \
        const float* xs1 = (L == 0) ? p.x_sample : p.out + (size_t)NP * 1024; \
        (void)W; (void)xs0; (void)xs1;                       \
        __VA_ARGS__;                                         \
        if (ph + 1 < ph_end) xcd_barrier(xb);                \
      }                                                      \
    }                                                        \
  }
  if (L > 0) RUN_PHASE(0, phase_norm(p, L))
  RUN_PHASE_R(1, REP_INPROJ, phase_inproj(p, sc, L, smem))
  RUN_PHASE_R(2, REP_C, { phase_C1(p, L, smem); phase_C2(p, L, smem); })
  RUN_PHASE(3, phase_D(p, L, smem))
  RUN_PHASE_R(4, REP_E, phase_E(p, L, smem))
  RUN_PHASE_R(5, REP_F, phase_F(p, L, smem))
  RUN_PHASE_R(6, REP_G, phase_G(p, sc, smem))
  RUN_PHASE(7, { EpiRes epi{xs0, xs1, (L == 0) ? (const u16*)nullptr : (const u16*)xres(p), xres(p), nullptr}; phase_gemm128(sc, actp(p), LDA, W + W_OUT, LDW, 1024, 272, 8, 8, smem, epi); })
  RUN_PHASE_R(8, REP_NORM, phase_norm(p, 1))
  RUN_PHASE(9, { EpiStoreBf16 epi{wsb(p, WS_BIG + B_QX), LDA, 1024, nullptr}; phase_gemm128(sc, actp(p), LDA, W + W_XQ, LDW, 1024, 272, 8, 8, smem, epi); })
  RUN_PHASE_R(10, REP_K, phase_K(p, smem))
  RUN_PHASE(11, { EpiRes epi{nullptr, nullptr, xres(p), xres(p), nullptr}; phase_gemm128(sc, actp(p), LDA, W + W_XO, LDW, 1024, 272, 8, 8, smem, epi); })
  RUN_PHASE(12, phase_norm(p, 1))
  RUN_PHASE_R(13, REP_FF1, { EpiRelu2 epi{wsb(p, WS_BIG + B_H1), LDH1}; phase_gemm128(sc, actp(p), LDA, W + W_FF1, LDW, 1024, 272, 32, 16, smem, epi); })
  RUN_PHASE(14, { EpiRes epi{nullptr, nullptr, xres(p), xres(p), (L == 1) ? p.out : (float*)nullptr}; phase_gemm128(sc, wsb(p, WS_BIG + B_H1), LDH1, W + W_FF2, LDW2, 4096, 272, 8, 8, smem, epi); })
#undef RUN_PHASE
#undef RUN_PHASE_R
}

__global__ void __launch_bounds__(256, 2) fwd_megakernel(Params p, int ph_begin, int ph_end) {
  __shared__ __attribute__((aligned(16))) char smem[SMEM_BYTES];
  cg::grid_group grid = cg::this_grid();
  __shared__ int s_rank;
  __shared__ __attribute__((aligned(16))) unsigned xb_words[4];
  if (tidx() < 4) xb_words[tidx()] = 0u;
  __syncthreads();
  const XcdBarrier xb = xcd_barrier_post((unsigned*)(p.ws + WS_BAR), (volatile LAS unsigned*)&xb_words);
  Sched sc;
  sc.xg = (int)((unsigned)__builtin_amdgcn_s_getreg((3 << 11) | 20) & 7u);
  unsigned* cnt = (unsigned*)(p.ws + WS_CNT);
  if (tidx() == 0) s_rank = (int)atomicAdd(&cnt[sc.xg], 1u);
  __syncthreads();
  sc.xi = __builtin_amdgcn_readfirstlane(s_rank);
  sc.ok = 0;
  if (ph_begin <= 0 && 0 < ph_end) {
    phase_prep(p, smem);
    if (ph_end < 0) grid.sync();
    if (1 < ph_end) xcd_barrier(xb);
  }
  {
    int ok = (gridDim.x == 512);
#pragma unroll
    for (int i = 0; i < 8; i++) ok &= (__atomic_load_n(&cnt[i], __ATOMIC_RELAXED) == 64u);
    sc.ok = ok;
  }
  run_layer<0>(sc, ph_begin, ph_end, smem, xb);
  run_layer<1>(sc, ph_begin, ph_end, smem, xb);
}

extern "C" void kernel_launch(void* const* d_in, const int* in_sizes, int n_in, void* d_out, int out_size, void* d_ws, size_t ws_size,
                              hipStream_t stream) {
  static int grid_blocks = 0;
  if (!grid_blocks) {
    int dev = 0, cus = 0, per_cu = 0;
    (void)hipGetDevice(&dev);
    (void)hipDeviceGetAttribute(&cus, hipDeviceAttributeMultiprocessorCount, dev);
    (void)hipOccupancyMaxActiveBlocksPerMultiprocessor(&per_cu, fwd_megakernel, 256, 0);
    per_cu = 2;
    grid_blocks = cus * per_cu;
  }
  Params p{};
  const float** pp = (const float**)&p;
  for (int i = 0; i < 36; i++) pp[i] = (const float*)d_in[i];
  p.out = (float*)d_out;
  p.ws = (char*)d_ws;
  int ph_begin = 0, ph_end = 31;
  (void)hipMemsetAsync((char*)d_ws + WS_CNT, 0, 256 + 16384, stream);
  void* args[] = {&p, &ph_begin, &ph_end};
  hipError_t e = hipLaunchCooperativeKernel((void*)fwd_megakernel, dim3(grid_blocks), dim3(256), args, 0, stream);
  if (e != hipSuccess) fprintf(stderr, "cooperative launch failed: %s (grid %d)\n", hipGetErrorString(e), grid_blocks);
}
```
